# Optimizing an MI355X kernel written in HIP

```python
import jax, jax.numpy as jnp
from jax import lax
import numpy as np

D_MODEL = 1024
BATCH = 8
SEQ = 2048
DEPTH = 2

N_A_LAYERS = DEPTH // 2
N_B_LAYERS = DEPTH - N_A_LAYERS
EPS = 1e-6

GLA_HEADS = 4
GLA_QK_TOT = D_MODEL // 2
GLA_V_TOT = D_MODEL
GLA_DK = GLA_QK_TOT // GLA_HEADS
GLA_DV = GLA_V_TOT // GLA_HEADS
GLA_GATE_RANK = 16
GLA_TAU = 16.0
GLA_CHUNK = 64
GLA_SPLITS = [GLA_QK_TOT, 2 * GLA_QK_TOT, 2 * GLA_QK_TOT + GLA_V_TOT, 2 * GLA_QK_TOT + 2 * GLA_V_TOT]
GLA_IN_TOT = 2 * GLA_QK_TOT + 2 * GLA_V_TOT + GLA_GATE_RANK

FOX_HD = 64
FOX_HEADS = D_MODEL // FOX_HD
FOX_BLOCK = 128
KV_SPLITS = [D_MODEL, 2 * D_MODEL]
KV_TOT = 2 * D_MODEL + FOX_HEADS

PEER_HEADS = 8
PEER_KEYS = 128
PEER_N = PEER_KEYS * PEER_KEYS
PEER_TOPK = 16
PEER_DHALF = 128
PEER_DQ = 2 * PEER_DHALF
PEER_CHUNK = 128

kernel_name = "yoco_gla_fox_peer_hybrid"


def rmsnorm(x, g):
    xf = x.astype(jnp.float32)
    y = xf * lax.rsqrt(jnp.mean(xf * xf, axis=-1, keepdims=True) + EPS)
    return (y * g.astype(jnp.float32)).astype(x.dtype)


def gla_mixer(xn, w_in, w_g2, b_g, g_o, w_o):
    B, S, _ = xn.shape
    C = GLA_CHUNK
    p = jnp.einsum('bsd,de->bse', xn, w_in).astype(jnp.float32)
    q, k, v, r, glr = jnp.split(p, GLA_SPLITS, axis=-1)
    log_a = jax.nn.log_sigmoid(glr @ w_g2.astype(jnp.float32) + b_g.astype(jnp.float32)) / GLA_TAU

    def heads(t, d):
        return t.reshape(B, S // C, C, GLA_HEADS, d).transpose(1, 0, 3, 2, 4)

    qh = heads(q * (GLA_DK ** -0.5), GLA_DK)
    kh = heads(k, GLA_DK)
    vh = heads(v, GLA_DV)
    lah = heads(log_a, GLA_DK)
    causal = jnp.tril(jnp.ones((C, C), dtype=bool))

    def step(state, inp):
        qc, kc, vc, lac = inp
        bcum = jnp.cumsum(lac, axis=2)
        o_inter = jnp.einsum('bhik,bhkv->bhiv', qc * jnp.exp(bcum), state)
        diff = bcum[:, :, :, None, :] - bcum[:, :, None, :, :]
        diff = jnp.where(causal[:, :, None], diff, -jnp.inf)
        attn = jnp.einsum('bhik,bhjk,bhijk->bhij', qc, kc, jnp.exp(diff))
        o_intra = jnp.einsum('bhij,bhjv->bhiv', attn, vc)
        b_last = bcum[:, :, -1:, :]
        k_dec = kc * jnp.exp(b_last - bcum)
        state = state * jnp.exp(b_last[:, :, 0, :, None]) + jnp.einsum('bhjk,bhjv->bhkv', k_dec, vc)
        return state, o_inter + o_intra

    state0 = jnp.zeros((B, GLA_HEADS, GLA_DK, GLA_DV), jnp.float32)
    _, o = lax.scan(step, state0, (qh, kh, vh, lah))
    o = o.transpose(1, 0, 3, 2, 4).reshape(B, S, GLA_HEADS, GLA_DV)
    o = o * lax.rsqrt(jnp.mean(o * o, axis=-1, keepdims=True) + EPS)
    o = o * g_o.astype(jnp.float32).reshape(GLA_HEADS, GLA_DV)
    o = o.reshape(B, S, GLA_V_TOT) * jax.nn.silu(r)
    return jnp.einsum('bse,ed->bsd', o.astype(xn.dtype), w_o)


def shared_kv(h, g_kv, w_kv, b_f):
    B, S, _ = h.shape
    hn = rmsnorm(h, g_kv)
    p = jnp.einsum('bsd,de->bse', hn, w_kv)
    k, v, fl = jnp.split(p, KV_SPLITS, axis=-1)
    k = k.reshape(B, S, FOX_HEADS, FOX_HD).transpose(0, 2, 1, 3).astype(jnp.float32)
    v = v.reshape(B, S, FOX_HEADS, FOX_HD).transpose(0, 2, 1, 3).astype(jnp.float32)
    log_f = jax.nn.log_sigmoid(fl.astype(jnp.float32) + b_f.astype(jnp.float32))
    c = jnp.cumsum(log_f, axis=1).transpose(0, 2, 1)
    return k, v, c


def fox_mixer(hn, w_q, w_o, k, v, c):
    B, S, _ = hn.shape
    q = jnp.einsum('bsd,de->bse', hn, w_q).astype(jnp.float32)
    q = q.reshape(B, S, FOX_HEADS, FOX_HD).transpose(0, 2, 1, 3) * (FOX_HD ** -0.5)
    outs = []
    for blk in range(S // FOX_BLOCK):
        lo, hi = blk * FOX_BLOCK, (blk + 1) * FOX_BLOCK
        logits = jnp.einsum('bhqd,bhkd->bhqk', q[:, :, lo:hi], k[:, :, :hi])
        logits = logits + c[:, :, lo:hi, None] - c[:, :, None, :hi]
        mask = jnp.arange(lo, hi)[:, None] >= jnp.arange(hi)[None, :]
        probs = jax.nn.softmax(jnp.where(mask, logits, -jnp.inf), axis=-1)
        outs.append(jnp.einsum('bhqk,bhkd->bhqd', probs, v[:, :, :hi]))
    o = jnp.concatenate(outs, axis=2)
    o = o.transpose(0, 2, 1, 3).reshape(B, S, D_MODEL).astype(hn.dtype)
    return jnp.einsum('bse,ed->bsd', o, w_o)


def peer_ffn(xn, w_pq, sub_keys, u_tab, v_tab):
    B, S, D = xn.shape
    T = B * S
    xt = xn.reshape(T, D)
    q = jnp.einsum('td,de->te', xt, w_pq).reshape(T, PEER_HEADS, 2, PEER_DHALF)
    s = jnp.einsum('thcd,hcnd->thcn', q, sub_keys)
    s_top, i_top = lax.top_k(s, PEER_TOPK)
    cand = s_top[:, :, 0, :, None] + s_top[:, :, 1, None, :]
    cand_idx = i_top[:, :, 0, :, None] * PEER_KEYS + i_top[:, :, 1, None, :]
    best, pos = lax.top_k(cand.reshape(T, PEER_HEADS, PEER_TOPK * PEER_TOPK), PEER_TOPK)
    ids = jnp.take_along_axis(cand_idx.reshape(T, PEER_HEADS, PEER_TOPK * PEER_TOPK), pos, axis=-1)
    gates = jax.nn.softmax(best.astype(jnp.float32), axis=-1).astype(xn.dtype)
    n_chunks = T // PEER_CHUNK

    def expert_chunk(args):
        xc, idc, gc = args
        u = jnp.take(u_tab, idc, axis=0)
        a = jax.nn.gelu(jnp.einsum('cd,chkd->chk', xc, u), approximate=False)
        vv = jnp.take(v_tab, idc, axis=0)
        return jnp.einsum('chk,chkd->cd', gc * a, vv)

    out = lax.map(expert_chunk, (xt.reshape(n_chunks, PEER_CHUNK, D),
                                 ids.reshape(n_chunks, PEER_CHUNK, PEER_HEADS, PEER_TOPK),
                                 gates.reshape(n_chunks, PEER_CHUNK, PEER_HEADS, PEER_TOPK)))
    return out.reshape(B, S, D)


def setup_inputs(seed: int = 0) -> dict:
    key = jax.random.key(seed)
    ks = jax.random.split(key, 20)
    f32 = jnp.float32
    D = D_MODEL
    nrm = lambda k, shp, sc: jax.random.normal(k, shp, f32) * sc
    return {
        'x': nrm(ks[0], (BATCH, SEQ, D), 1.0),
        'norm_mix': 1.0 + nrm(ks[1], (DEPTH, D), 0.02),
        'norm_ffn': 1.0 + nrm(ks[2], (DEPTH, D), 0.02),
        'gla_w_in': nrm(ks[3], (N_A_LAYERS, D, GLA_IN_TOT), D ** -0.5),
        'gla_w_g2': nrm(ks[4], (N_A_LAYERS, GLA_GATE_RANK, GLA_QK_TOT), GLA_GATE_RANK ** -0.5),
        'gla_b_g': nrm(ks[5], (N_A_LAYERS, GLA_QK_TOT), 0.5),
        'gla_norm_o': 1.0 + nrm(ks[6], (N_A_LAYERS, GLA_V_TOT), 0.02),
        'gla_w_o': nrm(ks[7], (N_A_LAYERS, GLA_V_TOT, D), 0.5 * GLA_V_TOT ** -0.5),
        'kv_norm': 1.0 + nrm(ks[8], (D,), 0.02),
        'kv_w': nrm(ks[9], (D, KV_TOT), D ** -0.5),
        'fox_b_f': jax.random.uniform(ks[10], (FOX_HEADS,), f32, 1.0, 4.0),
        'fox_w_q': nrm(ks[11], (N_B_LAYERS, D, D), D ** -0.5),
        'fox_w_o': nrm(ks[12], (N_B_LAYERS, D, D), 0.5 * D ** -0.5),
        'peer_w_q': nrm(ks[13], (DEPTH, D, PEER_HEADS * PEER_DQ), D ** -0.5),
        'peer_sub_keys': nrm(ks[14], (DEPTH, PEER_HEADS, 2, PEER_KEYS, PEER_DHALF), PEER_DHALF ** -0.5),
        'peer_u': nrm(ks[15], (DEPTH, PEER_N, D), D ** -0.5),
        'peer_v': nrm(ks[16], (DEPTH, PEER_N, D), PEER_HEADS ** -0.5),
        'norm_final': 1.0 + nrm(ks[17], (D,), 0.02),
    }


def reference(x, norm_mix, norm_ffn, gla_w_in, gla_w_g2, gla_b_g, gla_norm_o, gla_w_o,
              kv_norm, kv_w, fox_b_f, fox_w_q, fox_w_o,
              peer_w_q, peer_sub_keys, peer_u, peer_v, norm_final):
    h = x
    k_sh = v_sh = c_sh = None
    for layer in range(DEPTH):
        hn = rmsnorm(h, norm_mix[layer])
        if layer < N_A_LAYERS:
            h = h + gla_mixer(hn, gla_w_in[layer], gla_w_g2[layer], gla_b_g[layer],
                              gla_norm_o[layer], gla_w_o[layer])
        else:
            if layer == N_A_LAYERS:
                k_sh, v_sh, c_sh = shared_kv(h, kv_norm, kv_w, fox_b_f)
            j = layer - N_A_LAYERS
            hn_q = hn
            h = h + fox_mixer(hn_q, fox_w_q[j], fox_w_o[j], k_sh, v_sh, c_sh)
        h = h + peer_ffn(rmsnorm(h, norm_ffn[layer]), peer_w_q[layer], peer_sub_keys[layer],
                         peer_u[layer], peer_v[layer])
    return rmsnorm(h, norm_final)
```

```cpp
#define MK_PER_PHASE 1
#include <hip/hip_runtime.h>
#include <cstdio>
#include <cstdint>
namespace pg8 {
#define PG8_LAS __attribute__((address_space(3)))
typedef unsigned short bf16_t;
typedef short bf16x8 __attribute__((ext_vector_type(8)));
typedef float f32x4 __attribute__((ext_vector_type(4)));
typedef unsigned u32x4 __attribute__((ext_vector_type(4)));
constexpr int BM = 256, BK = 64, HALF = 128, HTB = HALF * BK * 2  , STAGE_BYTES = 8 * HTB, NXCD = 8, WGM = 8;

__host__ __device__ __forceinline__ int lds_byte(int r, int c) { const int st = (r >> 4) * 2 + (c >> 5), rr = r & 15, cc = c & 31, ob = rr * 64 + cc * 2; return st * 1024 + (ob ^ (((ob >> 9) & 1) << 5)); }
__host__ __device__ __forceinline__ void stage_rc(int b, int& R, int& C) { const int st = b / 1024, sb = b % 1024, swz = sb ^ (((sb >> 9) & 1) << 5); R = (st >> 1) * 16 + swz / 64; C = (st & 1) * 32 + (swz % 64) / 2; }
__host__ __device__ __forceinline__ int perm32(int rho) { const int n = rho >> 4, i = rho & 15; return 8 * (i >> 2) + 4 * n + (i & 3); }

struct Unit { int pm, pn; };
struct Gemm { const bf16_t* A; const bf16_t* Bt; int M, N, K; };

struct StaticOrder {
    int nM, nN, nwg, G, c;
    __host__ __device__ void init(int M, int N, int G_, int c_) { nM = M / BM; nN = N / BM; nwg = nM * nN; G = G_; c = c_; }
    __host__ __device__ bool next(int i, Unit& u) const {
        const long L = (long)i * G + c; if (L >= nwg) return false;
        int wgid = (int)L; { const int q = nwg / NXCD, r = nwg % NXCD, xcd = wgid % NXCD, off = wgid / NXCD; wgid = (xcd < r ? xcd * (q + 1) : r * (q + 1) + (xcd - r) * q) + off; }
        const int nig = WGM * nN, gid = wgid / nig, fm = gid * WGM, gsz = (nM - fm) < WGM ? (nM - fm) : WGM;
        u.pm = fm + ((wgid % nig) % gsz); u.pn = (wgid % nig) / gsz; return true;
    }
    __device__ __forceinline__ void a_ready(const Unit&) const {}
    __device__ __forceinline__ void done(const Unit&) const {}
};

__device__ __forceinline__ unsigned cvt_pk_bf16(float lo, float hi) { unsigned r; asm volatile("v_cvt_pk_bf16_f32 %0, %1, %2" : "=v"(r) : "v"(lo), "v"(hi)); return r; }
typedef unsigned u32x2 __attribute__((ext_vector_type(2)));
constexpr float RMS_EPS = 1e-6f;
__device__ __forceinline__ float row_rstd(const float* rowpart, int row) {
    const f32x4* p = (const f32x4*)(rowpart + (size_t)row * 16);
    const f32x4 a = p[0], b = p[1], c = p[2], d = p[3];
    const float s = (((a[0] + a[1]) + (a[2] + a[3])) + ((b[0] + b[1]) + (b[2] + b[3]))) + (((c[0] + c[1]) + (c[2] + c[3])) + ((d[0] + d[1]) + (d[2] + d[3])));
    return 1.0f / sqrtf(s * (1.0f / 1024.0f) + RMS_EPS);
}
struct EpiBf16RS {
    static constexpr bool PERM = true, AFTER_DRAIN = false;
    bf16_t* O; int ldc; int split_cols; size_t split_stride; float scale0; const float* rowpart;
    __device__ __forceinline__ void operator()(const f32x4 (&acc)[2][2][4][2], const Unit& u, int wr, int wc, int fr, int fq) const {
        const int row0 = u.pm * BM + wr * 64 + fr; int colt = u.pn * BM; bf16_t* base = O;
        float sc = 1.f; if (split_cols) { const int t = colt / split_cols; base += (size_t)t * split_stride; colt -= t * split_cols; if (t == 0) sc = scale0; }
        const int col0 = colt + wc * 32 + 8 * fq;
#pragma unroll
        for (int ai = 0; ai < 2; ++ai)
#pragma unroll
            for (int m = 0; m < 4; ++m) { const int row = row0 + ai * HALF + m * 16; const float rs = rowpart ? sc * row_rstd(rowpart, row) : sc;
                bf16_t* rowp = base + (size_t)row * ldc + col0;
#pragma unroll
                for (int bj = 0; bj < 2; ++bj) { const f32x4 v0 = acc[ai][bj][m][0] * rs, v1 = acc[ai][bj][m][1] * rs;
                    u32x4 w; w.x = cvt_pk_bf16(v0[0], v0[1]); w.y = cvt_pk_bf16(v0[2], v0[3]); w.z = cvt_pk_bf16(v1[0], v1[1]); w.w = cvt_pk_bf16(v1[2], v1[3]);
                    *(u32x4*)(rowp + bj * HALF) = w; } }
    }
};
struct EpiF32RS {
    static constexpr bool PERM = false, AFTER_DRAIN = false;
    float* C; int ldc; const float* rowpart;
    __device__ __forceinline__ void operator()(const f32x4 (&acc)[2][2][4][2], const Unit& u, int wr, int wc, int fr, int fq) const {
        const int row0 = u.pm * BM + wr * 64 + fr, col0 = u.pn * BM + wc * 32 + 4 * fq;
#pragma unroll
        for (int ai = 0; ai < 2; ++ai)
#pragma unroll
            for (int m = 0; m < 4; ++m) { const int row = row0 + ai * HALF + m * 16; const float rs = row_rstd(rowpart, row);
                float* rowp = C + (size_t)row * ldc + col0;
#pragma unroll
                for (int bj = 0; bj < 2; ++bj)
#pragma unroll
                    for (int n = 0; n < 2; ++n) *(f32x4*)(rowp + bj * HALF + n * 16) = acc[ai][bj][m][n] * rs; }
    }
};
struct EpiResid {
    static constexpr bool PERM = false, AFTER_DRAIN = false;
    const float* base; float* out; bf16_t* hb; float* rowpart; int ldc;
    __device__ __forceinline__ void operator()(const f32x4 (&acc)[2][2][4][2], const Unit& u, int wr, int wc, int fr, int fq) const {
        const int row0 = u.pm * BM + wr * 64 + fr, col0 = u.pn * BM + wc * 32 + 4 * fq;
#pragma unroll
        for (int ai = 0; ai < 2; ++ai)
#pragma unroll
            for (int m = 0; m < 4; ++m) { const int row = row0 + ai * HALF + m * 16; const size_t off = (size_t)row * ldc + col0; float ss = 0.f;
#pragma unroll
                for (int bj = 0; bj < 2; ++bj)
#pragma unroll
                    for (int n = 0; n < 2; ++n) { const f32x4 b = *(const f32x4*)(base + off + bj * HALF + n * 16); const f32x4 v = b + acc[ai][bj][m][n];
                        *(f32x4*)(out + off + bj * HALF + n * 16) = v; ss += (v[0] * v[0] + v[1] * v[1]) + (v[2] * v[2] + v[3] * v[3]);
                        u32x2 w; w.x = cvt_pk_bf16(v[0], v[1]); w.y = cvt_pk_bf16(v[2], v[3]); *(u32x2*)(hb + off + bj * HALF + n * 16) = w; }
                ss += __shfl_xor(ss, 16); ss += __shfl_xor(ss, 32);
                if (fq == 0) rowpart[(size_t)row * 16 + u.pn * 4 + wc] = ss; }
    }
};

template <class Epi, class Sched, bool ALIGN_EPI = false, bool SP2 = false>
__device__ __forceinline__ void gemm_phase(PG8_LAS unsigned char* lds, const Gemm g, const Sched& S, const Epi& E) {
    const int tid = threadIdx.x, wid = __builtin_amdgcn_readfirstlane(tid >> 6), lane = tid & 63, wr = wid >> 2, wc = wid & 3, fr = lane & 15, fq = lane >> 4;
    const int K = g.K, nt = K / BK;
    unsigned voffA[2], voffB[2];
#pragma unroll
    for (int i = 0; i < 2; ++i) { int R, C; stage_rc(tid * 16 + i * 8192, R, C); const int Rb = Epi::PERM ? ((R & ~31) + perm32(R & 31)) : R;
        voffA[i] = (unsigned)(R * K + C) * 2u; voffB[i] = (unsigned)(Rb * K + C) * 2u; }
    const size_t kstep = (size_t)(BK * 2);
    const size_t hstep = (size_t)HALF * K * 2;
    const size_t tstep = 2 * hstep;
    const unsigned ldsw = (unsigned)wid * 1024u;
    const int aoff = lds_byte(wr * 64 + fr, fq * 8), boff = lds_byte(wc * 32 + fr, fq * 8);
#define PG8_SA(b, h) (((b) * 2 + (h)) * HTB)
#define PG8_SB(b, h) ((4 + (b) * 2 + (h)) * HTB)
#define PG8_STAGE(bufoff, gbase, voff) do { _Pragma("unroll") for (int _i = 0; _i < 2; ++_i) \
        __builtin_amdgcn_global_load_lds((const unsigned*)((const char*)(gbase) + (voff)[_i]), (PG8_LAS unsigned*)(lds + (bufoff) + ldsw + _i * 8192), 16, 0, 0); } while (0)
#define PG8_LDA(dst, b, h) do { _Pragma("unroll") for (int m = 0; m < 4; ++m) _Pragma("unroll") for (int k = 0; k < 2; ++k) dst[m][k] = *(const PG8_LAS bf16x8*)(lds + PG8_SA(b, h) + aoff + m * 2048 + k * 1024); } while (0)
#define PG8_LDB(dst, b, h) do { _Pragma("unroll") for (int n = 0; n < 2; ++n) _Pragma("unroll") for (int k = 0; k < 2; ++k) dst[n][k] = *(const PG8_LAS bf16x8*)(lds + PG8_SB(b, h) + boff + n * 2048 + k * 1024); } while (0)
#define PG8_MMA(ai, bj, At, Bt) do { __builtin_amdgcn_s_setprio(1); _Pragma("unroll") for (int m = 0; m < 4; ++m) _Pragma("unroll") for (int n = 0; n < 2; ++n) _Pragma("unroll") for (int k = 0; k < 2; ++k) \
        acc[ai][bj][m][n] = __builtin_amdgcn_mfma_f32_16x16x32_bf16(Bt[n][k], At[m][k], acc[ai][bj][m][n], 0, 0, 0); __builtin_amdgcn_s_setprio(0); } while (0)
#define PG8_WAIT_V(n) asm volatile("s_waitcnt vmcnt(" #n ")" ::: "memory")
#define PG8_WAIT_L(n) asm volatile("s_waitcnt lgkmcnt(" #n ")" ::: "memory")
#define PG8_BAR __builtin_amdgcn_s_barrier()
#define PG8_SCHED __builtin_amdgcn_sched_barrier(0)
    Unit cur, nxt; int ui = 0;
    if (!S.next(0, cur)) return;
    f32x4 acc[2][2][4][2];
#pragma unroll
    for (int a = 0; a < 2; ++a)
#pragma unroll
        for (int b = 0; b < 2; ++b)
#pragma unroll
            for (int m = 0; m < 4; ++m)
#pragma unroll
                for (int n = 0; n < 2; ++n) acc[a][b][m][n] = (f32x4){0.f, 0.f, 0.f, 0.f};
    bf16x8 At[4][2], B0[2][2], B1[2][2];
    const char* cA = (const char*)g.A + (size_t)cur.pm * tstep; const char* cB = (const char*)g.Bt + (size_t)cur.pn * tstep;
    S.a_ready(cur);
    if constexpr (SP2) {
        PG8_STAGE(PG8_SB(0, 0), cB, voffB); PG8_STAGE(PG8_SB(0, 1), cB + hstep, voffB); PG8_STAGE(PG8_SA(0, 0), cA, voffA); PG8_STAGE(PG8_SA(0, 1), cA + hstep, voffA);
        if (wr == 1) PG8_BAR;
        PG8_WAIT_V(2); PG8_BAR;
        PG8_STAGE(PG8_SB(1, 0), cB + kstep, voffB); PG8_STAGE(PG8_SA(1, 0), cA + kstep, voffA); PG8_STAGE(PG8_SB(1, 1), cB + hstep + kstep, voffB);
        PG8_WAIT_V(6); PG8_BAR;
    } else {
        PG8_STAGE(PG8_SB(0, 0), cB, voffB); PG8_STAGE(PG8_SA(0, 0), cA, voffA); PG8_STAGE(PG8_SB(0, 1), cB + hstep, voffB); PG8_STAGE(PG8_SA(0, 1), cA + hstep, voffA);
        if (wr == 1) PG8_BAR;
        PG8_WAIT_V(4); PG8_BAR;
        PG8_STAGE(PG8_SB(1, 0), cB + kstep, voffB); PG8_STAGE(PG8_SA(1, 0), cA + kstep, voffA); PG8_STAGE(PG8_SB(1, 1), cB + hstep + kstep, voffB);
        PG8_WAIT_V(6); PG8_BAR;
    }
    for (;;) {
        const bool has_next = S.next(ui + 1, nxt);
        const char* nA = has_next ? (const char*)g.A + (size_t)nxt.pm * tstep : cA; const char* nB = has_next ? (const char*)g.Bt + (size_t)nxt.pn * tstep : cB;
        for (int t = 0; t < nt; t += 2) {
            const bool last = (t == nt - 2);
            const char* a1 = cA + (size_t)(t + 1) * kstep;
            const char* a2 = last ? nA : cA + (size_t)(t + 2) * kstep; const char* b2 = last ? nB : cB + (size_t)(t + 2) * kstep;
            const char* a3 = a2 + kstep; const char* b3 = b2 + kstep;
            if (last && has_next) S.a_ready(nxt);
            if constexpr (SP2) {
            PG8_LDB(B0, 0, 0); PG8_LDB(B1, 0, 1); PG8_SCHED; PG8_LDA(At, 0, 0); PG8_STAGE(PG8_SA(1, 1), a1 + hstep, voffA);
            PG8_WAIT_V(8); PG8_WAIT_L(0); PG8_BAR; PG8_MMA(0, 0, At, B0); PG8_MMA(0, 1, At, B1); PG8_BAR; PG8_SCHED;
            PG8_LDA(At, 0, 1); PG8_STAGE(PG8_SB(0, 0), b2, voffB); PG8_STAGE(PG8_SB(0, 1), b2 + hstep, voffB); PG8_STAGE(PG8_SA(0, 0), a2, voffA);
            PG8_WAIT_V(8); PG8_WAIT_L(0); PG8_BAR; PG8_MMA(1, 0, At, B0); PG8_MMA(1, 1, At, B1); PG8_BAR; PG8_SCHED;
            PG8_LDB(B0, 1, 0); PG8_LDB(B1, 1, 1); PG8_SCHED; PG8_LDA(At, 1, 0); PG8_STAGE(PG8_SA(0, 1), a2 + hstep, voffA);
            PG8_WAIT_V(8); PG8_WAIT_L(0); PG8_BAR; PG8_MMA(0, 0, At, B0); PG8_MMA(0, 1, At, B1); PG8_BAR; PG8_SCHED;
            PG8_LDA(At, 1, 1); PG8_STAGE(PG8_SB(1, 0), b3, voffB); PG8_STAGE(PG8_SB(1, 1), b3 + hstep, voffB); PG8_STAGE(PG8_SA(1, 0), a3, voffA);
            PG8_WAIT_V(8); PG8_WAIT_L(0); PG8_BAR; PG8_MMA(1, 0, At, B0); PG8_MMA(1, 1, At, B1); PG8_BAR; PG8_SCHED;
            } else {
            PG8_LDB(B0, 0, 0); PG8_SCHED; PG8_LDA(At, 0, 0); PG8_STAGE(PG8_SA(1, 1), a1 + hstep, voffA);
            PG8_WAIT_L(8); PG8_BAR; PG8_WAIT_L(0); PG8_MMA(0, 0, At, B0); PG8_BAR; PG8_SCHED;
            PG8_LDB(B1, 0, 1); PG8_STAGE(PG8_SB(0, 0), b2, voffB);
            PG8_BAR; PG8_WAIT_L(0); PG8_MMA(0, 1, At, B1); PG8_BAR;
            PG8_LDA(At, 0, 1); PG8_STAGE(PG8_SA(0, 0), a2, voffA);
            PG8_BAR; PG8_WAIT_L(0); PG8_MMA(1, 0, At, B0); PG8_BAR; PG8_SCHED;
            PG8_STAGE(PG8_SB(0, 1), b2 + hstep, voffB);
            PG8_WAIT_V(6); PG8_BAR; PG8_MMA(1, 1, At, B1); PG8_BAR;
            PG8_LDB(B0, 1, 0); PG8_SCHED; PG8_LDA(At, 1, 0); PG8_STAGE(PG8_SA(0, 1), a2 + hstep, voffA);
            PG8_WAIT_L(8); PG8_BAR; PG8_WAIT_L(0); PG8_MMA(0, 0, At, B0); PG8_BAR; PG8_SCHED;
            PG8_LDB(B1, 1, 1); PG8_STAGE(PG8_SB(1, 0), b3, voffB);
            PG8_BAR; PG8_WAIT_L(0); PG8_MMA(0, 1, At, B1); PG8_BAR;
            PG8_LDA(At, 1, 1); PG8_STAGE(PG8_SA(1, 0), a3, voffA);
            PG8_BAR; PG8_WAIT_L(0); PG8_MMA(1, 0, At, B0); PG8_BAR; PG8_SCHED;
            PG8_STAGE(PG8_SB(1, 1), b3 + hstep, voffB);
            PG8_WAIT_V(6); PG8_BAR; PG8_MMA(1, 1, At, B1); PG8_BAR;
            }
        }
        if constexpr (ALIGN_EPI) { if (wr == 0) PG8_BAR; }
        if constexpr (!Epi::AFTER_DRAIN) { E(acc, cur, wr, wc, fr, fq); S.done(cur); }
        if (!has_next) break;
#pragma unroll
        for (int a = 0; a < 2; ++a)
#pragma unroll
            for (int b = 0; b < 2; ++b)
#pragma unroll
                for (int m = 0; m < 4; ++m)
#pragma unroll
                    for (int n = 0; n < 2; ++n) acc[a][b][m][n] = (f32x4){0.f, 0.f, 0.f, 0.f};
        cur = nxt; cA = nA; cB = nB; ++ui;
        if constexpr (ALIGN_EPI) { if (wr == 1) PG8_BAR; }
    }
    PG8_WAIT_V(0);
    if constexpr (!ALIGN_EPI) { if (wr == 0) PG8_BAR; }
    PG8_BAR;
    if constexpr (Epi::AFTER_DRAIN) { E.fused(acc, cur, wr, wc, fr, fq, lds, wid, lane); S.done(cur); }
#undef PG8_SA
#undef PG8_SB
#undef PG8_STAGE
#undef PG8_LDA
#undef PG8_LDB
#undef PG8_MMA
#undef PG8_WAIT_V
#undef PG8_WAIT_L
#undef PG8_BAR
#undef PG8_SCHED
}
}
#include <hip/hip_bf16.h>
#include <cmath>
namespace attn_body {
using bf16=__hip_bfloat16;
using bf16x8=__attribute__((ext_vector_type(8)))short;
using s16x4=__attribute__((ext_vector_type(4)))short;
using f32x16=__attribute__((ext_vector_type(16)))float;
using u32x4=__attribute__((ext_vector_type(4)))unsigned;
constexpr int BATCH=8,NHEAD=16,SEQ=2048,D=64,DM=NHEAD*D;
constexpr int NW=8,QBLK=32,QB=QBLK*NW,KVBLK=64,NQB=SEQ/QB;
constexpr int ATTN_PITCH=DM, ATTN_UNIT_ROWS=QB;
__device__ __forceinline__ int crow(int r,int hi){return (r&3)+8*(r>>2)+4*hi;}
#define SBAR() __builtin_amdgcn_sched_barrier(0)
__device__ __forceinline__ void cmask(f32x16&p0,f32x16&p1,int jb,int qrel,int hi){
  const float NEG=-INFINITY; int kb=64*jb+4*hi;
  #pragma unroll
  for(int r=0;r<16;++r){int kv=kb+(r&3)+8*(r>>2); if(kv>qrel)p0[r]=NEG; if(kv+32>qrel)p1[r]=NEG;}
}

constexpr int NSLOT=3, SLOTB=8192;
constexpr int LDS_K=0, LDS_V=NSLOT*SLOTB, LDS_WS=2*NSLOT*SLOTB, LDS_OST=LDS_WS+NW*64*4, LDS_BYTES=LDS_OST+NW*4096, LDS_CB=LDS_BYTES, LDS_TOTAL=LDS_CB+SEQ*4;
constexpr float C2=0.125f*1.4426950408889634f;
__device__ __forceinline__ void glds16(const void*gsrc,unsigned lds_dst){unsigned keep;
  asm volatile("s_mov_b32 %0, m0\n\ts_mov_b32 m0, %2\n\ts_nop 0\n\tglobal_load_lds_dwordx4 %1, off\n\ts_mov_b32 m0, %0":"=&s"(keep):"v"(gsrc),"s"(lds_dst):"memory");}
__device__ __forceinline__ float max3f(float a,float b,float c){float r;asm("v_max3_f32 %0, %1, %2, %3":"=v"(r):"v"(a),"v"(b),"v"(c));return r;}
__device__ __forceinline__ float max2f(float a,float b){float r;asm("v_max_f32_e32 %0, %1, %2":"=v"(r):"v"(a),"v"(b));return r;}
__device__ __forceinline__ float fadd_s(float a,float b){float r;asm("v_add_f32_e32 %0, %1, %2":"=v"(r):"v"(a),"v"(b));return r;}
__device__ __forceinline__ float fsub_s(float a,float b){float r;asm("v_sub_f32_e32 %0, %1, %2":"=v"(r):"v"(a),"v"(b));return r;}
typedef float f32x2_t __attribute__((ext_vector_type(2))); typedef __bf16 bf16x2_t __attribute__((ext_vector_type(2)));
__device__ __forceinline__ unsigned cvtpk_s(float lo,float hi){f32x2_t v={lo,hi};bf16x2_t b=__builtin_convertvector(v,bf16x2_t);return __builtin_bit_cast(unsigned,b);}
#define WAIT_BAR(N) asm volatile("s_waitcnt vmcnt(" #N ") lgkmcnt(0)\n\ts_barrier":::"memory")

__device__ __forceinline__ void qkt(f32x16&p0,f32x16&p1,const char*Kslot,const bf16x8*qr,const f32x16&negm,int r32,int hi){
  const char*kb=Kslot+hi*1024+r32*16;
  #pragma unroll
  for(int d0=0;d0<4;++d0){
    const bf16x8 b0=*reinterpret_cast<const bf16x8*>(kb+d0*2048);
    const bf16x8 b1=*reinterpret_cast<const bf16x8*>(kb+d0*2048+512);
    if(d0==0){p0=__builtin_amdgcn_mfma_f32_32x32x16_bf16(b0,qr[0],negm,0,0,0);p1=__builtin_amdgcn_mfma_f32_32x32x16_bf16(b1,qr[0],negm,0,0,0);}
    else{p0=__builtin_amdgcn_mfma_f32_32x32x16_bf16(b0,qr[d0],p0,0,0,0);p1=__builtin_amdgcn_mfma_f32_32x32x16_bf16(b1,qr[d0],p1,0,0,0);}}
}
typedef __attribute__((address_space(3))) const char* lds_cptr;
typedef short v4i16_t __attribute__((ext_vector_type(4)));
__device__ __forceinline__ void kload8(bf16x8*kf,lds_cptr kp){
  kf[0]=*(const __attribute__((address_space(3))) bf16x8*)(kp);      kf[1]=*(const __attribute__((address_space(3))) bf16x8*)(kp+512);
  kf[2]=*(const __attribute__((address_space(3))) bf16x8*)(kp+2048); kf[3]=*(const __attribute__((address_space(3))) bf16x8*)(kp+2560);
  kf[4]=*(const __attribute__((address_space(3))) bf16x8*)(kp+4096); kf[5]=*(const __attribute__((address_space(3))) bf16x8*)(kp+4608);
  kf[6]=*(const __attribute__((address_space(3))) bf16x8*)(kp+6144); kf[7]=*(const __attribute__((address_space(3))) bf16x8*)(kp+6656);
}
__device__ __forceinline__ void kload2(bf16x8*kf,lds_cptr kp,int j){ kf[2*j]=*(const __attribute__((address_space(3))) bf16x8*)(kp+j*2048); kf[2*j+1]=*(const __attribute__((address_space(3))) bf16x8*)(kp+j*2048+512); }
__device__ __forceinline__ s16x4 vtr(lds_cptr p){ return __builtin_bit_cast(s16x4,__builtin_amdgcn_ds_read_tr16_b64_v4i16((__attribute__((address_space(3))) v4i16_t*)p)); }
__device__ __forceinline__ float rowmax(const f32x16&p0,const f32x16&p1){
  float a=max3f(p0[0],p0[1],p1[0]),b=max3f(p0[2],p0[3],p1[1]);a=max3f(a,p1[2],p1[3]);
  #pragma unroll
  for(int r=4;r<16;r+=4){a=max3f(a,p0[r],p0[r+1]);b=max3f(b,p0[r+2],p0[r+3]);a=max3f(a,p1[r],p1[r+1]);b=max3f(b,p1[r+2],p1[r+3]);}
  const float m=max2f(a,b);
  auto rr=__builtin_amdgcn_permlane32_swap(__float_as_uint(m),__float_as_uint(m),false,false);
  return max2f(__uint_as_float(rr[0]),__uint_as_float(rr[1]));
}
__device__ __forceinline__ void pv(f32x16*o,int vb,bf16x8 pa0,bf16x8 pa1,bf16x8 pa2,bf16x8 pa3){
  #pragma unroll
  for(int d0=0;d0<2;++d0){s16x4 lo[4],hi[4];
    #pragma unroll
    for(int ks=0;ks<4;++ks){
      asm volatile("ds_read_b64_tr_b16 %0,%1 offset:%c2":"=&v"(lo[ks]):"v"(vb),"i"(d0*4096+ks*1024):"memory");
      asm volatile("ds_read_b64_tr_b16 %0,%1 offset:%c2":"=&v"(hi[ks]):"v"(vb),"i"(d0*4096+ks*1024+512):"memory");}
    asm volatile("s_waitcnt lgkmcnt(0)":::"memory");SBAR();
    #define PK(k) (bf16x8){lo[k][0],lo[k][1],lo[k][2],lo[k][3],hi[k][0],hi[k][1],hi[k][2],hi[k][3]}
    o[d0]=__builtin_amdgcn_mfma_f32_32x32x16_bf16(pa0,PK(0),o[d0],0,0,0);
    o[d0]=__builtin_amdgcn_mfma_f32_32x32x16_bf16(pa1,PK(1),o[d0],0,0,0);
    o[d0]=__builtin_amdgcn_mfma_f32_32x32x16_bf16(pa2,PK(2),o[d0],0,0,0);
    o[d0]=__builtin_amdgcn_mfma_f32_32x32x16_bf16(pa3,PK(3),o[d0],0,0,0);
    #undef PK
  }
}

#ifndef ATTN_STORE16
#define ATTN_STORE16(p,v) (*(u32x4*)(p)=(v))
#endif
typedef float f32x4v __attribute__((ext_vector_type(4)));
template<int THRL> __device__ __forceinline__ void attn_unit(int b,int h,int qb,const bf16*Q,const bf16*__restrict__ K,const bf16*__restrict__ V,bf16*O,char*shm){
  const int tid=threadIdx.x,lane=tid&63,r32=lane&31,hi=lane>>5; const int wid=__builtin_amdgcn_readfirstlane(tid>>6);
  const long rowbase=(long)b*SEQ; const int q0=qb*QB;
  const bf16*Qw=Q+(rowbase+q0+wid*QBLK)*DM+h*D;
  const bf16*Kh=K+rowbase*DM+h*D,*Vh=V+rowbase*DM+h*D;
  const unsigned lds0=(unsigned)(uintptr_t)shm;
  float*wsf=(float*)(shm+LDS_WS)+wid*64;
  const bf16*ksrc=Kh+(long)lane*DM+wid*8;
  const bf16*vsrc=Vh+(long)(16*(wid&3)+(lane>>2))*DM+(wid>>2)*32+(lane&3)*8;
  const unsigned kdst=lds0+LDS_K+wid*1024, vdst=lds0+LDS_V+wid*1024;
  #define DMA_K(t,slot) glds16(ksrc+(long)(t)*KVBLK*DM,(unsigned)__builtin_amdgcn_readfirstlane(kdst+(slot)))
  #define DMA_V(t,slot) glds16(vsrc+(long)(t)*KVBLK*DM,(unsigned)__builtin_amdgcn_readfirstlane(vdst+(slot)))
  const int vb0=(int)(lds0+LDS_V)+((lane>>4)&1)*32+(lane&3)*8+(4*hi+((lane&15)>>2))*64;
  const char*Kbase=shm+LDS_K; bf16x8 kf[8];
  const lds_cptr shm3=(lds_cptr)shm; const lds_cptr kp0=shm3+LDS_K+hi*1024+r32*16; const lds_cptr vp0=shm3+LDS_V+((lane>>4)&1)*32+(lane&3)*8+(4*hi+((lane&15)>>2))*64;
  const int NT=(q0+QB)/KVBLK;
  DMA_K(0,0);DMA_V(0,0);DMA_K(1,SLOTB);
  bf16x8 qr[4];
  #pragma unroll
  for(int d0=0;d0<4;++d0)qr[d0]=*reinterpret_cast<const bf16x8*>(&Qw[(long)r32*DM+d0*16+hi*8]);
  float mhat=0.f,l_reg=0.f;f32x16 o[2];o[0]=f32x16{};o[1]=f32x16{};float z0_=0.f;asm volatile("":"+v"(z0_));f32x16 negm;_Pragma("unroll") for(int r=0;r<16;++r)negm[r]=z0_;asm volatile("":"+v"(negm));
  const int qrel=wid*QBLK+r32;
  #define CMASK(P0,P1,t) do{int jb_=(t)-(NT-4); if(jb_>=0)cmask(P0,P1,jb_,qrel,hi);}while(0)
  #define BIAS(P0,P1,t) do{ const __attribute__((address_space(3))) f32x4v* cbt_=(const __attribute__((address_space(3))) f32x4v*)(shm3+LDS_CB+(64*(t)+4*hi)*4); \
    _Pragma("unroll") for(int g_=0;g_<4;++g_){ const f32x4v b0_=cbt_[2*g_], b1_=cbt_[8+2*g_]; \
      P0[4*g_]+=b0_[0];P0[4*g_+1]+=b0_[1];P0[4*g_+2]+=b0_[2];P0[4*g_+3]+=b0_[3]; P1[4*g_]+=b1_[0];P1[4*g_+1]+=b1_[1];P1[4*g_+2]+=b1_[2];P1[4*g_+3]+=b1_[3]; } }while(0)
  bool resc=false;
  #define START(P0,P1) do{ const float rm=rowmax(P0,P1); resc=false; \
    { const float dl=rm; mhat=fadd_s(mhat,dl); \
      _Pragma("unroll") for(int r=0;r<16;++r){P0[r]=fsub_s(P0[r],dl);P1[r]=fsub_s(P1[r],dl);} \
      _Pragma("unroll") for(int r=0;r<16;++r)negm[r]=-mhat; asm volatile("":"+v"(negm)); } \
    _Pragma("unroll") for(int r=0;r<16;++r)P0[r]=__builtin_amdgcn_exp2f(P0[r]); }while(0)
  #define RESC() do{ if(resc){ asm volatile("s_waitcnt lgkmcnt(0)":::"memory"); \
      _Pragma("unroll") for(int d_=0;d_<2;++d_) _Pragma("unroll") for(int r=0;r<16;++r)o[d_][r]*=wsf[crow(r,hi)]; } }while(0)
  f32x16 pA0,pA1,pB0,pB1;
  int sl_prev=0,sl_cur=0,sl_next=SLOTB;
  #define ROT() do{sl_prev=sl_cur;sl_cur=sl_next;sl_next=(sl_next==(NSLOT-1)*SLOTB)?0:sl_next+SLOTB;}while(0)
  DMA_K(2,2*SLOTB);
  WAIT_BAR(3);
  qkt(pA0,pA1,Kbase,qr,negm,r32,hi);asm volatile("s_nop 15\n\ts_nop 7":"+v"(pA0),"+v"(pA1));BIAS(pA0,pA1,0);CMASK(pA0,pA1,0);
  START(pA0,pA1);
  _Pragma("unroll") for(int r=0;r<16;++r)pA1[r]=__builtin_amdgcn_exp2f(pA1[r]);
  WAIT_BAR(0);
  DMA_K(3,0);DMA_V(1,SLOTB);
  ROT();
  kload8(kf,kp0+sl_cur);
  WAIT_BAR(2);
  s16x4 vlo[8],vhi[8]; u32x4 pw0,pw1,pw2,pw3;
  #define PKW(P,B) cvtpk_s(P[B],P[B+1])
  #define PAF(k) __builtin_bit_cast(bf16x8,pw##k)
  #define VFR(i) (bf16x8){vlo[i][0],vlo[i][1],vlo[i][2],vlo[i][3],vhi[i][0],vhi[i][1],vhi[i][2],vhi[i][3]}
  #define PIN(x) asm volatile("":"+v"(x))
  #define MX3(a,b,c) __builtin_fmaxf(__builtin_fmaxf((a),(b)),(c))
  #define GAPA(MF,A0,A1,A2,A3,W0,W1,PW) do{ MF; sacc+=A0; sacc+=A1; sacc+=A2; sacc+=A3; PIN(sacc); W0; W1; PIN(PW); SBAR(); }while(0)
  #define EX(v) __builtin_amdgcn_exp2f(v)
  #define GAPB(MF,X,B) do{ MF; X[B]=EX(X[B]); X[B+1]=EX(X[B+1]); X[B+2]=EX(X[B+2]); X[B+3]=EX(X[B+3]); PIN(X); SBAR(); }while(0)
  #define VRD(i) do{ vlo[i]=vtr(vp_+(((i)>>2)*4096+((i)&3)*1024)); vhi[i]=vtr(vp_+(((i)>>2)*4096+((i)&3)*1024+512)); }while(0)
  #define KRD(G,j) do{ if(G){ kload2(kf,kp0+sl_next,j); SBAR(); } }while(0)
  #define STEP(C0,C1,P0,P1,t,GK,GV,GL) do{ SBAR(); \
    const lds_cptr vp_=vp0+sl_prev; \
    VRD(0); SBAR(); float sacc=(P0[0]+P0[1]); \
    GAPA(C0=__builtin_amdgcn_mfma_f32_32x32x16_bf16(kf[0],qr[0],negm,0,0,0), P0[2],P0[3],P0[4],P0[5],     pw0[0]=PKW(P0,0), pw0[1]=PKW(P0,2), pw0); \
    VRD(4); SBAR(); GAPA(C1=__builtin_amdgcn_mfma_f32_32x32x16_bf16(kf[1],qr[0],negm,0,0,0), P0[6],P0[7],P0[8],P0[9],     pw0[2]=PKW(P0,4), pw0[3]=PKW(P0,6), pw0); \
    VRD(1); SBAR(); GAPA(C0=__builtin_amdgcn_mfma_f32_32x32x16_bf16(kf[2],qr[1],C0,0,0,0),   P0[10],P0[11],P0[12],P0[13], pw1[0]=PKW(P0,8), pw1[1]=PKW(P0,10), pw1); \
    VRD(5); SBAR(); GAPA(C1=__builtin_amdgcn_mfma_f32_32x32x16_bf16(kf[3],qr[1],C1,0,0,0),   P0[14],P0[15],P1[0],P1[1],   pw1[2]=PKW(P0,12),pw1[3]=PKW(P0,14), pw1); \
    VRD(2); SBAR(); GAPA(C0=__builtin_amdgcn_mfma_f32_32x32x16_bf16(kf[4],qr[2],C0,0,0,0),   P1[2],P1[3],P1[4],P1[5],     pw2[0]=PKW(P1,0), pw2[1]=PKW(P1,2), pw2); \
    VRD(6); SBAR(); GAPA(C1=__builtin_amdgcn_mfma_f32_32x32x16_bf16(kf[5],qr[2],C1,0,0,0),   P1[6],P1[7],P1[8],P1[9],     pw2[2]=PKW(P1,4), pw2[3]=PKW(P1,6), pw2); \
    VRD(3); SBAR(); GAPA(C0=__builtin_amdgcn_mfma_f32_32x32x16_bf16(kf[6],qr[3],C0,0,0,0),   P1[10],P1[11],P1[12],P1[13], pw3[0]=PKW(P1,8), pw3[1]=PKW(P1,10), pw3); \
    VRD(7); SBAR(); GAPA(C1=__builtin_amdgcn_mfma_f32_32x32x16_bf16(kf[7],qr[3],C1,0,0,0),   P1[14],P1[15],0.f,0.f,       pw3[2]=PKW(P1,12),pw3[3]=PKW(P1,14), pw3); \
    l_reg+=sacc; \
    if(GK){DMA_K((t)+3,sl_cur);} if(GV){DMA_V((t)+1,sl_next);} \
    { const __attribute__((address_space(3))) f32x4v* cbt_=(const __attribute__((address_space(3))) f32x4v*)(shm3+LDS_CB+(64*(t)+4*hi)*4); \
      _Pragma("unroll") for(int g_=0;g_<4;++g_){ const f32x4v b0_=cbt_[2*g_]; C0[4*g_]+=b0_[0];C0[4*g_+1]+=b0_[1];C0[4*g_+2]+=b0_[2];C0[4*g_+3]+=b0_[3]; SBAR(); \
        const f32x4v b1_=cbt_[8+2*g_]; C1[4*g_]+=b1_[0];C1[4*g_+1]+=b1_[1];C1[4*g_+2]+=b1_[2];C1[4*g_+3]+=b1_[3]; SBAR(); } } \
    CMASK(C0,C1,t); \
    { float a=MX3(C0[0],C0[1],C1[0]),b=MX3(C0[2],C0[3],C1[1]); a=MX3(a,C1[2],C1[3]); \
      _Pragma("unroll") for(int r=4;r<16;r+=4){a=MX3(a,C0[r],C0[r+1]);b=MX3(b,C0[r+2],C0[r+3]);a=MX3(a,C1[r],C1[r+1]);b=MX3(b,C1[r+2],C1[r+3]);} \
      float rm=__builtin_fmaxf(a,b); { auto rr=__builtin_amdgcn_permlane32_swap(__float_as_uint(rm),__float_as_uint(rm),false,false); rm=__builtin_fmaxf(__uint_as_float(rr[0]),__uint_as_float(rr[1])); } \
      resc=false; \
      if(__builtin_expect(__any(rm>(float)THRL),0)){ const float dl=__builtin_fmaxf(rm,0.f); mhat+=dl; \
        _Pragma("unroll") for(int r=0;r<16;++r){C0[r]-=dl;C1[r]-=dl;} \
        _Pragma("unroll") for(int r=0;r<16;++r)negm[r]=-mhat; asm volatile("":"+v"(negm)); \
        const float f=__builtin_amdgcn_exp2f(-dl); l_reg*=f; if(hi==0)wsf[r32]=f; resc=true; } } \
    SBAR(); \
    GAPB(o[0]=__builtin_amdgcn_mfma_f32_32x32x16_bf16(PAF(0),VFR(0),o[0],0,0,0), C0,0); \
    GAPB(o[1]=__builtin_amdgcn_mfma_f32_32x32x16_bf16(PAF(0),VFR(4),o[1],0,0,0), C0,4); \
    KRD(GL,0); GAPB(o[0]=__builtin_amdgcn_mfma_f32_32x32x16_bf16(PAF(1),VFR(1),o[0],0,0,0), C0,8); \
    KRD(GL,1); GAPB(o[1]=__builtin_amdgcn_mfma_f32_32x32x16_bf16(PAF(1),VFR(5),o[1],0,0,0), C0,12); \
    KRD(GL,2); GAPB(o[0]=__builtin_amdgcn_mfma_f32_32x32x16_bf16(PAF(2),VFR(2),o[0],0,0,0), C1,0); \
    KRD(GL,3); GAPB(o[1]=__builtin_amdgcn_mfma_f32_32x32x16_bf16(PAF(2),VFR(6),o[1],0,0,0), C1,4); \
    GAPB(o[0]=__builtin_amdgcn_mfma_f32_32x32x16_bf16(PAF(3),VFR(3),o[0],0,0,0), C1,8); \
    GAPB(o[1]=__builtin_amdgcn_mfma_f32_32x32x16_bf16(PAF(3),VFR(7),o[1],0,0,0), C1,12); \
    }while(0)
  int t=1;
  #undef CMASK
  #define CMASK(P0,P1,t) do{}while(0)
  for(;t+5<NT;t+=2){
    STEP(pB0,pB1,pA0,pA1,t,true,true,true);     WAIT_BAR(2); RESC(); ROT();
    STEP(pA0,pA1,pB0,pB1,t+1,true,true,true);   WAIT_BAR(2); RESC(); ROT();
  }
  #undef CMASK
  #define CMASK(P0,P1,t) do{int jb_=(t)-(NT-4); if(jb_>=0)cmask(P0,P1,jb_,qrel,hi);}while(0)
  #define ENDW(tt) do{ if((tt)+3<NT){WAIT_BAR(2);} else if((tt)+2<NT){WAIT_BAR(1);} else {WAIT_BAR(0);} }while(0)
  for(;t+1<NT;t+=2){
    STEP(pB0,pB1,pA0,pA1,t,(t+3<NT),(t+1<NT),(t+1<NT));       ENDW(t);   RESC(); ROT();
    STEP(pA0,pA1,pB0,pB1,t+1,(t+4<NT),(t+2<NT),(t+2<NT));     ENDW(t+1); RESC(); ROT();
  }
  STEP(pB0,pB1,pA0,pA1,NT-1,false,false,false); RESC();
  { float sacc=pB0[0]+pB0[1]; _Pragma("unroll") for(int r=2;r<16;++r)sacc+=pB0[r]; _Pragma("unroll") for(int r=0;r<16;++r)sacc+=pB1[r]; l_reg+=sacc;
    pw0=(u32x4){PKW(pB0,0),PKW(pB0,2),PKW(pB0,4),PKW(pB0,6)};pw1=(u32x4){PKW(pB0,8),PKW(pB0,10),PKW(pB0,12),PKW(pB0,14)};pw2=(u32x4){PKW(pB1,0),PKW(pB1,2),PKW(pB1,4),PKW(pB1,6)};pw3=(u32x4){PKW(pB1,8),PKW(pB1,10),PKW(pB1,12),PKW(pB1,14)};
    SBAR(); pv(o,vb0+sl_cur,PAF(0),PAF(1),PAF(2),PAF(3)); }
  #undef PKW
  #undef PAF
  #undef VFR
  #undef PIN
  #undef MX3
  #undef GAPA
  #undef GAPB
  #undef EX
  #undef VRD
  #undef KRD
  #undef STEP
  #undef ENDW
  {auto rr=__builtin_amdgcn_permlane32_swap(__float_as_uint(l_reg),__float_as_uint(l_reg),false,false);l_reg=__uint_as_float(rr[0])+__uint_as_float(rr[1]);}
  if(hi==0)wsf[32+r32]=l_reg;asm volatile("s_waitcnt lgkmcnt(0)":::"memory");
  float rli[16];
  #pragma unroll
  for(int r=0;r<16;++r)rli[r]=__builtin_amdgcn_rcpf(wsf[32+crow(r,hi)]);
  bf16*Ow=O+(rowbase+q0+wid*QBLK)*DM+h*D;
  { bf16*stg=(bf16*)(shm+LDS_OST)+wid*2048;
    #pragma unroll
    for(int r=0;r<16;++r){const int orow=crow(r,hi);
      #pragma unroll
      for(int d0=0;d0<2;++d0)stg[orow*64+d0*32+r32]=__float2bfloat16(o[d0][r]*rli[r]);}
    asm volatile("s_waitcnt lgkmcnt(0)":::"memory");
    #pragma unroll
    for(int i=0;i<4;++i){const int row=i*8+(lane>>3),ch=lane&7; const u32x4 v=*(const u32x4*)(stg+row*64+ch*8); ATTN_STORE16(Ow+(long)row*DM+ch*8,v);} }
  asm volatile("s_waitcnt lgkmcnt(0)\n\ts_barrier":::"memory");
  #undef DMA_K
  #undef DMA_V
  #undef BIAS
  #undef CMASK
  #undef START
  #undef RESC
  #undef ROT
}
constexpr int ATTN_LDS_BYTES=LDS_TOTAL;
struct AttnTensors { const bf16* Q; const bf16* K; const bf16* V; bf16* O; };
struct AttnUnit { int bh; int qb; };
struct StaticOrder {
  int vcu;
  __device__ __forceinline__ explicit StaticOrder(int grid,int block):vcu((block%8)*(grid/8)+block/8){}
  __device__ __forceinline__ bool next(int i,AttnUnit&u)const{ if(i>=4)return false; const int s=2*(vcu&1)+(i>>1); u.bh=vcu>>1; u.qb=(i&1)?7-s:s; return true; }
  __device__ __forceinline__ void a_ready(const AttnUnit&)const{}
  __device__ __forceinline__ void done(const AttnUnit&)const{}
};
template<class Sched,int THRL=8> __device__ __forceinline__ void attn_phase(char*lds,const AttnTensors&T,const Sched&S){
  AttnUnit u;
  for(int i=0;S.next(i,u);++i){ S.a_ready(u); attn_unit<THRL>(u.bh/NHEAD,u.bh%NHEAD,u.qb,T.Q,T.K,T.V,T.O,lds); S.done(u); }
}
#undef SBAR
#undef WAIT_BAR
}
#define GAS __attribute__((address_space(1)))
#define LAS __attribute__((address_space(3)))
typedef unsigned short bf16;
typedef unsigned v4u __attribute__((ext_vector_type(4)));
typedef float f32x4 __attribute__((ext_vector_type(4)));
typedef short bf16x8 __attribute__((ext_vector_type(8)));
typedef GAS unsigned gu32;
typedef GAS unsigned long long gu64;
#define RLX_AGENT __ATOMIC_RELAXED, __HIP_MEMORY_SCOPE_AGENT
#define LDS_WAIT() asm volatile("s_waitcnt lgkmcnt(0)" ::: "memory")
#define VM_WAIT() asm volatile("s_waitcnt vmcnt(0)" ::: "memory")
__device__ __forceinline__ unsigned long long rt() { return __builtin_amdgcn_s_memrealtime(); }
__device__ __forceinline__ unsigned f2bf(float f) { unsigned u = __builtin_bit_cast(unsigned, f); return (u + 0x7fffu + ((u >> 16) & 1u)) >> 16; }
__device__ __forceinline__ unsigned pk2(float lo, float hi) { return f2bf(lo) | (f2bf(hi) << 16); }

#define XB_TMO      128
#define XB_XCNT(j)  (256  + 64 * (j))
#define XB_XSUB(j)  (1280 + 64 * (j))
#define XB_XGEN(j)  (2304 + 64 * (j))
#define XB_TOP      3328
#define XB_TOPGEN   3392
#define XCD_BAR_WORDS 3456
#define XB_SPIN_CAP (1u << 18)

__device__ __forceinline__ unsigned xb_ld(unsigned* p)              { return __hip_atomic_load(p, __ATOMIC_RELAXED, __HIP_MEMORY_SCOPE_AGENT); }
__device__ __forceinline__ unsigned xb_add(unsigned* p, unsigned v) { return __hip_atomic_fetch_add(p, v, __ATOMIC_RELAXED, __HIP_MEMORY_SCOPE_AGENT); }
__device__ __forceinline__ unsigned xb_xcc_id() { return (unsigned)__builtin_amdgcn_s_getreg((3 << 11) | 20) & 0xFu; }
#define XB_SPIN(cond, bar) do { unsigned _sp = 0; while (cond) { __builtin_amdgcn_s_sleep(1); \
    if ((++_sp & 255u) == 0u) { if (xb_ld(&(bar)[XB_TMO])) break; if (_sp > XB_SPIN_CAP) { atomicAdd(&(bar)[XB_TMO], 1u); break; } } } } while (0)

struct XcdBarrier {
    unsigned* bar; unsigned x;
    volatile LAS unsigned* st;
};

__device__ __forceinline__ XcdBarrier xcd_barrier_post(unsigned* bar, volatile LAS unsigned* st) {
    XcdBarrier b; b.bar = bar; b.x = xb_xcc_id(); b.st = st;
    if (threadIdx.x == 0) (void)xb_add(&bar[XB_XCNT(b.x)], 1u);
    return b;
}
__device__ __forceinline__ void xcd_barrier_complete(unsigned* bar, unsigned x, unsigned& nloc, unsigned& nx) {
    const unsigned G = gridDim.x * gridDim.y * gridDim.z;
    unsigned sum, cnt, mine, sp = 0u;
    for (;;) {
        sum = 0u; cnt = 0u; mine = 0u;
#pragma unroll
        for (unsigned j = 0; j < 16; ++j) { const unsigned c = xb_ld(&bar[XB_XCNT(j)]); sum += c; cnt += (c > 0u) ? 1u : 0u; mine = (j == x) ? c : mine; }
        if (sum == G) break;
        __builtin_amdgcn_s_sleep(1);
        if ((++sp & 255u) == 0u) { if (xb_ld(&bar[XB_TMO])) break; if (sp > XB_SPIN_CAP) { atomicAdd(&bar[XB_TMO], 1u); break; } }
    }
    nloc = mine > 0u ? mine : 1u; nx = cnt > 0u ? cnt : 1u;
}

__device__ __forceinline__ void xcd_barrier(const XcdBarrier& b) {
    asm volatile("s_waitcnt vmcnt(0)" ::: "memory");
    __syncthreads();
    if (threadIdx.x == 0) {
        unsigned* bar = b.bar;
        __builtin_amdgcn_s_waitcnt(0);
        unsigned nloc = b.st[0], nx = b.st[1];
        if (nloc == 0u) { xcd_barrier_complete(bar, b.x, nloc, nx); b.st[0] = nloc; b.st[1] = nx; }
        const unsigned old = xb_add(&bar[XB_XSUB(b.x)], 1u);
        const unsigned gen = old / nloc;
        if (old + 1u == (gen + 1u) * nloc) {
            __builtin_amdgcn_fence(__ATOMIC_RELEASE, "agent");
            asm volatile("s_waitcnt vmcnt(0)" ::: "memory");
            const unsigned og = xb_add(&bar[XB_TOP], 1u);
            const unsigned tg = og / nx;
            if (og + 1u == (tg + 1u) * nx) xb_add(&bar[XB_TOPGEN], 1u);
            else XB_SPIN(xb_ld(&bar[XB_TOPGEN]) == tg, bar);
            __builtin_amdgcn_fence(__ATOMIC_ACQUIRE, "agent");
            xb_add(&bar[XB_XGEN(b.x)], 1u);
            asm volatile("s_waitcnt vmcnt(0)" ::: "memory");
        } else {
            XB_SPIN(xb_ld(&bar[XB_XGEN(b.x)]) == gen, bar);
            __builtin_amdgcn_fence(__ATOMIC_ACQUIRE, "agent");
            asm volatile("s_waitcnt vmcnt(0)" ::: "memory");
        }
    }
    __syncthreads();
}
constexpr int NWAVES = 8, NTHR = NWAVES * 64;
constexpr int T_TOK = 16384, DMODEL = 1024, NB = 8, SEQ = 2048;
constexpr int GLA_H = 4, GLA_DK = 128, GLA_DV = 256, GLA_C = 64, GLA_NCH = SEQ / GLA_C, GLA_IN = 3088;
constexpr int NCHUNK = NB * GLA_H * GLA_NCH;
constexpr int KV_TOT = 2064, FOX_H = 16;
constexpr int PEER_H = 8, PEER_K = 16, PEER_NEXP = 16384, PEER_SEL = PEER_H * PEER_K;
constexpr float EPS = 1e-6f;
constexpr float L2E = 1.4426950408889634f;

constexpr size_t MiB = 1u << 20;
constexpr size_t WS_CTL = 0, CTL_ZERO_BYTES = 1 * MiB;
constexpr size_t WS_WIN = 2 * MiB, WS_WGO = 8 * MiB, WS_WQKV = 10 * MiB, WS_WFO = 16 * MiB, WS_WEFF = 18 * MiB;
constexpr size_t WS_FL = 27 * MiB, WS_RP = 28 * MiB, WS_DEXP = 30 * MiB, WS_WGL = 30 * MiB + 512 * 1024, WS_WFL = WS_WGL + 64 * 1024;
constexpr size_t WS_A0 = 32 * MiB;
constexpr size_t WS_HB = 64 * MiB;
constexpr size_t WS_PQ = 96 * MiB;
constexpr size_t WS_QT = 192 * MiB, WS_KT = 208 * MiB, WS_AT = 224 * MiB, WS_VT = 232 * MiB;
constexpr size_t WS_SC = 96 * MiB;
constexpr size_t WS_IDS = 264 * MiB, WS_GATES = 272 * MiB;
constexpr size_t WS_TAB = 280 * MiB;
constexpr size_t WS_END = 408 * MiB;
constexpr int CW_BAR = 4096;

constexpr int RING_BYTES = 131072;
constexpr int LDSCTL_OFF = RING_BYTES, MISC_OFF = LDSCTL_OFF + 320;
constexpr int LDS_BYTES = 147456;

typedef unsigned v2u __attribute__((ext_vector_type(2)));
typedef float f32x16 __attribute__((ext_vector_type(16)));
__device__ __forceinline__ float bf2f(unsigned b) { return __builtin_bit_cast(float, b << 16); }
__device__ __forceinline__ float bflo(unsigned w) { return __builtin_bit_cast(float, w << 16); }
__device__ __forceinline__ float bfhi(unsigned w) { return __builtin_bit_cast(float, w & 0xffff0000u); }
__device__ __forceinline__ float wave_sum(float v) {
#pragma unroll
    for (int o = 1; o < 64; o <<= 1) v += __shfl_xor(v, o);
    return v;
}
__device__ __forceinline__ float wave_max(float v) {
#pragma unroll
    for (int o = 1; o < 64; o <<= 1) v = fmaxf(v, __shfl_xor(v, o));
    return v;
}
__device__ __forceinline__ float log_sigmoid(float x) { return fminf(x, 0.f) - log1pf(__expf(-fabsf(x))); }
__device__ __forceinline__ int crow16(int r, int hi) { return (r & 3) + 8 * (r >> 2) + 4 * hi; }

struct Frame {
    LAS unsigned char* lds;
    volatile LAS unsigned* MISC;
    gu32* ctl;
    int tid, lane, wave, vcu, G;
    unsigned char* ws;
    const float* in[18];
    float* out;
};
enum { IN_X = 0, IN_NORM_MIX, IN_NORM_FFN, IN_GLA_W_IN, IN_GLA_W_G2, IN_GLA_B_G, IN_GLA_NORM_O, IN_GLA_W_O, IN_KV_NORM, IN_KV_W, IN_FOX_B_F, IN_FOX_W_Q, IN_FOX_W_O,
       IN_PEER_W_Q, IN_PEER_SUB, IN_PEER_U, IN_PEER_V, IN_NORM_FINAL };

__device__ __forceinline__ void p0_transpose_item(const float* W, int K, int ldw, int c0, int N, bf16* WT, int row_off, const float* gk, int ns, float cs, LAS float* scr, int item, int lane) {
    const int nblk = N / 32, kb = item / nblk, nb = item % nblk, k0 = 64 * kb, n0 = 32 * nb;
#pragma unroll 8
    for (int i = 0; i < 32; ++i) { const int kk = 2 * i + (lane >> 5); const float g = gk ? gk[k0 + kk] : 1.f; scr[kk * 33 + (lane & 31)] = W[(size_t)(k0 + kk) * ldw + c0 + n0 + (lane & 31)] * g; }
    LDS_WAIT(); asm volatile("" ::: "memory");
    const int c = lane & 7;
#pragma unroll
    for (int j = 0; j < 4; ++j) { const int n = (lane >> 3) + 8 * j; const LAS float* s = scr + (8 * c) * 33 + n; const float sc = (n0 + n < ns) ? cs : 1.f;
        v4u o; o.x = pk2(s[0 * 33] * sc, s[1 * 33] * sc); o.y = pk2(s[2 * 33] * sc, s[3 * 33] * sc); o.z = pk2(s[4 * 33] * sc, s[5 * 33] * sc); o.w = pk2(s[6 * 33] * sc, s[7 * 33] * sc);
        *(GAS v4u*)(WT + (size_t)(row_off + n0 + n) * K + k0 + 8 * c) = o; }
    LDS_WAIT(); asm volatile("" ::: "memory");
}
__device__ __forceinline__ void p0_weff_item(Frame& F, int item) {
    const int l = item >> 8, gi = (item >> 4) & 15, kb = item & 15, k0 = kb * 64, tid = F.tid;
    const float* wpq = F.in[IN_PEER_W_Q] + (size_t)l * DMODEL * 2048; const float* sub = F.in[IN_PEER_SUB] + ((size_t)l * 16 + gi) * 128 * 128; const float* gf = F.in[IN_NORM_FFN] + l * DMODEL;
    bf16* WT = (bf16*)(F.ws + WS_WEFF) + (size_t)l * 2048 * DMODEL;
    LAS float* At = (LAS float*)F.lds;
    LAS float* Bt = (LAS float*)(F.lds + 32768);
    { const int kk = tid >> 3, d0 = (tid & 7) * 16; const float g = gf[k0 + kk]; const f32x4* src = (const f32x4*)(wpq + (size_t)(k0 + kk) * 2048 + gi * 128 + d0);
#pragma unroll
      for (int i = 0; i < 4; ++i) { f32x4 v = src[i]; *(LAS f32x4*)(At + kk * 128 + d0 + 4 * i) = v * g; } }
    { const int n = tid >> 2, d0 = (tid & 3) * 32; const f32x4* src = (const f32x4*)(sub + (size_t)n * 128 + d0);
#pragma unroll
      for (int i = 0; i < 8; ++i) { f32x4 v = src[i]; *(LAS f32x4*)(Bt + n * 132 + d0 + 4 * i) = v; } }
    __syncthreads();
    const int n = tid & 127, kq = tid >> 7;
    float acc[16];
#pragma unroll
    for (int i = 0; i < 16; ++i) acc[i] = 0.f;
    for (int dc = 0; dc < 32; ++dc) { const f32x4 bv = *(const LAS f32x4*)(Bt + n * 132 + 4 * dc);
#pragma unroll
        for (int kk = 0; kk < 16; ++kk) { const f32x4 av = *(const LAS f32x4*)(At + (kq * 16 + kk) * 128 + 4 * dc); acc[kk] += (av[0] * bv[0] + av[1] * bv[1]) + (av[2] * bv[2] + av[3] * bv[3]); } }
    v4u o0, o1; o0.x = pk2(acc[0], acc[1]); o0.y = pk2(acc[2], acc[3]); o0.z = pk2(acc[4], acc[5]); o0.w = pk2(acc[6], acc[7]);
    o1.x = pk2(acc[8], acc[9]); o1.y = pk2(acc[10], acc[11]); o1.z = pk2(acc[12], acc[13]); o1.w = pk2(acc[14], acc[15]);
    GAS v4u* dst = (GAS v4u*)(WT + (size_t)(gi * 128 + n) * DMODEL + k0 + kq * 16); dst[0] = o0; dst[1] = o1;
    __syncthreads();
}
__device__ __forceinline__ void rms_row_to_bf16(int lane, const float* xrow, const float* g, bf16* orow) {
    const GAS f32x4* xr = (const GAS f32x4*)xrow + lane; const GAS f32x4* gr = (const GAS f32x4*)g + lane;
    f32x4 v[4]; float s = 0.f;
#pragma unroll
    for (int j = 0; j < 4; ++j) { v[j] = xr[64 * j]; s += (v[j].x * v[j].x + v[j].y * v[j].y) + (v[j].z * v[j].z + v[j].w * v[j].w); }
    const float rstd = 1.f / sqrtf(wave_sum(s) * (1.f / DMODEL) + EPS);
    GAS unsigned long long* o8 = (GAS unsigned long long*)orow + lane;
#pragma unroll
    for (int j = 0; j < 4; ++j) { const f32x4 gg = gr[64 * j]; o8[64 * j] = (unsigned long long)pk2(v[j].x * rstd * gg.x, v[j].y * rstd * gg.y) | ((unsigned long long)pk2(v[j].z * rstd * gg.z, v[j].w * rstd * gg.w) << 32); }
}
__device__ __forceinline__ void tab_row_to_bf16(int lane, const float* src, bf16* dst) {
    const GAS f32x4* s = (const GAS f32x4*)src + 2 * lane;
    const f32x4 a0 = s[0], a1 = s[1], b0 = s[128], b1 = s[129];
    v4u o0, o1; o0.x = pk2(a0.x, a0.y); o0.y = pk2(a0.z, a0.w); o0.z = pk2(a1.x, a1.y); o0.w = pk2(a1.z, a1.w);
    o1.x = pk2(b0.x, b0.y); o1.y = pk2(b0.z, b0.w); o1.z = pk2(b1.x, b1.y); o1.w = pk2(b1.z, b1.w);
    GAS v4u* d = (GAS v4u*)dst + lane; d[0] = o0; d[64] = o1;
}
__device__ __forceinline__ void p0_prologue(Frame& F) {
    for (int it = blockIdx.x; it < 512; it += F.G) p0_weff_item(F, it);
    LAS float* scr = (LAS float*)(F.lds + F.wave * 16384);
    const int gw = blockIdx.x * NWAVES + F.wave, NGW = F.G * NWAVES;
    constexpr int I_IN = 16 * 96, I_SQ = 16 * 32, I_KV = 16 * 64;
    constexpr int NITEMS = I_IN + 3 * I_SQ + I_KV;
    for (int it = gw; it < NITEMS; it += NGW) {
        int r = it;
        if (r < I_IN) { p0_transpose_item(F.in[IN_GLA_W_IN], DMODEL, GLA_IN, 0, 3072, (bf16*)(F.ws + WS_WIN), 0, nullptr, 512, 0.08838834764831845f, scr, r, F.lane); continue; } r -= I_IN;
        if (r < I_SQ) { p0_transpose_item(F.in[IN_GLA_W_O], DMODEL, DMODEL, 0, 1024, (bf16*)(F.ws + WS_WGO), 0, nullptr, 0, 1.f, scr, r, F.lane); continue; } r -= I_SQ;
        if (r < I_SQ) { p0_transpose_item(F.in[IN_FOX_W_Q], DMODEL, DMODEL, 0, 1024, (bf16*)(F.ws + WS_WQKV), 0, F.in[IN_NORM_MIX] + DMODEL, 0, 1.f, scr, r, F.lane); continue; } r -= I_SQ;
        if (r < I_KV) { p0_transpose_item(F.in[IN_KV_W], DMODEL, KV_TOT, 0, 2048, (bf16*)(F.ws + WS_WQKV), 1024, F.in[IN_KV_NORM], 0, 1.f, scr, r, F.lane); continue; } r -= I_KV;
        p0_transpose_item(F.in[IN_FOX_W_O], DMODEL, DMODEL, 0, 1024, (bf16*)(F.ws + WS_WFO), 0, nullptr, 0, 1.f, scr, r, F.lane);
    }
    { const int gt = blockIdx.x * NTHR + F.tid, NT = F.G * NTHR;
      for (int idx = gt; idx < 2 * 16 * DMODEL; idx += NT) { const int which = idx >> 14, j = (idx >> 10) & 15, k = idx & 1023;
          if (which == 0) ((bf16*)(F.ws + WS_WGL))[j * DMODEL + k] = (bf16)f2bf(F.in[IN_GLA_W_IN][(size_t)k * GLA_IN + 3072 + j]);
          else ((bf16*)(F.ws + WS_WFL))[j * DMODEL + k] = (bf16)f2bf(F.in[IN_KV_W][(size_t)k * KV_TOT + 2048 + j] * F.in[IN_KV_NORM][k]); } }
    for (int m = gw; m < T_TOK; m += NGW) rms_row_to_bf16(F.lane, F.in[IN_X] + (size_t)m * DMODEL, F.in[IN_NORM_MIX], (bf16*)(F.ws + WS_A0) + (size_t)m * DMODEL);
    for (int r = gw; r < 4 * PEER_NEXP; r += NGW) { const int tb = r >> 14, e = r & (PEER_NEXP - 1), l = tb >> 1;
        const float* src = ((tb & 1) ? F.in[IN_PEER_V] : F.in[IN_PEER_U]) + ((size_t)l * PEER_NEXP + e) * DMODEL;
        tab_row_to_bf16(F.lane, src, (bf16*)(F.ws + WS_TAB) + ((size_t)tb * PEER_NEXP + e) * DMODEL); }
}

__device__ __forceinline__ f32x4 skinny16(const bf16* A  , const bf16* Wt, int wave, int lane) {
    f32x4 acc = (f32x4){0.f, 0.f, 0.f, 0.f};
    const bf16x8* ap = (const bf16x8*)(A + (size_t)(16 * wave + (lane & 15)) * DMODEL + 8 * (lane >> 4));
    const bf16x8* bp = (const bf16x8*)(Wt + (size_t)(lane & 15) * DMODEL + 8 * (lane >> 4));
#pragma unroll 8
    for (int kk = 0; kk < 32; ++kk) acc = __builtin_amdgcn_mfma_f32_16x16x32_bf16(ap[4 * kk], bp[4 * kk], acc, 0, 0, 0);
    return acc;
}
__device__ __forceinline__ int perm16(int k16) { return 8 * ((k16 >> 2) & 1) + 4 * (k16 >> 3) + (k16 & 3); }
__device__ __forceinline__ void p2a_item(Frame& F, int cid) {
    const int tid = F.tid, lane = F.lane, wave = F.wave;
    const int b = cid >> 7, h = (cid >> 5) & 3, n = cid & 31, t0 = b * SEQ + n * GLA_C;
    const bf16* PQ = (const bf16*)(F.ws + WS_PQ);
    LAS float* glrL = (LAS float*)F.lds;
    LAS float* SEG = (LAS float*)(F.lds + 4096);
    LAS unsigned char* QI = F.lds + 8192;
    LAS unsigned char* KI = F.lds + 8192 + 16384;
    if (wave < 4) { const f32x4 a = skinny16((const bf16*)(F.ws + WS_A0) + (size_t)t0 * DMODEL, (const bf16*)(F.ws + WS_WGL), wave, lane);
#pragma unroll
        for (int r = 0; r < 4; ++r) glrL[(16 * wave + 4 * (lane >> 4) + r) * 16 + (lane & 15)] = a[r]; }
    const int k = tid & 127, iq = tid >> 7;
    float wg[16];
#pragma unroll
    for (int j = 0; j < 16; ++j) wg[j] = F.in[IN_GLA_W_G2][j * 512 + h * 128 + k];
    const float bg = F.in[IN_GLA_B_G][h * 128 + k];
    __syncthreads();
    float bc[16];
#pragma unroll
    for (int ii = 0; ii < 16; ++ii) { const LAS f32x4* gp = (const LAS f32x4*)(glrL + (iq * 16 + ii) * 16); float s = bg;
#pragma unroll
        for (int q4 = 0; q4 < 4; ++q4) { const f32x4 gv = gp[q4]; s += (gv[0] * wg[4 * q4] + gv[1] * wg[4 * q4 + 1]) + (gv[2] * wg[4 * q4 + 2] + gv[3] * wg[4 * q4 + 3]); }
        bc[ii] = log_sigmoid(s) * (1.0f / 16.0f); }
#pragma unroll
    for (int ii = 1; ii < 16; ++ii) bc[ii] += bc[ii - 1];
    SEG[iq * 128 + k] = bc[15];
    __syncthreads();
    float off = 0.f, tot = 0.f;
#pragma unroll
    for (int q = 0; q < 4; ++q) { const float sv = SEG[q * 128 + k]; tot += sv; if (q < iq) off += sv; }
    const int pos = (k & ~15) | perm16(k & 15);
    unsigned kt[8];
#pragma unroll
    for (int ii = 0; ii < 16; ii += 2) {
        float qa[2], ka[2];
#pragma unroll
        for (int e = 0; e < 2; ++e) { const int i = iq * 16 + ii + e; const float bb = bc[ii + e] + off;
            const float qv = bf2f(PQ[(size_t)(t0 + i) * 3072 + h * 128 + k]), kv = bf2f(PQ[(size_t)(t0 + i) * 3072 + 512 + h * 128 + k]);
            qa[e] = qv * __expf(bb); ka[e] = kv * __expf(-bb);
            *(LAS unsigned short*)(QI + i * 256 + pos * 2) = (unsigned short)f2bf(qa[e]);
            *(LAS unsigned short*)(KI + i * 256 + pos * 2) = (unsigned short)f2bf(ka[e]); }
        kt[ii >> 1] = pk2(ka[0], ka[1]); }
    { GAS v4u* dst = (GAS v4u*)((bf16*)(F.ws + WS_KT) + (size_t)cid * 8192 + k * 64 + iq * 16);
      dst[0] = (v4u){kt[0], kt[1], kt[2], kt[3]}; dst[1] = (v4u){kt[4], kt[5], kt[6], kt[7]}; }
    if (iq == 0) ((float*)(F.ws + WS_DEXP))[(size_t)cid * 128 + k] = __expf(tot);
    __syncthreads();
    if (wave < 4) { const int ib = (wave == 1 || wave == 2) ? 1 : 0, jb = (wave >= 2) ? 1 : 0, r32 = lane & 31, hi = lane >> 5;
        f32x16 acc = (f32x16){};
        if (wave != 3) {
#pragma unroll
            for (int kk = 0; kk < 8; ++kk) { const bf16x8 af = *(const LAS bf16x8*)(KI + (32 * jb + r32) * 256 + (16 * kk + 8 * hi) * 2);
                const bf16x8 bfr = *(const LAS bf16x8*)(QI + (32 * ib + r32) * 256 + (16 * kk + 8 * hi) * 2);
                acc = __builtin_amdgcn_mfma_f32_32x32x16_bf16(af, bfr, acc, 0, 0, 0); } }
        const int i = 32 * ib + r32;
        bf16* at = (bf16*)(F.ws + WS_AT) + (size_t)cid * 4096 + i * 64 + 32 * jb + 4 * hi;
#pragma unroll
        for (int g = 0; g < 4; ++g) { float v[4];
#pragma unroll
            for (int e = 0; e < 4; ++e) { const int j = 32 * jb + 8 * g + 4 * hi + e; v[e] = (j <= i) ? acc[4 * g + e] : 0.f; }
            *(GAS v2u*)(at + 8 * g) = (v2u){pk2(v[0], v[1]), pk2(v[2], v[3])}; } }
    { GAS v4u* dst = (GAS v4u*)((bf16*)(F.ws + WS_QT) + (size_t)cid * 8192); const LAS v4u* src = (const LAS v4u*)QI; dst[tid] = src[tid]; dst[tid + 512] = src[tid + 512]; }
    { const int nn = tid & 255, jh = tid >> 8; unsigned w[16];
#pragma unroll
      for (int jj = 0; jj < 32; jj += 2) { const unsigned lo = PQ[(size_t)(t0 + 32 * jh + jj) * 3072 + 1024 + h * 256 + nn], hi2 = PQ[(size_t)(t0 + 32 * jh + jj + 1) * 3072 + 1024 + h * 256 + nn]; w[jj >> 1] = lo | (hi2 << 16); }
      GAS v4u* dst = (GAS v4u*)((bf16*)(F.ws + WS_VT) + (size_t)cid * 16384 + nn * 64 + 32 * jh);
#pragma unroll
      for (int q = 0; q < 4; ++q) dst[q] = (v4u){w[4 * q], w[4 * q + 1], w[4 * q + 2], w[4 * q + 3]}; }
    __syncthreads();
}

__device__ __forceinline__ unsigned cvtpk(float lo, float hi) { typedef float f2 __attribute__((ext_vector_type(2))); typedef __bf16 b2 __attribute__((ext_vector_type(2))); f2 v = {lo, hi}; b2 r = __builtin_convertvector(v, b2); return __builtin_bit_cast(unsigned, r); }
__device__ __forceinline__ void p2b_seq(Frame& F, int bh) {
    const int lane = F.lane, wave = F.wave, r32 = lane & 31, hi = lane >> 5;
    const int b = bh >> 2, h = bh & 3;
    const bf16* PQ = (const bf16*)(F.ws + WS_PQ); bf16* OG = (bf16*)(F.ws + WS_A0);
    LAS float* red = (LAS float*)F.lds;
    f32x16 S[4];
#pragma unroll
    for (int kb = 0; kb < 4; ++kb) S[kb] = (f32x16){};
    const float* go = F.in[IN_GLA_NORM_O] + h * 256 + 32 * wave;
    for (int n = 0; n < GLA_NCH; ++n) {
        const int cid = bh * 32 + n, t0 = b * SEQ + n * GLA_C;
        const bf16* QT = (const bf16*)(F.ws + WS_QT) + (size_t)cid * 8192; const bf16* KT = (const bf16*)(F.ws + WS_KT) + (size_t)cid * 8192;
        const bf16* AT = (const bf16*)(F.ws + WS_AT) + (size_t)cid * 4096; const bf16* VT = (const bf16*)(F.ws + WS_VT) + (size_t)cid * 16384;
        const float* DX = (const float*)(F.ws + WS_DEXP) + (size_t)cid * 128;
        bf16x8 vf[4];
#pragma unroll
        for (int s = 0; s < 4; ++s) vf[s] = *(const bf16x8*)(VT + (32 * wave + r32) * 64 + 16 * s + 8 * hi);
        f32x16 oT[2];
#pragma unroll
        for (int ib = 0; ib < 2; ++ib) { f32x16 a = (f32x16){};
#pragma unroll
            for (int s = 0; s < 4; ++s) { const bf16x8 bf = *(const bf16x8*)(AT + (32 * ib + r32) * 64 + 16 * s + 8 * hi); a = __builtin_amdgcn_mfma_f32_32x32x16_bf16(vf[s], bf, a, 0, 0, 0); }
            oT[ib] = a; }
#pragma unroll
        for (int kb = 0; kb < 4; ++kb)
#pragma unroll
            for (int s = 0; s < 2; ++s) { v4u sw; sw.x = cvtpk(S[kb][8 * s], S[kb][8 * s + 1]); sw.y = cvtpk(S[kb][8 * s + 2], S[kb][8 * s + 3]); sw.z = cvtpk(S[kb][8 * s + 4], S[kb][8 * s + 5]); sw.w = cvtpk(S[kb][8 * s + 6], S[kb][8 * s + 7]);
                const bf16x8 sf = __builtin_bit_cast(bf16x8, sw);
#pragma unroll
                for (int ib = 0; ib < 2; ++ib) { const bf16x8 qf = *(const bf16x8*)(QT + (32 * ib + r32) * 128 + 32 * kb + 16 * s + 8 * hi); oT[ib] = __builtin_amdgcn_mfma_f32_32x32x16_bf16(sf, qf, oT[ib], 0, 0, 0); } }
#pragma unroll
        for (int kb = 0; kb < 4; ++kb) {
#pragma unroll
            for (int s = 0; s < 4; ++s) { const bf16x8 kf = *(const bf16x8*)(KT + (32 * kb + r32) * 64 + 16 * s + 8 * hi); S[kb] = __builtin_amdgcn_mfma_f32_32x32x16_bf16(kf, vf[s], S[kb], 0, 0, 0); }
#pragma unroll
            for (int g = 0; g < 4; ++g) { const f32x4 dv = *(const f32x4*)(DX + 32 * kb + 8 * g + 4 * hi);
                S[kb][4 * g] *= dv[0]; S[kb][4 * g + 1] *= dv[1]; S[kb][4 * g + 2] *= dv[2]; S[kb][4 * g + 3] *= dv[3]; } }
        LAS float* rp = red + (n & 1) * 512;
#pragma unroll
        for (int ib = 0; ib < 2; ++ib) { float ss = 0.f;
#pragma unroll
            for (int r = 0; r < 16; ++r) ss += oT[ib][r] * oT[ib][r];
            ss += __shfl_xor(ss, 32);
            if (hi == 0) rp[wave * 64 + 32 * ib + r32] = ss; }
        __syncthreads();
#pragma unroll
        for (int ib = 0; ib < 2; ++ib) { float tot = 0.f;
#pragma unroll
            for (int w = 0; w < 8; ++w) tot += rp[w * 64 + 32 * ib + r32];
            const float rstd = 1.0f / sqrtf(tot * (1.0f / 256.0f) + EPS);
            const int t = t0 + 32 * ib + r32;
            const bf16* rrow = PQ + (size_t)t * 3072 + 2048 + h * 256 + 32 * wave + 4 * hi; bf16* orow = OG + (size_t)t * DMODEL + h * 256 + 32 * wave + 4 * hi;
#pragma unroll
            for (int g = 0; g < 4; ++g) { const v2u rw = *(const GAS v2u*)(rrow + 8 * g); const f32x4 gg = *(const f32x4*)(go + 8 * g + 4 * hi);
                float rv[4] = {bflo(rw.x), bfhi(rw.x), bflo(rw.y), bfhi(rw.y)}; float ov[4];
#pragma unroll
                for (int e = 0; e < 4; ++e) { const float sl = rv[e] / (1.0f + __expf(-rv[e])); ov[e] = oT[ib][4 * g + e] * rstd * gg[e] * sl; }
                *(GAS v2u*)(orow + 8 * g) = (v2u){pk2(ov[0], ov[1]), pk2(ov[2], ov[3])}; } }
    }
}
__device__ __forceinline__ unsigned mono(float f) { const unsigned u = __builtin_bit_cast(unsigned, f); return (u & 0x80000000u) ? ~u : (u | 0x80000000u); }
__device__ __forceinline__ float unmono(unsigned m) { const unsigned u = (m & 0x80000000u) ? (m ^ 0x80000000u) : ~m; return __builtin_bit_cast(float, u); }
#define KMAX(a, b) ((a) > (b) ? (a) : (b))
#define KMIN(a, b) ((a) < (b) ? (a) : (b))
#define INSERT16(L, x) do { unsigned x_ = (x); _Pragma("unroll") for (int p_ = 0; p_ < 16; ++p_) { const unsigned t_ = KMAX(L[p_], x_); x_ = KMIN(L[p_], x_); L[p_] = t_; } } while (0)
#define MERGE16(L, O) do { _Pragma("unroll") for (int p_ = 0; p_ < 16; ++p_) L[p_] = KMAX(L[p_], O[15 - p_]); \
    _Pragma("unroll") for (int st_ = 8; st_ >= 1; st_ >>= 1) { _Pragma("unroll") for (int p_ = 0; p_ < 16; ++p_) { if ((p_ & st_) == 0) { const unsigned a_ = L[p_], b_ = L[p_ + st_]; L[p_] = KMAX(a_, b_); L[p_ + st_] = KMIN(a_, b_); } } } } while (0)
__device__ __forceinline__ void p5_tile(Frame& F, const LAS float* tile, int tok0, int* ids, float* gates) {
    const int lane = F.lane, wave = F.wave;
    const int q = lane & 3, c = (lane >> 2) & 1, head = lane >> 3, r8 = lane & 7;
    const LAS float* row = tile + wave * 2048;
    const LAS float* mine = row + lane * 32;
    unsigned L[16];
#pragma unroll
    for (int p = 0; p < 16; ++p) L[p] = 0u;
    const int sw = (lane >> 1) & 7;
#pragma unroll
    for (int it = 0; it < 8; ++it) { const int c16 = it ^ sw; const f32x4 v = *(const LAS f32x4*)(mine + 4 * c16);
#pragma unroll
        for (int e = 0; e < 4; ++e) { const int idx = q * 32 + c16 * 4 + e; const unsigned key = (mono(v[e]) & ~127u) | (unsigned)(127 - idx); INSERT16(L, key); } }
    unsigned O[16];
#pragma unroll
    for (int p = 0; p < 16; ++p) O[p] = __shfl_xor(L[p], 1);
    MERGE16(L, O);
#pragma unroll
    for (int p = 0; p < 16; ++p) O[p] = __shfl_xor(L[p], 2);
    MERGE16(L, O);
#pragma unroll
    for (int p = 0; p < 16; ++p) O[p] = __shfl_xor(L[p], 4);
    unsigned A[16], B[16];
#pragma unroll
    for (int p = 0; p < 16; ++p) { A[p] = c ? O[p] : L[p]; B[p] = c ? L[p] : O[p]; }
    unsigned ka = A[0], kb8 = A[8];
#pragma unroll
    for (int p = 1; p < 8; ++p) { ka = (r8 == p) ? A[p] : ka; kb8 = (r8 == p) ? A[8 + p] : kb8; }
    const float va = unmono(ka & ~127u), va8 = unmono(kb8 & ~127u);
    const unsigned pa = ((127u - (ka & 127u)) << 7), pa8 = ((127u - (kb8 & 127u)) << 7);
    const int nvalid = 16 / (r8 + 1);
    unsigned Cn[16];
#pragma unroll
    for (int j = 0; j < 16; ++j) { const float vb = unmono(B[j] & ~127u); const unsigned pb = 127u - (B[j] & 127u);
        const unsigned key = (mono(va + vb) & ~16383u) | pa | pb; Cn[j] = (j < nvalid) ? key : 0u; }
    { const float vb0 = unmono(B[0] & ~127u); const unsigned pb0 = 127u - (B[0] & 127u); const unsigned key = (mono(va8 + vb0) & ~16383u) | pa8 | pb0; INSERT16(Cn, key); }
#pragma unroll
    for (int p = 0; p < 16; ++p) O[p] = __shfl_xor(Cn[p], 1);
    MERGE16(Cn, O);
#pragma unroll
    for (int p = 0; p < 16; ++p) O[p] = __shfl_xor(Cn[p], 2);
    MERGE16(Cn, O);
#pragma unroll
    for (int p = 0; p < 16; ++p) O[p] = __shfl_xor(Cn[p], 4);
    MERGE16(Cn, O);
    unsigned k0 = Cn[0], k1 = Cn[8];
#pragma unroll
    for (int p = 1; p < 8; ++p) { k0 = (r8 == p) ? Cn[p] : k0; k1 = (r8 == p) ? Cn[8 + p] : k1; }
    const int ia0 = (k0 >> 7) & 127, ib0 = k0 & 127, ia1 = (k1 >> 7) & 127, ib1 = k1 & 127;
    const LAS float* hrow = row + head * 256;
    const float s0 = hrow[ia0] + hrow[128 + ib0], s1 = hrow[ia1] + hrow[128 + ib1];
    float mx = fmaxf(s0, s1);
    mx = fmaxf(mx, __shfl_xor(mx, 1)); mx = fmaxf(mx, __shfl_xor(mx, 2)); mx = fmaxf(mx, __shfl_xor(mx, 4));
    const float e0 = __expf(s0 - mx), e1 = __expf(s1 - mx);
    float sm = e0 + e1;
    sm += __shfl_xor(sm, 1); sm += __shfl_xor(sm, 2); sm += __shfl_xor(sm, 4);
    const float inv = 1.0f / sm;
    const size_t o = (size_t)(tok0 + wave) * PEER_SEL + head * 16 + r8;
    ids[o] = ia0 * 128 + ib0; ids[o + 8] = ia1 * 128 + ib1; gates[o] = e0 * inv; gates[o + 8] = e1 * inv;
}
__device__ __forceinline__ void p5_topk(Frame& F) {
    const float* SC = (const float*)(F.ws + WS_SC); int* ids = (int*)(F.ws + WS_IDS); float* gates = (float*)(F.ws + WS_GATES);
    LAS float* tile = (LAS float*)F.lds;
    for (int g = blockIdx.x; g < T_TOK / 8; g += F.G) {
        const f32x4* src = (const f32x4*)(SC + (size_t)g * 8 * 2048);
#pragma unroll
        for (int i = 0; i < 8; ++i) { const f32x4 v = src[F.tid + 512 * i]; *(LAS f32x4*)(tile + 4 * (F.tid + 512 * i)) = v; }
        __syncthreads();
        p5_tile(F, tile, g * 8, ids, gates);
        __syncthreads();
    }
}

template <bool FINAL>
__device__ __forceinline__ void peer_gather(Frame& F, int layer) {
    const int lane = F.lane; const int gw = blockIdx.x * NWAVES + F.wave, NGW = F.G * NWAVES;
    const bf16* UT = (const bf16*)(F.ws + WS_TAB) + (size_t)(2 * layer) * PEER_NEXP * DMODEL; const bf16* VT = UT + (size_t)PEER_NEXP * DMODEL;
    const int* ids = (const int*)(F.ws + WS_IDS); const float* gates = (const float*)(F.ws + WS_GATES);
    const float* gf = F.in[IN_NORM_FFN] + layer * DMODEL; const float* gfin = F.in[IN_NORM_FINAL];
    float* H = F.out; bf16* HB = (bf16*)(F.ws + WS_HB); float* RP = (float*)(F.ws + WS_RP);
    float gfa[8], gfb[8];
    { const f32x4* g4 = (const f32x4*)gf + 2 * lane; const f32x4 a0 = g4[0], a1 = g4[1], b0 = g4[128], b1 = g4[129];
#pragma unroll
      for (int e = 0; e < 4; ++e) { gfa[e] = a0[e]; gfa[4 + e] = a1[e]; gfb[e] = b0[e]; gfb[4 + e] = b1[e]; } }
    for (int t = gw; t < T_TOK; t += NGW) {
        f32x4* hrow = (f32x4*)(H + (size_t)t * DMODEL) + 2 * lane;
        float ha[8], hb[8];
        { const f32x4 a0 = hrow[0], a1 = hrow[1], b0 = hrow[128], b1 = hrow[129];
#pragma unroll
          for (int e = 0; e < 4; ++e) { ha[e] = a0[e]; ha[4 + e] = a1[e]; hb[e] = b0[e]; hb[4 + e] = b1[e]; } }
        float ss = 0.f;
#pragma unroll
        for (int e = 0; e < 8; ++e) ss += ha[e] * ha[e] + hb[e] * hb[e];
        const float rstd = 1.0f / sqrtf(wave_sum(ss) * (1.0f / DMODEL) + EPS);
        float xa[8], xb[8], acca[8], accb[8];
#pragma unroll
        for (int e = 0; e < 8; ++e) { xa[e] = ha[e] * rstd * gfa[e]; xb[e] = hb[e] * rstd * gfb[e]; acca[e] = 0.f; accb[e] = 0.f; }
        const int id0 = ids[(size_t)t * PEER_SEL + lane], id1 = ids[(size_t)t * PEER_SEL + 64 + lane];
        const float gt0 = gates[(size_t)t * PEER_SEL + lane], gt1 = gates[(size_t)t * PEER_SEL + 64 + lane];
        for (int bt = 0; bt < 16; ++bt) {
            const int idv = (bt < 8) ? id0 : id1; const float gtv = (bt < 8) ? gt0 : gt1; const int lbase = (bt & 7) * 8;
            v4u ua[8], ub[8], va[8], vb[8];
#pragma unroll
            for (int j = 0; j < 8; ++j) { const int e = __builtin_amdgcn_readlane(idv, lbase + j);
                const GAS v4u* up = (const GAS v4u*)(UT + (size_t)e * DMODEL) + lane; ua[j] = up[0]; ub[j] = up[64]; }
#pragma unroll
            for (int j = 0; j < 8; ++j) { const int e = __builtin_amdgcn_readlane(idv, lbase + j);
                const GAS v4u* vp = (const GAS v4u*)(VT + (size_t)e * DMODEL) + lane; va[j] = vp[0]; vb[j] = vp[64]; }
            float p[8];
#pragma unroll
            for (int j = 0; j < 8; ++j) { float s = 0.f;
                s += bflo(ua[j].x) * xa[0] + bfhi(ua[j].x) * xa[1]; s += bflo(ua[j].y) * xa[2] + bfhi(ua[j].y) * xa[3]; s += bflo(ua[j].z) * xa[4] + bfhi(ua[j].z) * xa[5]; s += bflo(ua[j].w) * xa[6] + bfhi(ua[j].w) * xa[7];
                s += bflo(ub[j].x) * xb[0] + bfhi(ub[j].x) * xb[1]; s += bflo(ub[j].y) * xb[2] + bfhi(ub[j].y) * xb[3]; s += bflo(ub[j].z) * xb[4] + bfhi(ub[j].z) * xb[5]; s += bflo(ub[j].w) * xb[6] + bfhi(ub[j].w) * xb[7];
                p[j] = s; }
            float r4[4], r2[2], r1;
            { const bool up = (lane & 32) != 0;
#pragma unroll
              for (int j = 0; j < 4; ++j) { const float keep = up ? p[j + 4] : p[j], send = up ? p[j] : p[j + 4]; r4[j] = keep + __shfl_xor(send, 32); } }
            { const bool up = (lane & 16) != 0;
#pragma unroll
              for (int j = 0; j < 2; ++j) { const float keep = up ? r4[j + 2] : r4[j], send = up ? r4[j] : r4[j + 2]; r2[j] = keep + __shfl_xor(send, 16); } }
            { const bool up = (lane & 8) != 0; const float keep = up ? r2[1] : r2[0], send = up ? r2[0] : r2[1]; r1 = keep + __shfl_xor(send, 8); }
            r1 += __shfl_xor(r1, 4); r1 += __shfl_xor(r1, 2); r1 += __shfl_xor(r1, 1);
            const int jl = 4 * ((lane >> 5) & 1) + 2 * ((lane >> 4) & 1) + ((lane >> 3) & 1);
            const float gte = __shfl(gtv, lbase + jl);
            const float act = 0.5f * r1 * (1.0f + erff(r1 * 0.70710678118654752f)) * gte;
#pragma unroll
            for (int j = 0; j < 8; ++j) { const float w = __builtin_bit_cast(float, __builtin_amdgcn_readlane(__builtin_bit_cast(int, act), 32 * ((j >> 2) & 1) + 16 * ((j >> 1) & 1) + 8 * (j & 1)));
                acca[0] += w * bflo(va[j].x); acca[1] += w * bfhi(va[j].x); acca[2] += w * bflo(va[j].y); acca[3] += w * bfhi(va[j].y); acca[4] += w * bflo(va[j].z); acca[5] += w * bfhi(va[j].z); acca[6] += w * bflo(va[j].w); acca[7] += w * bfhi(va[j].w);
                accb[0] += w * bflo(vb[j].x); accb[1] += w * bfhi(vb[j].x); accb[2] += w * bflo(vb[j].y); accb[3] += w * bfhi(vb[j].y); accb[4] += w * bflo(vb[j].z); accb[5] += w * bfhi(vb[j].z); accb[6] += w * bflo(vb[j].w); accb[7] += w * bfhi(vb[j].w); }
        }
        float s2 = 0.f;
#pragma unroll
        for (int e = 0; e < 8; ++e) { ha[e] += acca[e]; hb[e] += accb[e]; s2 += ha[e] * ha[e] + hb[e] * hb[e]; }
        s2 = wave_sum(s2);
        if (FINAL) {
            const float rs = 1.0f / sqrtf(s2 * (1.0f / DMODEL) + EPS);
            const f32x4* g4 = (const f32x4*)gfin + 2 * lane; const f32x4 a0 = g4[0], a1 = g4[1], b0 = g4[128], b1 = g4[129];
            hrow[0] = (f32x4){ha[0] * rs * a0[0], ha[1] * rs * a0[1], ha[2] * rs * a0[2], ha[3] * rs * a0[3]}; hrow[1] = (f32x4){ha[4] * rs * a1[0], ha[5] * rs * a1[1], ha[6] * rs * a1[2], ha[7] * rs * a1[3]};
            hrow[128] = (f32x4){hb[0] * rs * b0[0], hb[1] * rs * b0[1], hb[2] * rs * b0[2], hb[3] * rs * b0[3]}; hrow[129] = (f32x4){hb[4] * rs * b1[0], hb[5] * rs * b1[1], hb[6] * rs * b1[2], hb[7] * rs * b1[3]};
        } else {
            hrow[0] = (f32x4){ha[0], ha[1], ha[2], ha[3]}; hrow[1] = (f32x4){ha[4], ha[5], ha[6], ha[7]}; hrow[128] = (f32x4){hb[0], hb[1], hb[2], hb[3]}; hrow[129] = (f32x4){hb[4], hb[5], hb[6], hb[7]};
            GAS v4u* hbp = (GAS v4u*)(HB + (size_t)t * DMODEL) + lane;
            hbp[0] = (v4u){pk2(ha[0], ha[1]), pk2(ha[2], ha[3]), pk2(ha[4], ha[5]), pk2(ha[6], ha[7])}; hbp[64] = (v4u){pk2(hb[0], hb[1]), pk2(hb[2], hb[3]), pk2(hb[4], hb[5]), pk2(hb[6], hb[7])};
            if (lane < 16) RP[(size_t)t * 16 + lane] = (lane == 0) ? s2 : 0.f;
        }
    }
}

__device__ __forceinline__ void p7_forget_logits(Frame& F) {
    if (F.wave < 4) {
        const int rows0 = blockIdx.x * 64;
        for (int r0 = rows0; r0 < T_TOK; r0 += F.G * 64) {
            const f32x4 a = skinny16((const bf16*)(F.ws + WS_HB) + (size_t)r0 * DMODEL, (const bf16*)(F.ws + WS_WFL), F.wave, F.lane);
#pragma unroll
            for (int r = 0; r < 4; ++r) { const int row = r0 + 16 * F.wave + 4 * (F.lane >> 4) + r; const float rs = pg8::row_rstd((const float*)(F.ws + WS_RP), row);
                ((float*)(F.ws + WS_FL))[(size_t)row * 16 + (F.lane & 15)] = a[r] * rs; } }
    }
}
__device__ __forceinline__ void p9_key_bias(Frame& F, int bh, LAS float* cbL, LAS float* scr  ) {
    const int b = bh >> 4, hd = bh & 15, tid = F.tid;
    const float* FL = (const float*)(F.ws + WS_FL) + (size_t)b * SEQ * 16 + hd; const float bf = F.in[IN_FOX_B_F][hd];
    float v[4];
#pragma unroll
    for (int e = 0; e < 4; ++e) v[e] = log_sigmoid(FL[(size_t)(4 * tid + e) * 16] + bf);
    v[1] += v[0]; v[2] += v[1]; v[3] += v[2];
    float inc = v[3];
#pragma unroll
    for (int o = 1; o < 64; o <<= 1) { const float y = __shfl_up(inc, o); if (F.lane >= o) inc += y; }
    if (F.lane == 63) scr[F.wave] = inc;
    __syncthreads();
    float woff = 0.f;
#pragma unroll
    for (int w = 0; w < 8; ++w) { const float sv = scr[w]; if (w < F.wave) woff += sv; }
    const float excl = woff + inc - v[3];
    *(LAS f32x4*)(cbL + 4 * tid) = (f32x4){-L2E * (excl + v[0]), -L2E * (excl + v[1]), -L2E * (excl + v[2]), -L2E * (excl + v[3])};
    __syncthreads();
}
constexpr int N_PHASES = 14;
#ifndef MK_PER_PHASE
#define MK_PER_PHASE 0
#endif
struct Args { const float* in[18]; float* out; unsigned char* ws; int ph_lo, ph_hi; };
__global__ void __launch_bounds__(NWAVES * 64, 2) yoco_fwd(Args args) {
    extern __shared__ __attribute__((aligned(16))) unsigned char lds[];
    Frame F;
    F.lds = (LAS unsigned char*)lds;
    F.MISC = (volatile LAS unsigned*)(F.lds + MISC_OFF);
    F.tid = threadIdx.x; F.lane = F.tid & 63; F.wave = __builtin_amdgcn_readfirstlane(F.tid >> 6);
    F.G = gridDim.x; { const int bx = blockIdx.x; F.vcu = (F.G % 8 == 0) ? (bx % 8) * (F.G / 8) + bx / 8 : bx; }
    F.ws = args.ws; F.ctl = (gu32*)(args.ws + WS_CTL); F.out = args.out;
#pragma unroll
    for (int i = 0; i < 18; ++i) F.in[i] = args.in[i];
    for (int u = F.tid; u < (LDS_BYTES - LDSCTL_OFF) / 4; u += NWAVES * 64) ((LAS unsigned*)(F.lds + LDSCTL_OFF))[u] = 0u;
    __syncthreads();
    XcdBarrier bar; bar.bar = (unsigned*)(F.ctl + CW_BAR); bar.x = 0; bar.st = nullptr;
    if (!MK_PER_PHASE) bar = xcd_barrier_post((unsigned*)(F.ctl + CW_BAR), F.MISC + 8);
    const int lo = args.ph_lo, hi = args.ph_hi;
#ifndef PHASE_OFF
#define PHASE_OFF 0
#endif
#define IN(k) (lo <= (k) && (k) < hi && !((PHASE_OFF >> (k)) & 1))
#define SEAM(k) do { if (IN(k) && IN((k) + 1)) xcd_barrier(bar); } while (0)
    bf16* const A0 = (bf16*)(F.ws + WS_A0); bf16* const HB = (bf16*)(F.ws + WS_HB); bf16* const PQ = (bf16*)(F.ws + WS_PQ);
    float* const RP = (float*)(F.ws + WS_RP); float* const SC = (float*)(F.ws + WS_SC);

    if (IN(0)) { p0_prologue(F); } SEAM(0);
    if (IN(1)) { pg8::Gemm g{A0, (const bf16*)(F.ws + WS_WIN), T_TOK, 3072, DMODEL}; pg8::StaticOrder S; S.init(T_TOK, 3072, F.G, (int)blockIdx.x);
        pg8::EpiBf16RS E{PQ, 3072, 0, 0, 1.f, nullptr};
        pg8::gemm_phase<pg8::EpiBf16RS, pg8::StaticOrder, true, true>(F.lds, g, S, E); } SEAM(1);
    if (IN(2)) { for (int c = blockIdx.x * 4; c < NCHUNK; c += F.G * 4) for (int j = 0; j < 4; ++j) p2a_item(F, c + j); } SEAM(2);
    if (IN(3)) { if ((int)blockIdx.x < NB * GLA_H) p2b_seq(F, blockIdx.x); } SEAM(3);
    if (IN(4)) { pg8::Gemm g{A0, (const bf16*)(F.ws + WS_WGO), T_TOK, DMODEL, DMODEL}; pg8::StaticOrder S; S.init(T_TOK, DMODEL, F.G, (int)blockIdx.x);
        pg8::EpiResid E{F.in[IN_X], F.out, HB, RP, DMODEL};
        pg8::gemm_phase<pg8::EpiResid, pg8::StaticOrder, false, true>(F.lds, g, S, E); } SEAM(4);
    if (IN(5)) { pg8::Gemm g{HB, (const bf16*)(F.ws + WS_WEFF), T_TOK, 2048, DMODEL}; pg8::StaticOrder S; S.init(T_TOK, 2048, F.G, (int)blockIdx.x);
        pg8::EpiF32RS E{SC, 2048, RP};
        pg8::gemm_phase<pg8::EpiF32RS, pg8::StaticOrder, true, true>(F.lds, g, S, E); } SEAM(5);
    if (IN(6)) { p5_topk(F); } SEAM(6);
    if (IN(7)) { peer_gather<false>(F, 0); } SEAM(7);
    if (IN(8)) { p7_forget_logits(F);
        pg8::Gemm g{HB, (const bf16*)(F.ws + WS_WQKV), T_TOK, 3072, DMODEL}; pg8::StaticOrder S; S.init(T_TOK, 3072, F.G, (int)blockIdx.x);
        pg8::EpiBf16RS E{PQ, DMODEL, DMODEL, (size_t)T_TOK * DMODEL, attn_body::C2, RP};
        pg8::gemm_phase<pg8::EpiBf16RS, pg8::StaticOrder, true, true>(F.lds, g, S, E); } SEAM(8);
    if (IN(9)) { p9_key_bias(F, F.vcu >> 1, (LAS float*)(F.lds + attn_body::LDS_CB), (LAS float*)(F.lds + attn_body::LDS_TOTAL));
        const attn_body::AttnTensors AT{(const attn_body::bf16*)PQ, (const attn_body::bf16*)(PQ + (size_t)T_TOK * DMODEL), (const attn_body::bf16*)(PQ + 2 * (size_t)T_TOK * DMODEL), (attn_body::bf16*)PQ};
        const attn_body::StaticOrder S((int)F.G, (int)blockIdx.x);
        attn_body::attn_phase<attn_body::StaticOrder>((char*)lds, AT, S); } SEAM(9);
    if (IN(10)) { pg8::Gemm g{PQ, (const bf16*)(F.ws + WS_WFO), T_TOK, DMODEL, DMODEL}; pg8::StaticOrder S; S.init(T_TOK, DMODEL, F.G, (int)blockIdx.x);
        pg8::EpiResid E{F.out, F.out, HB, RP, DMODEL};
        pg8::gemm_phase<pg8::EpiResid, pg8::StaticOrder, false, true>(F.lds, g, S, E); } SEAM(10);
    if (IN(11)) { pg8::Gemm g{HB, (const bf16*)(F.ws + WS_WEFF) + (size_t)2048 * DMODEL, T_TOK, 2048, DMODEL}; pg8::StaticOrder S; S.init(T_TOK, 2048, F.G, (int)blockIdx.x);
        pg8::EpiF32RS E{SC, 2048, RP};
        pg8::gemm_phase<pg8::EpiF32RS, pg8::StaticOrder, true, true>(F.lds, g, S, E); } SEAM(11);
    if (IN(12)) { p5_topk(F); } SEAM(12);
    if (IN(13)) { peer_gather<true>(F, 1); }
#undef IN
#undef SEAM
}

extern "C" void kernel_launch(void* const* d_in, const int* in_sizes, int n_in, void* d_out, int out_size, void* d_ws, size_t ws_size, hipStream_t stream) {
    static int grid = 0;
    if (grid == 0) {
        if (n_in != 18 || in_sizes[0] != T_TOK * DMODEL || out_size != T_TOK * DMODEL || ws_size < WS_END) { fprintf(stderr, "kernel_launch: unexpected shapes (n_in %d, in0 %d, out %d, ws %zu); nothing launched\n", n_in, n_in > 0 ? in_sizes[0] : -1, out_size, ws_size); grid = -1; return; }
        int dev = 0, cus = 0;
        if (hipGetDevice(&dev) != hipSuccess || hipDeviceGetAttribute(&cus, hipDeviceAttributeMultiprocessorCount, dev) != hipSuccess) { grid = -1; return; }
        if (hipFuncSetAttribute((const void*)yoco_fwd, hipFuncAttributeMaxDynamicSharedMemorySize, LDS_BYTES) != hipSuccess) { fprintf(stderr, "kernel_launch: hipFuncSetAttribute failed\n"); grid = -1; return; }
        (void)hipGetLastError();
        grid = cus;
        if (grid != 256) { fprintf(stderr, "kernel_launch: built for a 256-CU device, found %d; nothing launched\n", cus); grid = -1; return; }
    }
    if (grid < 0) return;
    if (hipMemsetAsync((char*)d_ws + WS_CTL, 0, CTL_ZERO_BYTES, stream) != hipSuccess) return;
    Args a{};
    for (int i = 0; i < 18; ++i) a.in[i] = (const float*)d_in[i];
    a.out = (float*)d_out; a.ws = (unsigned char*)d_ws;
#if MK_PER_PHASE
    for (int p = 0; p < N_PHASES; ++p) { a.ph_lo = p; a.ph_hi = p + 1; hipLaunchKernelGGL(yoco_fwd, dim3(grid), dim3(NWAVES * 64), LDS_BYTES, stream, a); }
#else
    a.ph_lo = 0; a.ph_hi = N_PHASES; hipLaunchKernelGGL(yoco_fwd, dim3(grid), dim3(NWAVES * 64), LDS_BYTES, stream, a);
#endif
}
```

```cpp
#define NSLICE_LOG 0
#define VCH 32
#define TWO_STAGE 0
#include <hip/hip_runtime.h>
#include <cstdio>
#include <cstdint>
namespace pg8 {
#define PG8_LAS __attribute__((address_space(3)))
typedef unsigned short bf16_t;
typedef short bf16x8 __attribute__((ext_vector_type(8)));
typedef float f32x4 __attribute__((ext_vector_type(4)));
typedef unsigned u32x4 __attribute__((ext_vector_type(4)));
constexpr int BM = 256, BK = 64, HALF = 128, HTB = HALF * BK * 2  , STAGE_BYTES = 8 * HTB, NXCD = 8, WGM = 8;

__host__ __device__ __forceinline__ int lds_byte(int r, int c) { const int st = (r >> 4) * 2 + (c >> 5), rr = r & 15, cc = c & 31, ob = rr * 64 + cc * 2; return st * 1024 + (ob ^ (((ob >> 9) & 1) << 5)); }
__host__ __device__ __forceinline__ void stage_rc(int b, int& R, int& C) { const int st = b / 1024, sb = b % 1024, swz = sb ^ (((sb >> 9) & 1) << 5); R = (st >> 1) * 16 + swz / 64; C = (st & 1) * 32 + (swz % 64) / 2; }
__host__ __device__ __forceinline__ int perm32(int rho) { const int n = rho >> 4, i = rho & 15; return 8 * (i >> 2) + 4 * n + (i & 3); }

struct Unit { int pm, pn; };
struct Gemm { const bf16_t* A; const bf16_t* Bt; int M, N, K; };

struct StaticOrder {
    int nM, nN, nwg, G, c;
    __host__ __device__ void init(int M, int N, int G_, int c_) { nM = M / BM; nN = N / BM; nwg = nM * nN; G = G_; c = c_; }
    __host__ __device__ bool next(int i, Unit& u) const {
        const long L = (long)i * G + c; if (L >= nwg) return false;
        int wgid = (int)L; { const int q = nwg / NXCD, r = nwg % NXCD, xcd = wgid % NXCD, off = wgid / NXCD; wgid = (xcd < r ? xcd * (q + 1) : r * (q + 1) + (xcd - r) * q) + off; }
        const int nig = WGM * nN, gid = wgid / nig, fm = gid * WGM, gsz = (nM - fm) < WGM ? (nM - fm) : WGM;
        u.pm = fm + ((wgid % nig) % gsz); u.pn = (wgid % nig) / gsz; return true;
    }
    __device__ __forceinline__ void a_ready(const Unit&) const {}
    __device__ __forceinline__ void done(const Unit&) const {}
};

__device__ __forceinline__ unsigned cvt_pk_bf16(float lo, float hi) { unsigned r; asm volatile("v_cvt_pk_bf16_f32 %0, %1, %2" : "=v"(r) : "v"(lo), "v"(hi)); return r; }
typedef unsigned u32x2 __attribute__((ext_vector_type(2)));
constexpr float RMS_EPS = 1e-6f;
__device__ __forceinline__ float row_rstd(const float* rowpart, int row) {
    const f32x4* p = (const f32x4*)(rowpart + (size_t)row * 16);
    const f32x4 a = p[0], b = p[1], c = p[2], d = p[3];
    const float s = (((a[0] + a[1]) + (a[2] + a[3])) + ((b[0] + b[1]) + (b[2] + b[3]))) + (((c[0] + c[1]) + (c[2] + c[3])) + ((d[0] + d[1]) + (d[2] + d[3])));
    return 1.0f / sqrtf(s * (1.0f / 1024.0f) + RMS_EPS);
}
struct EpiBf16RS {
    static constexpr bool PERM = true, AFTER_DRAIN = false;
    bf16_t* O; int ldc; int split_cols; size_t split_stride; float scale0; const PG8_LAS float* rs_tab; int pm0, pm1;
    const float* gate_w; int gate_col0;
    __device__ __forceinline__ void operator()(const f32x4 (&acc)[2][2][4][2], const Unit& u, int wr, int wc, int fr, int fq) const {
        const int row0 = u.pm * BM + wr * 64 + fr; int colt = u.pn * BM; bf16_t* base = O;
        float sc = 1.f; if (split_cols) { const int t = colt / split_cols; base += (size_t)t * split_stride; colt -= t * split_cols; if (t == 0) sc = scale0; }
        const int col0 = colt + wc * 32 + 8 * fq;
#pragma unroll
        for (int ai = 0; ai < 2; ++ai)
#pragma unroll
            for (int m = 0; m < 4; ++m) { const int row = row0 + ai * HALF + m * 16; const float rs = rs_tab ? sc * rs_tab[((u.pm == pm0) ? 0 : (u.pm == pm1) ? 256 : 512) + (row & 255)] : sc;
                bf16_t* rowp = base + (size_t)row * ldc + col0;
#pragma unroll
                for (int bj = 0; bj < 2; ++bj) { f32x4 v0 = acc[ai][bj][m][0] * rs, v1 = acc[ai][bj][m][1] * rs;
                    if (gate_w && colt >= gate_col0) { const f32x4 g0 = *(const f32x4*)(gate_w + col0 - gate_col0 + bj * HALF), g1 = *(const f32x4*)(gate_w + col0 - gate_col0 + bj * HALF + 4);
#pragma unroll
                        for (int e_ = 0; e_ < 4; ++e_) { v0[e_] = v0[e_] * __builtin_amdgcn_rcpf(1.0f + __expf(-v0[e_])) * g0[e_]; v1[e_] = v1[e_] * __builtin_amdgcn_rcpf(1.0f + __expf(-v1[e_])) * g1[e_]; } }
                    u32x4 w; w.x = cvt_pk_bf16(v0[0], v0[1]); w.y = cvt_pk_bf16(v0[2], v0[3]); w.z = cvt_pk_bf16(v1[0], v1[1]); w.w = cvt_pk_bf16(v1[2], v1[3]);
                    *(u32x4*)(rowp + bj * HALF) = w; } }
    }
};
struct EpiF32RS {
    static constexpr bool PERM = false, AFTER_DRAIN = false;
    float* C; int ldc; const PG8_LAS float* rs_tab; int pm0, pm1;
    __device__ __forceinline__ void operator()(const f32x4 (&acc)[2][2][4][2], const Unit& u, int wr, int wc, int fr, int fq) const {
        const int row0 = u.pm * BM + wr * 64 + fr, col0 = u.pn * BM + wc * 32 + 4 * fq;
#pragma unroll
        for (int ai = 0; ai < 2; ++ai)
#pragma unroll
            for (int m = 0; m < 4; ++m) { const int row = row0 + ai * HALF + m * 16; const float rs = rs_tab[((u.pm == pm0) ? 0 : (u.pm == pm1) ? 256 : 512) + (row & 255)];
                float* rowp = C + (size_t)row * ldc + col0;
#pragma unroll
                for (int bj = 0; bj < 2; ++bj)
#pragma unroll
                    for (int n = 0; n < 2; ++n) *(f32x4*)(rowp + bj * HALF + n * 16) = acc[ai][bj][m][n] * rs; }
    }
};
template <bool BASE_BF16> struct EpiResid {
    static constexpr bool PERM = false, AFTER_DRAIN = false;
    const float* base; bf16_t* hb; float* rowpart; int ldc;
    __device__ __forceinline__ void operator()(const f32x4 (&acc)[2][2][4][2], const Unit& u, int wr, int wc, int fr, int fq) const {
        const int row0 = u.pm * BM + wr * 64 + fr, col0 = u.pn * BM + wc * 32 + 4 * fq;
#pragma unroll
        for (int ai = 0; ai < 2; ++ai) {
            f32x4 bv[4][2][2];
#pragma unroll
            for (int m = 0; m < 4; ++m) { const size_t off = (size_t)(row0 + ai * HALF + m * 16) * ldc + col0;
#pragma unroll
                for (int bj = 0; bj < 2; ++bj)
#pragma unroll
                    for (int n = 0; n < 2; ++n) {
                        if (BASE_BF16) { const u32x2 bw = *(const u32x2*)(hb + off + bj * HALF + n * 16); bv[m][bj][n] = (f32x4){__builtin_bit_cast(float, bw.x << 16), __builtin_bit_cast(float, bw.x & 0xffff0000u), __builtin_bit_cast(float, bw.y << 16), __builtin_bit_cast(float, bw.y & 0xffff0000u)}; }
                        else bv[m][bj][n] = *(const f32x4*)(base + off + bj * HALF + n * 16); } }
            asm volatile("" ::: "memory");
#pragma unroll
            for (int m = 0; m < 4; ++m) { const int row = row0 + ai * HALF + m * 16; const size_t off = (size_t)row * ldc + col0; float ss = 0.f;
#pragma unroll
                for (int bj = 0; bj < 2; ++bj)
#pragma unroll
                    for (int n = 0; n < 2; ++n) { const f32x4 v = bv[m][bj][n] + acc[ai][bj][m][n];
                        ss += (v[0] * v[0] + v[1] * v[1]) + (v[2] * v[2] + v[3] * v[3]);
                        u32x2 w; w.x = cvt_pk_bf16(v[0], v[1]); w.y = cvt_pk_bf16(v[2], v[3]); *(u32x2*)(hb + off + bj * HALF + n * 16) = w; }
                ss += __shfl_xor(ss, 16); ss += __shfl_xor(ss, 32);
                if (fq == 0) rowpart[(size_t)row * 16 + u.pn * 4 + wc] = ss; } }
    }
};

template <class Epi, class Sched, bool ALIGN_EPI = false, bool SP2 = false>
__device__ __forceinline__ void gemm_phase(PG8_LAS unsigned char* lds, const Gemm g, const Sched& S, const Epi& E) {
    const int tid = threadIdx.x, wid = __builtin_amdgcn_readfirstlane(tid >> 6), lane = tid & 63, wr = wid >> 2, wc = wid & 3, fr = lane & 15, fq = lane >> 4;
    const int K = g.K, nt = K / BK;
    unsigned voffA[2], voffB[2];
#pragma unroll
    for (int i = 0; i < 2; ++i) { int R, C; stage_rc(tid * 16 + i * 8192, R, C); const int Rb = Epi::PERM ? ((R & ~31) + perm32(R & 31)) : R;
        voffA[i] = (unsigned)(R * K + C) * 2u; voffB[i] = (unsigned)(Rb * K + C) * 2u; }
    const size_t kstep = (size_t)(BK * 2);
    const size_t hstep = (size_t)HALF * K * 2;
    const size_t tstep = 2 * hstep;
    const unsigned ldsw = (unsigned)wid * 1024u;
    const int aoff = lds_byte(wr * 64 + fr, fq * 8), boff = lds_byte(wc * 32 + fr, fq * 8);
#define PG8_SA(b, h) (((b) * 2 + (h)) * HTB)
#define PG8_SB(b, h) ((4 + (b) * 2 + (h)) * HTB)
#define PG8_STAGE(bufoff, gbase, voff) do { _Pragma("unroll") for (int _i = 0; _i < 2; ++_i) \
        __builtin_amdgcn_global_load_lds((const unsigned*)((const char*)(gbase) + (voff)[_i]), (PG8_LAS unsigned*)(lds + (bufoff) + ldsw + _i * 8192), 16, 0, 0); } while (0)
#define PG8_LDA(dst, b, h) do { _Pragma("unroll") for (int m = 0; m < 4; ++m) _Pragma("unroll") for (int k = 0; k < 2; ++k) dst[m][k] = *(const PG8_LAS bf16x8*)(lds + PG8_SA(b, h) + aoff + m * 2048 + k * 1024); } while (0)
#define PG8_LDB(dst, b, h) do { _Pragma("unroll") for (int n = 0; n < 2; ++n) _Pragma("unroll") for (int k = 0; k < 2; ++k) dst[n][k] = *(const PG8_LAS bf16x8*)(lds + PG8_SB(b, h) + boff + n * 2048 + k * 1024); } while (0)
#define PG8_MMA(ai, bj, At, Bt) do { __builtin_amdgcn_s_setprio(1); _Pragma("unroll") for (int m = 0; m < 4; ++m) _Pragma("unroll") for (int n = 0; n < 2; ++n) _Pragma("unroll") for (int k = 0; k < 2; ++k) \
        acc[ai][bj][m][n] = __builtin_amdgcn_mfma_f32_16x16x32_bf16(Bt[n][k], At[m][k], acc[ai][bj][m][n], 0, 0, 0); __builtin_amdgcn_s_setprio(0); } while (0)
#define PG8_WAIT_V(n) asm volatile("s_waitcnt vmcnt(" #n ")" ::: "memory")
#define PG8_WAIT_L(n) asm volatile("s_waitcnt lgkmcnt(" #n ")" ::: "memory")
#define PG8_BAR __builtin_amdgcn_s_barrier()
#define PG8_SCHED __builtin_amdgcn_sched_barrier(0)
    Unit cur, nxt; int ui = 0;
    if (!S.next(0, cur)) return;
    f32x4 acc[2][2][4][2];
#pragma unroll
    for (int a = 0; a < 2; ++a)
#pragma unroll
        for (int b = 0; b < 2; ++b)
#pragma unroll
            for (int m = 0; m < 4; ++m)
#pragma unroll
                for (int n = 0; n < 2; ++n) acc[a][b][m][n] = (f32x4){0.f, 0.f, 0.f, 0.f};
    bf16x8 At[4][2], B0[2][2], B1[2][2];
    const char* cA = (const char*)g.A + (size_t)cur.pm * tstep; const char* cB = (const char*)g.Bt + (size_t)cur.pn * tstep;
    S.a_ready(cur);
    if constexpr (SP2) {
        PG8_STAGE(PG8_SB(0, 0), cB, voffB); PG8_STAGE(PG8_SB(0, 1), cB + hstep, voffB); PG8_STAGE(PG8_SA(0, 0), cA, voffA); PG8_STAGE(PG8_SA(0, 1), cA + hstep, voffA);
        if (wr == 1) PG8_BAR;
        PG8_WAIT_V(2); PG8_BAR;
        PG8_STAGE(PG8_SB(1, 0), cB + kstep, voffB); PG8_STAGE(PG8_SA(1, 0), cA + kstep, voffA); PG8_STAGE(PG8_SB(1, 1), cB + hstep + kstep, voffB);
        PG8_WAIT_V(6); PG8_BAR;
    } else {
        PG8_STAGE(PG8_SB(0, 0), cB, voffB); PG8_STAGE(PG8_SA(0, 0), cA, voffA); PG8_STAGE(PG8_SB(0, 1), cB + hstep, voffB); PG8_STAGE(PG8_SA(0, 1), cA + hstep, voffA);
        if (wr == 1) PG8_BAR;
        PG8_WAIT_V(4); PG8_BAR;
        PG8_STAGE(PG8_SB(1, 0), cB + kstep, voffB); PG8_STAGE(PG8_SA(1, 0), cA + kstep, voffA); PG8_STAGE(PG8_SB(1, 1), cB + hstep + kstep, voffB);
        PG8_WAIT_V(6); PG8_BAR;
    }
    for (;;) {
        const bool has_next = S.next(ui + 1, nxt);
        const char* nA = has_next ? (const char*)g.A + (size_t)nxt.pm * tstep : cA; const char* nB = has_next ? (const char*)g.Bt + (size_t)nxt.pn * tstep : cB;
        for (int t = 0; t < nt; t += 2) {
            const bool last = (t == nt - 2);
            const char* a1 = cA + (size_t)(t + 1) * kstep;
            const char* a2 = last ? nA : cA + (size_t)(t + 2) * kstep; const char* b2 = last ? nB : cB + (size_t)(t + 2) * kstep;
            const char* a3 = a2 + kstep; const char* b3 = b2 + kstep;
            if (last && has_next) S.a_ready(nxt);
            if constexpr (SP2) {
            PG8_LDB(B0, 0, 0); PG8_LDB(B1, 0, 1); PG8_SCHED; PG8_LDA(At, 0, 0); PG8_STAGE(PG8_SA(1, 1), a1 + hstep, voffA);
            PG8_WAIT_V(8); PG8_WAIT_L(0); PG8_BAR; PG8_MMA(0, 0, At, B0); PG8_MMA(0, 1, At, B1); PG8_BAR; PG8_SCHED;
            PG8_LDA(At, 0, 1); PG8_STAGE(PG8_SB(0, 0), b2, voffB); PG8_STAGE(PG8_SB(0, 1), b2 + hstep, voffB); PG8_STAGE(PG8_SA(0, 0), a2, voffA);
            PG8_WAIT_V(8); PG8_WAIT_L(0); PG8_BAR; PG8_MMA(1, 0, At, B0); PG8_MMA(1, 1, At, B1); PG8_BAR; PG8_SCHED;
            PG8_LDB(B0, 1, 0); PG8_LDB(B1, 1, 1); PG8_SCHED; PG8_LDA(At, 1, 0); PG8_STAGE(PG8_SA(0, 1), a2 + hstep, voffA);
            PG8_WAIT_V(8); PG8_WAIT_L(0); PG8_BAR; PG8_MMA(0, 0, At, B0); PG8_MMA(0, 1, At, B1); PG8_BAR; PG8_SCHED;
            PG8_LDA(At, 1, 1); PG8_STAGE(PG8_SB(1, 0), b3, voffB); PG8_STAGE(PG8_SB(1, 1), b3 + hstep, voffB); PG8_STAGE(PG8_SA(1, 0), a3, voffA);
            PG8_WAIT_V(8); PG8_WAIT_L(0); PG8_BAR; PG8_MMA(1, 0, At, B0); PG8_MMA(1, 1, At, B1); PG8_BAR; PG8_SCHED;
            } else {
            PG8_LDB(B0, 0, 0); PG8_SCHED; PG8_LDA(At, 0, 0); PG8_STAGE(PG8_SA(1, 1), a1 + hstep, voffA);
            PG8_WAIT_L(8); PG8_BAR; PG8_WAIT_L(0); PG8_MMA(0, 0, At, B0); PG8_BAR; PG8_SCHED;
            PG8_LDB(B1, 0, 1); PG8_STAGE(PG8_SB(0, 0), b2, voffB);
            PG8_BAR; PG8_WAIT_L(0); PG8_MMA(0, 1, At, B1); PG8_BAR;
            PG8_LDA(At, 0, 1); PG8_STAGE(PG8_SA(0, 0), a2, voffA);
            PG8_BAR; PG8_WAIT_L(0); PG8_MMA(1, 0, At, B0); PG8_BAR; PG8_SCHED;
            PG8_STAGE(PG8_SB(0, 1), b2 + hstep, voffB);
            PG8_WAIT_V(6); PG8_BAR; PG8_MMA(1, 1, At, B1); PG8_BAR;
            PG8_LDB(B0, 1, 0); PG8_SCHED; PG8_LDA(At, 1, 0); PG8_STAGE(PG8_SA(0, 1), a2 + hstep, voffA);
            PG8_WAIT_L(8); PG8_BAR; PG8_WAIT_L(0); PG8_MMA(0, 0, At, B0); PG8_BAR; PG8_SCHED;
            PG8_LDB(B1, 1, 1); PG8_STAGE(PG8_SB(1, 0), b3, voffB);
            PG8_BAR; PG8_WAIT_L(0); PG8_MMA(0, 1, At, B1); PG8_BAR;
            PG8_LDA(At, 1, 1); PG8_STAGE(PG8_SA(1, 0), a3, voffA);
            PG8_BAR; PG8_WAIT_L(0); PG8_MMA(1, 0, At, B0); PG8_BAR; PG8_SCHED;
            PG8_STAGE(PG8_SB(1, 1), b3 + hstep, voffB);
            PG8_WAIT_V(6); PG8_BAR; PG8_MMA(1, 1, At, B1); PG8_BAR;
            }
        }
        if constexpr (ALIGN_EPI) { if (wr == 0) PG8_BAR; }
        if constexpr (!Epi::AFTER_DRAIN) { E(acc, cur, wr, wc, fr, fq); S.done(cur); }
        if (!has_next) break;
#pragma unroll
        for (int a = 0; a < 2; ++a)
#pragma unroll
            for (int b = 0; b < 2; ++b)
#pragma unroll
                for (int m = 0; m < 4; ++m)
#pragma unroll
                    for (int n = 0; n < 2; ++n) acc[a][b][m][n] = (f32x4){0.f, 0.f, 0.f, 0.f};
        cur = nxt; cA = nA; cB = nB; ++ui;
        if constexpr (ALIGN_EPI) { if (wr == 1) PG8_BAR; }
    }
    PG8_WAIT_V(0);
    if constexpr (!ALIGN_EPI) { if (wr == 0) PG8_BAR; }
    PG8_BAR;
    if constexpr (Epi::AFTER_DRAIN) { E.fused(acc, cur, wr, wc, fr, fq, lds, wid, lane); S.done(cur); }
#undef PG8_SA
#undef PG8_SB
#undef PG8_STAGE
#undef PG8_LDA
#undef PG8_LDB
#undef PG8_MMA
#undef PG8_WAIT_V
#undef PG8_WAIT_L
#undef PG8_BAR
#undef PG8_SCHED
}
}
#include <hip/hip_bf16.h>
#include <cmath>
namespace attn_body {
using bf16=__hip_bfloat16;
using bf16x8=__attribute__((ext_vector_type(8)))short;
using s16x4=__attribute__((ext_vector_type(4)))short;
using f32x16=__attribute__((ext_vector_type(16)))float;
using u32x4=__attribute__((ext_vector_type(4)))unsigned;
constexpr int BATCH=8,NHEAD=16,SEQ=2048,D=64,DM=NHEAD*D;
constexpr int NW=8,QBLK=32,QB=QBLK*NW,KVBLK=64,NQB=SEQ/QB;
constexpr int ATTN_PITCH=DM, ATTN_UNIT_ROWS=QB;
__device__ __forceinline__ int crow(int r,int hi){return (r&3)+8*(r>>2)+4*hi;}
#define SBAR() __builtin_amdgcn_sched_barrier(0)
__device__ __forceinline__ void cmask(f32x16&p0,f32x16&p1,int jb,int qrel,int hi){
  const float NEG=-INFINITY; int kb=64*jb+4*hi;
  #pragma unroll
  for(int r=0;r<16;++r){int kv=kb+(r&3)+8*(r>>2); if(kv>qrel)p0[r]=NEG; if(kv+32>qrel)p1[r]=NEG;}
}

constexpr int NSLOT=3, SLOTB=8192;
constexpr int LDS_K=0, LDS_V=NSLOT*SLOTB, LDS_WS=2*NSLOT*SLOTB, LDS_OST=LDS_WS+NW*64*4, LDS_BYTES=LDS_OST+NW*4096, LDS_CB=LDS_BYTES, LDS_TOTAL=LDS_CB+SEQ*4;
constexpr float C2=0.125f*1.4426950408889634f;
__device__ __forceinline__ void glds16(const void*gsrc,unsigned lds_dst){unsigned keep;
  asm volatile("s_mov_b32 %0, m0\n\ts_mov_b32 m0, %2\n\ts_nop 0\n\tglobal_load_lds_dwordx4 %1, off\n\ts_mov_b32 m0, %0":"=&s"(keep):"v"(gsrc),"s"(lds_dst):"memory");}
__device__ __forceinline__ float max3f(float a,float b,float c){float r;asm("v_max3_f32 %0, %1, %2, %3":"=v"(r):"v"(a),"v"(b),"v"(c));return r;}
__device__ __forceinline__ float max2f(float a,float b){float r;asm("v_max_f32_e32 %0, %1, %2":"=v"(r):"v"(a),"v"(b));return r;}
__device__ __forceinline__ float fadd_s(float a,float b){float r;asm("v_add_f32_e32 %0, %1, %2":"=v"(r):"v"(a),"v"(b));return r;}
__device__ __forceinline__ float fsub_s(float a,float b){float r;asm("v_sub_f32_e32 %0, %1, %2":"=v"(r):"v"(a),"v"(b));return r;}
typedef float f32x2_t __attribute__((ext_vector_type(2))); typedef __bf16 bf16x2_t __attribute__((ext_vector_type(2)));
__device__ __forceinline__ unsigned cvtpk_s(float lo,float hi){f32x2_t v={lo,hi};bf16x2_t b=__builtin_convertvector(v,bf16x2_t);return __builtin_bit_cast(unsigned,b);}
#define WAIT_BAR(N) asm volatile("s_waitcnt vmcnt(" #N ") lgkmcnt(0)\n\ts_barrier":::"memory")

__device__ __forceinline__ void qkt(f32x16&p0,f32x16&p1,const char*Kslot,const bf16x8*qr,const f32x16&negm,int r32,int hi){
  const char*kb=Kslot+hi*1024+r32*16;
  #pragma unroll
  for(int d0=0;d0<4;++d0){
    const bf16x8 b0=*reinterpret_cast<const bf16x8*>(kb+d0*2048);
    const bf16x8 b1=*reinterpret_cast<const bf16x8*>(kb+d0*2048+512);
    if(d0==0){p0=__builtin_amdgcn_mfma_f32_32x32x16_bf16(b0,qr[0],negm,0,0,0);p1=__builtin_amdgcn_mfma_f32_32x32x16_bf16(b1,qr[0],negm,0,0,0);}
    else{p0=__builtin_amdgcn_mfma_f32_32x32x16_bf16(b0,qr[d0],p0,0,0,0);p1=__builtin_amdgcn_mfma_f32_32x32x16_bf16(b1,qr[d0],p1,0,0,0);}}
}
typedef __attribute__((address_space(3))) const char* lds_cptr;
typedef short v4i16_t __attribute__((ext_vector_type(4)));
__device__ __forceinline__ void kload8(bf16x8*kf,lds_cptr kp){
  kf[0]=*(const __attribute__((address_space(3))) bf16x8*)(kp);      kf[1]=*(const __attribute__((address_space(3))) bf16x8*)(kp+512);
  kf[2]=*(const __attribute__((address_space(3))) bf16x8*)(kp+2048); kf[3]=*(const __attribute__((address_space(3))) bf16x8*)(kp+2560);
  kf[4]=*(const __attribute__((address_space(3))) bf16x8*)(kp+4096); kf[5]=*(const __attribute__((address_space(3))) bf16x8*)(kp+4608);
  kf[6]=*(const __attribute__((address_space(3))) bf16x8*)(kp+6144); kf[7]=*(const __attribute__((address_space(3))) bf16x8*)(kp+6656);
}
__device__ __forceinline__ void kload2(bf16x8*kf,lds_cptr kp,int j){ kf[2*j]=*(const __attribute__((address_space(3))) bf16x8*)(kp+j*2048); kf[2*j+1]=*(const __attribute__((address_space(3))) bf16x8*)(kp+j*2048+512); }
__device__ __forceinline__ s16x4 vtr(lds_cptr p){ return __builtin_bit_cast(s16x4,__builtin_amdgcn_ds_read_tr16_b64_v4i16((__attribute__((address_space(3))) v4i16_t*)p)); }
__device__ __forceinline__ float rowmax(const f32x16&p0,const f32x16&p1){
  float a=max3f(p0[0],p0[1],p1[0]),b=max3f(p0[2],p0[3],p1[1]);a=max3f(a,p1[2],p1[3]);
  #pragma unroll
  for(int r=4;r<16;r+=4){a=max3f(a,p0[r],p0[r+1]);b=max3f(b,p0[r+2],p0[r+3]);a=max3f(a,p1[r],p1[r+1]);b=max3f(b,p1[r+2],p1[r+3]);}
  const float m=max2f(a,b);
  auto rr=__builtin_amdgcn_permlane32_swap(__float_as_uint(m),__float_as_uint(m),false,false);
  return max2f(__uint_as_float(rr[0]),__uint_as_float(rr[1]));
}
__device__ __forceinline__ void pv(f32x16*o,int vb,bf16x8 pa0,bf16x8 pa1,bf16x8 pa2,bf16x8 pa3){
  #pragma unroll
  for(int d0=0;d0<2;++d0){s16x4 lo[4],hi[4];
    #pragma unroll
    for(int ks=0;ks<4;++ks){
      asm volatile("ds_read_b64_tr_b16 %0,%1 offset:%c2":"=&v"(lo[ks]):"v"(vb),"i"(d0*4096+ks*1024):"memory");
      asm volatile("ds_read_b64_tr_b16 %0,%1 offset:%c2":"=&v"(hi[ks]):"v"(vb),"i"(d0*4096+ks*1024+512):"memory");}
    asm volatile("s_waitcnt lgkmcnt(0)":::"memory");SBAR();
    #define PK(k) (bf16x8){lo[k][0],lo[k][1],lo[k][2],lo[k][3],hi[k][0],hi[k][1],hi[k][2],hi[k][3]}
    o[d0]=__builtin_amdgcn_mfma_f32_32x32x16_bf16(pa0,PK(0),o[d0],0,0,0);
    o[d0]=__builtin_amdgcn_mfma_f32_32x32x16_bf16(pa1,PK(1),o[d0],0,0,0);
    o[d0]=__builtin_amdgcn_mfma_f32_32x32x16_bf16(pa2,PK(2),o[d0],0,0,0);
    o[d0]=__builtin_amdgcn_mfma_f32_32x32x16_bf16(pa3,PK(3),o[d0],0,0,0);
    #undef PK
  }
}

#ifndef ATTN_STORE16
#define ATTN_STORE16(p,v) (*(u32x4*)(p)=(v))
#endif
typedef float f32x4v __attribute__((ext_vector_type(4)));
template<int THRL> __device__ __forceinline__ void attn_unit(int b,int h,int qb,const bf16*Q,const bf16*__restrict__ K,const bf16*__restrict__ V,bf16*O,char*shm){
  const int tid=threadIdx.x,lane=tid&63,r32=lane&31,hi=lane>>5; const int wid=__builtin_amdgcn_readfirstlane(tid>>6);
  const long rowbase=(long)b*SEQ; const int q0=qb*QB;
  const bf16*Qw=Q+(rowbase+q0+wid*QBLK)*DM+h*D;
  const bf16*Kh=K+rowbase*DM+h*D,*Vh=V+rowbase*DM+h*D;
  const unsigned lds0=(unsigned)(uintptr_t)shm;
  float*wsf=(float*)(shm+LDS_WS)+wid*64;
  const bf16*ksrc=Kh+(long)lane*DM+wid*8;
  const bf16*vsrc=Vh+(long)(16*(wid&3)+(lane>>2))*DM+(wid>>2)*32+(lane&3)*8;
  const unsigned kdst=lds0+LDS_K+wid*1024, vdst=lds0+LDS_V+wid*1024;
  #define DMA_K(t,slot) glds16(ksrc+(long)(t)*KVBLK*DM,(unsigned)__builtin_amdgcn_readfirstlane(kdst+(slot)))
  #define DMA_V(t,slot) glds16(vsrc+(long)(t)*KVBLK*DM,(unsigned)__builtin_amdgcn_readfirstlane(vdst+(slot)))
  const int vb0=(int)(lds0+LDS_V)+((lane>>4)&1)*32+(lane&3)*8+(4*hi+((lane&15)>>2))*64;
  const char*Kbase=shm+LDS_K; bf16x8 kf[8];
  const lds_cptr shm3=(lds_cptr)shm; const lds_cptr kp0=shm3+LDS_K+hi*1024+r32*16; const lds_cptr vp0=shm3+LDS_V+((lane>>4)&1)*32+(lane&3)*8+(4*hi+((lane&15)>>2))*64;
  const int NT=(q0+QB)/KVBLK;
  DMA_K(0,0);DMA_V(0,0);DMA_K(1,SLOTB);
  bf16x8 qr[4];
  #pragma unroll
  for(int d0=0;d0<4;++d0)qr[d0]=*reinterpret_cast<const bf16x8*>(&Qw[(long)r32*DM+d0*16+hi*8]);
  float mhat=0.f,l_reg=0.f;f32x16 o[2];o[0]=f32x16{};o[1]=f32x16{};float z0_=0.f;asm volatile("":"+v"(z0_));f32x16 negm;_Pragma("unroll") for(int r=0;r<16;++r)negm[r]=z0_;asm volatile("":"+v"(negm));
  const int qrel=wid*QBLK+r32;
  #define CMASK(P0,P1,t) do{int jb_=(t)-(NT-4); if(jb_>=0)cmask(P0,P1,jb_,qrel,hi);}while(0)
  #define BIAS(P0,P1,t) do{ const __attribute__((address_space(3))) f32x4v* cbt_=(const __attribute__((address_space(3))) f32x4v*)(shm3+LDS_CB+(64*(t)+4*hi)*4); \
    _Pragma("unroll") for(int g_=0;g_<4;++g_){ const f32x4v b0_=cbt_[2*g_], b1_=cbt_[8+2*g_]; \
      P0[4*g_]+=b0_[0];P0[4*g_+1]+=b0_[1];P0[4*g_+2]+=b0_[2];P0[4*g_+3]+=b0_[3]; P1[4*g_]+=b1_[0];P1[4*g_+1]+=b1_[1];P1[4*g_+2]+=b1_[2];P1[4*g_+3]+=b1_[3]; } }while(0)
  bool resc=false;
  #define START(P0,P1) do{ const float rm=rowmax(P0,P1); resc=false; \
    { const float dl=rm; mhat=fadd_s(mhat,dl); \
      _Pragma("unroll") for(int r=0;r<16;++r){P0[r]=fsub_s(P0[r],dl);P1[r]=fsub_s(P1[r],dl);} \
      _Pragma("unroll") for(int r=0;r<16;++r)negm[r]=-mhat; asm volatile("":"+v"(negm)); } \
    _Pragma("unroll") for(int r=0;r<16;++r)P0[r]=__builtin_amdgcn_exp2f(P0[r]); }while(0)
  #define RESC() do{ if(resc){ asm volatile("s_waitcnt lgkmcnt(0)":::"memory"); \
      _Pragma("unroll") for(int d_=0;d_<2;++d_) _Pragma("unroll") for(int r=0;r<16;++r)o[d_][r]*=wsf[crow(r,hi)]; } }while(0)
  f32x16 pA0,pA1,pB0,pB1;
  int sl_prev=0,sl_cur=0,sl_next=SLOTB;
  #define ROT() do{sl_prev=sl_cur;sl_cur=sl_next;sl_next=(sl_next==(NSLOT-1)*SLOTB)?0:sl_next+SLOTB;}while(0)
  DMA_K(2,2*SLOTB);
  WAIT_BAR(3);
  qkt(pA0,pA1,Kbase,qr,negm,r32,hi);asm volatile("s_nop 15\n\ts_nop 7":"+v"(pA0),"+v"(pA1));BIAS(pA0,pA1,0);CMASK(pA0,pA1,0);
  START(pA0,pA1);
  _Pragma("unroll") for(int r=0;r<16;++r)pA1[r]=__builtin_amdgcn_exp2f(pA1[r]);
  WAIT_BAR(0);
  DMA_K(3,0);DMA_V(1,SLOTB);
  ROT();
  kload8(kf,kp0+sl_cur);
  WAIT_BAR(2);
  s16x4 vlo[8],vhi[8]; u32x4 pw0,pw1,pw2,pw3;
  #define PKW(P,B) cvtpk_s(P[B],P[B+1])
  #define PAF(k) __builtin_bit_cast(bf16x8,pw##k)
  #define VFR(i) (bf16x8){vlo[i][0],vlo[i][1],vlo[i][2],vlo[i][3],vhi[i][0],vhi[i][1],vhi[i][2],vhi[i][3]}
  #define PIN(x) asm volatile("":"+v"(x))
  #define MX3(a,b,c) __builtin_fmaxf(__builtin_fmaxf((a),(b)),(c))
  #define GAPA(MF,A0,A1,A2,A3,W0,W1,PW) do{ MF; sacc+=A0; sacc+=A1; sacc+=A2; sacc+=A3; PIN(sacc); W0; W1; PIN(PW); SBAR(); }while(0)
  #define EX(v) __builtin_amdgcn_exp2f(v)
  #define GAPB(MF,X,B) do{ MF; X[B]=EX(X[B]); X[B+1]=EX(X[B+1]); X[B+2]=EX(X[B+2]); X[B+3]=EX(X[B+3]); PIN(X); SBAR(); }while(0)
  #define VRD(i) do{ vlo[i]=vtr(vp_+(((i)>>2)*4096+((i)&3)*1024)); vhi[i]=vtr(vp_+(((i)>>2)*4096+((i)&3)*1024+512)); }while(0)
  #define KRD(G,j) do{ if(G){ kload2(kf,kp0+sl_next,j); SBAR(); } }while(0)
  #define STEP(C0,C1,P0,P1,t,GK,GV,GL) do{ SBAR(); \
    const lds_cptr vp_=vp0+sl_prev; \
    VRD(0); SBAR(); float sacc=(P0[0]+P0[1]); \
    GAPA(C0=__builtin_amdgcn_mfma_f32_32x32x16_bf16(kf[0],qr[0],negm,0,0,0), P0[2],P0[3],P0[4],P0[5],     pw0[0]=PKW(P0,0), pw0[1]=PKW(P0,2), pw0); \
    VRD(4); SBAR(); GAPA(C1=__builtin_amdgcn_mfma_f32_32x32x16_bf16(kf[1],qr[0],negm,0,0,0), P0[6],P0[7],P0[8],P0[9],     pw0[2]=PKW(P0,4), pw0[3]=PKW(P0,6), pw0); \
    VRD(1); SBAR(); GAPA(C0=__builtin_amdgcn_mfma_f32_32x32x16_bf16(kf[2],qr[1],C0,0,0,0),   P0[10],P0[11],P0[12],P0[13], pw1[0]=PKW(P0,8), pw1[1]=PKW(P0,10), pw1); \
    VRD(5); SBAR(); GAPA(C1=__builtin_amdgcn_mfma_f32_32x32x16_bf16(kf[3],qr[1],C1,0,0,0),   P0[14],P0[15],P1[0],P1[1],   pw1[2]=PKW(P0,12),pw1[3]=PKW(P0,14), pw1); \
    VRD(2); SBAR(); GAPA(C0=__builtin_amdgcn_mfma_f32_32x32x16_bf16(kf[4],qr[2],C0,0,0,0),   P1[2],P1[3],P1[4],P1[5],     pw2[0]=PKW(P1,0), pw2[1]=PKW(P1,2), pw2); \
    VRD(6); SBAR(); GAPA(C1=__builtin_amdgcn_mfma_f32_32x32x16_bf16(kf[5],qr[2],C1,0,0,0),   P1[6],P1[7],P1[8],P1[9],     pw2[2]=PKW(P1,4), pw2[3]=PKW(P1,6), pw2); \
    VRD(3); SBAR(); GAPA(C0=__builtin_amdgcn_mfma_f32_32x32x16_bf16(kf[6],qr[3],C0,0,0,0),   P1[10],P1[11],P1[12],P1[13], pw3[0]=PKW(P1,8), pw3[1]=PKW(P1,10), pw3); \
    VRD(7); SBAR(); GAPA(C1=__builtin_amdgcn_mfma_f32_32x32x16_bf16(kf[7],qr[3],C1,0,0,0),   P1[14],P1[15],0.f,0.f,       pw3[2]=PKW(P1,12),pw3[3]=PKW(P1,14), pw3); \
    l_reg+=sacc; \
    if(GK){DMA_K((t)+3,sl_cur);} if(GV){DMA_V((t)+1,sl_next);} \
    { const __attribute__((address_space(3))) f32x4v* cbt_=(const __attribute__((address_space(3))) f32x4v*)(shm3+LDS_CB+(64*(t)+4*hi)*4); \
      _Pragma("unroll") for(int g_=0;g_<4;++g_){ const f32x4v b0_=cbt_[2*g_]; C0[4*g_]+=b0_[0];C0[4*g_+1]+=b0_[1];C0[4*g_+2]+=b0_[2];C0[4*g_+3]+=b0_[3]; SBAR(); \
        const f32x4v b1_=cbt_[8+2*g_]; C1[4*g_]+=b1_[0];C1[4*g_+1]+=b1_[1];C1[4*g_+2]+=b1_[2];C1[4*g_+3]+=b1_[3]; SBAR(); } } \
    CMASK(C0,C1,t); \
    { float a=MX3(C0[0],C0[1],C1[0]),b=MX3(C0[2],C0[3],C1[1]); a=MX3(a,C1[2],C1[3]); \
      _Pragma("unroll") for(int r=4;r<16;r+=4){a=MX3(a,C0[r],C0[r+1]);b=MX3(b,C0[r+2],C0[r+3]);a=MX3(a,C1[r],C1[r+1]);b=MX3(b,C1[r+2],C1[r+3]);} \
      float rm=__builtin_fmaxf(a,b); { auto rr=__builtin_amdgcn_permlane32_swap(__float_as_uint(rm),__float_as_uint(rm),false,false); rm=__builtin_fmaxf(__uint_as_float(rr[0]),__uint_as_float(rr[1])); } \
      resc=false; \
      if(__builtin_expect(__any(rm>(float)THRL),0)){ const float dl=__builtin_fmaxf(rm,0.f); mhat+=dl; \
        _Pragma("unroll") for(int r=0;r<16;++r){C0[r]-=dl;C1[r]-=dl;} \
        _Pragma("unroll") for(int r=0;r<16;++r)negm[r]=-mhat; asm volatile("":"+v"(negm)); \
        const float f=__builtin_amdgcn_exp2f(-dl); l_reg*=f; if(hi==0)wsf[r32]=f; resc=true; } } \
    SBAR(); \
    GAPB(o[0]=__builtin_amdgcn_mfma_f32_32x32x16_bf16(PAF(0),VFR(0),o[0],0,0,0), C0,0); \
    GAPB(o[1]=__builtin_amdgcn_mfma_f32_32x32x16_bf16(PAF(0),VFR(4),o[1],0,0,0), C0,4); \
    KRD(GL,0); GAPB(o[0]=__builtin_amdgcn_mfma_f32_32x32x16_bf16(PAF(1),VFR(1),o[0],0,0,0), C0,8); \
    KRD(GL,1); GAPB(o[1]=__builtin_amdgcn_mfma_f32_32x32x16_bf16(PAF(1),VFR(5),o[1],0,0,0), C0,12); \
    KRD(GL,2); GAPB(o[0]=__builtin_amdgcn_mfma_f32_32x32x16_bf16(PAF(2),VFR(2),o[0],0,0,0), C1,0); \
    KRD(GL,3); GAPB(o[1]=__builtin_amdgcn_mfma_f32_32x32x16_bf16(PAF(2),VFR(6),o[1],0,0,0), C1,4); \
    GAPB(o[0]=__builtin_amdgcn_mfma_f32_32x32x16_bf16(PAF(3),VFR(3),o[0],0,0,0), C1,8); \
    GAPB(o[1]=__builtin_amdgcn_mfma_f32_32x32x16_bf16(PAF(3),VFR(7),o[1],0,0,0), C1,12); \
    }while(0)
  int t=1;
  #undef CMASK
  #define CMASK(P0,P1,t) do{}while(0)
  for(;t+5<NT;t+=2){
    STEP(pB0,pB1,pA0,pA1,t,true,true,true);     WAIT_BAR(2); RESC(); ROT();
    STEP(pA0,pA1,pB0,pB1,t+1,true,true,true);   WAIT_BAR(2); RESC(); ROT();
  }
  #undef CMASK
  #define CMASK(P0,P1,t) do{int jb_=(t)-(NT-4); if(jb_>=0)cmask(P0,P1,jb_,qrel,hi);}while(0)
  #define ENDW(tt) do{ if((tt)+3<NT){WAIT_BAR(2);} else if((tt)+2<NT){WAIT_BAR(1);} else {WAIT_BAR(0);} }while(0)
  for(;t+1<NT;t+=2){
    STEP(pB0,pB1,pA0,pA1,t,(t+3<NT),(t+1<NT),(t+1<NT));       ENDW(t);   RESC(); ROT();
    STEP(pA0,pA1,pB0,pB1,t+1,(t+4<NT),(t+2<NT),(t+2<NT));     ENDW(t+1); RESC(); ROT();
  }
  STEP(pB0,pB1,pA0,pA1,NT-1,false,false,false); RESC();
  { float sacc=pB0[0]+pB0[1]; _Pragma("unroll") for(int r=2;r<16;++r)sacc+=pB0[r]; _Pragma("unroll") for(int r=0;r<16;++r)sacc+=pB1[r]; l_reg+=sacc;
    pw0=(u32x4){PKW(pB0,0),PKW(pB0,2),PKW(pB0,4),PKW(pB0,6)};pw1=(u32x4){PKW(pB0,8),PKW(pB0,10),PKW(pB0,12),PKW(pB0,14)};pw2=(u32x4){PKW(pB1,0),PKW(pB1,2),PKW(pB1,4),PKW(pB1,6)};pw3=(u32x4){PKW(pB1,8),PKW(pB1,10),PKW(pB1,12),PKW(pB1,14)};
    SBAR(); pv(o,vb0+sl_cur,PAF(0),PAF(1),PAF(2),PAF(3)); }
  #undef PKW
  #undef PAF
  #undef VFR
  #undef PIN
  #undef MX3
  #undef GAPA
  #undef GAPB
  #undef EX
  #undef VRD
  #undef KRD
  #undef STEP
  #undef ENDW
  {auto rr=__builtin_amdgcn_permlane32_swap(__float_as_uint(l_reg),__float_as_uint(l_reg),false,false);l_reg=__uint_as_float(rr[0])+__uint_as_float(rr[1]);}
  if(hi==0)wsf[32+r32]=l_reg;asm volatile("s_waitcnt lgkmcnt(0)":::"memory");
  float rli[16];
  #pragma unroll
  for(int r=0;r<16;++r)rli[r]=__builtin_amdgcn_rcpf(wsf[32+crow(r,hi)]);
  bf16*Ow=O+(rowbase+q0+wid*QBLK)*DM+h*D;
  { bf16*stg=(bf16*)(shm+LDS_OST)+wid*2048;
    #pragma unroll
    for(int r=0;r<16;++r){const int orow=crow(r,hi);
      #pragma unroll
      for(int d0=0;d0<2;++d0)stg[orow*64+d0*32+r32]=__float2bfloat16(o[d0][r]*rli[r]);}
    asm volatile("s_waitcnt lgkmcnt(0)":::"memory");
    #pragma unroll
    for(int i=0;i<4;++i){const int row=i*8+(lane>>3),ch=lane&7; const u32x4 v=*(const u32x4*)(stg+row*64+ch*8); ATTN_STORE16(Ow+(long)row*DM+ch*8,v);} }
  asm volatile("s_waitcnt lgkmcnt(0)\n\ts_barrier":::"memory");
  #undef DMA_K
  #undef DMA_V
  #undef BIAS
  #undef CMASK
  #undef START
  #undef RESC
  #undef ROT
}
constexpr int ATTN_LDS_BYTES=LDS_TOTAL;
struct AttnTensors { const bf16* Q; const bf16* K; const bf16* V; bf16* O; };
struct AttnUnit { int bh; int qb; };
struct StaticOrder {
  int vcu;
  __device__ __forceinline__ explicit StaticOrder(int grid,int block):vcu((block%8)*(grid/8)+block/8){}
  __device__ __forceinline__ bool next(int i,AttnUnit&u)const{ if(i>=4)return false; const int s=2*(vcu&1)+(i>>1); u.bh=vcu>>1; u.qb=(i&1)?7-s:s; return true; }
  __device__ __forceinline__ void a_ready(const AttnUnit&)const{}
  __device__ __forceinline__ void done(const AttnUnit&)const{}
};
template<class Sched,int THRL=8> __device__ __forceinline__ void attn_phase(char*lds,const AttnTensors&T,const Sched&S){
  AttnUnit u;
  for(int i=0;S.next(i,u);++i){ S.a_ready(u); attn_unit<THRL>(u.bh/NHEAD,u.bh%NHEAD,u.qb,T.Q,T.K,T.V,T.O,lds); S.done(u); }
}
#undef SBAR
#undef WAIT_BAR
}
#define GAS __attribute__((address_space(1)))
#define LAS __attribute__((address_space(3)))
typedef unsigned short bf16;
typedef unsigned v4u __attribute__((ext_vector_type(4)));
typedef float f32x4 __attribute__((ext_vector_type(4)));
typedef short bf16x8 __attribute__((ext_vector_type(8)));
typedef GAS unsigned gu32;
typedef GAS unsigned long long gu64;
#define RLX_AGENT __ATOMIC_RELAXED, __HIP_MEMORY_SCOPE_AGENT
#define LDS_WAIT() asm volatile("s_waitcnt lgkmcnt(0)" ::: "memory")
#define VM_WAIT() asm volatile("s_waitcnt vmcnt(0)" ::: "memory")
__device__ __forceinline__ unsigned long long rt() { return __builtin_amdgcn_s_memrealtime(); }
__device__ __forceinline__ unsigned f2bf(float f) { unsigned u = __builtin_bit_cast(unsigned, f); return (u + 0x7fffu + ((u >> 16) & 1u)) >> 16; }
__device__ __forceinline__ unsigned pk2(float lo, float hi) { return f2bf(lo) | (f2bf(hi) << 16); }

#define XB_TMO      128
#define XB_XCNT(j)  (256  + 64 * (j))
#define XB_XSUB(j)  (1280 + 64 * (j))
#define XB_XGEN(j)  (2304 + 64 * (j))
#define XB_TOP      3328
#define XB_TOPGEN   3392
#define XCD_BAR_WORDS 3456
#define XB_SPIN_CAP (1u << 18)

__device__ __forceinline__ unsigned xb_ld(unsigned* p)              { return __hip_atomic_load(p, __ATOMIC_RELAXED, __HIP_MEMORY_SCOPE_AGENT); }
__device__ __forceinline__ unsigned xb_add(unsigned* p, unsigned v) { return __hip_atomic_fetch_add(p, v, __ATOMIC_RELAXED, __HIP_MEMORY_SCOPE_AGENT); }
__device__ __forceinline__ unsigned xb_xcc_id() { return (unsigned)__builtin_amdgcn_s_getreg((3 << 11) | 20) & 0xFu; }
#define XB_SPIN(cond, bar) do { unsigned _sp = 0; while (cond) { __builtin_amdgcn_s_sleep(1); \
    if ((++_sp & 255u) == 0u) { if (xb_ld(&(bar)[XB_TMO])) break; if (_sp > XB_SPIN_CAP) { atomicAdd(&(bar)[XB_TMO], 1u); break; } } } } while (0)

struct XcdBarrier {
    unsigned* bar; unsigned x;
    volatile LAS unsigned* st;
};

__device__ __forceinline__ XcdBarrier xcd_barrier_post(unsigned* bar, volatile LAS unsigned* st) {
    XcdBarrier b; b.bar = bar; b.x = xb_xcc_id(); b.st = st;
    if (threadIdx.x == 0) (void)xb_add(&bar[XB_XCNT(b.x)], 1u);
    return b;
}
__device__ __forceinline__ void xcd_barrier_complete(unsigned* bar, unsigned x, unsigned& nloc, unsigned& nx) {
    const unsigned G = gridDim.x * gridDim.y * gridDim.z;
    unsigned sum, cnt, mine, sp = 0u;
    for (;;) {
        sum = 0u; cnt = 0u; mine = 0u;
#pragma unroll
        for (unsigned j = 0; j < 16; ++j) { const unsigned c = xb_ld(&bar[XB_XCNT(j)]); sum += c; cnt += (c > 0u) ? 1u : 0u; mine = (j == x) ? c : mine; }
        if (sum == G) break;
        __builtin_amdgcn_s_sleep(1);
        if ((++sp & 255u) == 0u) { if (xb_ld(&bar[XB_TMO])) break; if (sp > XB_SPIN_CAP) { atomicAdd(&bar[XB_TMO], 1u); break; } }
    }
    nloc = mine > 0u ? mine : 1u; nx = cnt > 0u ? cnt : 1u;
}

__device__ __forceinline__ void xcd_barrier(const XcdBarrier& b) {
    asm volatile("s_waitcnt vmcnt(0)" ::: "memory");
    __syncthreads();
    if (threadIdx.x == 0) {
        unsigned* bar = b.bar;
        __builtin_amdgcn_s_waitcnt(0);
        unsigned nloc = b.st[0], nx = b.st[1];
        if (nloc == 0u) { xcd_barrier_complete(bar, b.x, nloc, nx); b.st[0] = nloc; b.st[1] = nx; }
        const unsigned old = xb_add(&bar[XB_XSUB(b.x)], 1u);
        const unsigned gen = old / nloc;
        if (old + 1u == (gen + 1u) * nloc) {
            __builtin_amdgcn_fence(__ATOMIC_RELEASE, "agent");
            asm volatile("s_waitcnt vmcnt(0)" ::: "memory");
            const unsigned og = xb_add(&bar[XB_TOP], 1u);
            const unsigned tg = og / nx;
            if (og + 1u == (tg + 1u) * nx) xb_add(&bar[XB_TOPGEN], 1u);
            else XB_SPIN(xb_ld(&bar[XB_TOPGEN]) == tg, bar);
            __builtin_amdgcn_fence(__ATOMIC_ACQUIRE, "agent");
            xb_add(&bar[XB_XGEN(b.x)], 1u);
            asm volatile("s_waitcnt vmcnt(0)" ::: "memory");
        } else {
            XB_SPIN(xb_ld(&bar[XB_XGEN(b.x)]) == gen, bar);
            __builtin_amdgcn_fence(__ATOMIC_ACQUIRE, "agent");
            asm volatile("s_waitcnt vmcnt(0)" ::: "memory");
        }
    }
    __syncthreads();
}
constexpr int NWAVES = 8, NTHR = NWAVES * 64;
constexpr int T_TOK = 16384, DMODEL = 1024, NB = 8, SEQ = 2048;
constexpr int GLA_H = 4, GLA_DK = 128, GLA_DV = 256, GLA_C = 64, GLA_NCH = SEQ / GLA_C, GLA_IN = 3088;
constexpr int NCHUNK = NB * GLA_H * GLA_NCH;
constexpr int KV_TOT = 2064, FOX_H = 16;
constexpr int PEER_H = 8, PEER_K = 16, PEER_NEXP = 16384, PEER_SEL = PEER_H * PEER_K;
constexpr float EPS = 1e-6f;
constexpr float L2E = 1.4426950408889634f;

constexpr size_t MiB = 1u << 20;
constexpr size_t WS_CTL = 0, CTL_ZERO_BYTES = 64 * 1024;
constexpr size_t WS_WIN = 2 * MiB, WS_WGO = 8 * MiB, WS_WQKV = 10 * MiB, WS_WFO = 16 * MiB, WS_WEFF = 18 * MiB;
constexpr size_t WS_FL = 27 * MiB, WS_RP = 28 * MiB, WS_DEXP = 30 * MiB, WS_WGL = 30 * MiB + 512 * 1024, WS_WFL = WS_WGL + 64 * 1024, WS_WFLF = WS_WFL + 64 * 1024;
constexpr size_t WS_A0 = 32 * MiB;
constexpr size_t WS_HB = 64 * MiB;
constexpr size_t WS_PQ = 96 * MiB;
constexpr size_t WS_QT = 192 * MiB, WS_KT = 208 * MiB, WS_AT = 224 * MiB, WS_VT = 232 * MiB;
constexpr size_t WS_SC = 96 * MiB;
constexpr size_t WS_IDS = 264 * MiB, WS_GATES = 272 * MiB;
constexpr size_t WS_TAB = 280 * MiB;
constexpr size_t WS_OG = 312 * MiB;
constexpr size_t WS_TSC = 344 * MiB;
constexpr size_t WS_END = 408 * MiB;
constexpr int CW_BAR = 4096;

constexpr int RING_BYTES = 155648;
constexpr int LDSCTL_OFF = RING_BYTES, MISC_OFF = LDSCTL_OFF + 320;
constexpr int LDS_BYTES = 163840;

typedef unsigned v2u __attribute__((ext_vector_type(2)));
typedef float f32x16 __attribute__((ext_vector_type(16)));
__device__ __forceinline__ float bf2f(unsigned b) { return __builtin_bit_cast(float, b << 16); }
__device__ __forceinline__ float bflo(unsigned w) { return __builtin_bit_cast(float, w << 16); }
__device__ __forceinline__ float bfhi(unsigned w) { return __builtin_bit_cast(float, w & 0xffff0000u); }
__device__ __forceinline__ float wave_sum(float v) {
#pragma unroll
    for (int o = 1; o < 64; o <<= 1) v += __shfl_xor(v, o);
    return v;
}
__device__ __forceinline__ float wave_max(float v) {
#pragma unroll
    for (int o = 1; o < 64; o <<= 1) v = fmaxf(v, __shfl_xor(v, o));
    return v;
}
__device__ __forceinline__ float log_sigmoid(float x) { return fminf(x, 0.f) - __logf(1.0f + __expf(-fabsf(x))); }
__device__ __forceinline__ int crow16(int r, int hi) { return (r & 3) + 8 * (r >> 2) + 4 * hi; }

struct Frame {
    LAS unsigned char* lds;
    volatile LAS unsigned* MISC;
    gu32* ctl;
    int tid, lane, wave, vcu, G;
    unsigned char* ws;
    const float* in[18];
    float* out;
};
enum { IN_X = 0, IN_NORM_MIX, IN_NORM_FFN, IN_GLA_W_IN, IN_GLA_W_G2, IN_GLA_B_G, IN_GLA_NORM_O, IN_GLA_W_O, IN_KV_NORM, IN_KV_W, IN_FOX_B_F, IN_FOX_W_Q, IN_FOX_W_O,
       IN_PEER_W_Q, IN_PEER_SUB, IN_PEER_U, IN_PEER_V, IN_NORM_FINAL };

__device__ __forceinline__ void p0_transpose_item(const float* W, int K, int ldw, int c0, int N, bf16* WT, int row_off, const float* gk, int ns, float cs, LAS float* scr, int item, int lane) {
    const int nblk = N / 32, kb = item / nblk, nb = item % nblk, k0 = 64 * kb, n0 = 32 * nb;
#pragma unroll 8
    for (int i = 0; i < 32; ++i) { const int kk = 2 * i + (lane >> 5); const float g = gk ? gk[k0 + kk] : 1.f; scr[kk * 33 + (lane & 31)] = __builtin_nontemporal_load(W + (size_t)(k0 + kk) * ldw + c0 + n0 + (lane & 31)) * g; }
    LDS_WAIT(); asm volatile("" ::: "memory");
    const int c = lane & 7;
#pragma unroll
    for (int j = 0; j < 4; ++j) { const int n = (lane >> 3) + 8 * j; const LAS float* s = scr + (8 * c) * 33 + n; const float sc = (n0 + n < ns) ? cs : 1.f;
        v4u o; o.x = pk2(s[0 * 33] * sc, s[1 * 33] * sc); o.y = pk2(s[2 * 33] * sc, s[3 * 33] * sc); o.z = pk2(s[4 * 33] * sc, s[5 * 33] * sc); o.w = pk2(s[6 * 33] * sc, s[7 * 33] * sc);
        *(GAS v4u*)(WT + (size_t)(row_off + n0 + n) * K + k0 + 8 * c) = o; }
    LDS_WAIT(); asm volatile("" ::: "memory");
}
__device__ __forceinline__ void p0_weff_item(Frame& F, int item) {
    const int l = item >> 8, gi = (item >> 4) & 15, kb = item & 15, k0 = kb * 64, tid = F.tid, lane = F.lane, wave = F.wave;
    const float* wpq = F.in[IN_PEER_W_Q] + (size_t)l * DMODEL * 2048; const float* sub = F.in[IN_PEER_SUB] + ((size_t)l * 16 + gi) * 128 * 128; const float* gf = F.in[IN_NORM_FFN] + l * DMODEL;
    bf16* WT = (bf16*)(F.ws + WS_WEFF) + (size_t)l * 2048 * DMODEL;
    LAS float* At = (LAS float*)F.lds;
    LAS float* Bt = (LAS float*)(F.lds + 33792);
    { const int kk = tid >> 3, d0 = (tid & 7) * 16; const float g = gf[k0 + kk]; const f32x4* src = (const f32x4*)(wpq + (size_t)(k0 + kk) * 2048 + gi * 128 + d0);
#pragma unroll
      for (int i = 0; i < 4; ++i) { const f32x4 v = __builtin_nontemporal_load(src + i) * g; LAS float* d = At + kk * 129 + d0 + 4 * i; d[0] = v[0]; d[1] = v[1]; d[2] = v[2]; d[3] = v[3]; } }
    { const int n = tid >> 2, d0 = (tid & 3) * 32; const f32x4* src = (const f32x4*)(sub + (size_t)n * 128 + d0);
#pragma unroll
      for (int i = 0; i < 8; ++i) { const f32x4 v = src[i]; LAS float* d = Bt + n * 129 + d0 + 4 * i; d[0] = v[0]; d[1] = v[1]; d[2] = v[2]; d[3] = v[3]; } }
    __syncthreads();
    const int ti = wave >> 2, tj = wave & 3, r32 = lane & 31, hi = lane >> 5;
    const LAS float* ap = At + (32 * ti + r32) * 129 + hi; const LAS float* bp = Bt + (32 * tj + r32) * 129 + hi;
    f32x16 acc = (f32x16){};
#pragma unroll 16
    for (int s = 0; s < 64; ++s) acc = __builtin_amdgcn_mfma_f32_32x32x2f32(ap[2 * s], bp[2 * s], acc, 0, 0, 0);
    bf16* dst = WT + (size_t)(gi * 128 + 32 * tj + r32) * DMODEL + k0 + 32 * ti + 4 * hi;
#pragma unroll
    for (int g = 0; g < 4; ++g) *(GAS v2u*)(dst + 8 * g) = (v2u){pk2(acc[4 * g], acc[4 * g + 1]), pk2(acc[4 * g + 2], acc[4 * g + 3])};
    __syncthreads();
}
template <int NR> __device__ __forceinline__ void rms_rows_to_bf16(int lane, const float* const (&xrow)[NR], const float* g, bf16* const (&orow)[NR]) {
    f32x4 v[NR][4];
#pragma unroll
    for (int r = 0; r < NR; ++r) { const GAS f32x4* xr = (const GAS f32x4*)xrow[r] + lane;
#pragma unroll
        for (int j = 0; j < 4; ++j) v[r][j] = __builtin_nontemporal_load(xr + 64 * j); }
    const GAS f32x4* gr = (const GAS f32x4*)g + lane;
    f32x4 gg[4];
#pragma unroll
    for (int j = 0; j < 4; ++j) gg[j] = gr[64 * j];
#pragma unroll
    for (int r = 0; r < NR; ++r) { float s = 0.f;
#pragma unroll
        for (int j = 0; j < 4; ++j) s += (v[r][j].x * v[r][j].x + v[r][j].y * v[r][j].y) + (v[r][j].z * v[r][j].z + v[r][j].w * v[r][j].w);
        const float rstd = 1.f / sqrtf(wave_sum(s) * (1.f / DMODEL) + EPS);
        GAS unsigned long long* o8 = (GAS unsigned long long*)orow[r] + lane;
#pragma unroll
        for (int j = 0; j < 4; ++j) o8[64 * j] = (unsigned long long)pk2(v[r][j].x * rstd * gg[j].x, v[r][j].y * rstd * gg[j].y) | ((unsigned long long)pk2(v[r][j].z * rstd * gg[j].z, v[r][j].w * rstd * gg[j].w) << 32); }
}
__device__ __forceinline__ unsigned fp4_code(float y) {
    const float a = fabsf(y);
    const unsigned mag = (unsigned)(a >= 0.25f) + (unsigned)(a >= 0.75f) + (unsigned)(a >= 1.25f) + (unsigned)(a >= 1.75f) + (unsigned)(a >= 2.5f) + (unsigned)(a >= 3.5f) + (unsigned)(a >= 5.0f);
    return mag | ((__builtin_bit_cast(unsigned, y) >> 28) & 8u);
}
template <int NR> __device__ __forceinline__ void tab_rows_to_fp4(int lane, const float* const (&src)[NR], unsigned char* const (&dst)[NR], float* const (&sc_out)[NR]) {
    f32x4 a[NR], b[NR], c[NR], d[NR];
#pragma unroll
    for (int r = 0; r < NR; ++r) { const GAS f32x4* s = (const GAS f32x4*)src[r] + 4 * lane;
        a[r] = __builtin_nontemporal_load(s); b[r] = __builtin_nontemporal_load(s + 1); c[r] = __builtin_nontemporal_load(s + 2); d[r] = __builtin_nontemporal_load(s + 3); }
#pragma unroll
    for (int r = 0; r < NR; ++r) {
        float m = fmaxf(fmaxf(fmaxf(fabsf(a[r].x), fabsf(a[r].y)), fmaxf(fabsf(a[r].z), fabsf(a[r].w))), fmaxf(fmaxf(fabsf(b[r].x), fabsf(b[r].y)), fmaxf(fabsf(b[r].z), fabsf(b[r].w))));
        m = fmaxf(m, fmaxf(fmaxf(fmaxf(fabsf(c[r].x), fabsf(c[r].y)), fmaxf(fabsf(c[r].z), fabsf(c[r].w))), fmaxf(fmaxf(fabsf(d[r].x), fabsf(d[r].y)), fmaxf(fabsf(d[r].z), fabsf(d[r].w)))));
        m = wave_max(m);
        const float enc = (m > 0.f) ? 6.0f / m : 1.0f;
        unsigned w0 = 0, w1 = 0;
        w0 = __builtin_amdgcn_cvt_scalef32_pk_fp4_f32(w0, a[r].x * enc, a[r].y * enc, 1.0f, 0); w0 = __builtin_amdgcn_cvt_scalef32_pk_fp4_f32(w0, a[r].z * enc, a[r].w * enc, 1.0f, 1);
        w0 = __builtin_amdgcn_cvt_scalef32_pk_fp4_f32(w0, b[r].x * enc, b[r].y * enc, 1.0f, 2); w0 = __builtin_amdgcn_cvt_scalef32_pk_fp4_f32(w0, b[r].z * enc, b[r].w * enc, 1.0f, 3);
        w1 = __builtin_amdgcn_cvt_scalef32_pk_fp4_f32(w1, c[r].x * enc, c[r].y * enc, 1.0f, 0); w1 = __builtin_amdgcn_cvt_scalef32_pk_fp4_f32(w1, c[r].z * enc, c[r].w * enc, 1.0f, 1);
        w1 = __builtin_amdgcn_cvt_scalef32_pk_fp4_f32(w1, d[r].x * enc, d[r].y * enc, 1.0f, 2); w1 = __builtin_amdgcn_cvt_scalef32_pk_fp4_f32(w1, d[r].z * enc, d[r].w * enc, 1.0f, 3);
        ((GAS v2u*)dst[r])[lane] = (v2u){w0, w1};
        if (lane == 0) *sc_out[r] = (m > 0.f) ? m * (1.0f / 6.0f) : 1.0f; }
}
__device__ __forceinline__ void p0_prologue(Frame& F) {
    LAS float* scr = (LAS float*)(F.lds + F.wave * 16384);
    const int gw = blockIdx.x * NWAVES + F.wave, NGW = F.G * NWAVES;
    constexpr int I_IN = 16 * 96, I_SQ = 16 * 32;
    for (int it = gw; it < I_IN + I_SQ; it += NGW) {
        if (it < I_IN) p0_transpose_item(F.in[IN_GLA_W_IN], DMODEL, GLA_IN, 0, 3072, (bf16*)(F.ws + WS_WIN), 0, nullptr, 512, 0.08838834764831845f, scr, it, F.lane);
        else p0_transpose_item(F.in[IN_GLA_W_O], DMODEL, DMODEL, 0, 1024, (bf16*)(F.ws + WS_WGO), 0, nullptr, 0, 1.f, scr, it - I_IN, F.lane); }
    { const int gt = blockIdx.x * NTHR + F.tid, NT = F.G * NTHR;
      for (int idx = gt; idx < 16 * DMODEL; idx += NT) { const int j = idx >> 10, k = idx & 1023; ((bf16*)(F.ws + WS_WGL))[j * DMODEL + k] = (bf16)f2bf(F.in[IN_GLA_W_IN][(size_t)k * GLA_IN + 3072 + j]); } }
    for (int m = gw; m < T_TOK; m += 4 * NGW) {
        const float* xr[4]; bf16* orow[4];
#pragma unroll
        for (int i = 0; i < 4; ++i) { int mm = m + i * NGW; mm = mm < T_TOK ? mm : T_TOK - 1; xr[i] = F.in[IN_X] + (size_t)mm * DMODEL; orow[i] = (bf16*)(F.ws + WS_A0) + (size_t)mm * DMODEL; }
        rms_rows_to_bf16<4>(F.lane, xr, F.in[IN_NORM_MIX], orow); }
}
__device__ __forceinline__ void late_weights(Frame& F, int wg0, int nwg) {
    const int p = (int)blockIdx.x - wg0;
    for (int it = p; it < 512; it += nwg) p0_weff_item(F, it);
    LAS float* scr = (LAS float*)(F.lds + F.wave * 16384);
    const int gw = p * NWAVES + F.wave, NGW = nwg * NWAVES;
    constexpr int I_SQ = 16 * 32, I_KV = 16 * 64;
    for (int it = gw; it < 2 * I_SQ + I_KV; it += NGW) {
        int r = it;
        if (r < I_SQ) { p0_transpose_item(F.in[IN_FOX_W_Q], DMODEL, DMODEL, 0, 1024, (bf16*)(F.ws + WS_WQKV), 0, F.in[IN_NORM_MIX] + DMODEL, 0, 1.f, scr, r, F.lane); continue; } r -= I_SQ;
        if (r < I_KV) { p0_transpose_item(F.in[IN_KV_W], DMODEL, KV_TOT, 0, 2048, (bf16*)(F.ws + WS_WQKV), 1024, F.in[IN_KV_NORM], 0, 1.f, scr, r, F.lane); continue; } r -= I_KV;
        p0_transpose_item(F.in[IN_FOX_W_O], DMODEL, DMODEL, 0, 1024, (bf16*)(F.ws + WS_WFO), 0, nullptr, 0, 1.f, scr, r, F.lane); }
    { const int gt = p * NTHR + F.tid, NT = nwg * NTHR;
      for (int idx = gt; idx < 16 * DMODEL; idx += NT) { const int j = idx >> 10, k = idx & 1023;
          const float wv = F.in[IN_KV_W][(size_t)k * KV_TOT + 2048 + j] * F.in[IN_KV_NORM][k]; ((bf16*)(F.ws + WS_WFL))[j * DMODEL + k] = (bf16)f2bf(wv); ((float*)(F.ws + WS_WFLF))[j * DMODEL + k] = wv; } }
}

#ifndef TAB_ROWS_PER_ITER
#define TAB_ROWS_PER_ITER 1
#endif
__device__ __forceinline__ void peer_tables_convert(Frame& F, int w0, int nw) {
    const int gw = blockIdx.x * NWAVES + F.wave - w0;
    if (gw < 0 || gw >= nw) return;
    constexpr int NR = TAB_ROWS_PER_ITER;
    for (int r0 = gw; r0 < 4 * PEER_NEXP; r0 += NR * nw) {
        const float* src[NR]; unsigned char* dst[NR]; float* sc[NR];
#pragma unroll
        for (int i = 0; i < NR; ++i) { int r = r0 + i * nw; r = r < 4 * PEER_NEXP ? r : 4 * PEER_NEXP - 1; const int tb = r >> 14, e = r & (PEER_NEXP - 1), l = tb >> 1;
            src[i] = ((tb & 1) ? F.in[IN_PEER_V] : F.in[IN_PEER_U]) + ((size_t)l * PEER_NEXP + e) * DMODEL;
            dst[i] = F.ws + WS_TAB + ((size_t)tb * PEER_NEXP + e) * (DMODEL / 2); sc[i] = (float*)(F.ws + WS_TSC) + (size_t)tb * PEER_NEXP + e; }
        tab_rows_to_fp4<NR>(F.lane, src, dst, sc); }
}

__device__ __forceinline__ f32x4 skinny16(const bf16* A  , const bf16* Wt, int wave, int lane, LAS float* scr) {
    f32x4 acc = (f32x4){0.f, 0.f, 0.f, 0.f};
    const bf16x8* ap = (const bf16x8*)(A + (size_t)(16 * (wave & 3) + (lane & 15)) * DMODEL + 512 * (wave >> 2) + 8 * (lane >> 4));
    const bf16x8* bp = (const bf16x8*)(Wt + (size_t)(lane & 15) * DMODEL + 512 * (wave >> 2) + 8 * (lane >> 4));
    bf16x8 af[16], bfr[16];
#pragma unroll
    for (int kk = 0; kk < 16; ++kk) { af[kk] = ap[4 * kk]; bfr[kk] = bp[4 * kk]; }
#pragma unroll
    for (int kk = 0; kk < 16; ++kk) acc = __builtin_amdgcn_mfma_f32_16x16x32_bf16(af[kk], bfr[kk], acc, 0, 0, 0);
    if (wave >= 4) *(LAS f32x4*)(scr + (wave - 4) * 256 + 4 * lane) = acc;
    __syncthreads();
    if (wave < 4) acc += *(const LAS f32x4*)(scr + wave * 256 + 4 * lane);
    return acc;
}
__device__ __forceinline__ int perm16(int k16) { return 8 * ((k16 >> 2) & 1) + 4 * (k16 >> 3) + (k16 & 3); }
__device__ __forceinline__ void p2a_item(Frame& F, int b, int n) {
    const int tid = F.tid, lane = F.lane, wave = F.wave;
    const int t0 = b * SEQ + n * GLA_C;
    const bf16* PQ = (const bf16*)(F.ws + WS_PQ);
    LAS float* glrL = (LAS float*)F.lds;
    LAS float* SEG = (LAS float*)(F.lds + 4096);
    LAS unsigned char* QI = F.lds + 8192;
    LAS unsigned char* KI = F.lds + 24576;
    LAS unsigned char* RQ = F.lds + 40960;
    LAS unsigned char* RK = F.lds + 57344;
    LAS unsigned char* RV = F.lds + 73728;
    v4u rq[2], rk[2], rv[4];
#define P2A_LOAD(hh) do { _Pragma("unroll") for (int i_ = 0; i_ < 2; ++i_) { const int p_ = tid + 512 * i_; const bf16* src_ = PQ + (size_t)(t0 + (p_ >> 4)) * 3072 + (hh) * 128 + (p_ & 15) * 8; \
        rq[i_] = *(const GAS v4u*)src_; rk[i_] = *(const GAS v4u*)(src_ + 512); } \
      _Pragma("unroll") for (int i_ = 0; i_ < 4; ++i_) { const int p_ = tid + 512 * i_; rv[i_] = *(const GAS v4u*)(PQ + (size_t)(t0 + (p_ >> 5)) * 3072 + 1024 + (hh) * 256 + (p_ & 31) * 8); } } while (0)
#define P2A_STORE() do { _Pragma("unroll") for (int i_ = 0; i_ < 2; ++i_) { const int p_ = tid + 512 * i_; *(LAS v4u*)(RQ + p_ * 16) = rq[i_]; *(LAS v4u*)(RK + p_ * 16) = rk[i_]; } \
      _Pragma("unroll") for (int i_ = 0; i_ < 4; ++i_) { const int p_ = tid + 512 * i_; *(LAS v4u*)(RV + p_ * 16) = rv[i_]; } } while (0)
    P2A_LOAD(0);
    { const f32x4 a = skinny16((const bf16*)(F.ws + WS_A0) + (size_t)t0 * DMODEL, (const bf16*)(F.ws + WS_WGL), wave, lane, (LAS float*)(F.lds + 106496));
      if (wave < 4) {
#pragma unroll
        for (int r = 0; r < 4; ++r) glrL[(16 * wave + 4 * (lane >> 4) + r) * 16 + (lane & 15)] = a[r]; } }
    P2A_STORE();
    __syncthreads();
    const int k = tid & 127, iq = tid >> 7;
    const int pos = (k & ~15) | perm16(k & 15);
    for (int h = 0; h < GLA_H; ++h) {
        const int cid = (b * 4 + h) * 32 + n;
        if (h + 1 < GLA_H) P2A_LOAD(h + 1);
        float wg[16];
#pragma unroll
        for (int j = 0; j < 16; ++j) wg[j] = F.in[IN_GLA_W_G2][j * 512 + h * 128 + k];
        const float bg = F.in[IN_GLA_B_G][h * 128 + k];
        float bc[16];
#pragma unroll
        for (int ii = 0; ii < 16; ++ii) { const LAS f32x4* gp = (const LAS f32x4*)(glrL + (iq * 16 + ii) * 16); float s = bg;
#pragma unroll
            for (int q4 = 0; q4 < 4; ++q4) { const f32x4 gv = gp[q4]; s += (gv[0] * wg[4 * q4] + gv[1] * wg[4 * q4 + 1]) + (gv[2] * wg[4 * q4 + 2] + gv[3] * wg[4 * q4 + 3]); }
            bc[ii] = log_sigmoid(s) * (1.0f / 16.0f); }
#pragma unroll
        for (int ii = 1; ii < 16; ++ii) bc[ii] += bc[ii - 1];
        SEG[iq * 128 + k] = bc[15];
        __syncthreads();
        float off = 0.f, tot = 0.f;
#pragma unroll
        for (int q = 0; q < 4; ++q) { const float sv = SEG[q * 128 + k]; tot += sv; if (q < iq) off += sv; }
        unsigned kt[8];
#pragma unroll
        for (int ii = 0; ii < 16; ii += 2) {
            float qa[2], ka[2];
#pragma unroll
            for (int e = 0; e < 2; ++e) { const int i = iq * 16 + ii + e; const float bb = bc[ii + e] + off;
                const float qv = bf2f(*(const LAS unsigned short*)(RQ + i * 256 + k * 2)), kv = bf2f(*(const LAS unsigned short*)(RK + i * 256 + k * 2));
                qa[e] = qv * __expf(bb); ka[e] = kv * __expf(-bb);
                *(LAS unsigned short*)(QI + i * 256 + pos * 2) = (unsigned short)f2bf(qa[e]);
                *(LAS unsigned short*)(KI + i * 256 + pos * 2) = (unsigned short)f2bf(ka[e]); }
            kt[ii >> 1] = pk2(ka[0], ka[1]); }
        { GAS v4u* dst = (GAS v4u*)((bf16*)(F.ws + WS_KT) + (size_t)cid * 8192 + k * 64 + iq * 16);
          dst[0] = (v4u){kt[0], kt[1], kt[2], kt[3]}; dst[1] = (v4u){kt[4], kt[5], kt[6], kt[7]}; }
        if (iq == 0) ((float*)(F.ws + WS_DEXP))[(size_t)cid * 128 + k] = __expf(tot);
        { const int nn = tid & 255, jh = tid >> 8; unsigned w[16];
#pragma unroll
          for (int jj = 0; jj < 32; jj += 2) { const unsigned lo = *(const LAS unsigned short*)(RV + (32 * jh + jj) * 512 + nn * 2), hi2 = *(const LAS unsigned short*)(RV + (32 * jh + jj + 1) * 512 + nn * 2); w[jj >> 1] = lo | (hi2 << 16); }
          GAS v4u* dst = (GAS v4u*)((bf16*)(F.ws + WS_VT) + (size_t)cid * 16384 + nn * 64 + 32 * jh);
#pragma unroll
          for (int q = 0; q < 4; ++q) dst[q] = (v4u){w[4 * q], w[4 * q + 1], w[4 * q + 2], w[4 * q + 3]}; }
        __syncthreads();
        if (wave < 4) { const int ib = (wave == 1 || wave == 2) ? 1 : 0, jb = (wave >= 2) ? 1 : 0, r32 = lane & 31, hi = lane >> 5;
            f32x16 acc = (f32x16){};
            if (wave != 3) {
#pragma unroll
                for (int kk = 0; kk < 8; ++kk) { const bf16x8 af = *(const LAS bf16x8*)(KI + (32 * jb + r32) * 256 + (16 * kk + 8 * hi) * 2);
                    const bf16x8 bfr = *(const LAS bf16x8*)(QI + (32 * ib + r32) * 256 + (16 * kk + 8 * hi) * 2);
                    acc = __builtin_amdgcn_mfma_f32_32x32x16_bf16(af, bfr, acc, 0, 0, 0); } }
            const int i = 32 * ib + r32;
            bf16* at = (bf16*)(F.ws + WS_AT) + (size_t)cid * 4096 + i * 64 + 32 * jb + 4 * hi;
#pragma unroll
            for (int g = 0; g < 4; ++g) { float v[4];
#pragma unroll
                for (int e = 0; e < 4; ++e) { const int j = 32 * jb + 8 * g + 4 * hi + e; v[e] = (j <= i) ? acc[4 * g + e] : 0.f; }
                *(GAS v2u*)(at + 8 * g) = (v2u){pk2(v[0], v[1]), pk2(v[2], v[3])}; } }
        { GAS v4u* dst = (GAS v4u*)((bf16*)(F.ws + WS_QT) + (size_t)cid * 8192); const LAS v4u* src = (const LAS v4u*)QI; dst[tid] = src[tid]; dst[tid + 512] = src[tid + 512]; }
        if (h + 1 < GLA_H) P2A_STORE();
        __syncthreads();
    }
#undef P2A_LOAD
#undef P2A_STORE
}

__device__ __forceinline__ unsigned cvtpk(float lo, float hi) { typedef float f2 __attribute__((ext_vector_type(2))); typedef __bf16 b2 __attribute__((ext_vector_type(2))); f2 v = {lo, hi}; b2 r = __builtin_convertvector(v, b2); return __builtin_bit_cast(unsigned, r); }
__device__ __forceinline__ void glds16s(const void* sbase, unsigned voff, unsigned lds_dst) { unsigned keep;
    asm volatile("s_mov_b32 %0, m0\n\ts_mov_b32 m0, %3\n\ts_nop 0\n\tglobal_load_lds_dwordx4 %1, %2\n\ts_mov_b32 m0, %0" : "=&s"(keep) : "v"(voff), "s"(sbase), "s"(lds_dst) : "memory"); }
__device__ __forceinline__ void glds16s_nt(const void* sbase, unsigned voff, unsigned lds_dst) { unsigned keep;
    asm volatile("s_mov_b32 %0, m0\n\ts_mov_b32 m0, %3\n\ts_nop 0\n\tglobal_load_lds_dwordx4 %1, %2 nt\n\ts_mov_b32 m0, %0" : "=&s"(keep) : "v"(voff), "s"(sbase), "s"(lds_dst) : "memory"); }
constexpr int P2B_STAGE = 40960, P2B_BUF0 = 4096;
__device__ __forceinline__ void p2b_seq(Frame& F, int bh, int probe_skip = 0) {
    const int lane = F.lane, wave = F.wave, r32 = lane & 31, hi = lane >> 5;
    const int b = bh >> 2, h = bh & 3;
    const bf16* PQ = (const bf16*)(F.ws + WS_PQ); bf16* OG = (bf16*)(F.ws + WS_A0);
    LAS float* red = (LAS float*)F.lds;
    const unsigned lds0 = (unsigned)(uintptr_t)F.lds + P2B_BUF0;
    f32x16 S[4];
#pragma unroll
    for (int kb = 0; kb < 4; ++kb) S[kb] = (f32x16){};
    int sq[2], sk[2];
#pragma unroll
    for (int i = 0; i < 2; ++i) { const int P = wave + 8 * i;
        { const int row = 4 * P + (lane >> 4), c = (lane & 15) ^ (row & 15); sq[i] = row * 256 + c * 16; }
        { const int row = 8 * P + (lane >> 3), c = (lane & 7) ^ ((row >> 1) & 7); sk[i] = row * 128 + c * 16; } }
#define P2B_DMA(cid_, bufi_) do { const unsigned d_ = lds0 + (bufi_) * P2B_STAGE; \
        const char* q_ = (const char*)(F.ws + WS_QT) + (size_t)(cid_) * 16384; const char* k_ = (const char*)(F.ws + WS_KT) + (size_t)(cid_) * 16384; const char* a_ = (const char*)(F.ws + WS_AT) + (size_t)(cid_) * 8192; \
        glds16s(q_, sq[0], (unsigned)__builtin_amdgcn_readfirstlane(d_ + wave * 1024)); glds16s(q_, sq[1], (unsigned)__builtin_amdgcn_readfirstlane(d_ + (wave + 8) * 1024)); \
        glds16s(k_, sk[0], (unsigned)__builtin_amdgcn_readfirstlane(d_ + 16384 + wave * 1024)); glds16s(k_, sk[1], (unsigned)__builtin_amdgcn_readfirstlane(d_ + 16384 + (wave + 8) * 1024)); \
        glds16s(a_, sk[0], (unsigned)__builtin_amdgcn_readfirstlane(d_ + 32768 + wave * 1024)); } while (0)
    bf16x8 vf[4];
    LAS float* dxL = (LAS float*)(F.lds + P2B_BUF0 + 2 * P2B_STAGE);
    const int tid = F.tid;
    constexpr int P2B_VTW = P2B_BUF0 + 2 * P2B_STAGE + 1024, P2B_RW = P2B_VTW + 32768;
    static_assert(P2B_RW + 32768 <= RING_BYTES, "GLA recurrence LDS map");
    const unsigned vtw0 = (unsigned)(uintptr_t)F.lds + P2B_VTW + wave * 4096, rw0 = (unsigned)(uintptr_t)F.lds + P2B_RW + wave * 4096;
    int sv[4], sr[4];
#pragma unroll
    for (int i = 0; i < 4; ++i) { { const int row = 8 * i + (lane >> 3), c = (lane & 7) ^ ((row >> 1) & 7); sv[i] = (32 * wave + row) * 128 + c * 16; }
                                  { const int row = 16 * i + (lane >> 2), c = (lane & 3) ^ ((row >> 2) & 3); sr[i] = row * 6144 + c * 16; } }
#define P2B_DMA_V(cid_) do { const char* v_ = (const char*)(F.ws + WS_VT) + (size_t)(cid_) * 32768; _Pragma("unroll") for (int i_ = 0; i_ < 4; ++i_) glds16s(v_, sv[i_], (unsigned)__builtin_amdgcn_readfirstlane(vtw0 + i_ * 1024)); } while (0)
#define P2B_DMA_R(t0_) do { const char* r_ = (const char*)(PQ + (size_t)(t0_) * 3072 + 2048 + h * 256 + 32 * wave); _Pragma("unroll") for (int i_ = 0; i_ < 4; ++i_) glds16s(r_, sr[i_], (unsigned)__builtin_amdgcn_readfirstlane(rw0 + i_ * 1024)); } while (0)
    const LAS unsigned char* vtw = F.lds + P2B_VTW + wave * 4096 + r32 * 128; const LAS unsigned char* rwl = F.lds + P2B_RW + wave * 4096;
    { const int cid = bh * 32;
      P2B_DMA(cid, 0); P2B_DMA_V(cid); P2B_DMA_R(b * SEQ);
      if (tid < 32) *(LAS f32x4*)(dxL + 4 * tid) = *(const f32x4*)((const float*)(F.ws + WS_DEXP) + (size_t)cid * 128 + 4 * tid); }
    asm volatile("s_waitcnt vmcnt(0)" ::: "memory");
    __syncthreads();
    const int kx0 = (r32 >> 1) & 7;
#pragma unroll
    for (int s = 0; s < 4; ++s) vf[s] = *(const LAS bf16x8*)(vtw + (((2 * s + hi) ^ kx0) << 4));
    const int qoff = r32 * 256, koff = 16384 + r32 * 128, aoff = 32768 + r32 * 128;
    const int qx = r32 & 15, kx = (r32 >> 1) & 7;
    for (int n = 0; n < GLA_NCH; ++n) {
        const int cid = bh * 32 + n, t0 = b * SEQ + n * GLA_C;
        const LAS unsigned char* buf = F.lds + P2B_BUF0 + (n & 1) * P2B_STAGE;
        const LAS float* DX = dxL + (n & 1) * 128;
        f32x4 dxn = (f32x4){0.f, 0.f, 0.f, 0.f};
        if (n + 1 < GLA_NCH) { P2B_DMA(cid + 1, (n + 1) & 1);
            if (tid < 32) dxn = *(const f32x4*)((const float*)(F.ws + WS_DEXP) + (size_t)(cid + 1) * 128 + 4 * tid); }
        if (n + 1 < GLA_NCH) P2B_DMA_V(cid + 1);
        f32x16 oT[2];
        oT[0] = (f32x16){}; oT[1] = (f32x16){};
#pragma unroll
        for (int kb = 0; kb < 4; ++kb) {
            bf16x8 qf[2][2];
#pragma unroll
            for (int s = 0; s < 2; ++s)
#pragma unroll
                for (int ib = 0; ib < 2; ++ib) qf[s][ib] = *(const LAS bf16x8*)(buf + qoff + ib * 8192 + (((4 * kb + 2 * s + hi) ^ qx) << 4));
            __builtin_amdgcn_sched_barrier(0);
#pragma unroll
            for (int s = 0; s < 2; ++s) { v4u sw; sw.x = cvtpk(S[kb][8 * s], S[kb][8 * s + 1]); sw.y = cvtpk(S[kb][8 * s + 2], S[kb][8 * s + 3]); sw.z = cvtpk(S[kb][8 * s + 4], S[kb][8 * s + 5]); sw.w = cvtpk(S[kb][8 * s + 6], S[kb][8 * s + 7]);
                const bf16x8 sf = __builtin_bit_cast(bf16x8, sw);
#pragma unroll
                for (int ib = 0; ib < 2; ++ib) oT[ib] = __builtin_amdgcn_mfma_f32_32x32x16_bf16(sf, qf[s][ib], oT[ib], 0, 0, 0); }
            __builtin_amdgcn_sched_barrier(0); }
        { bf16x8 af[2][4];
#pragma unroll
          for (int ib = 0; ib < 2; ++ib)
#pragma unroll
              for (int s = 0; s < 4; ++s) af[ib][s] = *(const LAS bf16x8*)(buf + aoff + ib * 4096 + (((2 * s + hi) ^ kx) << 4));
          __builtin_amdgcn_sched_barrier(0);
#pragma unroll
          for (int ib = 0; ib < 2; ++ib)
#pragma unroll
              for (int s = 0; s < 4; ++s) oT[ib] = __builtin_amdgcn_mfma_f32_32x32x16_bf16(vf[s], af[ib][s], oT[ib], 0, 0, 0);
          __builtin_amdgcn_sched_barrier(0); }
#pragma unroll
        for (int kh = 0; kh < 2; ++kh) { bf16x8 kf[2][4];
#pragma unroll
            for (int kb = 0; kb < 2; ++kb)
#pragma unroll
                for (int s = 0; s < 4; ++s) kf[kb][s] = *(const LAS bf16x8*)(buf + koff + (2 * kh + kb) * 4096 + (((2 * s + hi) ^ kx) << 4));
            __builtin_amdgcn_sched_barrier(0);
#pragma unroll
            for (int kb = 0; kb < 2; ++kb)
#pragma unroll
                for (int s = 0; s < 4; ++s) S[2 * kh + kb] = __builtin_amdgcn_mfma_f32_32x32x16_bf16(kf[kb][s], vf[s], S[2 * kh + kb], 0, 0, 0);
            __builtin_amdgcn_sched_barrier(0); }
#pragma unroll
        for (int kb = 0; kb < 4; ++kb)
#pragma unroll
            for (int g = 0; g < 4; ++g) { const f32x4 dv = *(const LAS f32x4*)(DX + 32 * kb + 8 * g + 4 * hi);
                S[kb][4 * g] *= dv[0]; S[kb][4 * g + 1] *= dv[1]; S[kb][4 * g + 2] *= dv[2]; S[kb][4 * g + 3] *= dv[3]; }
        LAS float* rp = red + (n & 1) * 512;
#pragma unroll
        for (int ib = 0; ib < 2; ++ib) { float ss = 0.f;
#pragma unroll
            for (int r = 0; r < 16; ++r) ss += oT[ib][r] * oT[ib][r];
            ss += __shfl_xor(ss, 32);
            if (hi == 0) rp[wave * 64 + 32 * ib + r32] = ss; }
        if (n + 1 < GLA_NCH && tid < 32) *(LAS f32x4*)(dxL + ((n + 1) & 1) * 128 + 4 * tid) = dxn;
        asm volatile("s_waitcnt vmcnt(0)" ::: "memory");
        __syncthreads();
        if (probe_skip != 1)
#pragma unroll
        for (int ib = 0; ib < 2; ++ib) { float tot = 0.f;
#pragma unroll
            for (int w = 0; w < 8; ++w) tot += rp[w * 64 + 32 * ib + r32];
            const float rstd = __builtin_amdgcn_rsqf(tot * (1.0f / 256.0f) + EPS);
            const int t = t0 + 32 * ib + r32;
            bf16* orow = OG + (size_t)t * DMODEL + h * 256 + 32 * wave + 4 * hi;
#pragma unroll
            for (int g = 0; g < 4; ++g) { const int ri = 32 * ib + r32; const v2u rwv = *(const LAS v2u*)(rwl + ri * 64 + ((g ^ ((ri >> 2) & 3)) << 4) + 8 * hi);
                *(GAS v2u*)(orow + 8 * g) = (v2u){cvtpk(oT[ib][4 * g] * rstd * bflo(rwv.x), oT[ib][4 * g + 1] * rstd * bfhi(rwv.x)), cvtpk(oT[ib][4 * g + 2] * rstd * bflo(rwv.y), oT[ib][4 * g + 3] * rstd * bfhi(rwv.y))};
                __builtin_amdgcn_sched_barrier(0); } }
        if (n + 1 < GLA_NCH) {
#pragma unroll
            for (int s = 0; s < 4; ++s) vf[s] = *(const LAS bf16x8*)(vtw + (((2 * s + hi) ^ kx0) << 4));
            asm volatile("s_waitcnt lgkmcnt(0)" ::: "memory");
            P2B_DMA_R(t0 + GLA_C); }
    }
#undef P2B_DMA_V
#undef P2B_DMA_R
#undef P2B_DMA
}
__device__ __forceinline__ unsigned mono(float f) { const unsigned u = __builtin_bit_cast(unsigned, f); return (u & 0x80000000u) ? ~u : (u | 0x80000000u); }
__device__ __forceinline__ float unmono(unsigned m) { const unsigned u = (m & 0x80000000u) ? (m ^ 0x80000000u) : ~m; return __builtin_bit_cast(float, u); }
#define KMAX(a, b) ((a) > (b) ? (a) : (b))
#define KMIN(a, b) ((a) < (b) ? (a) : (b))
#define INSERT16(L, x) do { unsigned x_ = (x); _Pragma("unroll") for (int p_ = 0; p_ < 16; ++p_) { const unsigned t_ = KMAX(L[p_], x_); x_ = KMIN(L[p_], x_); L[p_] = t_; } } while (0)
#define MERGE16(L, O) do { _Pragma("unroll") for (int p_ = 0; p_ < 16; ++p_) L[p_] = KMAX(L[p_], O[15 - p_]); \
    _Pragma("unroll") for (int st_ = 8; st_ >= 1; st_ >>= 1) { _Pragma("unroll") for (int p_ = 0; p_ < 16; ++p_) { if ((p_ & st_) == 0) { const unsigned a_ = L[p_], b_ = L[p_ + st_]; L[p_] = KMAX(a_, b_); L[p_ + st_] = KMIN(a_, b_); } } } } while (0)
#define SORT16(L) do { _Pragma("unroll") for (int k_ = 2; k_ <= 16; k_ <<= 1) { _Pragma("unroll") for (int j_ = k_ >> 1; j_ >= 1; j_ >>= 1) { _Pragma("unroll") for (int i_ = 0; i_ < 16; ++i_) { \
    if ((i_ & j_) == 0) { const unsigned a_ = L[i_], b_ = L[i_ | j_]; const bool desc_ = ((i_ & k_) == 0) || (k_ == 16); L[i_] = desc_ ? KMAX(a_, b_) : KMIN(a_, b_); L[i_ | j_] = desc_ ? KMIN(a_, b_) : KMAX(a_, b_); } } } } } while (0)
__device__ __forceinline__ void p5_wave(int lane, const LAS unsigned short* row, LAS int* idsL, LAS float* gatesL) {
    const int q = lane & 3, c = (lane >> 2) & 1, head = lane >> 3, r8 = lane & 7;
    const LAS unsigned short* mine = row + lane * 32;
    unsigned L[16], O[16];
    const int sw = (lane >> 2) & 3;
#pragma unroll
    for (int it = 0; it < 4; ++it) { const int c16 = it ^ sw; const v4u v = *(const LAS v4u*)(mine + 8 * c16);
#pragma unroll
        for (int e = 0; e < 8; ++e) { const int idx = q * 32 + c16 * 8 + e; const unsigned wv = v[e >> 1]; const float sv = (e & 1) ? bfhi(wv) : bflo(wv);
            const unsigned key = (mono(sv) & ~127u) | (unsigned)(127 - idx); if (it < 2) L[8 * it + e] = key; else O[8 * (it - 2) + e] = key; } }
    SORT16(L); SORT16(O); MERGE16(L, O);
#pragma unroll
    for (int p = 0; p < 16; ++p) O[p] = __shfl_xor(L[p], 1);
    MERGE16(L, O);
#pragma unroll
    for (int p = 0; p < 16; ++p) O[p] = __shfl_xor(L[p], 2);
    MERGE16(L, O);
#pragma unroll
    for (int p = 0; p < 16; ++p) O[p] = __shfl_xor(L[p], 4);
    unsigned A[16], B[16];
#pragma unroll
    for (int p = 0; p < 16; ++p) { A[p] = c ? O[p] : L[p]; B[p] = c ? L[p] : O[p]; }
    unsigned ka = A[0], kb8 = A[8];
#pragma unroll
    for (int p = 1; p < 8; ++p) { ka = (r8 == p) ? A[p] : ka; kb8 = (r8 == p) ? A[8 + p] : kb8; }
    const float va = unmono(ka & ~127u), va8 = unmono(kb8 & ~127u);
    const unsigned pa = ((127u - (ka & 127u)) << 7), pa8 = ((127u - (kb8 & 127u)) << 7);
    const int nvalid = 16 / (r8 + 1);
    unsigned Cn[16];
#pragma unroll
    for (int j = 0; j < 16; ++j) { const float vb = unmono(B[j] & ~127u); const unsigned pb = 127u - (B[j] & 127u);
        const unsigned key = (mono(va + vb) & ~16383u) | pa | pb; Cn[j] = (j < nvalid) ? key : 0u; }
    { const float vb0 = unmono(B[0] & ~127u); const unsigned pb0 = 127u - (B[0] & 127u); const unsigned key = (mono(va8 + vb0) & ~16383u) | pa8 | pb0; INSERT16(Cn, key); }
#pragma unroll
    for (int p = 0; p < 16; ++p) O[p] = __shfl_xor(Cn[p], 1);
    MERGE16(Cn, O);
#pragma unroll
    for (int p = 0; p < 16; ++p) O[p] = __shfl_xor(Cn[p], 2);
    MERGE16(Cn, O);
#pragma unroll
    for (int p = 0; p < 16; ++p) O[p] = __shfl_xor(Cn[p], 4);
    MERGE16(Cn, O);
    unsigned k0 = Cn[0], k1 = Cn[8];
#pragma unroll
    for (int p = 1; p < 8; ++p) { k0 = (r8 == p) ? Cn[p] : k0; k1 = (r8 == p) ? Cn[8 + p] : k1; }
    const int ia0 = (k0 >> 7) & 127, ib0 = k0 & 127, ia1 = (k1 >> 7) & 127, ib1 = k1 & 127;
    const LAS unsigned short* hrow = row + head * 256;
    const float s0 = bf2f(hrow[ia0]) + bf2f(hrow[128 + ib0]), s1 = bf2f(hrow[ia1]) + bf2f(hrow[128 + ib1]);
    float mx = fmaxf(s0, s1);
    mx = fmaxf(mx, __shfl_xor(mx, 1)); mx = fmaxf(mx, __shfl_xor(mx, 2)); mx = fmaxf(mx, __shfl_xor(mx, 4));
    const float e0 = __expf(s0 - mx), e1 = __expf(s1 - mx);
    float sm = e0 + e1;
    sm += __shfl_xor(sm, 1); sm += __shfl_xor(sm, 2); sm += __shfl_xor(sm, 4);
    const float inv = 1.0f / sm;
    const int o = head * 16 + r8;
    idsL[o] = ia0 * 128 + ib0; idsL[o + 8] = ia1 * 128 + ib1; gatesL[o] = e0 * inv; gatesL[o + 8] = e1 * inv;
}
typedef float f32x2 __attribute__((ext_vector_type(2)));
typedef int i32x8 __attribute__((ext_vector_type(8)));
#ifndef MFMA_U
#define MFMA_U 1
#endif
#define FP4_CVT(W, SEL) __builtin_amdgcn_cvt_scalef32_pk_f32_fp4((W), 1.0f, (SEL))
template <bool FINAL>
__device__ __forceinline__ void peer_gather(Frame& F, int layer, const bf16* HBin, float* Hout, bf16* HB, float* RP) {
    const int lane = F.lane, half = lane >> 5; const int gw = blockIdx.x * NWAVES + F.wave, NGW = F.G * NWAVES;
    const unsigned char* UT = F.ws + WS_TAB + (size_t)(2 * layer) * PEER_NEXP * 512; const unsigned char* VT = UT + (size_t)PEER_NEXP * 512;
    const float* USC = (const float*)(F.ws + WS_TSC) + (size_t)(2 * layer) * PEER_NEXP; const float* VSC = USC + PEER_NEXP;
    const float* gf = F.in[IN_NORM_FFN] + layer * DMODEL; const float* gfin = F.in[IN_NORM_FINAL];
    LAS unsigned short* rowL = (LAS unsigned short*)(F.lds + F.wave * 8192);
    LAS int* idsL = (LAS int*)(F.lds + 65536 + F.wave * 1024); LAS float* gatesL = (LAS float*)(F.lds + 65536 + F.wave * 1024 + 512);
    LAS float* actL = (LAS float*)(F.lds + 73728 + F.wave * 512);
    LAS unsigned char* xbL = (LAS unsigned char*)(F.lds + 143360 + F.wave * 1024);
    const bf16* SC = (const bf16*)(F.ws + WS_SC);
    LAS float* wfl = (LAS float*)(F.lds + 77824);
    if (!FINAL) { const f32x4* src = (const f32x4*)(F.ws + WS_WFLF);
#pragma unroll
        for (int i = 0; i < 8; ++i) { const int ch = F.tid + 512 * i, c = ch >> 8, jb = (ch >> 3) & 31, q = ch & 7; *(LAS f32x4*)(wfl + c * 1024 + jb * 32 + ((q ^ (jb & 7)) << 2)) = src[ch]; }
        __syncthreads(); }
    const unsigned rowA = (unsigned)(uintptr_t)F.lds + F.wave * 8192;
#define ROW_DMA(tt) do { const char* r_ = (const char*)(SC + (size_t)(tt) * 2048); _Pragma("unroll") for (int i_ = 0; i_ < 4; ++i_) glds16s(r_, (unsigned)(lane * 16 + i_ * 1024), (unsigned)__builtin_amdgcn_readfirstlane(rowA + i_ * 1024)); } while (0)
    gu32* tctr = F.ctl + 2048 + 64 * (8 * layer + ((int)blockIdx.x & 7)); const int tg = (int)blockIdx.x & 7;
    int kcur = 0;
    if (lane == 0) kcur = (int)__hip_atomic_fetch_add(tctr, 1u, __ATOMIC_RELAXED, __HIP_MEMORY_SCOPE_AGENT);
    kcur = __builtin_amdgcn_readfirstlane(kcur);
    if (kcur < T_TOK / 8) ROW_DMA(8 * kcur + tg);
    while (kcur < T_TOK / 8) {
        const int t = 8 * kcur + tg;
        int j32 = lane & 31; asm volatile("" : "+v"(j32));
        asm volatile("s_waitcnt vmcnt(0)" ::: "memory");
        const GAS v4u* hin = (const GAS v4u*)(HBin + (size_t)t * DMODEL) + 4 * j32;
        v4u hw[4];
#pragma unroll
        for (int q = 0; q < 4; ++q) hw[q] = hin[q];
        int knext = 0;
        if (lane == 0) knext = (int)__hip_atomic_fetch_add(tctr, 1u, __ATOMIC_RELAXED, __HIP_MEMORY_SCOPE_AGENT);
        p5_wave(lane, rowL, idsL, gatesL);
        asm volatile("s_waitcnt lgkmcnt(0)" ::: "memory");
        knext = __builtin_amdgcn_readfirstlane(knext);
        if (knext < T_TOK / 8) ROW_DMA(8 * knext + tg);
#if MFMA_U
        int l16 = lane & 15, lq = lane >> 4; asm volatile("" : "+v"(l16)); asm volatile("" : "+v"(lq));
        int one_e8 = 0x7f7f7f7f; asm volatile("" : "+v"(one_e8));
        v4u xb[8]; float xsc;
        { float ss = 0.f; f32x4 hv[8];
#pragma unroll
          for (int q = 0; q < 4; ++q) { const v4u w = hw[q]; hv[2 * q] = (f32x4){bflo(w.x), bfhi(w.x), bflo(w.y), bfhi(w.y)}; hv[2 * q + 1] = (f32x4){bflo(w.z), bfhi(w.z), bflo(w.w), bfhi(w.w)}; }
#pragma unroll
          for (int q = 0; q < 8; ++q) { ss += (hv[q][0] * hv[q][0] + hv[q][1] * hv[q][1]) + (hv[q][2] * hv[q][2] + hv[q][3] * hv[q][3]); }
          const float rstd = __builtin_amdgcn_rsqf(wave_sum(ss) * (0.5f / DMODEL) + EPS);
          const f32x4* g4 = (const f32x4*)gf + 8 * j32;
          float mx = 0.f;
#pragma unroll
          for (int q = 0; q < 8; ++q) { const f32x4 g = g4[q]; hv[q] = (f32x4){hv[q][0] * rstd * g[0], hv[q][1] * rstd * g[1], hv[q][2] * rstd * g[2], hv[q][3] * rstd * g[3]};
              mx = fmaxf(mx, fmaxf(fmaxf(fabsf(hv[q][0]), fabsf(hv[q][1])), fmaxf(fabsf(hv[q][2]), fabsf(hv[q][3])))); }
          mx = wave_max(mx);
          const float enc = (mx > 0.f) ? 6.0f * __builtin_amdgcn_rcpf(mx) : 1.0f; xsc = (mx > 0.f) ? mx * (1.0f / 6.0f) : 1.0f;
          unsigned xw[4];
#pragma unroll
          for (int q = 0; q < 4; ++q) { unsigned w = 0;
              w = __builtin_amdgcn_cvt_scalef32_pk_fp4_f32(w, hv[2 * q][0] * enc, hv[2 * q][1] * enc, 1.0f, 0); w = __builtin_amdgcn_cvt_scalef32_pk_fp4_f32(w, hv[2 * q][2] * enc, hv[2 * q][3] * enc, 1.0f, 1);
              w = __builtin_amdgcn_cvt_scalef32_pk_fp4_f32(w, hv[2 * q + 1][0] * enc, hv[2 * q + 1][1] * enc, 1.0f, 2); w = __builtin_amdgcn_cvt_scalef32_pk_fp4_f32(w, hv[2 * q + 1][2] * enc, hv[2 * q + 1][3] * enc, 1.0f, 3); xw[q] = w; }
          if (half == 0) *(LAS v4u*)(xbL + j32 * 16) = (v4u){xw[0], xw[1], xw[2], xw[3]};
          const LAS v4u* xbr = (const LAS v4u*)(xbL + lq * 16);
#pragma unroll
          for (int kb = 0; kb < 8; ++kb) xb[kb] = xbr[4 * kb]; }
        __builtin_amdgcn_sched_barrier(0);
#else
        typedef __bf16 bf16x2_t __attribute__((ext_vector_type(2)));
        bf16x2_t xv[16];
        { float ss = 0.f; f32x4 hv[8];
#pragma unroll
          for (int q = 0; q < 4; ++q) { const v4u w = hw[q]; hv[2 * q] = (f32x4){bflo(w.x), bfhi(w.x), bflo(w.y), bfhi(w.y)}; hv[2 * q + 1] = (f32x4){bflo(w.z), bfhi(w.z), bflo(w.w), bfhi(w.w)}; }
#pragma unroll
          for (int q = 0; q < 8; ++q) { ss += (hv[q][0] * hv[q][0] + hv[q][1] * hv[q][1]) + (hv[q][2] * hv[q][2] + hv[q][3] * hv[q][3]); }
          const float rstd = __builtin_amdgcn_rsqf(wave_sum(ss) * (0.5f / DMODEL) + EPS);
          const f32x4* g4 = (const f32x4*)gf + 8 * j32;
#pragma unroll
          for (int q = 0; q < 8; ++q) { const f32x4 g = g4[q]; xv[2 * q] = __builtin_bit_cast(bf16x2_t, cvtpk(hv[q][0] * rstd * g[0], hv[q][1] * rstd * g[1])); xv[2 * q + 1] = __builtin_bit_cast(bf16x2_t, cvtpk(hv[q][2] * rstd * g[2], hv[q][3] * rstd * g[3])); } }
#endif
        const int id0 = idsL[lane], id1 = idsL[64 + lane];
        const float gt0 = gatesL[lane], gt1 = gatesL[64 + lane];
        const float su0 = USC[id0], su1 = USC[id1], sv0 = VSC[id0], sv1 = VSC[id1];
#if MFMA_U
        for (int bt = 0; bt < 2; ++bt) {
            const float gtv = bt ? gt1 : gt0, suv = bt ? su1 : su0, svv = bt ? sv1 : sv0;
            v4u uw[4][8];
#pragma unroll
            for (int g = 0; g < 4; ++g) { const int e = idsL[64 * bt + 16 * g + l16]; const GAS v4u* rp = (const GAS v4u*)(UT + (size_t)e * 512) + lq;
#pragma unroll
                for (int kb = 0; kb < 8; ++kb) uw[g][kb] = rp[4 * kb]; }
            __builtin_amdgcn_sched_barrier(0);
            f32x4 ac[4];
#pragma unroll
            for (int g = 0; g < 4; ++g) { f32x4 a = (f32x4){0.f, 0.f, 0.f, 0.f};
#pragma unroll
                for (int kb = 0; kb < 8; ++kb) { const v4u w = uw[g][kb];
                    const v4u xk = xb[kb];
                    a = __builtin_amdgcn_mfma_scale_f32_16x16x128_f8f6f4((i32x8){(int)w.x, (int)w.y, (int)w.z, (int)w.w, 0, 0, 0, 0}, (i32x8){(int)xk.x, (int)xk.y, (int)xk.z, (int)xk.w, 0, 0, 0, 0}, a, 4, 4, 0, one_e8, 0, one_e8); }
                ac[g] = a; }
            const int gs = (lane >> 2) & 3, rr = lane & 3;
            const f32x4 sg = gs == 0 ? ac[0] : gs == 1 ? ac[1] : gs == 2 ? ac[2] : ac[3];
            const float r1 = rr == 0 ? sg[0] : rr == 1 ? sg[1] : rr == 2 ? sg[2] : sg[3];
            const int xb_ = 16 * gs + 4 * lq + rr;
            const float gte = __shfl(gtv, xb_), sue = __shfl(suv, xb_), sve = __shfl(svv, xb_);
            const float d = r1 * sue * xsc;
            const float act = 0.5f * d * (1.0f + erff(d * 0.70710678118654752f)) * gte * sve;
            actL[64 * bt + xb_] = act;
        }
#else
        for (int bt = 0; bt < 2; ++bt) {
            const int idv = bt ? id1 : id0; const float gtv = bt ? gt1 : gt0, suv = bt ? su1 : su0, svv = bt ? sv1 : sv0;
            v4u uw[32];
#pragma unroll
            for (int p = 0; p < 32; ++p) { const int ea = __builtin_amdgcn_readlane(idv, 2 * p), eb = __builtin_amdgcn_readlane(idv, 2 * p + 1); const int e = half ? eb : ea;
                uw[p] = ((const GAS v4u*)(UT + (size_t)e * 512))[j32]; }
            float pd[32];
#pragma unroll
            for (int p = 0; p < 32; ++p) { float sa = 0.f, sb = 0.f;
#pragma unroll
                for (int w = 0; w < 4; ++w) { const unsigned ww = uw[p][w];
                    sa = __builtin_amdgcn_fdot2_f32_bf16(__builtin_amdgcn_cvt_scalef32_pk_bf16_fp4(ww, 1.0f, 0), xv[4 * w], sa, false); sb = __builtin_amdgcn_fdot2_f32_bf16(__builtin_amdgcn_cvt_scalef32_pk_bf16_fp4(ww, 1.0f, 1), xv[4 * w + 1], sb, false);
                    sa = __builtin_amdgcn_fdot2_f32_bf16(__builtin_amdgcn_cvt_scalef32_pk_bf16_fp4(ww, 1.0f, 2), xv[4 * w + 2], sa, false); sb = __builtin_amdgcn_fdot2_f32_bf16(__builtin_amdgcn_cvt_scalef32_pk_bf16_fp4(ww, 1.0f, 3), xv[4 * w + 3], sb, false); }
                pd[p] = sa + sb; }
            float r16[16], r8[8], r4[4], r2[2], r1;
            { const bool up = (lane & 16) != 0;
#pragma unroll
              for (int p = 0; p < 16; ++p) { const float keep = up ? pd[p + 16] : pd[p], send = up ? pd[p] : pd[p + 16]; r16[p] = keep + __shfl_xor(send, 16); } }
            { const bool up = (lane & 8) != 0;
#pragma unroll
              for (int p = 0; p < 8; ++p) { const float keep = up ? r16[p + 8] : r16[p], send = up ? r16[p] : r16[p + 8]; r8[p] = keep + __shfl_xor(send, 8); } }
            { const bool up = (lane & 4) != 0;
#pragma unroll
              for (int p = 0; p < 4; ++p) { const float keep = up ? r8[p + 4] : r8[p], send = up ? r8[p] : r8[p + 4]; r4[p] = keep + __shfl_xor(send, 4); } }
            { const bool up = (lane & 2) != 0;
#pragma unroll
              for (int p = 0; p < 2; ++p) { const float keep = up ? r4[p + 2] : r4[p], send = up ? r4[p] : r4[p + 2]; r2[p] = keep + __shfl_xor(send, 2); } }
            { const bool up = (lane & 1) != 0; const float keep = up ? r2[1] : r2[0], send = up ? r2[0] : r2[1]; r1 = keep + __shfl_xor(send, 1); }
            const int xb = 2 * (16 * ((lane >> 4) & 1) + 8 * ((lane >> 3) & 1) + 4 * ((lane >> 2) & 1) + 2 * ((lane >> 1) & 1) + (lane & 1)) + half;
            const float gte = __shfl(gtv, xb), sue = __shfl(suv, xb), sve = __shfl(svv, xb);
            const float d = r1 * sue;
            const float act = 0.5f * d * (1.0f + erff(d * 0.70710678118654752f)) * gte * sve;
            actL[64 * bt + xb] = act;
        }
#endif
        v4u hw2[4];
#pragma unroll
        for (int q = 0; q < 4; ++q) hw2[q] = hin[q];
        f32x2 acc[16];
#pragma unroll
        for (int e = 0; e < 16; ++e) acc[e] = (f32x2){0.f, 0.f};
        for (int bt = 0; bt < 2; ++bt) {
            const int idv = bt ? id1 : id0;
            v4u vw[32];
#pragma unroll
            for (int p = 0; p < 32; ++p) { const int ea = __builtin_amdgcn_readlane(idv, 2 * p), eb = __builtin_amdgcn_readlane(idv, 2 * p + 1); const int e = half ? eb : ea;
                vw[p] = ((const GAS v4u*)(VT + (size_t)e * 512))[j32]; }
            const LAS float* ap = actL + 64 * bt + half;
#pragma unroll
            for (int p = 0; p < 32; ++p) { const float w1 = ap[2 * p]; const f32x2 w2 = (f32x2){w1, w1};
#pragma unroll
                for (int w = 0; w < 4; ++w) { const unsigned ww = vw[p][w];
                    acc[4 * w] += w2 * FP4_CVT(ww, 0); acc[4 * w + 1] += w2 * FP4_CVT(ww, 1); acc[4 * w + 2] += w2 * FP4_CVT(ww, 2); acc[4 * w + 3] += w2 * FP4_CVT(ww, 3); } }
        }
        float s2 = 0.f; f32x4 hn[8];
#pragma unroll
        for (int q = 0; q < 8; ++q) { const v4u w = hw2[q >> 1]; const f32x4 hv = (q & 1) ? (f32x4){bflo(w.z), bfhi(w.z), bflo(w.w), bfhi(w.w)} : (f32x4){bflo(w.x), bfhi(w.x), bflo(w.y), bfhi(w.y)};
            const float a0 = acc[2 * q].x + __shfl_xor(acc[2 * q].x, 32), a1 = acc[2 * q].y + __shfl_xor(acc[2 * q].y, 32), a2 = acc[2 * q + 1].x + __shfl_xor(acc[2 * q + 1].x, 32), a3 = acc[2 * q + 1].y + __shfl_xor(acc[2 * q + 1].y, 32);
            hn[q] = (f32x4){hv[0] + a0, hv[1] + a1, hv[2] + a2, hv[3] + a3};
            s2 += (hn[q][0] * hn[q][0] + hn[q][1] * hn[q][1]) + (hn[q][2] * hn[q][2] + hn[q][3] * hn[q][3]); }
        s2 = wave_sum(s2) * 0.5f;
        const float rs = __builtin_amdgcn_rsqf(s2 * (1.0f / DMODEL) + EPS);
        if (FINAL) {
            const f32x4* g4 = (const f32x4*)gfin + 8 * j32; f32x4* hrow = (f32x4*)(Hout + (size_t)t * DMODEL) + 8 * j32;
            if (half == 0) {
#pragma unroll
                for (int q = 0; q < 8; ++q) { const f32x4 g = g4[q]; hrow[q] = (f32x4){hn[q][0] * rs * g[0], hn[q][1] * rs * g[1], hn[q][2] * rs * g[2], hn[q][3] * rs * g[3]}; } }
        } else {
            if (half == 0) {
                GAS v4u* hbp = (GAS v4u*)(HB + (size_t)t * DMODEL) + 4 * j32;
#pragma unroll
                for (int q = 0; q < 4; ++q) hbp[q] = (v4u){pk2(hn[2 * q][0], hn[2 * q][1]), pk2(hn[2 * q][2], hn[2 * q][3]), pk2(hn[2 * q + 1][0], hn[2 * q + 1][1]), pk2(hn[2 * q + 1][2], hn[2 * q + 1][3])}; }
            if (lane < 16) RP[(size_t)t * 16 + lane] = (lane == 0) ? s2 : 0.f;
            float pf[16];
#pragma unroll
            for (int c = 0; c < 16; ++c) { float a = 0.f;
#pragma unroll
                for (int q = 0; q < 8; ++q) { const f32x4 wv = *(const LAS f32x4*)(wfl + c * 1024 + j32 * 32 + ((q ^ (j32 & 7)) << 2)); a += (hn[q][0] * wv[0] + hn[q][1] * wv[1]) + (hn[q][2] * wv[2] + hn[q][3] * wv[3]); }
                pf[c] = a; __builtin_amdgcn_sched_barrier(0); }
            float f8[8], f4[4], f2[2], f1;
            { const bool up = (lane & 16) != 0;
#pragma unroll
              for (int p = 0; p < 8; ++p) { const float keep = up ? pf[p + 8] : pf[p], send = up ? pf[p] : pf[p + 8]; f8[p] = keep + __shfl_xor(send, 16); } }
            { const bool up = (lane & 8) != 0;
#pragma unroll
              for (int p = 0; p < 4; ++p) { const float keep = up ? f8[p + 4] : f8[p], send = up ? f8[p] : f8[p + 4]; f4[p] = keep + __shfl_xor(send, 8); } }
            { const bool up = (lane & 4) != 0;
#pragma unroll
              for (int p = 0; p < 2; ++p) { const float keep = up ? f4[p + 2] : f4[p], send = up ? f4[p] : f4[p + 2]; f2[p] = keep + __shfl_xor(send, 4); } }
            { const bool up = (lane & 2) != 0; const float keep = up ? f2[1] : f2[0], send = up ? f2[0] : f2[1]; f1 = keep + __shfl_xor(send, 2); }
            f1 += __shfl_xor(f1, 1);
            if ((lane & 33) == 0) ((float*)(F.ws + WS_FL))[(size_t)t * 16 + 8 * ((lane >> 4) & 1) + 4 * ((lane >> 3) & 1) + 2 * ((lane >> 2) & 1) + ((lane >> 1) & 1)] = f1 * rs;
        }
        kcur = knext;
    }
}

#undef ROW_DMA
__device__ __forceinline__ void p7_forget_logits(Frame& F) {
    const int rows0 = blockIdx.x * 64;
    for (int r0 = rows0; r0 < T_TOK; r0 += F.G * 64) {
        const f32x4 a = skinny16((const bf16*)(F.ws + WS_HB) + (size_t)r0 * DMODEL, (const bf16*)(F.ws + WS_WFL), F.wave, F.lane, (LAS float*)F.lds);
        if (F.wave < 4) {
#pragma unroll
            for (int r = 0; r < 4; ++r) { const int row = r0 + 16 * F.wave + 4 * (F.lane >> 4) + r; const float rs = pg8::row_rstd((const float*)(F.ws + WS_RP), row);
                ((float*)(F.ws + WS_FL))[(size_t)row * 16 + (F.lane & 15)] = a[r] * rs; } }
        __syncthreads(); }
}
template <class Sched> __device__ __forceinline__ void rstd_table(Frame& F, const Sched& S, LAS float* tab, int& pm0, int& pm1) {
    pm0 = -1; pm1 = -1;
#pragma unroll
    for (int i = 0; i < 3; ++i) { pg8::Unit u; if (S.next(i, u)) { if (i == 0) pm0 = u.pm; if (i == 1) pm1 = u.pm;
        if (F.tid < 256) tab[i * 256 + F.tid] = pg8::row_rstd((const float*)(F.ws + WS_RP), u.pm * 256 + F.tid); } }
    __syncthreads();
}
__device__ __forceinline__ void p9_key_bias(Frame& F, int bh, LAS float* cbL, LAS float* scr  ) {
    const int b = bh >> 4, hd = bh & 15, tid = F.tid;
    const float* FL = (const float*)(F.ws + WS_FL) + (size_t)b * SEQ * 16 + hd; const float bf = F.in[IN_FOX_B_F][hd];
    float v[4];
#pragma unroll
    for (int e = 0; e < 4; ++e) v[e] = log_sigmoid(FL[(size_t)(4 * tid + e) * 16] + bf);
    v[1] += v[0]; v[2] += v[1]; v[3] += v[2];
    float inc = v[3];
#pragma unroll
    for (int o = 1; o < 64; o <<= 1) { const float y = __shfl_up(inc, o); if (F.lane >= o) inc += y; }
    if (F.lane == 63) scr[F.wave] = inc;
    __syncthreads();
    float woff = 0.f;
#pragma unroll
    for (int w = 0; w < 8; ++w) { const float sv = scr[w]; if (w < F.wave) woff += sv; }
    const float excl = woff + inc - v[3];
    *(LAS f32x4*)(cbL + 4 * tid) = (f32x4){-L2E * (excl + v[0]), -L2E * (excl + v[1]), -L2E * (excl + v[2]), -L2E * (excl + v[3])};
    __syncthreads();
}
__device__ __forceinline__ float u2f_(unsigned u) { return __builtin_bit_cast(float, u); }
#ifndef VCH
#define VCH 16
#endif
#ifndef REF_V
#define REF_V 0
#endif
#ifndef REF_U
#define REF_U 0
#endif
#ifndef NSLICE_LOG
#define NSLICE_LOG 2
#endif
template <bool FINAL, int STAGE>
__device__ __forceinline__ void peer_gather_sl(Frame& F, int layer, const bf16* HBin, float* Hout, bf16* HB, float* RP) {
    constexpr int NSL = 1 << NSLICE_LOG;
    const int lane = F.lane;
    const unsigned char* UT = F.ws + WS_TAB + (size_t)(2 * layer) * PEER_NEXP * 512; const unsigned char* VT = UT + (size_t)PEER_NEXP * 512;
    const float* USC = (const float*)(F.ws + WS_TSC) + (size_t)(2 * layer) * PEER_NEXP; const float* VSC = USC + PEER_NEXP;
    const float* gf = F.in[IN_NORM_FFN] + layer * DMODEL; const float* gfin = F.in[IN_NORM_FINAL];
    LAS unsigned short* rowL = (LAS unsigned short*)(F.lds + F.wave * 8192);
    LAS v2u* metaL = (LAS v2u*)(F.lds + F.wave * 8192 + 4096);
    LAS int* idsL = (LAS int*)(F.lds + 65536 + F.wave * 1024); LAS float* gatesL = (LAS float*)(F.lds + 65536 + F.wave * 1024 + 512);
    LAS unsigned char* xqL = (LAS unsigned char*)(F.lds + 73728 + F.wave * 2048);
    LAS unsigned char* accL = (LAS unsigned char*)(F.lds + 90112 + F.wave * 8192);
    const bf16* SC = (const bf16*)(F.ws + WS_SC);
    const unsigned rowA = (unsigned)(uintptr_t)F.lds + F.wave * 8192;
#define ROW_DMA(tt, ln_) do { const char* r_ = (const char*)(SC + (size_t)__builtin_amdgcn_readfirstlane(tt) * 2048); _Pragma("unroll") for (int i_ = 0; i_ < 4; ++i_) glds16s(r_, (unsigned)((ln_) * 16 + i_ * 1024), (unsigned)__builtin_amdgcn_readfirstlane(rowA + i_ * 1024)); } while (0)
    gu32* tctr = F.ctl + 2048 + 64 * ((STAGE == 1 ? 16 : 0) + 8 * layer + ((int)blockIdx.x & 7)); const int tg = (int)blockIdx.x & 7;
    v2u* const metaG = (v2u*)(F.ws + WS_IDS);
    int kq = 0;
    if (lane == 0) kq = (int)__hip_atomic_fetch_add(tctr, 1u, __ATOMIC_RELAXED, __HIP_MEMORY_SCOPE_AGENT);
    kq = __builtin_amdgcn_readfirstlane(kq);
    if (STAGE != 1) { if (kq < T_TOK / 32) ROW_DMA(8 * (4 * kq) + tg, lane); }
    while (kq < T_TOK / 32) {
        int kqn = 0;
        LAS unsigned* rstL = (LAS unsigned*)(F.lds + MISC_OFF + 256 + F.wave * 64);
        if (STAGE != 1) {
        { int l64 = lane; asm volatile("" : "+v"(l64));
          unsigned zz = 0u; asm volatile("" : "+v"(zz));
          v4u hw0[4], hw1[4];
#pragma unroll
          for (int i = 0; i < 4; ++i) { const GAS v4u* hin = (const GAS v4u*)(HBin + (size_t)(8 * (4 * kq + i) + tg) * DMODEL) + 2 * l64; hw0[i] = hin[0]; hw1[i] = hin[1]; }
          const f32x4* g4 = (const f32x4*)gf + 4 * l64;
          f32x4 gq[4];
#pragma unroll
          for (int q = 0; q < 4; ++q) gq[q] = g4[q];
#pragma unroll
          for (int i = 0; i < 4; ++i) { float hv[16];
#pragma unroll
              for (int k = 0; k < 4; ++k) { hv[2 * k] = bflo(hw0[i][k]); hv[2 * k + 1] = bfhi(hw0[i][k]); hv[8 + 2 * k] = bflo(hw1[i][k]); hv[8 + 2 * k + 1] = bfhi(hw1[i][k]); }
              float ss = 0.f;
#pragma unroll
              for (int e = 0; e < 16; ++e) ss += hv[e] * hv[e];
              const float rstd = __builtin_amdgcn_rsqf(wave_sum(ss) * (1.0f / DMODEL) + EPS);
              float mx = 0.f;
#pragma unroll
              for (int q = 0; q < 4; ++q) {
#pragma unroll
                  for (int e = 0; e < 4; ++e) { hv[4 * q + e] = hv[4 * q + e] * rstd * gq[q][e]; mx = fmaxf(mx, fabsf(hv[4 * q + e])); } }
              mx = wave_max(mx);
              const float enc = (mx > 0.f) ? 6.0f * __builtin_amdgcn_rcpf(mx) : 1.0f; const float xsc = (mx > 0.f) ? mx * (1.0f / 6.0f) : 1.0f;
              unsigned w0 = 0, w1 = 0;
              w0 = __builtin_amdgcn_cvt_scalef32_pk_fp4_f32(w0, hv[0] * enc, hv[1] * enc, 1.0f, 0); w0 = __builtin_amdgcn_cvt_scalef32_pk_fp4_f32(w0, hv[2] * enc, hv[3] * enc, 1.0f, 1);
              w0 = __builtin_amdgcn_cvt_scalef32_pk_fp4_f32(w0, hv[4] * enc, hv[5] * enc, 1.0f, 2); w0 = __builtin_amdgcn_cvt_scalef32_pk_fp4_f32(w0, hv[6] * enc, hv[7] * enc, 1.0f, 3);
              w1 = __builtin_amdgcn_cvt_scalef32_pk_fp4_f32(w1, hv[8] * enc, hv[9] * enc, 1.0f, 0); w1 = __builtin_amdgcn_cvt_scalef32_pk_fp4_f32(w1, hv[10] * enc, hv[11] * enc, 1.0f, 1);
              w1 = __builtin_amdgcn_cvt_scalef32_pk_fp4_f32(w1, hv[12] * enc, hv[13] * enc, 1.0f, 2); w1 = __builtin_amdgcn_cvt_scalef32_pk_fp4_f32(w1, hv[14] * enc, hv[15] * enc, 1.0f, 3);
              *(LAS v2u*)(xqL + i * 512 + l64 * 8) = (v2u){w0, w1};
              if (l64 == 0) rstL[i] = __builtin_bit_cast(unsigned, xsc);
              { LAS v4u* st = (LAS v4u*)(accL + i * 2048 + l64 * 32); st[0] = (v4u){zz, zz, zz, zz}; st[1] = (v4u){zz, zz, zz, zz}; } } }
#pragma nounroll
        for (int i = 0; i < 4; ++i) {
            const int t = 8 * (4 * kq + i) + tg;
            int ln = lane; asm volatile("" : "+v"(ln));
            asm volatile("s_waitcnt vmcnt(0)" ::: "memory");
            if (i == 3) { if (ln == 0) kqn = (int)__hip_atomic_fetch_add(tctr, 1u, __ATOMIC_RELAXED, __HIP_MEMORY_SCOPE_AGENT); }
            p5_wave(ln, rowL, idsL, gatesL);
            asm volatile("s_waitcnt lgkmcnt(0)" ::: "memory");
            if (i < 3) ROW_DMA(t + 8, ln);
            else { kqn = __builtin_amdgcn_readfirstlane(kqn); if (kqn < T_TOK / 32) ROW_DMA(8 * (4 * kqn) + tg, ln); }
            const int id0 = idsL[ln], id1 = idsL[64 + ln];
            const float gt0 = gatesL[ln], gt1 = gatesL[64 + ln];
            const float su0 = USC[id0], su1 = USC[id1], sv0 = VSC[id0], sv1 = VSC[id1];
            { const int k0 = id0 >> (14 - NSLICE_LOG), k1 = id1 >> (14 - NSLICE_LOG);
              int pos0 = 0, pos1 = 0, base = 0; unsigned offp = 0;
#pragma unroll
              for (int s = 0; s < NSL; ++s) {
                  const unsigned long long m0 = __ballot(k0 == s), m1 = __ballot(k1 == s);
                  const int c0 = __popcll(m0), c1 = __popcll(m1);
                  const int r0 = (int)__builtin_amdgcn_mbcnt_hi((unsigned)(m0 >> 32), __builtin_amdgcn_mbcnt_lo((unsigned)m0, 0u));
                  const int r1 = (int)__builtin_amdgcn_mbcnt_hi((unsigned)(m1 >> 32), __builtin_amdgcn_mbcnt_lo((unsigned)m1, 0u));
                  if (k0 == s) pos0 = base + r0;
                  if (k1 == s) pos1 = base + c0 + r1;
                  base += c0 + c1;
                  if (s < NSL - 1) offp |= (unsigned)base << (8 * s); }
              if (ln == 0) rstL[4 + i] = offp;
              const unsigned sb0 = (__builtin_bit_cast(unsigned, su0) + 0x8000u) & 0xffff0000u, sb1 = (__builtin_bit_cast(unsigned, su1) + 0x8000u) & 0xffff0000u;
              metaL[i * 128 + pos0] = (v2u){sb0 | (unsigned)id0, __builtin_bit_cast(unsigned, gt0 * sv0)};
              metaL[i * 128 + pos1] = (v2u){sb1 | (unsigned)id1, __builtin_bit_cast(unsigned, gt1 * sv1)}; }
        }
#pragma nounroll
        for (int si = 0; si < 4 * NSL; ++si) {
            const int s = si >> 2, i = si & 3;
            int ln = lane; asm volatile("" : "+v"(ln)); const int l16 = ln & 15, lq = ln >> 4;
            int one_e8 = 0x7f7f7f7f; asm volatile("" : "+v"(one_e8));
            const unsigned o = (unsigned)__builtin_amdgcn_readfirstlane((int)rstL[4 + i]);
            const float xs = u2f_(__builtin_amdgcn_readfirstlane((int)rstL[i]));
            const int lo = s == 0 ? 0 : (int)((o >> (8 * (s - 1))) & 255u), hi = s == NSL - 1 ? 128 : (int)((o >> (8 * s)) & 255u);
            const int n = hi - lo;
            if (n <= 0) continue;
#if REF_U
            {
              const int t = 8 * (4 * __builtin_amdgcn_readfirstlane(kq) + i) + tg;
              const GAS v4u* hin = (const GAS v4u*)(HBin + (size_t)t * DMODEL) + 2 * ln;
              const v4u h0 = hin[0], h1 = hin[1]; float hv[16];
#pragma unroll
              for (int k = 0; k < 4; ++k) { hv[2 * k] = bflo(h0[k]); hv[2 * k + 1] = bfhi(h0[k]); hv[8 + 2 * k] = bflo(h1[k]); hv[8 + 2 * k + 1] = bfhi(h1[k]); }
              float ss = 0.f;
#pragma unroll
              for (int e = 0; e < 16; ++e) ss += hv[e] * hv[e];
              const float rstd = __builtin_amdgcn_rsqf(wave_sum(ss) * (1.0f / DMODEL) + EPS);
              const f32x4* g4 = (const f32x4*)gf + 4 * ln;
#pragma unroll
              for (int q = 0; q < 4; ++q) { const f32x4 g = g4[q];
#pragma unroll
                  for (int e = 0; e < 4; ++e) hv[4 * q + e] = hv[4 * q + e] * rstd * g[e]; }
              LAS v2u* mt = metaL + i * 128 + lo;
              for (int p = 0; p < n; ++p) { const v2u m = mt[p]; const unsigned e = m.x & 0xffffu;
                  const v2u uw = ((const GAS v2u*)(UT + (size_t)e * 512))[ln];
                  float ds = 0.f;
#pragma unroll
                  for (int w = 0; w < 2; ++w) { const unsigned ww = uw[w];
                      const f32x2 c0 = FP4_CVT(ww, 0), c1 = FP4_CVT(ww, 1), c2 = FP4_CVT(ww, 2), c3 = FP4_CVT(ww, 3);
                      ds += c0.x * hv[8 * w] + c0.y * hv[8 * w + 1] + c1.x * hv[8 * w + 2] + c1.y * hv[8 * w + 3] + c2.x * hv[8 * w + 4] + c2.y * hv[8 * w + 5] + c3.x * hv[8 * w + 6] + c3.y * hv[8 * w + 7]; }
                  ds = wave_sum(ds);
                  const float d = ds * u2f_(m.x & 0xffff0000u);
                  const float act = 0.5f * d * (1.0f + erff(d * 0.70710678118654752f)) * u2f_(m.y);
                  if (ln == 0) ((LAS unsigned*)(mt + p))[1] = __builtin_bit_cast(unsigned, act); } }
            (void)xs; (void)l16; (void)lq; (void)one_e8;
        }
#else
            v4u xb[8];
            { const LAS v4u* xbr = (const LAS v4u*)(xqL + i * 512) + lq;
#pragma unroll
              for (int kb = 0; kb < 8; ++kb) xb[kb] = xbr[4 * kb]; }
            LAS v2u* mt = metaL + i * 128 + lo;
            for (int g0 = 0; g0 < n; g0 += 64) {
                const int rem = n - g0;
                v4u uw[4][8];
#pragma unroll
                for (int g = 0; g < 4; ++g) if (16 * g < rem) { int p = g0 + 16 * g + l16; p = p < n ? p : n - 1; const unsigned e = mt[p].x & 0xffffu; const GAS v4u* rp = (const GAS v4u*)(UT + (size_t)e * 512) + lq;
#pragma unroll
                    for (int kb = 0; kb < 8; ++kb) uw[g][kb] = rp[4 * kb]; }
                __builtin_amdgcn_sched_barrier(0);
                f32x4 ac[4];
#pragma unroll
                for (int g = 0; g < 4; ++g) { f32x4 a = (f32x4){0.f, 0.f, 0.f, 0.f};
                    if (16 * g < rem) {
                        asm volatile("s_nop 4\n\t"
                            "v_mfma_scale_f32_16x16x128_f8f6f4 %0, %1, %9, %0, %17, %17 op_sel_hi:[0,0,0] cbsz:4 blgp:4\n\t"
                            "v_mfma_scale_f32_16x16x128_f8f6f4 %0, %2, %10, %0, %17, %17 op_sel_hi:[0,0,0] cbsz:4 blgp:4\n\t"
                            "v_mfma_scale_f32_16x16x128_f8f6f4 %0, %3, %11, %0, %17, %17 op_sel_hi:[0,0,0] cbsz:4 blgp:4\n\t"
                            "v_mfma_scale_f32_16x16x128_f8f6f4 %0, %4, %12, %0, %17, %17 op_sel_hi:[0,0,0] cbsz:4 blgp:4\n\t"
                            "v_mfma_scale_f32_16x16x128_f8f6f4 %0, %5, %13, %0, %17, %17 op_sel_hi:[0,0,0] cbsz:4 blgp:4\n\t"
                            "v_mfma_scale_f32_16x16x128_f8f6f4 %0, %6, %14, %0, %17, %17 op_sel_hi:[0,0,0] cbsz:4 blgp:4\n\t"
                            "v_mfma_scale_f32_16x16x128_f8f6f4 %0, %7, %15, %0, %17, %17 op_sel_hi:[0,0,0] cbsz:4 blgp:4\n\t"
                            "v_mfma_scale_f32_16x16x128_f8f6f4 %0, %8, %16, %0, %17, %17 op_sel_hi:[0,0,0] cbsz:4 blgp:4"
                            : "+v"(a)
                            : "v"(uw[g][0]), "v"(uw[g][1]), "v"(uw[g][2]), "v"(uw[g][3]), "v"(uw[g][4]), "v"(uw[g][5]), "v"(uw[g][6]), "v"(uw[g][7]),
                              "v"(xb[0]), "v"(xb[1]), "v"(xb[2]), "v"(xb[3]), "v"(xb[4]), "v"(xb[5]), "v"(xb[6]), "v"(xb[7]), "v"(one_e8)); }
                    ac[g] = a; }
                asm volatile("s_nop 15\n\ts_nop 7" : "+v"(ac[0]), "+v"(ac[1]), "+v"(ac[2]), "+v"(ac[3]));
                const int gs = (ln >> 2) & 3, rr = ln & 3;
                const f32x4 sg = gs == 0 ? ac[0] : gs == 1 ? ac[1] : gs == 2 ? ac[2] : ac[3];
                const float r1 = rr == 0 ? sg[0] : rr == 1 ? sg[1] : rr == 2 ? sg[2] : sg[3];
                const int pp = g0 + 16 * gs + 4 * lq + rr; const bool ok = pp < n; const int pc = ok ? pp : n - 1;
                const v2u m = mt[pc];
                const float d = r1 * u2f_(m.x & 0xffff0000u) * xs;
                const float act = 0.5f * d * (1.0f + erff(d * 0.70710678118654752f)) * u2f_(m.y);
                if (ok) ((LAS unsigned*)(mt + pc))[1] = __builtin_bit_cast(unsigned, act);
            }
        }
#endif
        }
        if (STAGE == 0) {
            int ln = lane; asm volatile("" : "+v"(ln));
            const int kqs = __builtin_amdgcn_readfirstlane(kq);
#pragma unroll
            for (int i = 0; i < 4; ++i) { const int t = 8 * (4 * kqs + i) + tg; ((GAS v4u*)(metaG + (size_t)t * 128))[ln] = ((const LAS v4u*)(metaL + i * 128))[ln]; }
        }
        if (STAGE == 1) {
            int ln = lane; asm volatile("" : "+v"(ln));
            unsigned zz = 0u; asm volatile("" : "+v"(zz));
            if (ln == 0) kqn = (int)__hip_atomic_fetch_add(tctr, 1u, __ATOMIC_RELAXED, __HIP_MEMORY_SCOPE_AGENT);
            const int kqs = __builtin_amdgcn_readfirstlane(kq);
            v4u mb[4];
#pragma unroll
            for (int i = 0; i < 4; ++i) { const int t = 8 * (4 * kqs + i) + tg; mb[i] = ((const GAS v4u*)(metaG + (size_t)t * 128))[ln]; }
#pragma unroll
            for (int i = 0; i < 4; ++i) { ((LAS v4u*)(metaL + i * 128))[ln] = mb[i]; LAS v4u* st = (LAS v4u*)(accL + i * 2048 + ln * 32); st[0] = (v4u){zz, zz, zz, zz}; st[1] = (v4u){zz, zz, zz, zz}; }
        }
        if (STAGE != 0) {
#pragma nounroll
        for (int si = 0; si < 4 * NSL; ++si) {
            const int s = si >> 2, i = si & 3;
            int l64 = lane; asm volatile("" : "+v"(l64));
            const unsigned o = (unsigned)__builtin_amdgcn_readfirstlane((int)rstL[4 + i]);
            const int lo = s == 0 ? 0 : (int)((o >> (8 * (s - 1))) & 255u), hi = s == NSL - 1 ? 128 : (int)((o >> (8 * s)) & 255u);
            const int n = hi - lo;
            if (n <= 0) continue;
            const LAS v2u* mt = metaL + i * 128 + lo;
            f32x2 acc[8];
#pragma unroll
            for (int e = 0; e < 8; ++e) acc[e] = (f32x2){0.f, 0.f};
#if REF_V
            for (int p = 0; p < n; ++p) { const v2u m = mt[p]; const unsigned e = m.x & 0xffffu; float w1 = u2f_(m.y); asm volatile("" : "+v"(w1)); const f32x2 w2 = (f32x2){w1, w1};
                const v2u vr = ((const GAS v2u*)(VT + (size_t)e * 512))[l64];
#pragma unroll
                for (int w = 0; w < 2; ++w) { const unsigned ww = vr[w];
                    acc[4 * w] += w2 * FP4_CVT(ww, 0); acc[4 * w + 1] += w2 * FP4_CVT(ww, 1); acc[4 * w + 2] += w2 * FP4_CVT(ww, 2); acc[4 * w + 3] += w2 * FP4_CVT(ww, 3); } }
#else
            for (int c0 = 0; c0 < n; c0 += VCH) {
                const int rem = n - c0;
                int pm = c0 + (l64 & (VCH - 1)); const bool okm = pm < n; pm = okm ? pm : n - 1; const v2u m = mt[pm];
                const int idv = (int)(m.x & 0xffffu); const int avb = okm ? (int)m.y : 0;
                v2u vw[VCH];
#pragma unroll
                for (int r = 0; r < VCH; ++r) if (r < rem) { const int e = __builtin_amdgcn_readlane(idv, r); vw[r] = ((const GAS v2u*)(VT + (size_t)e * 512))[l64]; }
#pragma unroll
                for (int r = 0; r < VCH; ++r) if (r < rem) { const float w1 = u2f_(__builtin_amdgcn_readlane(avb, r)); const f32x2 w2 = (f32x2){w1, w1};
#pragma unroll
                    for (int w = 0; w < 2; ++w) { const unsigned ww = vw[r][w];
                        acc[4 * w] += w2 * FP4_CVT(ww, 0); acc[4 * w + 1] += w2 * FP4_CVT(ww, 1); acc[4 * w + 2] += w2 * FP4_CVT(ww, 2); acc[4 * w + 3] += w2 * FP4_CVT(ww, 3); } }
            }
#endif
            LAS v4u* st = (LAS v4u*)(accL + i * 2048 + l64 * 32);
            const v4u s0 = st[0], s1 = st[1];
            st[0] = (v4u){cvtpk(bflo(s0.x) + acc[0].x, bfhi(s0.x) + acc[0].y), cvtpk(bflo(s0.y) + acc[1].x, bfhi(s0.y) + acc[1].y), cvtpk(bflo(s0.z) + acc[2].x, bfhi(s0.z) + acc[2].y), cvtpk(bflo(s0.w) + acc[3].x, bfhi(s0.w) + acc[3].y)};
            st[1] = (v4u){cvtpk(bflo(s1.x) + acc[4].x, bfhi(s1.x) + acc[4].y), cvtpk(bflo(s1.y) + acc[5].x, bfhi(s1.y) + acc[5].y), cvtpk(bflo(s1.z) + acc[6].x, bfhi(s1.z) + acc[6].y), cvtpk(bflo(s1.w) + acc[7].x, bfhi(s1.w) + acc[7].y)};
        }
        int kqe = __builtin_amdgcn_readfirstlane(kq); asm volatile("" : "+s"(kqe));
#pragma nounroll
        for (int i = 0; i < 4; ++i) {
            const int t = 8 * (4 * kqe + i) + tg;
            int l64 = lane; asm volatile("" : "+v"(l64));
            const GAS v4u* hin = (const GAS v4u*)(HBin + (size_t)t * DMODEL) + 2 * l64;
            const v4u h0 = hin[0], h1 = hin[1];
            const LAS v4u* st = (const LAS v4u*)(accL + i * 2048 + l64 * 32);
            const v4u a0 = st[0], a1 = st[1];
            float hn[16]; float s2 = 0.f;
#pragma unroll
            for (int k = 0; k < 4; ++k) { hn[2 * k] = bflo(h0[k]) + bflo(a0[k]); hn[2 * k + 1] = bfhi(h0[k]) + bfhi(a0[k]); hn[8 + 2 * k] = bflo(h1[k]) + bflo(a1[k]); hn[8 + 2 * k + 1] = bfhi(h1[k]) + bfhi(a1[k]); }
#pragma unroll
            for (int e = 0; e < 16; ++e) s2 += hn[e] * hn[e];
            s2 = wave_sum(s2);
            if (FINAL) {
                const float rs = __builtin_amdgcn_rsqf(s2 * (1.0f / DMODEL) + EPS);
                const f32x4* g4 = (const f32x4*)gfin + 4 * l64; f32x4* hrow = (f32x4*)(Hout + (size_t)t * DMODEL) + 4 * l64;
#pragma unroll
                for (int q = 0; q < 4; ++q) { const f32x4 g = g4[q]; hrow[q] = (f32x4){hn[4 * q] * rs * g[0], hn[4 * q + 1] * rs * g[1], hn[4 * q + 2] * rs * g[2], hn[4 * q + 3] * rs * g[3]}; }
            } else {
                GAS v4u* hbp = (GAS v4u*)(HB + (size_t)t * DMODEL) + 2 * l64;
                hbp[0] = (v4u){cvtpk(hn[0], hn[1]), cvtpk(hn[2], hn[3]), cvtpk(hn[4], hn[5]), cvtpk(hn[6], hn[7])};
                hbp[1] = (v4u){cvtpk(hn[8], hn[9]), cvtpk(hn[10], hn[11]), cvtpk(hn[12], hn[13]), cvtpk(hn[14], hn[15])};
                if (l64 < 16) RP[(size_t)t * 16 + l64] = (l64 == 0) ? s2 : 0.f;
            }
        }
        }
        kq = __builtin_amdgcn_readfirstlane(kqn);
    }
}
#undef ROW_DMA
#ifndef TWO_STAGE
#define TWO_STAGE 1
#endif
constexpr int N_PHASES = 14;
#ifndef ATTN_THRL
#define ATTN_THRL 8
#endif
#ifndef MK_PER_PHASE
#define MK_PER_PHASE 0
#endif
struct Args { const float* in[18]; float* out; unsigned char* ws; int ph_lo, ph_hi, dry, li; };
__global__ void __launch_bounds__(NWAVES * 64, 2) yoco_fwd(Args args) {
    extern __shared__ __attribute__((aligned(16))) unsigned char lds[];
    Frame F;
    F.lds = (LAS unsigned char*)lds;
    F.MISC = (volatile LAS unsigned*)(F.lds + MISC_OFF);
    F.tid = threadIdx.x; F.lane = F.tid & 63; F.wave = __builtin_amdgcn_readfirstlane(F.tid >> 6);
    F.G = gridDim.x; { const int bx = blockIdx.x; F.vcu = (F.G % 8 == 0) ? (bx % 8) * (F.G / 8) + bx / 8 : bx; }
    F.ws = args.ws; F.ctl = (gu32*)(args.ws + WS_CTL); F.out = args.out;
#pragma unroll
    for (int i = 0; i < 18; ++i) F.in[i] = args.in[i];
    for (int u = F.tid; u < (LDS_BYTES - LDSCTL_OFF) / 4; u += NWAVES * 64) ((LAS unsigned*)(F.lds + LDSCTL_OFF))[u] = 0u;
    __syncthreads();
    XcdBarrier bar; bar.bar = (unsigned*)(F.ctl + CW_BAR) + args.li * XCD_BAR_WORDS; bar.x = 0; bar.st = nullptr;
    if (!MK_PER_PHASE) bar = xcd_barrier_post((unsigned*)(F.ctl + CW_BAR) + args.li * XCD_BAR_WORDS, F.MISC + 8);
    const int lo = args.ph_lo, hi = args.ph_hi;
#define REID() do { int t_ = threadIdx.x; asm volatile("" : "+v"(t_)); F.tid = t_; F.lane = t_ & 63; F.wave = __builtin_amdgcn_readfirstlane(t_ >> 6); } while (0)
#ifndef PHASE_OFF
#define PHASE_OFF 0
#endif
#define IN(k) (lo <= (k) && (k) < hi && !((PHASE_OFF >> (k)) & 1))
#define SEAM(k) do { if (IN(k) && IN((k) + 1)) xcd_barrier(bar); } while (0)
#define SEAM2(k, k2) do { if (IN(k) && IN(k2)) xcd_barrier(bar); } while (0)
#ifndef REPEAT_MASK
#define REPEAT_MASK 0
#endif
#define REP(k) ((REPEAT_MASK >> (k)) & 1)
#ifdef REP_WITH_BARRIER
#define REPBAR() xcd_barrier(bar)
#else
#define REPBAR() do {} while (0)
#endif
    float* const DUMF = (float*)(F.ws + WS_END); bf16* const DUMB = (bf16*)(F.ws + WS_END + 64 * MiB); float* const DUMR = (float*)(F.ws + WS_END + 96 * MiB);
    bf16* const A0 = (bf16*)(F.ws + WS_A0); bf16* const HB = (bf16*)(F.ws + WS_HB); bf16* const PQ = (bf16*)(F.ws + WS_PQ);
    float* const RP = (float*)(F.ws + WS_RP); float* const SC = (float*)(F.ws + WS_SC);

#ifndef NPASS
#define NPASS 1
#endif
    if (IN(0)) { REID(); if (REP(0)) { p0_prologue(F);  } p0_prologue(F); } SEAM(0);
    if (IN(1)) { REID(); if (REP(1)) { pg8::Gemm g{A0, (const bf16*)(F.ws + WS_WIN), T_TOK, 3072, DMODEL}; pg8::StaticOrder S; S.init(T_TOK, 3072, F.G, (int)blockIdx.x);
        pg8::EpiBf16RS E{PQ, 3072, 0, 0, 1.f, nullptr, -1, -1, F.in[IN_GLA_NORM_O], 2048};
        pg8::gemm_phase<pg8::EpiBf16RS, pg8::StaticOrder, true, true>(F.lds, g, S, E);  } if (REP(1)) REPBAR(); pg8::Gemm g{A0, (const bf16*)(F.ws + WS_WIN), T_TOK, 3072, DMODEL}; pg8::StaticOrder S; S.init(T_TOK, 3072, F.G, (int)blockIdx.x);
        pg8::EpiBf16RS E{PQ, 3072, 0, 0, 1.f, nullptr, -1, -1, F.in[IN_GLA_NORM_O], 2048};
        pg8::gemm_phase<pg8::EpiBf16RS, pg8::StaticOrder, true, true>(F.lds, g, S, E); } SEAM(1);
    if (IN(2)) { REID(); if (REP(2)) { for (int c = blockIdx.x; c < NB * GLA_NCH; c += F.G) p2a_item(F, c >> 5, c & 31);  } for (int c = blockIdx.x; c < NB * GLA_NCH; c += F.G) p2a_item(F, c >> 5, c & 31); } SEAM(2);
    if (IN(3)) { REID(); if (REP(3)) { if ((int)blockIdx.x < NB * GLA_H) p2b_seq(F, blockIdx.x, args.dry); else { late_weights(F, NB * GLA_H, F.G - NB * GLA_H); peer_tables_convert(F, NB * GLA_H * NWAVES, (F.G - NB * GLA_H) * NWAVES); }  } if ((int)blockIdx.x < NB * GLA_H) p2b_seq(F, blockIdx.x, args.dry); else { late_weights(F, NB * GLA_H, F.G - NB * GLA_H); peer_tables_convert(F, NB * GLA_H * NWAVES, (F.G - NB * GLA_H) * NWAVES); } } SEAM(3);
    if (IN(4)) { REID(); if (REP(4)) { pg8::Gemm g{A0, (const bf16*)(F.ws + WS_WGO), T_TOK, DMODEL, DMODEL}; pg8::StaticOrder S; S.init(T_TOK, DMODEL, F.G, (int)blockIdx.x);
        pg8::EpiResid<false> E{F.in[IN_X], HB, RP, DMODEL};
        pg8::gemm_phase<pg8::EpiResid<false>, pg8::StaticOrder, false, true>(F.lds, g, S, E);  } pg8::Gemm g{A0, (const bf16*)(F.ws + WS_WGO), T_TOK, DMODEL, DMODEL}; pg8::StaticOrder S; S.init(T_TOK, DMODEL, F.G, (int)blockIdx.x);
        pg8::EpiResid<false> E{F.in[IN_X], HB, RP, DMODEL};
        pg8::gemm_phase<pg8::EpiResid<false>, pg8::StaticOrder, false, true>(F.lds, g, S, E); } SEAM(4);
    if (IN(5)) { REID(); if (REP(5)) { pg8::Gemm g{HB, (const bf16*)(F.ws + WS_WEFF), T_TOK, 2048, DMODEL}; pg8::StaticOrder S; S.init(T_TOK, 2048, F.G, (int)blockIdx.x);
        int pm0, pm1; rstd_table(F, S, (LAS float*)(F.lds + 131072), pm0, pm1); pg8::EpiBf16RS E{(bf16*)SC, 2048, 0, 0, 1.f, (const LAS float*)(F.lds + 131072), pm0, pm1, nullptr, 0};
        pg8::gemm_phase<pg8::EpiBf16RS, pg8::StaticOrder, true, true>(F.lds, g, S, E);  } pg8::Gemm g{HB, (const bf16*)(F.ws + WS_WEFF), T_TOK, 2048, DMODEL}; pg8::StaticOrder S; S.init(T_TOK, 2048, F.G, (int)blockIdx.x);
        int pm0, pm1; rstd_table(F, S, (LAS float*)(F.lds + 131072), pm0, pm1); pg8::EpiBf16RS E{(bf16*)SC, 2048, 0, 0, 1.f, (const LAS float*)(F.lds + 131072), pm0, pm1, nullptr, 0};
        pg8::gemm_phase<pg8::EpiBf16RS, pg8::StaticOrder, true, true>(F.lds, g, S, E); } SEAM2(5, 7);
    if (IN(7)) { REID(); if (TWO_STAGE) { peer_gather_sl<false, 0>(F, 0, HB, nullptr, HB, RP); xcd_barrier(bar); REID(); peer_gather_sl<false, 1>(F, 0, HB, nullptr, HB, RP); } else peer_gather_sl<false, 2>(F, 0, HB, nullptr, HB, RP); } SEAM(7);
    if (IN(8)) { REID(); if (REP(8)) {
        pg8::Gemm g{HB, (const bf16*)(F.ws + WS_WQKV), T_TOK, 3072, DMODEL}; pg8::StaticOrder S; S.init(T_TOK, 3072, F.G, (int)blockIdx.x);
        int pm0, pm1; rstd_table(F, S, (LAS float*)(F.lds + 131072), pm0, pm1); pg8::EpiBf16RS E{PQ, DMODEL, DMODEL, (size_t)T_TOK * DMODEL, attn_body::C2, (const LAS float*)(F.lds + 131072), pm0, pm1, nullptr, 0};
        pg8::gemm_phase<pg8::EpiBf16RS, pg8::StaticOrder, true, true>(F.lds, g, S, E);  } if (REP(8)) REPBAR();
        p7_forget_logits(F);
        pg8::Gemm g{HB, (const bf16*)(F.ws + WS_WQKV), T_TOK, 3072, DMODEL}; pg8::StaticOrder S; S.init(T_TOK, 3072, F.G, (int)blockIdx.x);
        int pm0, pm1; rstd_table(F, S, (LAS float*)(F.lds + 131072), pm0, pm1); pg8::EpiBf16RS E{PQ, DMODEL, DMODEL, (size_t)T_TOK * DMODEL, attn_body::C2, (const LAS float*)(F.lds + 131072), pm0, pm1, nullptr, 0};
        pg8::gemm_phase<pg8::EpiBf16RS, pg8::StaticOrder, true, true>(F.lds, g, S, E); } SEAM(8);
    if (IN(9)) { REID(); for (int rep = REP(9) ? 0 : 1; rep < 2; ++rep) {
        p9_key_bias(F, F.vcu >> 1, (LAS float*)(F.lds + attn_body::LDS_CB), (LAS float*)(F.lds + attn_body::LDS_TOTAL));
        const attn_body::AttnTensors AT{(const attn_body::bf16*)PQ, (const attn_body::bf16*)(PQ + (size_t)T_TOK * DMODEL), (const attn_body::bf16*)(PQ + 2 * (size_t)T_TOK * DMODEL), (attn_body::bf16*)((rep == 0 || args.dry) ? DUMB : PQ)};
        const attn_body::StaticOrder S((int)F.G, (int)blockIdx.x);
        attn_body::attn_phase<attn_body::StaticOrder, ATTN_THRL>((char*)lds, AT, S); } } SEAM(9);
    if (IN(10)) { REID(); if (REP(10)) { pg8::Gemm g{PQ, (const bf16*)(F.ws + WS_WFO), T_TOK, DMODEL, DMODEL}; pg8::StaticOrder S; S.init(T_TOK, DMODEL, F.G, (int)blockIdx.x);
        pg8::EpiResid<false> E{DUMF, DUMB, DUMR, DMODEL};
        pg8::gemm_phase<pg8::EpiResid<false>, pg8::StaticOrder, false, true>(F.lds, g, S, E);  } pg8::Gemm g{PQ, (const bf16*)(F.ws + WS_WFO), T_TOK, DMODEL, DMODEL}; pg8::StaticOrder S; S.init(T_TOK, DMODEL, F.G, (int)blockIdx.x);
        pg8::EpiResid<true> E{nullptr, HB, RP, DMODEL};
        pg8::gemm_phase<pg8::EpiResid<true>, pg8::StaticOrder, false, true>(F.lds, g, S, E); } SEAM(10);
    if (IN(11)) { REID(); if (REP(11)) { pg8::Gemm g{HB, (const bf16*)(F.ws + WS_WEFF) + (size_t)2048 * DMODEL, T_TOK, 2048, DMODEL}; pg8::StaticOrder S; S.init(T_TOK, 2048, F.G, (int)blockIdx.x);
        int pm0, pm1; rstd_table(F, S, (LAS float*)(F.lds + 131072), pm0, pm1); pg8::EpiBf16RS E{(bf16*)SC, 2048, 0, 0, 1.f, (const LAS float*)(F.lds + 131072), pm0, pm1, nullptr, 0};
        pg8::gemm_phase<pg8::EpiBf16RS, pg8::StaticOrder, true, true>(F.lds, g, S, E);  } pg8::Gemm g{HB, (const bf16*)(F.ws + WS_WEFF) + (size_t)2048 * DMODEL, T_TOK, 2048, DMODEL}; pg8::StaticOrder S; S.init(T_TOK, 2048, F.G, (int)blockIdx.x);
        int pm0, pm1; rstd_table(F, S, (LAS float*)(F.lds + 131072), pm0, pm1); pg8::EpiBf16RS E{(bf16*)SC, 2048, 0, 0, 1.f, (const LAS float*)(F.lds + 131072), pm0, pm1, nullptr, 0};
        pg8::gemm_phase<pg8::EpiBf16RS, pg8::StaticOrder, true, true>(F.lds, g, S, E); } SEAM2(11, 13);
    if (IN(13)) { REID(); if (TWO_STAGE) { peer_gather_sl<true, 0>(F, 1, HB, F.out, nullptr, nullptr); xcd_barrier(bar); REID(); peer_gather_sl<true, 1>(F, 1, HB, F.out, nullptr, nullptr); } else peer_gather_sl<true, 2>(F, 1, HB, F.out, nullptr, nullptr); }
#undef IN
#undef SEAM
}

extern "C" void kernel_launch(void* const* d_in, const int* in_sizes, int n_in, void* d_out, int out_size, void* d_ws, size_t ws_size, hipStream_t stream) {
    static int grid = 0;
    if (grid == 0) {
        if (n_in != 18 || in_sizes[0] != T_TOK * DMODEL || out_size != T_TOK * DMODEL || ws_size < WS_END + ((REPEAT_MASK || MK_PER_PHASE) ? 97 * MiB : 0)) { fprintf(stderr, "kernel_launch: unexpected shapes (n_in %d, in0 %d, out %d, ws %zu); nothing launched\n", n_in, n_in > 0 ? in_sizes[0] : -1, out_size, ws_size); grid = -1; return; }
        int dev = 0, cus = 0;
        if (hipGetDevice(&dev) != hipSuccess || hipDeviceGetAttribute(&cus, hipDeviceAttributeMultiprocessorCount, dev) != hipSuccess) { grid = -1; return; }
        if (hipFuncSetAttribute((const void*)yoco_fwd, hipFuncAttributeMaxDynamicSharedMemorySize, LDS_BYTES) != hipSuccess) { fprintf(stderr, "kernel_launch: hipFuncSetAttribute failed\n"); grid = -1; return; }
        (void)hipGetLastError();
        grid = cus;
        if (grid != 256) { fprintf(stderr, "kernel_launch: built for a 256-CU device, found %d; nothing launched\n", cus); grid = -1; return; }
    }
    if (grid < 0) return;
    if (hipMemsetAsync((char*)d_ws + WS_CTL, 0, CTL_ZERO_BYTES, stream) != hipSuccess) return;
    Args a{};
    for (int i = 0; i < 18; ++i) a.in[i] = (const float*)d_in[i];
    a.out = (float*)d_out; a.ws = (unsigned char*)d_ws;
#if MK_PER_PHASE
    for (int p = 0; p < N_PHASES; ++p) { a.ph_lo = p; a.ph_hi = p + 1;
#ifdef DUP_PHASE
        if (p == DUP_PHASE) hipLaunchKernelGGL(yoco_fwd, dim3(grid), dim3(NWAVES * 64), LDS_BYTES, stream, a);
#endif
#ifdef DRY_PHASE
        if (p == DRY_PHASE) { a.dry = 1; hipLaunchKernelGGL(yoco_fwd, dim3(grid), dim3(NWAVES * 64), LDS_BYTES, stream, a); a.dry = 0; }
#endif
        hipLaunchKernelGGL(yoco_fwd, dim3(grid), dim3(NWAVES * 64), LDS_BYTES, stream, a); }
#else
    a.ph_lo = 0; a.ph_hi = N_PHASES;
    for (int li = 0; li < NPASS; ++li) { a.li = li; hipLaunchKernelGGL(yoco_fwd, dim3(grid), dim3(NWAVES * 64), LDS_BYTES, stream, a); }
#endif
}
```

```cpp
#define NSLICE_LOG 0
#define TWO_STAGE 0
#include <hip/hip_runtime.h>
#include <cstdio>
#include <cstdint>
namespace pg8 {
#define PG8_LAS __attribute__((address_space(3)))
typedef unsigned short bf16_t;
typedef short bf16x8 __attribute__((ext_vector_type(8)));
typedef float f32x4 __attribute__((ext_vector_type(4)));
typedef unsigned u32x4 __attribute__((ext_vector_type(4)));
constexpr int BM = 256, BK = 64, HALF = 128, HTB = HALF * BK * 2  , STAGE_BYTES = 8 * HTB, NXCD = 8, WGM = 8;

__host__ __device__ __forceinline__ int lds_byte(int r, int c) { const int st = (r >> 4) * 2 + (c >> 5), rr = r & 15, cc = c & 31, ob = rr * 64 + cc * 2; return st * 1024 + (ob ^ (((ob >> 9) & 1) << 5)); }
__host__ __device__ __forceinline__ void stage_rc(int b, int& R, int& C) { const int st = b / 1024, sb = b % 1024, swz = sb ^ (((sb >> 9) & 1) << 5); R = (st >> 1) * 16 + swz / 64; C = (st & 1) * 32 + (swz % 64) / 2; }
__host__ __device__ __forceinline__ int perm32(int rho) { const int n = rho >> 4, i = rho & 15; return 8 * (i >> 2) + 4 * n + (i & 3); }

struct Unit { int pm, pn; };
struct Gemm { const bf16_t* A; const bf16_t* Bt; int M, N, K; };

struct StaticOrder {
    int nM, nN, nwg, G, c;
    __host__ __device__ void init(int M, int N, int G_, int c_) { nM = M / BM; nN = N / BM; nwg = nM * nN; G = G_; c = c_; }
    __host__ __device__ bool next(int i, Unit& u) const {
        const long L = (long)i * G + c; if (L >= nwg) return false;
        int wgid = (int)L; { const int q = nwg / NXCD, r = nwg % NXCD, xcd = wgid % NXCD, off = wgid / NXCD; wgid = (xcd < r ? xcd * (q + 1) : r * (q + 1) + (xcd - r) * q) + off; }
        const int nig = WGM * nN, gid = wgid / nig, fm = gid * WGM, gsz = (nM - fm) < WGM ? (nM - fm) : WGM;
        u.pm = fm + ((wgid % nig) % gsz); u.pn = (wgid % nig) / gsz; return true;
    }
    __device__ __forceinline__ void a_ready(const Unit&) const {}
    __device__ __forceinline__ void done(const Unit&) const {}
};

__device__ __forceinline__ unsigned cvt_pk_bf16(float lo, float hi) { unsigned r; asm volatile("v_cvt_pk_bf16_f32 %0, %1, %2" : "=v"(r) : "v"(lo), "v"(hi)); return r; }
typedef unsigned u32x2 __attribute__((ext_vector_type(2)));
constexpr float RMS_EPS = 1e-6f;
__device__ __forceinline__ float row_rstd(const float* rowpart, int row) {
    const f32x4* p = (const f32x4*)(rowpart + (size_t)row * 16);
    const f32x4 a = p[0], b = p[1], c = p[2], d = p[3];
    const float s = (((a[0] + a[1]) + (a[2] + a[3])) + ((b[0] + b[1]) + (b[2] + b[3]))) + (((c[0] + c[1]) + (c[2] + c[3])) + ((d[0] + d[1]) + (d[2] + d[3])));
    return 1.0f / sqrtf(s * (1.0f / 1024.0f) + RMS_EPS);
}
struct EpiBf16RS {
    static constexpr bool PERM = true, AFTER_DRAIN = false;
    bf16_t* O; int ldc; int split_cols; size_t split_stride; float scale0; const PG8_LAS float* rs_tab; int pm0, pm1;
    const float* gate_w; int gate_col0;
    __device__ __forceinline__ void operator()(const f32x4 (&acc)[2][2][4][2], const Unit& u, int wr, int wc, int fr, int fq) const {
        const int row0 = u.pm * BM + wr * 64 + fr; int colt = u.pn * BM; bf16_t* base = O;
        float sc = 1.f; if (split_cols) { const int t = colt / split_cols; base += (size_t)t * split_stride; colt -= t * split_cols; if (t == 0) sc = scale0; }
        const int col0 = colt + wc * 32 + 8 * fq;
#pragma unroll
        for (int ai = 0; ai < 2; ++ai)
#pragma unroll
            for (int m = 0; m < 4; ++m) { const int row = row0 + ai * HALF + m * 16; const float rs = rs_tab ? sc * rs_tab[((u.pm == pm0) ? 0 : (u.pm == pm1) ? 256 : 512) + (row & 255)] : sc;
                bf16_t* rowp = base + (size_t)row * ldc + col0;
#pragma unroll
                for (int bj = 0; bj < 2; ++bj) { f32x4 v0 = acc[ai][bj][m][0] * rs, v1 = acc[ai][bj][m][1] * rs;
                    if (gate_w && colt >= gate_col0) { const f32x4 g0 = *(const f32x4*)(gate_w + col0 - gate_col0 + bj * HALF), g1 = *(const f32x4*)(gate_w + col0 - gate_col0 + bj * HALF + 4);
#pragma unroll
                        for (int e_ = 0; e_ < 4; ++e_) { v0[e_] = v0[e_] * __builtin_amdgcn_rcpf(1.0f + __expf(-v0[e_])) * g0[e_]; v1[e_] = v1[e_] * __builtin_amdgcn_rcpf(1.0f + __expf(-v1[e_])) * g1[e_]; } }
                    u32x4 w; w.x = cvt_pk_bf16(v0[0], v0[1]); w.y = cvt_pk_bf16(v0[2], v0[3]); w.z = cvt_pk_bf16(v1[0], v1[1]); w.w = cvt_pk_bf16(v1[2], v1[3]);
                    *(u32x4*)(rowp + bj * HALF) = w; } }
    }
};
struct EpiF32RS {
    static constexpr bool PERM = false, AFTER_DRAIN = false;
    float* C; int ldc; const PG8_LAS float* rs_tab; int pm0, pm1;
    __device__ __forceinline__ void operator()(const f32x4 (&acc)[2][2][4][2], const Unit& u, int wr, int wc, int fr, int fq) const {
        const int row0 = u.pm * BM + wr * 64 + fr, col0 = u.pn * BM + wc * 32 + 4 * fq;
#pragma unroll
        for (int ai = 0; ai < 2; ++ai)
#pragma unroll
            for (int m = 0; m < 4; ++m) { const int row = row0 + ai * HALF + m * 16; const float rs = rs_tab[((u.pm == pm0) ? 0 : (u.pm == pm1) ? 256 : 512) + (row & 255)];
                float* rowp = C + (size_t)row * ldc + col0;
#pragma unroll
                for (int bj = 0; bj < 2; ++bj)
#pragma unroll
                    for (int n = 0; n < 2; ++n) *(f32x4*)(rowp + bj * HALF + n * 16) = acc[ai][bj][m][n] * rs; }
    }
};
template <bool BASE_BF16> struct EpiResid {
    static constexpr bool PERM = false, AFTER_DRAIN = false;
    const float* base; bf16_t* hb; float* rowpart; int ldc;
    __device__ __forceinline__ void operator()(const f32x4 (&acc)[2][2][4][2], const Unit& u, int wr, int wc, int fr, int fq) const {
        const int row0 = u.pm * BM + wr * 64 + fr, col0 = u.pn * BM + wc * 32 + 4 * fq;
#pragma unroll
        for (int ai = 0; ai < 2; ++ai) {
            f32x4 bv[4][2][2];
#pragma unroll
            for (int m = 0; m < 4; ++m) { const size_t off = (size_t)(row0 + ai * HALF + m * 16) * ldc + col0;
#pragma unroll
                for (int bj = 0; bj < 2; ++bj)
#pragma unroll
                    for (int n = 0; n < 2; ++n) {
                        if (BASE_BF16) { const u32x2 bw = *(const u32x2*)(hb + off + bj * HALF + n * 16); bv[m][bj][n] = (f32x4){__builtin_bit_cast(float, bw.x << 16), __builtin_bit_cast(float, bw.x & 0xffff0000u), __builtin_bit_cast(float, bw.y << 16), __builtin_bit_cast(float, bw.y & 0xffff0000u)}; }
                        else bv[m][bj][n] = *(const f32x4*)(base + off + bj * HALF + n * 16); } }
            asm volatile("" ::: "memory");
#pragma unroll
            for (int m = 0; m < 4; ++m) { const int row = row0 + ai * HALF + m * 16; const size_t off = (size_t)row * ldc + col0; float ss = 0.f;
#pragma unroll
                for (int bj = 0; bj < 2; ++bj)
#pragma unroll
                    for (int n = 0; n < 2; ++n) { const f32x4 v = bv[m][bj][n] + acc[ai][bj][m][n];
                        ss += (v[0] * v[0] + v[1] * v[1]) + (v[2] * v[2] + v[3] * v[3]);
                        u32x2 w; w.x = cvt_pk_bf16(v[0], v[1]); w.y = cvt_pk_bf16(v[2], v[3]); *(u32x2*)(hb + off + bj * HALF + n * 16) = w; }
                ss += __shfl_xor(ss, 16); ss += __shfl_xor(ss, 32);
                if (fq == 0) rowpart[(size_t)row * 16 + u.pn * 4 + wc] = ss; } }
    }
};

template <class Epi, class Sched, bool ALIGN_EPI = false, bool SP2 = false>
__device__ __forceinline__ void gemm_phase(PG8_LAS unsigned char* lds, const Gemm g, const Sched& S, const Epi& E) {
    const int tid = threadIdx.x, wid = __builtin_amdgcn_readfirstlane(tid >> 6), lane = tid & 63, wr = wid >> 2, wc = wid & 3, fr = lane & 15, fq = lane >> 4;
    const int K = g.K, nt = K / BK;
    unsigned voffA[2], voffB[2];
#pragma unroll
    for (int i = 0; i < 2; ++i) { int R, C; stage_rc(tid * 16 + i * 8192, R, C); const int Rb = Epi::PERM ? ((R & ~31) + perm32(R & 31)) : R;
        voffA[i] = (unsigned)(R * K + C) * 2u; voffB[i] = (unsigned)(Rb * K + C) * 2u; }
    const size_t kstep = (size_t)(BK * 2);
    const size_t hstep = (size_t)HALF * K * 2;
    const size_t tstep = 2 * hstep;
    const unsigned ldsw = (unsigned)wid * 1024u;
    const int aoff = lds_byte(wr * 64 + fr, fq * 8), boff = lds_byte(wc * 32 + fr, fq * 8);
#define PG8_SA(b, h) (((b) * 2 + (h)) * HTB)
#define PG8_SB(b, h) ((4 + (b) * 2 + (h)) * HTB)
#define PG8_STAGE(bufoff, gbase, voff) do { _Pragma("unroll") for (int _i = 0; _i < 2; ++_i) \
        __builtin_amdgcn_global_load_lds((const unsigned*)((const char*)(gbase) + (voff)[_i]), (PG8_LAS unsigned*)(lds + (bufoff) + ldsw + _i * 8192), 16, 0, 0); } while (0)
#define PG8_LDA(dst, b, h) do { _Pragma("unroll") for (int m = 0; m < 4; ++m) _Pragma("unroll") for (int k = 0; k < 2; ++k) dst[m][k] = *(const PG8_LAS bf16x8*)(lds + PG8_SA(b, h) + aoff + m * 2048 + k * 1024); } while (0)
#define PG8_LDB(dst, b, h) do { _Pragma("unroll") for (int n = 0; n < 2; ++n) _Pragma("unroll") for (int k = 0; k < 2; ++k) dst[n][k] = *(const PG8_LAS bf16x8*)(lds + PG8_SB(b, h) + boff + n * 2048 + k * 1024); } while (0)
#define PG8_MMA(ai, bj, At, Bt) do { __builtin_amdgcn_s_setprio(1); _Pragma("unroll") for (int m = 0; m < 4; ++m) _Pragma("unroll") for (int n = 0; n < 2; ++n) _Pragma("unroll") for (int k = 0; k < 2; ++k) \
        acc[ai][bj][m][n] = __builtin_amdgcn_mfma_f32_16x16x32_bf16(Bt[n][k], At[m][k], acc[ai][bj][m][n], 0, 0, 0); __builtin_amdgcn_s_setprio(0); } while (0)
#define PG8_WAIT_V(n) asm volatile("s_waitcnt vmcnt(" #n ")" ::: "memory")
#define PG8_WAIT_L(n) asm volatile("s_waitcnt lgkmcnt(" #n ")" ::: "memory")
#define PG8_BAR __builtin_amdgcn_s_barrier()
#define PG8_SCHED __builtin_amdgcn_sched_barrier(0)
    Unit cur, nxt; int ui = 0;
    if (!S.next(0, cur)) return;
    f32x4 acc[2][2][4][2];
#pragma unroll
    for (int a = 0; a < 2; ++a)
#pragma unroll
        for (int b = 0; b < 2; ++b)
#pragma unroll
            for (int m = 0; m < 4; ++m)
#pragma unroll
                for (int n = 0; n < 2; ++n) acc[a][b][m][n] = (f32x4){0.f, 0.f, 0.f, 0.f};
    bf16x8 At[4][2], B0[2][2], B1[2][2];
    const char* cA = (const char*)g.A + (size_t)cur.pm * tstep; const char* cB = (const char*)g.Bt + (size_t)cur.pn * tstep;
    S.a_ready(cur);
    if constexpr (SP2) {
        PG8_STAGE(PG8_SB(0, 0), cB, voffB); PG8_STAGE(PG8_SB(0, 1), cB + hstep, voffB); PG8_STAGE(PG8_SA(0, 0), cA, voffA); PG8_STAGE(PG8_SA(0, 1), cA + hstep, voffA);
        if (wr == 1) PG8_BAR;
        PG8_WAIT_V(2); PG8_BAR;
        PG8_STAGE(PG8_SB(1, 0), cB + kstep, voffB); PG8_STAGE(PG8_SA(1, 0), cA + kstep, voffA); PG8_STAGE(PG8_SB(1, 1), cB + hstep + kstep, voffB);
        PG8_WAIT_V(6); PG8_BAR;
    } else {
        PG8_STAGE(PG8_SB(0, 0), cB, voffB); PG8_STAGE(PG8_SA(0, 0), cA, voffA); PG8_STAGE(PG8_SB(0, 1), cB + hstep, voffB); PG8_STAGE(PG8_SA(0, 1), cA + hstep, voffA);
        if (wr == 1) PG8_BAR;
        PG8_WAIT_V(4); PG8_BAR;
        PG8_STAGE(PG8_SB(1, 0), cB + kstep, voffB); PG8_STAGE(PG8_SA(1, 0), cA + kstep, voffA); PG8_STAGE(PG8_SB(1, 1), cB + hstep + kstep, voffB);
        PG8_WAIT_V(6); PG8_BAR;
    }
    for (;;) {
        const bool has_next = S.next(ui + 1, nxt);
        const char* nA = has_next ? (const char*)g.A + (size_t)nxt.pm * tstep : cA; const char* nB = has_next ? (const char*)g.Bt + (size_t)nxt.pn * tstep : cB;
        for (int t = 0; t < nt; t += 2) {
            const bool last = (t == nt - 2);
            const char* a1 = cA + (size_t)(t + 1) * kstep;
            const char* a2 = last ? nA : cA + (size_t)(t + 2) * kstep; const char* b2 = last ? nB : cB + (size_t)(t + 2) * kstep;
            const char* a3 = a2 + kstep; const char* b3 = b2 + kstep;
            if (last && has_next) S.a_ready(nxt);
            if constexpr (SP2) {
            PG8_LDB(B0, 0, 0); PG8_LDB(B1, 0, 1); PG8_SCHED; PG8_LDA(At, 0, 0); PG8_STAGE(PG8_SA(1, 1), a1 + hstep, voffA);
            PG8_WAIT_V(8); PG8_WAIT_L(0); PG8_BAR; PG8_MMA(0, 0, At, B0); PG8_MMA(0, 1, At, B1); PG8_BAR; PG8_SCHED;
            PG8_LDA(At, 0, 1); PG8_STAGE(PG8_SB(0, 0), b2, voffB); PG8_STAGE(PG8_SB(0, 1), b2 + hstep, voffB); PG8_STAGE(PG8_SA(0, 0), a2, voffA);
            PG8_WAIT_V(8); PG8_WAIT_L(0); PG8_BAR; PG8_MMA(1, 0, At, B0); PG8_MMA(1, 1, At, B1); PG8_BAR; PG8_SCHED;
            PG8_LDB(B0, 1, 0); PG8_LDB(B1, 1, 1); PG8_SCHED; PG8_LDA(At, 1, 0); PG8_STAGE(PG8_SA(0, 1), a2 + hstep, voffA);
            PG8_WAIT_V(8); PG8_WAIT_L(0); PG8_BAR; PG8_MMA(0, 0, At, B0); PG8_MMA(0, 1, At, B1); PG8_BAR; PG8_SCHED;
            PG8_LDA(At, 1, 1); PG8_STAGE(PG8_SB(1, 0), b3, voffB); PG8_STAGE(PG8_SB(1, 1), b3 + hstep, voffB); PG8_STAGE(PG8_SA(1, 0), a3, voffA);
            PG8_WAIT_V(8); PG8_WAIT_L(0); PG8_BAR; PG8_MMA(1, 0, At, B0); PG8_MMA(1, 1, At, B1); PG8_BAR; PG8_SCHED;
            } else {
            PG8_LDB(B0, 0, 0); PG8_SCHED; PG8_LDA(At, 0, 0); PG8_STAGE(PG8_SA(1, 1), a1 + hstep, voffA);
            PG8_WAIT_L(8); PG8_BAR; PG8_WAIT_L(0); PG8_MMA(0, 0, At, B0); PG8_BAR; PG8_SCHED;
            PG8_LDB(B1, 0, 1); PG8_STAGE(PG8_SB(0, 0), b2, voffB);
            PG8_BAR; PG8_WAIT_L(0); PG8_MMA(0, 1, At, B1); PG8_BAR;
            PG8_LDA(At, 0, 1); PG8_STAGE(PG8_SA(0, 0), a2, voffA);
            PG8_BAR; PG8_WAIT_L(0); PG8_MMA(1, 0, At, B0); PG8_BAR; PG8_SCHED;
            PG8_STAGE(PG8_SB(0, 1), b2 + hstep, voffB);
            PG8_WAIT_V(6); PG8_BAR; PG8_MMA(1, 1, At, B1); PG8_BAR;
            PG8_LDB(B0, 1, 0); PG8_SCHED; PG8_LDA(At, 1, 0); PG8_STAGE(PG8_SA(0, 1), a2 + hstep, voffA);
            PG8_WAIT_L(8); PG8_BAR; PG8_WAIT_L(0); PG8_MMA(0, 0, At, B0); PG8_BAR; PG8_SCHED;
            PG8_LDB(B1, 1, 1); PG8_STAGE(PG8_SB(1, 0), b3, voffB);
            PG8_BAR; PG8_WAIT_L(0); PG8_MMA(0, 1, At, B1); PG8_BAR;
            PG8_LDA(At, 1, 1); PG8_STAGE(PG8_SA(1, 0), a3, voffA);
            PG8_BAR; PG8_WAIT_L(0); PG8_MMA(1, 0, At, B0); PG8_BAR; PG8_SCHED;
            PG8_STAGE(PG8_SB(1, 1), b3 + hstep, voffB);
            PG8_WAIT_V(6); PG8_BAR; PG8_MMA(1, 1, At, B1); PG8_BAR;
            }
        }
        if constexpr (ALIGN_EPI) { if (wr == 0) PG8_BAR; }
        if constexpr (!Epi::AFTER_DRAIN) { E(acc, cur, wr, wc, fr, fq); S.done(cur); }
        if (!has_next) break;
#pragma unroll
        for (int a = 0; a < 2; ++a)
#pragma unroll
            for (int b = 0; b < 2; ++b)
#pragma unroll
                for (int m = 0; m < 4; ++m)
#pragma unroll
                    for (int n = 0; n < 2; ++n) acc[a][b][m][n] = (f32x4){0.f, 0.f, 0.f, 0.f};
        cur = nxt; cA = nA; cB = nB; ++ui;
        if constexpr (ALIGN_EPI) { if (wr == 1) PG8_BAR; }
    }
    PG8_WAIT_V(0);
    if constexpr (!ALIGN_EPI) { if (wr == 0) PG8_BAR; }
    PG8_BAR;
    if constexpr (Epi::AFTER_DRAIN) { E.fused(acc, cur, wr, wc, fr, fq, lds, wid, lane); S.done(cur); }
#undef PG8_SA
#undef PG8_SB
#undef PG8_STAGE
#undef PG8_LDA
#undef PG8_LDB
#undef PG8_MMA
#undef PG8_WAIT_V
#undef PG8_WAIT_L
#undef PG8_BAR
#undef PG8_SCHED
}
}
#include <hip/hip_bf16.h>
#include <cmath>
namespace attn_body {
using bf16=__hip_bfloat16;
using bf16x8=__attribute__((ext_vector_type(8)))short;
using s16x4=__attribute__((ext_vector_type(4)))short;
using f32x16=__attribute__((ext_vector_type(16)))float;
using u32x4=__attribute__((ext_vector_type(4)))unsigned;
constexpr int BATCH=8,NHEAD=16,SEQ=2048,D=64,DM=NHEAD*D;
constexpr int NW=8,QBLK=32,QB=QBLK*NW,KVBLK=64,NQB=SEQ/QB;
constexpr int ATTN_PITCH=DM, ATTN_UNIT_ROWS=QB;
__device__ __forceinline__ int crow(int r,int hi){return (r&3)+8*(r>>2)+4*hi;}
#define SBAR() __builtin_amdgcn_sched_barrier(0)
__device__ __forceinline__ void cmask(f32x16&p0,f32x16&p1,int jb,int qrel,int hi){
  const float NEG=-INFINITY; int kb=64*jb+4*hi;
  #pragma unroll
  for(int r=0;r<16;++r){int kv=kb+(r&3)+8*(r>>2); if(kv>qrel)p0[r]=NEG; if(kv+32>qrel)p1[r]=NEG;}
}

constexpr int NSLOT=3, SLOTB=8192;
constexpr int LDS_K=0, LDS_V=NSLOT*SLOTB, LDS_WS=2*NSLOT*SLOTB, LDS_OST=LDS_WS+NW*64*4, LDS_BYTES=LDS_OST+NW*4096, LDS_CB=LDS_BYTES, LDS_TOTAL=LDS_CB+SEQ*4;
constexpr float C2=0.125f*1.4426950408889634f;
__device__ __forceinline__ void glds16(const void*gsrc,unsigned lds_dst){unsigned keep;
  asm volatile("s_mov_b32 %0, m0\n\ts_mov_b32 m0, %2\n\ts_nop 0\n\tglobal_load_lds_dwordx4 %1, off\n\ts_mov_b32 m0, %0":"=&s"(keep):"v"(gsrc),"s"(lds_dst):"memory");}
__device__ __forceinline__ float max3f(float a,float b,float c){float r;asm("v_max3_f32 %0, %1, %2, %3":"=v"(r):"v"(a),"v"(b),"v"(c));return r;}
__device__ __forceinline__ float max2f(float a,float b){float r;asm("v_max_f32_e32 %0, %1, %2":"=v"(r):"v"(a),"v"(b));return r;}
__device__ __forceinline__ float fadd_s(float a,float b){float r;asm("v_add_f32_e32 %0, %1, %2":"=v"(r):"v"(a),"v"(b));return r;}
__device__ __forceinline__ float fsub_s(float a,float b){float r;asm("v_sub_f32_e32 %0, %1, %2":"=v"(r):"v"(a),"v"(b));return r;}
typedef float f32x2_t __attribute__((ext_vector_type(2))); typedef __bf16 bf16x2_t __attribute__((ext_vector_type(2)));
__device__ __forceinline__ unsigned cvtpk_s(float lo,float hi){f32x2_t v={lo,hi};bf16x2_t b=__builtin_convertvector(v,bf16x2_t);return __builtin_bit_cast(unsigned,b);}
#define WAIT_BAR(N) asm volatile("s_waitcnt vmcnt(" #N ") lgkmcnt(0)\n\ts_barrier":::"memory")

__device__ __forceinline__ void qkt(f32x16&p0,f32x16&p1,const char*Kslot,const bf16x8*qr,const f32x16&negm,int r32,int hi){
  const char*kb=Kslot+hi*1024+r32*16;
  #pragma unroll
  for(int d0=0;d0<4;++d0){
    const bf16x8 b0=*reinterpret_cast<const bf16x8*>(kb+d0*2048);
    const bf16x8 b1=*reinterpret_cast<const bf16x8*>(kb+d0*2048+512);
    if(d0==0){p0=__builtin_amdgcn_mfma_f32_32x32x16_bf16(b0,qr[0],negm,0,0,0);p1=__builtin_amdgcn_mfma_f32_32x32x16_bf16(b1,qr[0],negm,0,0,0);}
    else{p0=__builtin_amdgcn_mfma_f32_32x32x16_bf16(b0,qr[d0],p0,0,0,0);p1=__builtin_amdgcn_mfma_f32_32x32x16_bf16(b1,qr[d0],p1,0,0,0);}}
}
typedef __attribute__((address_space(3))) const char* lds_cptr;
typedef short v4i16_t __attribute__((ext_vector_type(4)));
__device__ __forceinline__ void kload8(bf16x8*kf,lds_cptr kp){
  kf[0]=*(const __attribute__((address_space(3))) bf16x8*)(kp);      kf[1]=*(const __attribute__((address_space(3))) bf16x8*)(kp+512);
  kf[2]=*(const __attribute__((address_space(3))) bf16x8*)(kp+2048); kf[3]=*(const __attribute__((address_space(3))) bf16x8*)(kp+2560);
  kf[4]=*(const __attribute__((address_space(3))) bf16x8*)(kp+4096); kf[5]=*(const __attribute__((address_space(3))) bf16x8*)(kp+4608);
  kf[6]=*(const __attribute__((address_space(3))) bf16x8*)(kp+6144); kf[7]=*(const __attribute__((address_space(3))) bf16x8*)(kp+6656);
}
__device__ __forceinline__ void kload2(bf16x8*kf,lds_cptr kp,int j){ kf[2*j]=*(const __attribute__((address_space(3))) bf16x8*)(kp+j*2048); kf[2*j+1]=*(const __attribute__((address_space(3))) bf16x8*)(kp+j*2048+512); }
__device__ __forceinline__ s16x4 vtr(lds_cptr p){ return __builtin_bit_cast(s16x4,__builtin_amdgcn_ds_read_tr16_b64_v4i16((__attribute__((address_space(3))) v4i16_t*)p)); }
__device__ __forceinline__ float rowmax(const f32x16&p0,const f32x16&p1){
  float a=max3f(p0[0],p0[1],p1[0]),b=max3f(p0[2],p0[3],p1[1]);a=max3f(a,p1[2],p1[3]);
  #pragma unroll
  for(int r=4;r<16;r+=4){a=max3f(a,p0[r],p0[r+1]);b=max3f(b,p0[r+2],p0[r+3]);a=max3f(a,p1[r],p1[r+1]);b=max3f(b,p1[r+2],p1[r+3]);}
  const float m=max2f(a,b);
  auto rr=__builtin_amdgcn_permlane32_swap(__float_as_uint(m),__float_as_uint(m),false,false);
  return max2f(__uint_as_float(rr[0]),__uint_as_float(rr[1]));
}
__device__ __forceinline__ void pv(f32x16*o,int vb,bf16x8 pa0,bf16x8 pa1,bf16x8 pa2,bf16x8 pa3){
  #pragma unroll
  for(int d0=0;d0<2;++d0){s16x4 lo[4],hi[4];
    #pragma unroll
    for(int ks=0;ks<4;++ks){
      asm volatile("ds_read_b64_tr_b16 %0,%1 offset:%c2":"=&v"(lo[ks]):"v"(vb),"i"(d0*4096+ks*1024):"memory");
      asm volatile("ds_read_b64_tr_b16 %0,%1 offset:%c2":"=&v"(hi[ks]):"v"(vb),"i"(d0*4096+ks*1024+512):"memory");}
    asm volatile("s_waitcnt lgkmcnt(0)":::"memory");SBAR();
    #define PK(k) (bf16x8){lo[k][0],lo[k][1],lo[k][2],lo[k][3],hi[k][0],hi[k][1],hi[k][2],hi[k][3]}
    o[d0]=__builtin_amdgcn_mfma_f32_32x32x16_bf16(pa0,PK(0),o[d0],0,0,0);
    o[d0]=__builtin_amdgcn_mfma_f32_32x32x16_bf16(pa1,PK(1),o[d0],0,0,0);
    o[d0]=__builtin_amdgcn_mfma_f32_32x32x16_bf16(pa2,PK(2),o[d0],0,0,0);
    o[d0]=__builtin_amdgcn_mfma_f32_32x32x16_bf16(pa3,PK(3),o[d0],0,0,0);
    #undef PK
  }
}

#ifndef ATTN_STORE16
#define ATTN_STORE16(p,v) (*(u32x4*)(p)=(v))
#endif
typedef float f32x4v __attribute__((ext_vector_type(4)));
template<int THRL> __device__ __forceinline__ void attn_unit(int b,int h,int qb,const bf16*Q,const bf16*__restrict__ K,const bf16*__restrict__ V,bf16*O,char*shm){
  const int tid=threadIdx.x,lane=tid&63,r32=lane&31,hi=lane>>5; const int wid=__builtin_amdgcn_readfirstlane(tid>>6);
  const long rowbase=(long)b*SEQ; const int q0=qb*QB;
  const bf16*Qw=Q+(rowbase+q0+wid*QBLK)*DM+h*D;
  const bf16*Kh=K+rowbase*DM+h*D,*Vh=V+rowbase*DM+h*D;
  const unsigned lds0=(unsigned)(uintptr_t)shm;
  float*wsf=(float*)(shm+LDS_WS)+wid*64;
  const bf16*ksrc=Kh+(long)lane*DM+wid*8;
  const bf16*vsrc=Vh+(long)(16*(wid&3)+(lane>>2))*DM+(wid>>2)*32+(lane&3)*8;
  const unsigned kdst=lds0+LDS_K+wid*1024, vdst=lds0+LDS_V+wid*1024;
  #define DMA_K(t,slot) glds16(ksrc+(long)(t)*KVBLK*DM,(unsigned)__builtin_amdgcn_readfirstlane(kdst+(slot)))
  #define DMA_V(t,slot) glds16(vsrc+(long)(t)*KVBLK*DM,(unsigned)__builtin_amdgcn_readfirstlane(vdst+(slot)))
  const int vb0=(int)(lds0+LDS_V)+((lane>>4)&1)*32+(lane&3)*8+(4*hi+((lane&15)>>2))*64;
  const char*Kbase=shm+LDS_K; bf16x8 kf[8];
  const lds_cptr shm3=(lds_cptr)shm; const lds_cptr kp0=shm3+LDS_K+hi*1024+r32*16; const lds_cptr vp0=shm3+LDS_V+((lane>>4)&1)*32+(lane&3)*8+(4*hi+((lane&15)>>2))*64;
  const int NT=(q0+QB)/KVBLK;
  DMA_K(0,0);DMA_V(0,0);DMA_K(1,SLOTB);
  bf16x8 qr[4];
  #pragma unroll
  for(int d0=0;d0<4;++d0)qr[d0]=*reinterpret_cast<const bf16x8*>(&Qw[(long)r32*DM+d0*16+hi*8]);
  float mhat=0.f,l_reg=0.f;f32x16 o[2];o[0]=f32x16{};o[1]=f32x16{};float z0_=0.f;asm volatile("":"+v"(z0_));f32x16 negm;_Pragma("unroll") for(int r=0;r<16;++r)negm[r]=z0_;asm volatile("":"+v"(negm));
  const int qrel=wid*QBLK+r32;
  #define CMASK(P0,P1,t) do{int jb_=(t)-(NT-4); if(jb_>=0)cmask(P0,P1,jb_,qrel,hi);}while(0)
  #define BIAS(P0,P1,t) do{ const __attribute__((address_space(3))) f32x4v* cbt_=(const __attribute__((address_space(3))) f32x4v*)(shm3+LDS_CB+(64*(t)+4*hi)*4); \
    _Pragma("unroll") for(int g_=0;g_<4;++g_){ const f32x4v b0_=cbt_[2*g_], b1_=cbt_[8+2*g_]; \
      P0[4*g_]+=b0_[0];P0[4*g_+1]+=b0_[1];P0[4*g_+2]+=b0_[2];P0[4*g_+3]+=b0_[3]; P1[4*g_]+=b1_[0];P1[4*g_+1]+=b1_[1];P1[4*g_+2]+=b1_[2];P1[4*g_+3]+=b1_[3]; } }while(0)
  bool resc=false;
  #define START(P0,P1) do{ const float rm=rowmax(P0,P1); resc=false; \
    { const float dl=rm; mhat=fadd_s(mhat,dl); \
      _Pragma("unroll") for(int r=0;r<16;++r){P0[r]=fsub_s(P0[r],dl);P1[r]=fsub_s(P1[r],dl);} \
      _Pragma("unroll") for(int r=0;r<16;++r)negm[r]=-mhat; asm volatile("":"+v"(negm)); } \
    _Pragma("unroll") for(int r=0;r<16;++r)P0[r]=__builtin_amdgcn_exp2f(P0[r]); }while(0)
  #define RESC() do{ if(resc){ asm volatile("s_waitcnt lgkmcnt(0)":::"memory"); \
      _Pragma("unroll") for(int d_=0;d_<2;++d_) _Pragma("unroll") for(int r=0;r<16;++r)o[d_][r]*=wsf[crow(r,hi)]; } }while(0)
  f32x16 pA0,pA1,pB0,pB1;
  int sl_prev=0,sl_cur=0,sl_next=SLOTB;
  #define ROT() do{sl_prev=sl_cur;sl_cur=sl_next;sl_next=(sl_next==(NSLOT-1)*SLOTB)?0:sl_next+SLOTB;}while(0)
  DMA_K(2,2*SLOTB);
  WAIT_BAR(3);
  qkt(pA0,pA1,Kbase,qr,negm,r32,hi);asm volatile("s_nop 15\n\ts_nop 7":"+v"(pA0),"+v"(pA1));BIAS(pA0,pA1,0);CMASK(pA0,pA1,0);
  START(pA0,pA1);
  _Pragma("unroll") for(int r=0;r<16;++r)pA1[r]=__builtin_amdgcn_exp2f(pA1[r]);
  WAIT_BAR(0);
  DMA_K(3,0);DMA_V(1,SLOTB);
  ROT();
  kload8(kf,kp0+sl_cur);
  WAIT_BAR(2);
  s16x4 vlo[8],vhi[8]; u32x4 pw0,pw1,pw2,pw3;
  #define PKW(P,B) cvtpk_s(P[B],P[B+1])
  #define PAF(k) __builtin_bit_cast(bf16x8,pw##k)
  #define VFR(i) (bf16x8){vlo[i][0],vlo[i][1],vlo[i][2],vlo[i][3],vhi[i][0],vhi[i][1],vhi[i][2],vhi[i][3]}
  #define PIN(x) asm volatile("":"+v"(x))
  #define MX3(a,b,c) __builtin_fmaxf(__builtin_fmaxf((a),(b)),(c))
  #define GAPA(MF,A0,A1,A2,A3,W0,W1,PW) do{ MF; sacc+=A0; sacc+=A1; sacc+=A2; sacc+=A3; PIN(sacc); W0; W1; PIN(PW); SBAR(); }while(0)
  #define EX(v) __builtin_amdgcn_exp2f(v)
  #define GAPB(MF,X,B) do{ MF; X[B]=EX(X[B]); X[B+1]=EX(X[B+1]); X[B+2]=EX(X[B+2]); X[B+3]=EX(X[B+3]); PIN(X); SBAR(); }while(0)
  #define VRD(i) do{ vlo[i]=vtr(vp_+(((i)>>2)*4096+((i)&3)*1024)); vhi[i]=vtr(vp_+(((i)>>2)*4096+((i)&3)*1024+512)); }while(0)
  #define KRD(G,j) do{ if(G){ kload2(kf,kp0+sl_next,j); SBAR(); } }while(0)
  #define STEP(C0,C1,P0,P1,t,GK,GV,GL) do{ SBAR(); \
    const lds_cptr vp_=vp0+sl_prev; \
    VRD(0); SBAR(); float sacc=(P0[0]+P0[1]); \
    GAPA(C0=__builtin_amdgcn_mfma_f32_32x32x16_bf16(kf[0],qr[0],negm,0,0,0), P0[2],P0[3],P0[4],P0[5],     pw0[0]=PKW(P0,0), pw0[1]=PKW(P0,2), pw0); \
    VRD(4); SBAR(); GAPA(C1=__builtin_amdgcn_mfma_f32_32x32x16_bf16(kf[1],qr[0],negm,0,0,0), P0[6],P0[7],P0[8],P0[9],     pw0[2]=PKW(P0,4), pw0[3]=PKW(P0,6), pw0); \
    VRD(1); SBAR(); GAPA(C0=__builtin_amdgcn_mfma_f32_32x32x16_bf16(kf[2],qr[1],C0,0,0,0),   P0[10],P0[11],P0[12],P0[13], pw1[0]=PKW(P0,8), pw1[1]=PKW(P0,10), pw1); \
    VRD(5); SBAR(); GAPA(C1=__builtin_amdgcn_mfma_f32_32x32x16_bf16(kf[3],qr[1],C1,0,0,0),   P0[14],P0[15],P1[0],P1[1],   pw1[2]=PKW(P0,12),pw1[3]=PKW(P0,14), pw1); \
    VRD(2); SBAR(); GAPA(C0=__builtin_amdgcn_mfma_f32_32x32x16_bf16(kf[4],qr[2],C0,0,0,0),   P1[2],P1[3],P1[4],P1[5],     pw2[0]=PKW(P1,0), pw2[1]=PKW(P1,2), pw2); \
    VRD(6); SBAR(); GAPA(C1=__builtin_amdgcn_mfma_f32_32x32x16_bf16(kf[5],qr[2],C1,0,0,0),   P1[6],P1[7],P1[8],P1[9],     pw2[2]=PKW(P1,4), pw2[3]=PKW(P1,6), pw2); \
    VRD(3); SBAR(); GAPA(C0=__builtin_amdgcn_mfma_f32_32x32x16_bf16(kf[6],qr[3],C0,0,0,0),   P1[10],P1[11],P1[12],P1[13], pw3[0]=PKW(P1,8), pw3[1]=PKW(P1,10), pw3); \
    VRD(7); SBAR(); GAPA(C1=__builtin_amdgcn_mfma_f32_32x32x16_bf16(kf[7],qr[3],C1,0,0,0),   P1[14],P1[15],0.f,0.f,       pw3[2]=PKW(P1,12),pw3[3]=PKW(P1,14), pw3); \
    l_reg+=sacc; \
    if(GK){DMA_K((t)+3,sl_cur);} if(GV){DMA_V((t)+1,sl_next);} \
    { const __attribute__((address_space(3))) f32x4v* cbt_=(const __attribute__((address_space(3))) f32x4v*)(shm3+LDS_CB+(64*(t)+4*hi)*4); \
      _Pragma("unroll") for(int g_=0;g_<4;++g_){ const f32x4v b0_=cbt_[2*g_]; C0[4*g_]+=b0_[0];C0[4*g_+1]+=b0_[1];C0[4*g_+2]+=b0_[2];C0[4*g_+3]+=b0_[3]; SBAR(); \
        const f32x4v b1_=cbt_[8+2*g_]; C1[4*g_]+=b1_[0];C1[4*g_+1]+=b1_[1];C1[4*g_+2]+=b1_[2];C1[4*g_+3]+=b1_[3]; SBAR(); } } \
    CMASK(C0,C1,t); \
    { float a=MX3(C0[0],C0[1],C1[0]),b=MX3(C0[2],C0[3],C1[1]); a=MX3(a,C1[2],C1[3]); \
      _Pragma("unroll") for(int r=4;r<16;r+=4){a=MX3(a,C0[r],C0[r+1]);b=MX3(b,C0[r+2],C0[r+3]);a=MX3(a,C1[r],C1[r+1]);b=MX3(b,C1[r+2],C1[r+3]);} \
      float rm=__builtin_fmaxf(a,b); { auto rr=__builtin_amdgcn_permlane32_swap(__float_as_uint(rm),__float_as_uint(rm),false,false); rm=__builtin_fmaxf(__uint_as_float(rr[0]),__uint_as_float(rr[1])); } \
      resc=false; \
      if(__builtin_expect(__any(rm>(float)THRL),0)){ const float dl=__builtin_fmaxf(rm,0.f); mhat+=dl; \
        _Pragma("unroll") for(int r=0;r<16;++r){C0[r]-=dl;C1[r]-=dl;} \
        _Pragma("unroll") for(int r=0;r<16;++r)negm[r]=-mhat; asm volatile("":"+v"(negm)); \
        const float f=__builtin_amdgcn_exp2f(-dl); l_reg*=f; if(hi==0)wsf[r32]=f; resc=true; } } \
    SBAR(); \
    GAPB(o[0]=__builtin_amdgcn_mfma_f32_32x32x16_bf16(PAF(0),VFR(0),o[0],0,0,0), C0,0); \
    GAPB(o[1]=__builtin_amdgcn_mfma_f32_32x32x16_bf16(PAF(0),VFR(4),o[1],0,0,0), C0,4); \
    KRD(GL,0); GAPB(o[0]=__builtin_amdgcn_mfma_f32_32x32x16_bf16(PAF(1),VFR(1),o[0],0,0,0), C0,8); \
    KRD(GL,1); GAPB(o[1]=__builtin_amdgcn_mfma_f32_32x32x16_bf16(PAF(1),VFR(5),o[1],0,0,0), C0,12); \
    KRD(GL,2); GAPB(o[0]=__builtin_amdgcn_mfma_f32_32x32x16_bf16(PAF(2),VFR(2),o[0],0,0,0), C1,0); \
    KRD(GL,3); GAPB(o[1]=__builtin_amdgcn_mfma_f32_32x32x16_bf16(PAF(2),VFR(6),o[1],0,0,0), C1,4); \
    GAPB(o[0]=__builtin_amdgcn_mfma_f32_32x32x16_bf16(PAF(3),VFR(3),o[0],0,0,0), C1,8); \
    GAPB(o[1]=__builtin_amdgcn_mfma_f32_32x32x16_bf16(PAF(3),VFR(7),o[1],0,0,0), C1,12); \
    }while(0)
  int t=1;
  #undef CMASK
  #define CMASK(P0,P1,t) do{}while(0)
  for(;t+5<NT;t+=2){
    STEP(pB0,pB1,pA0,pA1,t,true,true,true);     WAIT_BAR(2); RESC(); ROT();
    STEP(pA0,pA1,pB0,pB1,t+1,true,true,true);   WAIT_BAR(2); RESC(); ROT();
  }
  #undef CMASK
  #define CMASK(P0,P1,t) do{int jb_=(t)-(NT-4); if(jb_>=0)cmask(P0,P1,jb_,qrel,hi);}while(0)
  #define ENDW(tt) do{ if((tt)+3<NT){WAIT_BAR(2);} else if((tt)+2<NT){WAIT_BAR(1);} else {WAIT_BAR(0);} }while(0)
  for(;t+1<NT;t+=2){
    STEP(pB0,pB1,pA0,pA1,t,(t+3<NT),(t+1<NT),(t+1<NT));       ENDW(t);   RESC(); ROT();
    STEP(pA0,pA1,pB0,pB1,t+1,(t+4<NT),(t+2<NT),(t+2<NT));     ENDW(t+1); RESC(); ROT();
  }
  STEP(pB0,pB1,pA0,pA1,NT-1,false,false,false); RESC();
  { float sacc=pB0[0]+pB0[1]; _Pragma("unroll") for(int r=2;r<16;++r)sacc+=pB0[r]; _Pragma("unroll") for(int r=0;r<16;++r)sacc+=pB1[r]; l_reg+=sacc;
    pw0=(u32x4){PKW(pB0,0),PKW(pB0,2),PKW(pB0,4),PKW(pB0,6)};pw1=(u32x4){PKW(pB0,8),PKW(pB0,10),PKW(pB0,12),PKW(pB0,14)};pw2=(u32x4){PKW(pB1,0),PKW(pB1,2),PKW(pB1,4),PKW(pB1,6)};pw3=(u32x4){PKW(pB1,8),PKW(pB1,10),PKW(pB1,12),PKW(pB1,14)};
    SBAR(); pv(o,vb0+sl_cur,PAF(0),PAF(1),PAF(2),PAF(3)); }
  #undef PKW
  #undef PAF
  #undef VFR
  #undef PIN
  #undef MX3
  #undef GAPA
  #undef GAPB
  #undef EX
  #undef VRD
  #undef KRD
  #undef STEP
  #undef ENDW
  {auto rr=__builtin_amdgcn_permlane32_swap(__float_as_uint(l_reg),__float_as_uint(l_reg),false,false);l_reg=__uint_as_float(rr[0])+__uint_as_float(rr[1]);}
  if(hi==0)wsf[32+r32]=l_reg;asm volatile("s_waitcnt lgkmcnt(0)":::"memory");
  float rli[16];
  #pragma unroll
  for(int r=0;r<16;++r)rli[r]=__builtin_amdgcn_rcpf(wsf[32+crow(r,hi)]);
  bf16*Ow=O+(rowbase+q0+wid*QBLK)*DM+h*D;
  { bf16*stg=(bf16*)(shm+LDS_OST)+wid*2048;
    #pragma unroll
    for(int r=0;r<16;++r){const int orow=crow(r,hi);
      #pragma unroll
      for(int d0=0;d0<2;++d0)stg[orow*64+d0*32+r32]=__float2bfloat16(o[d0][r]*rli[r]);}
    asm volatile("s_waitcnt lgkmcnt(0)":::"memory");
    #pragma unroll
    for(int i=0;i<4;++i){const int row=i*8+(lane>>3),ch=lane&7; const u32x4 v=*(const u32x4*)(stg+row*64+ch*8); ATTN_STORE16(Ow+(long)row*DM+ch*8,v);} }
  asm volatile("s_waitcnt lgkmcnt(0)\n\ts_barrier":::"memory");
  #undef DMA_K
  #undef DMA_V
  #undef BIAS
  #undef CMASK
  #undef START
  #undef RESC
  #undef ROT
}
constexpr int ATTN_LDS_BYTES=LDS_TOTAL;
struct AttnTensors { const bf16* Q; const bf16* K; const bf16* V; bf16* O; };
struct AttnUnit { int bh; int qb; };
struct StaticOrder {
  int vcu;
  __device__ __forceinline__ explicit StaticOrder(int grid,int block):vcu((block%8)*(grid/8)+block/8){}
  __device__ __forceinline__ bool next(int i,AttnUnit&u)const{ if(i>=4)return false; const int s=2*(vcu&1)+(i>>1); u.bh=vcu>>1; u.qb=(i&1)?7-s:s; return true; }
  __device__ __forceinline__ void a_ready(const AttnUnit&)const{}
  __device__ __forceinline__ void done(const AttnUnit&)const{}
};
template<class Sched,int THRL=8> __device__ __forceinline__ void attn_phase(char*lds,const AttnTensors&T,const Sched&S){
  AttnUnit u;
  for(int i=0;S.next(i,u);++i){ S.a_ready(u); attn_unit<THRL>(u.bh/NHEAD,u.bh%NHEAD,u.qb,T.Q,T.K,T.V,T.O,lds); S.done(u); }
}
#undef SBAR
#undef WAIT_BAR
}
#define GAS __attribute__((address_space(1)))
#define LAS __attribute__((address_space(3)))
typedef unsigned short bf16;
typedef unsigned v4u __attribute__((ext_vector_type(4)));
typedef float f32x4 __attribute__((ext_vector_type(4)));
typedef short bf16x8 __attribute__((ext_vector_type(8)));
typedef GAS unsigned gu32;
typedef GAS unsigned long long gu64;
#define RLX_AGENT __ATOMIC_RELAXED, __HIP_MEMORY_SCOPE_AGENT
#define LDS_WAIT() asm volatile("s_waitcnt lgkmcnt(0)" ::: "memory")
#define VM_WAIT() asm volatile("s_waitcnt vmcnt(0)" ::: "memory")
__device__ __forceinline__ unsigned long long rt() { return __builtin_amdgcn_s_memrealtime(); }
__device__ __forceinline__ unsigned f2bf(float f) { unsigned u = __builtin_bit_cast(unsigned, f); return (u + 0x7fffu + ((u >> 16) & 1u)) >> 16; }
__device__ __forceinline__ unsigned pk2(float lo, float hi) { return f2bf(lo) | (f2bf(hi) << 16); }

#define XB_TMO      128
#define XB_XCNT(j)  (256  + 64 * (j))
#define XB_XSUB(j)  (1280 + 64 * (j))
#define XB_XGEN(j)  (2304 + 64 * (j))
#define XB_TOP      3328
#define XB_TOPGEN   3392
#define XCD_BAR_WORDS 3456
#define XB_SPIN_CAP (1u << 18)

__device__ __forceinline__ unsigned xb_ld(unsigned* p)              { return __hip_atomic_load(p, __ATOMIC_RELAXED, __HIP_MEMORY_SCOPE_AGENT); }
__device__ __forceinline__ unsigned xb_add(unsigned* p, unsigned v) { return __hip_atomic_fetch_add(p, v, __ATOMIC_RELAXED, __HIP_MEMORY_SCOPE_AGENT); }
__device__ __forceinline__ unsigned xb_xcc_id() { return (unsigned)__builtin_amdgcn_s_getreg((3 << 11) | 20) & 0xFu; }
#define XB_SPIN(cond, bar) do { unsigned _sp = 0; while (cond) { __builtin_amdgcn_s_sleep(1); \
    if ((++_sp & 255u) == 0u) { if (xb_ld(&(bar)[XB_TMO])) break; if (_sp > XB_SPIN_CAP) { atomicAdd(&(bar)[XB_TMO], 1u); break; } } } } while (0)

struct XcdBarrier {
    unsigned* bar; unsigned x;
    volatile LAS unsigned* st;
};

__device__ __forceinline__ XcdBarrier xcd_barrier_post(unsigned* bar, volatile LAS unsigned* st) {
    XcdBarrier b; b.bar = bar; b.x = xb_xcc_id(); b.st = st;
    if (threadIdx.x == 0) (void)xb_add(&bar[XB_XCNT(b.x)], 1u);
    return b;
}
__device__ __forceinline__ void xcd_barrier_complete(unsigned* bar, unsigned x, unsigned& nloc, unsigned& nx) {
    const unsigned G = gridDim.x * gridDim.y * gridDim.z;
    unsigned sum, cnt, mine, sp = 0u;
    for (;;) {
        sum = 0u; cnt = 0u; mine = 0u;
#pragma unroll
        for (unsigned j = 0; j < 16; ++j) { const unsigned c = xb_ld(&bar[XB_XCNT(j)]); sum += c; cnt += (c > 0u) ? 1u : 0u; mine = (j == x) ? c : mine; }
        if (sum == G) break;
        __builtin_amdgcn_s_sleep(1);
        if ((++sp & 255u) == 0u) { if (xb_ld(&bar[XB_TMO])) break; if (sp > XB_SPIN_CAP) { atomicAdd(&bar[XB_TMO], 1u); break; } }
    }
    nloc = mine > 0u ? mine : 1u; nx = cnt > 0u ? cnt : 1u;
}

__device__ __forceinline__ void xcd_barrier(const XcdBarrier& b) {
    asm volatile("s_waitcnt vmcnt(0)" ::: "memory");
    __syncthreads();
    if (threadIdx.x == 0) {
        unsigned* bar = b.bar;
        __builtin_amdgcn_s_waitcnt(0);
        unsigned nloc = b.st[0], nx = b.st[1];
        if (nloc == 0u) { xcd_barrier_complete(bar, b.x, nloc, nx); b.st[0] = nloc; b.st[1] = nx; }
        const unsigned old = xb_add(&bar[XB_XSUB(b.x)], 1u);
        const unsigned gen = old / nloc;
        if (old + 1u == (gen + 1u) * nloc) {
            __builtin_amdgcn_fence(__ATOMIC_RELEASE, "agent");
            asm volatile("s_waitcnt vmcnt(0)" ::: "memory");
            const unsigned og = xb_add(&bar[XB_TOP], 1u);
            const unsigned tg = og / nx;
            if (og + 1u == (tg + 1u) * nx) xb_add(&bar[XB_TOPGEN], 1u);
            else XB_SPIN(xb_ld(&bar[XB_TOPGEN]) == tg, bar);
            __builtin_amdgcn_fence(__ATOMIC_ACQUIRE, "agent");
            xb_add(&bar[XB_XGEN(b.x)], 1u);
            asm volatile("s_waitcnt vmcnt(0)" ::: "memory");
        } else {
            XB_SPIN(xb_ld(&bar[XB_XGEN(b.x)]) == gen, bar);
            __builtin_amdgcn_fence(__ATOMIC_ACQUIRE, "agent");
            asm volatile("s_waitcnt vmcnt(0)" ::: "memory");
        }
    }
    __syncthreads();
}

__device__ __forceinline__ void grp_barrier_complete(unsigned* bar, unsigned x, unsigned total, unsigned& nloc, unsigned& nx) {
    unsigned sum, cnt, mine, sp = 0u;
    for (;;) {
        sum = 0u; cnt = 0u; mine = 0u;
#pragma unroll
        for (unsigned j = 0; j < 16; ++j) { const unsigned c = xb_ld(&bar[XB_XCNT(j)]); sum += c; cnt += (c > 0u) ? 1u : 0u; mine = (j == x) ? c : mine; }
        if (sum == total) break;
        __builtin_amdgcn_s_sleep(1);
        if ((++sp & 255u) == 0u) { if (xb_ld(&bar[XB_TMO])) break; if (sp > XB_SPIN_CAP) { atomicAdd(&bar[XB_TMO], 1u); break; } }
    }
    nloc = mine > 0u ? mine : 1u; nx = cnt > 0u ? cnt : 1u;
}
__device__ __forceinline__ void grp_barrier(const XcdBarrier& b, unsigned total) {
    asm volatile("s_waitcnt vmcnt(0)" ::: "memory");
    __syncthreads();
    if (threadIdx.x == 0) {
        unsigned* bar = b.bar;
        __builtin_amdgcn_s_waitcnt(0);
        unsigned nloc = b.st[0], nx = b.st[1];
        if (nloc == 0u) { grp_barrier_complete(bar, b.x, total, nloc, nx); b.st[0] = nloc; b.st[1] = nx; }
        const unsigned old = xb_add(&bar[XB_XSUB(b.x)], 1u);
        const unsigned gen = old / nloc;
        if (old + 1u == (gen + 1u) * nloc) {
            __builtin_amdgcn_fence(__ATOMIC_RELEASE, "agent");
            asm volatile("s_waitcnt vmcnt(0)" ::: "memory");
            const unsigned og = xb_add(&bar[XB_TOP], 1u);
            const unsigned tg = og / nx;
            if (og + 1u == (tg + 1u) * nx) xb_add(&bar[XB_TOPGEN], 1u);
            else XB_SPIN(xb_ld(&bar[XB_TOPGEN]) == tg, bar);
            __builtin_amdgcn_fence(__ATOMIC_ACQUIRE, "agent");
            xb_add(&bar[XB_XGEN(b.x)], 1u);
            asm volatile("s_waitcnt vmcnt(0)" ::: "memory");
        } else {
            XB_SPIN(xb_ld(&bar[XB_XGEN(b.x)]) == gen, bar);
            __builtin_amdgcn_fence(__ATOMIC_ACQUIRE, "agent");
            asm volatile("s_waitcnt vmcnt(0)" ::: "memory");
        }
    }
    __syncthreads();
}
constexpr int NWAVES = 8, NTHR = NWAVES * 64;
constexpr int T_TOK = 16384, DMODEL = 1024, NB = 8, SEQ = 2048;
constexpr int GLA_H = 4, GLA_DK = 128, GLA_DV = 256, GLA_C = 64, GLA_NCH = SEQ / GLA_C, GLA_IN = 3088;
constexpr int NCHUNK = NB * GLA_H * GLA_NCH;
constexpr int KV_TOT = 2064, FOX_H = 16;
constexpr int PEER_H = 8, PEER_K = 16, PEER_NEXP = 16384, PEER_SEL = PEER_H * PEER_K;
constexpr float EPS = 1e-6f;
constexpr float L2E = 1.4426950408889634f;

constexpr size_t MiB = 1u << 20;
constexpr size_t WS_CTL = 0, CTL_ZERO_BYTES = 256 * 1024;
constexpr size_t WS_WIN = 2 * MiB, WS_WGO = 8 * MiB, WS_WQKV = 10 * MiB, WS_WFO = 16 * MiB, WS_WEFF = 18 * MiB;
constexpr size_t WS_FL = 27 * MiB, WS_RP = 28 * MiB, WS_DEXP = 30 * MiB, WS_WGL = 30 * MiB + 512 * 1024, WS_WFL = WS_WGL + 64 * 1024, WS_WFLF = WS_WFL + 64 * 1024;
constexpr size_t WS_A0 = 32 * MiB;
constexpr size_t WS_HB = 64 * MiB;
constexpr size_t WS_PQ = 96 * MiB;
constexpr size_t WS_QT = 192 * MiB, WS_KT = 208 * MiB, WS_AT = 224 * MiB, WS_VT = 232 * MiB;
constexpr size_t WS_SC = 96 * MiB;
constexpr size_t WS_IDS = 264 * MiB, WS_GATES = 272 * MiB;
constexpr size_t WS_TAB = 280 * MiB;
constexpr size_t WS_OG = 312 * MiB;
constexpr size_t WS_TSC = 344 * MiB;
constexpr size_t WS_END = 408 * MiB;
constexpr int CW_BAR = 4096, CW_GBAR = 16384;

constexpr int RING_BYTES = 155648;
constexpr int LDSCTL_OFF = RING_BYTES, MISC_OFF = LDSCTL_OFF + 320;
constexpr int LDS_BYTES = 163840;

typedef unsigned v2u __attribute__((ext_vector_type(2)));
typedef float f32x16 __attribute__((ext_vector_type(16)));
__device__ __forceinline__ float bf2f(unsigned b) { return __builtin_bit_cast(float, b << 16); }
__device__ __forceinline__ float bflo(unsigned w) { return __builtin_bit_cast(float, w << 16); }
__device__ __forceinline__ float bfhi(unsigned w) { return __builtin_bit_cast(float, w & 0xffff0000u); }
__device__ __forceinline__ float wave_sum(float v) {
#pragma unroll
    for (int o = 1; o < 64; o <<= 1) v += __shfl_xor(v, o);
    return v;
}
__device__ __forceinline__ float wave_max(float v) {
#pragma unroll
    for (int o = 1; o < 64; o <<= 1) v = fmaxf(v, __shfl_xor(v, o));
    return v;
}
__device__ __forceinline__ float log_sigmoid(float x) { return fminf(x, 0.f) - __logf(1.0f + __expf(-fabsf(x))); }
__device__ __forceinline__ int crow16(int r, int hi) { return (r & 3) + 8 * (r >> 2) + 4 * hi; }

struct Frame {
    LAS unsigned char* lds;
    volatile LAS unsigned* MISC;
    gu32* ctl;
    int tid, lane, wave, vcu, G;
    unsigned char* ws;
    const float* in[18];
    float* out;
};
enum { IN_X = 0, IN_NORM_MIX, IN_NORM_FFN, IN_GLA_W_IN, IN_GLA_W_G2, IN_GLA_B_G, IN_GLA_NORM_O, IN_GLA_W_O, IN_KV_NORM, IN_KV_W, IN_FOX_B_F, IN_FOX_W_Q, IN_FOX_W_O,
       IN_PEER_W_Q, IN_PEER_SUB, IN_PEER_U, IN_PEER_V, IN_NORM_FINAL };

__device__ __forceinline__ void p0_transpose_item(const float* W, int K, int ldw, int c0, int N, bf16* WT, int row_off, const float* gk, int ns, float cs, LAS float* scr, int item, int lane) {
    const int nblk = N / 32, kb = item / nblk, nb = item % nblk, k0 = 64 * kb, n0 = 32 * nb;
#pragma unroll 8
    for (int i = 0; i < 32; ++i) { const int kk = 2 * i + (lane >> 5); const float g = gk ? gk[k0 + kk] : 1.f; scr[kk * 33 + (lane & 31)] = __builtin_nontemporal_load(W + (size_t)(k0 + kk) * ldw + c0 + n0 + (lane & 31)) * g; }
    LDS_WAIT(); asm volatile("" ::: "memory");
    const int c = lane & 7;
#pragma unroll
    for (int j = 0; j < 4; ++j) { const int n = (lane >> 3) + 8 * j; const LAS float* s = scr + (8 * c) * 33 + n; const float sc = (n0 + n < ns) ? cs : 1.f;
        v4u o; o.x = pk2(s[0 * 33] * sc, s[1 * 33] * sc); o.y = pk2(s[2 * 33] * sc, s[3 * 33] * sc); o.z = pk2(s[4 * 33] * sc, s[5 * 33] * sc); o.w = pk2(s[6 * 33] * sc, s[7 * 33] * sc);
        *(GAS v4u*)(WT + (size_t)(row_off + n0 + n) * K + k0 + 8 * c) = o; }
    LDS_WAIT(); asm volatile("" ::: "memory");
}
__device__ __forceinline__ void p0_weff_item(Frame& F, int item) {
    const int l = item >> 8, gi = (item >> 4) & 15, kb = item & 15, k0 = kb * 64, tid = F.tid, lane = F.lane, wave = F.wave;
    const float* wpq = F.in[IN_PEER_W_Q] + (size_t)l * DMODEL * 2048; const float* sub = F.in[IN_PEER_SUB] + ((size_t)l * 16 + gi) * 128 * 128; const float* gf = F.in[IN_NORM_FFN] + l * DMODEL;
    bf16* WT = (bf16*)(F.ws + WS_WEFF) + (size_t)l * 2048 * DMODEL;
    LAS float* At = (LAS float*)F.lds;
    LAS float* Bt = (LAS float*)(F.lds + 33792);
    { const int kk = tid >> 3, d0 = (tid & 7) * 16; const float g = gf[k0 + kk]; const f32x4* src = (const f32x4*)(wpq + (size_t)(k0 + kk) * 2048 + gi * 128 + d0);
#pragma unroll
      for (int i = 0; i < 4; ++i) { const f32x4 v = __builtin_nontemporal_load(src + i) * g; LAS float* d = At + kk * 129 + d0 + 4 * i; d[0] = v[0]; d[1] = v[1]; d[2] = v[2]; d[3] = v[3]; } }
    { const int n = tid >> 2, d0 = (tid & 3) * 32; const f32x4* src = (const f32x4*)(sub + (size_t)n * 128 + d0);
#pragma unroll
      for (int i = 0; i < 8; ++i) { const f32x4 v = src[i]; LAS float* d = Bt + n * 129 + d0 + 4 * i; d[0] = v[0]; d[1] = v[1]; d[2] = v[2]; d[3] = v[3]; } }
    __syncthreads();
    const int ti = wave >> 2, tj = wave & 3, r32 = lane & 31, hi = lane >> 5;
    const LAS float* ap = At + (32 * ti + r32) * 129 + hi; const LAS float* bp = Bt + (32 * tj + r32) * 129 + hi;
    f32x16 acc = (f32x16){};
#pragma unroll 16
    for (int s = 0; s < 64; ++s) acc = __builtin_amdgcn_mfma_f32_32x32x2f32(ap[2 * s], bp[2 * s], acc, 0, 0, 0);
    bf16* dst = WT + (size_t)(gi * 128 + 32 * tj + r32) * DMODEL + k0 + 32 * ti + 4 * hi;
#pragma unroll
    for (int g = 0; g < 4; ++g) *(GAS v2u*)(dst + 8 * g) = (v2u){pk2(acc[4 * g], acc[4 * g + 1]), pk2(acc[4 * g + 2], acc[4 * g + 3])};
    __syncthreads();
}
template <int NR> __device__ __forceinline__ void rms_rows_to_bf16(int lane, const float* const (&xrow)[NR], const float* g, bf16* const (&orow)[NR]) {
    f32x4 v[NR][4];
#pragma unroll
    for (int r = 0; r < NR; ++r) { const GAS f32x4* xr = (const GAS f32x4*)xrow[r] + lane;
#pragma unroll
        for (int j = 0; j < 4; ++j) v[r][j] = __builtin_nontemporal_load(xr + 64 * j); }
    const GAS f32x4* gr = (const GAS f32x4*)g + lane;
    f32x4 gg[4];
#pragma unroll
    for (int j = 0; j < 4; ++j) gg[j] = gr[64 * j];
#pragma unroll
    for (int r = 0; r < NR; ++r) { float s = 0.f;
#pragma unroll
        for (int j = 0; j < 4; ++j) s += (v[r][j].x * v[r][j].x + v[r][j].y * v[r][j].y) + (v[r][j].z * v[r][j].z + v[r][j].w * v[r][j].w);
        const float rstd = 1.f / sqrtf(wave_sum(s) * (1.f / DMODEL) + EPS);
        GAS unsigned long long* o8 = (GAS unsigned long long*)orow[r] + lane;
#pragma unroll
        for (int j = 0; j < 4; ++j) o8[64 * j] = (unsigned long long)pk2(v[r][j].x * rstd * gg[j].x, v[r][j].y * rstd * gg[j].y) | ((unsigned long long)pk2(v[r][j].z * rstd * gg[j].z, v[r][j].w * rstd * gg[j].w) << 32); }
}
__device__ __forceinline__ unsigned fp4_code(float y) {
    const float a = fabsf(y);
    const unsigned mag = (unsigned)(a >= 0.25f) + (unsigned)(a >= 0.75f) + (unsigned)(a >= 1.25f) + (unsigned)(a >= 1.75f) + (unsigned)(a >= 2.5f) + (unsigned)(a >= 3.5f) + (unsigned)(a >= 5.0f);
    return mag | ((__builtin_bit_cast(unsigned, y) >> 28) & 8u);
}
template <int NR> __device__ __forceinline__ void tab_rows_to_fp4(int lane, const float* const (&src)[NR], unsigned char* const (&dst)[NR], float* const (&sc_out)[NR]) {
    f32x4 a[NR], b[NR], c[NR], d[NR];
#pragma unroll
    for (int r = 0; r < NR; ++r) { const GAS f32x4* s = (const GAS f32x4*)src[r] + 4 * lane;
        a[r] = __builtin_nontemporal_load(s); b[r] = __builtin_nontemporal_load(s + 1); c[r] = __builtin_nontemporal_load(s + 2); d[r] = __builtin_nontemporal_load(s + 3); }
#pragma unroll
    for (int r = 0; r < NR; ++r) {
        float m = fmaxf(fmaxf(fmaxf(fabsf(a[r].x), fabsf(a[r].y)), fmaxf(fabsf(a[r].z), fabsf(a[r].w))), fmaxf(fmaxf(fabsf(b[r].x), fabsf(b[r].y)), fmaxf(fabsf(b[r].z), fabsf(b[r].w))));
        m = fmaxf(m, fmaxf(fmaxf(fmaxf(fabsf(c[r].x), fabsf(c[r].y)), fmaxf(fabsf(c[r].z), fabsf(c[r].w))), fmaxf(fmaxf(fabsf(d[r].x), fabsf(d[r].y)), fmaxf(fabsf(d[r].z), fabsf(d[r].w)))));
        m = wave_max(m);
        const float enc = (m > 0.f) ? 6.0f / m : 1.0f;
        unsigned w0 = 0, w1 = 0;
        w0 = __builtin_amdgcn_cvt_scalef32_pk_fp4_f32(w0, a[r].x * enc, a[r].y * enc, 1.0f, 0); w0 = __builtin_amdgcn_cvt_scalef32_pk_fp4_f32(w0, a[r].z * enc, a[r].w * enc, 1.0f, 1);
        w0 = __builtin_amdgcn_cvt_scalef32_pk_fp4_f32(w0, b[r].x * enc, b[r].y * enc, 1.0f, 2); w0 = __builtin_amdgcn_cvt_scalef32_pk_fp4_f32(w0, b[r].z * enc, b[r].w * enc, 1.0f, 3);
        w1 = __builtin_amdgcn_cvt_scalef32_pk_fp4_f32(w1, c[r].x * enc, c[r].y * enc, 1.0f, 0); w1 = __builtin_amdgcn_cvt_scalef32_pk_fp4_f32(w1, c[r].z * enc, c[r].w * enc, 1.0f, 1);
        w1 = __builtin_amdgcn_cvt_scalef32_pk_fp4_f32(w1, d[r].x * enc, d[r].y * enc, 1.0f, 2); w1 = __builtin_amdgcn_cvt_scalef32_pk_fp4_f32(w1, d[r].z * enc, d[r].w * enc, 1.0f, 3);
        ((GAS v2u*)dst[r])[lane] = (v2u){w0, w1};
        if (lane == 0) *sc_out[r] = (m > 0.f) ? m * (1.0f / 6.0f) : 1.0f; }
}
__device__ __forceinline__ void p0_prologue(Frame& F) {
    LAS float* scr = (LAS float*)(F.lds + F.wave * 16384);
    const int gw = blockIdx.x * NWAVES + F.wave, NGW = F.G * NWAVES;
    constexpr int I_IN = 16 * 96, I_SQ = 16 * 32;
    for (int it = gw; it < I_IN + I_SQ; it += NGW) {
        if (it < I_IN) p0_transpose_item(F.in[IN_GLA_W_IN], DMODEL, GLA_IN, 0, 3072, (bf16*)(F.ws + WS_WIN), 0, nullptr, 512, 0.08838834764831845f, scr, it, F.lane);
        else p0_transpose_item(F.in[IN_GLA_W_O], DMODEL, DMODEL, 0, 1024, (bf16*)(F.ws + WS_WGO), 0, nullptr, 0, 1.f, scr, it - I_IN, F.lane); }
    { const int gt = blockIdx.x * NTHR + F.tid, NT = F.G * NTHR;
      for (int idx = gt; idx < 16 * DMODEL; idx += NT) { const int j = idx >> 10, k = idx & 1023; ((bf16*)(F.ws + WS_WGL))[j * DMODEL + k] = (bf16)f2bf(F.in[IN_GLA_W_IN][(size_t)k * GLA_IN + 3072 + j]); } }
    for (int m = gw; m < T_TOK; m += 4 * NGW) {
        const float* xr[4]; bf16* orow[4];
#pragma unroll
        for (int i = 0; i < 4; ++i) { int mm = m + i * NGW; mm = mm < T_TOK ? mm : T_TOK - 1; xr[i] = F.in[IN_X] + (size_t)mm * DMODEL; orow[i] = (bf16*)(F.ws + WS_A0) + (size_t)mm * DMODEL; }
        rms_rows_to_bf16<4>(F.lane, xr, F.in[IN_NORM_MIX], orow); }
}
__device__ __forceinline__ void late_weights(Frame& F, int wg0, int nwg) {
    const int p = (int)blockIdx.x - wg0;
    for (int it = p; it < 512; it += nwg) p0_weff_item(F, it);
    LAS float* scr = (LAS float*)(F.lds + F.wave * 16384);
    const int gw = p * NWAVES + F.wave, NGW = nwg * NWAVES;
    constexpr int I_SQ = 16 * 32, I_KV = 16 * 64;
    for (int it = gw; it < 2 * I_SQ + I_KV; it += NGW) {
        int r = it;
        if (r < I_SQ) { p0_transpose_item(F.in[IN_FOX_W_Q], DMODEL, DMODEL, 0, 1024, (bf16*)(F.ws + WS_WQKV), 0, F.in[IN_NORM_MIX] + DMODEL, 0, 1.f, scr, r, F.lane); continue; } r -= I_SQ;
        if (r < I_KV) { p0_transpose_item(F.in[IN_KV_W], DMODEL, KV_TOT, 0, 2048, (bf16*)(F.ws + WS_WQKV), 1024, F.in[IN_KV_NORM], 0, 1.f, scr, r, F.lane); continue; } r -= I_KV;
        p0_transpose_item(F.in[IN_FOX_W_O], DMODEL, DMODEL, 0, 1024, (bf16*)(F.ws + WS_WFO), 0, nullptr, 0, 1.f, scr, r, F.lane); }
    { const int gt = p * NTHR + F.tid, NT = nwg * NTHR;
      for (int idx = gt; idx < 16 * DMODEL; idx += NT) { const int j = idx >> 10, k = idx & 1023;
          const float wv = F.in[IN_KV_W][(size_t)k * KV_TOT + 2048 + j] * F.in[IN_KV_NORM][k]; ((bf16*)(F.ws + WS_WFL))[j * DMODEL + k] = (bf16)f2bf(wv); ((float*)(F.ws + WS_WFLF))[j * DMODEL + k] = wv; } }
}

#ifndef TAB_ROWS_PER_ITER
#define TAB_ROWS_PER_ITER 1
#endif
__device__ __forceinline__ void peer_tables_convert(Frame& F, int w0, int nw) {
    const int gw = blockIdx.x * NWAVES + F.wave - w0;
    if (gw < 0 || gw >= nw) return;
    constexpr int NR = TAB_ROWS_PER_ITER;
    for (int r0 = gw; r0 < 4 * PEER_NEXP; r0 += NR * nw) {
        const float* src[NR]; unsigned char* dst[NR]; float* sc[NR];
#pragma unroll
        for (int i = 0; i < NR; ++i) { int r = r0 + i * nw; r = r < 4 * PEER_NEXP ? r : 4 * PEER_NEXP - 1; const int tb = r >> 14, e = r & (PEER_NEXP - 1), l = tb >> 1;
            src[i] = ((tb & 1) ? F.in[IN_PEER_V] : F.in[IN_PEER_U]) + ((size_t)l * PEER_NEXP + e) * DMODEL;
            dst[i] = F.ws + WS_TAB + ((size_t)tb * PEER_NEXP + e) * (DMODEL / 2); sc[i] = (float*)(F.ws + WS_TSC) + (size_t)tb * PEER_NEXP + e; }
        tab_rows_to_fp4<NR>(F.lane, src, dst, sc); }
}

__device__ __forceinline__ f32x4 skinny16(const bf16* A  , const bf16* Wt, int wave, int lane, LAS float* scr) {
    f32x4 acc = (f32x4){0.f, 0.f, 0.f, 0.f};
    const bf16x8* ap = (const bf16x8*)(A + (size_t)(16 * (wave & 3) + (lane & 15)) * DMODEL + 512 * (wave >> 2) + 8 * (lane >> 4));
    const bf16x8* bp = (const bf16x8*)(Wt + (size_t)(lane & 15) * DMODEL + 512 * (wave >> 2) + 8 * (lane >> 4));
    bf16x8 af[16], bfr[16];
#pragma unroll
    for (int kk = 0; kk < 16; ++kk) { af[kk] = ap[4 * kk]; bfr[kk] = bp[4 * kk]; }
#pragma unroll
    for (int kk = 0; kk < 16; ++kk) acc = __builtin_amdgcn_mfma_f32_16x16x32_bf16(af[kk], bfr[kk], acc, 0, 0, 0);
    if (wave >= 4) *(LAS f32x4*)(scr + (wave - 4) * 256 + 4 * lane) = acc;
    __syncthreads();
    if (wave < 4) acc += *(const LAS f32x4*)(scr + wave * 256 + 4 * lane);
    return acc;
}
__device__ __forceinline__ int perm16(int k16) { return 8 * ((k16 >> 2) & 1) + 4 * (k16 >> 3) + (k16 & 3); }
__device__ __forceinline__ void p2a_item(Frame& F, int b, int n) {
    const int tid = F.tid, lane = F.lane, wave = F.wave;
    const int t0 = b * SEQ + n * GLA_C;
    const bf16* PQ = (const bf16*)(F.ws + WS_PQ);
    LAS float* glrL = (LAS float*)F.lds;
    LAS float* SEG = (LAS float*)(F.lds + 4096);
    LAS unsigned char* QI = F.lds + 8192;
    LAS unsigned char* KI = F.lds + 24576;
    LAS unsigned char* RQ = F.lds + 40960;
    LAS unsigned char* RK = F.lds + 57344;
    LAS unsigned char* RV = F.lds + 73728;
    v4u rq[2], rk[2], rv[4];
#define P2A_LOAD(hh) do { _Pragma("unroll") for (int i_ = 0; i_ < 2; ++i_) { const int p_ = tid + 512 * i_; const bf16* src_ = PQ + (size_t)(t0 + (p_ >> 4)) * 3072 + (hh) * 128 + (p_ & 15) * 8; \
        rq[i_] = *(const GAS v4u*)src_; rk[i_] = *(const GAS v4u*)(src_ + 512); } \
      _Pragma("unroll") for (int i_ = 0; i_ < 4; ++i_) { const int p_ = tid + 512 * i_; rv[i_] = *(const GAS v4u*)(PQ + (size_t)(t0 + (p_ >> 5)) * 3072 + 1024 + (hh) * 256 + (p_ & 31) * 8); } } while (0)
#define P2A_STORE() do { _Pragma("unroll") for (int i_ = 0; i_ < 2; ++i_) { const int p_ = tid + 512 * i_; *(LAS v4u*)(RQ + p_ * 16) = rq[i_]; *(LAS v4u*)(RK + p_ * 16) = rk[i_]; } \
      _Pragma("unroll") for (int i_ = 0; i_ < 4; ++i_) { const int p_ = tid + 512 * i_; *(LAS v4u*)(RV + p_ * 16) = rv[i_]; } } while (0)
    P2A_LOAD(0);
    { const f32x4 a = skinny16((const bf16*)(F.ws + WS_A0) + (size_t)t0 * DMODEL, (const bf16*)(F.ws + WS_WGL), wave, lane, (LAS float*)(F.lds + 106496));
      if (wave < 4) {
#pragma unroll
        for (int r = 0; r < 4; ++r) glrL[(16 * wave + 4 * (lane >> 4) + r) * 16 + (lane & 15)] = a[r]; } }
    P2A_STORE();
    __syncthreads();
    const int k = tid & 127, iq = tid >> 7;
    const int pos = (k & ~15) | perm16(k & 15);
    for (int h = 0; h < GLA_H; ++h) {
        const int cid = (b * 4 + h) * 32 + n;
        if (h + 1 < GLA_H) P2A_LOAD(h + 1);
        float wg[16];
#pragma unroll
        for (int j = 0; j < 16; ++j) wg[j] = F.in[IN_GLA_W_G2][j * 512 + h * 128 + k];
        const float bg = F.in[IN_GLA_B_G][h * 128 + k];
        float bc[16];
#pragma unroll
        for (int ii = 0; ii < 16; ++ii) { const LAS f32x4* gp = (const LAS f32x4*)(glrL + (iq * 16 + ii) * 16); float s = bg;
#pragma unroll
            for (int q4 = 0; q4 < 4; ++q4) { const f32x4 gv = gp[q4]; s += (gv[0] * wg[4 * q4] + gv[1] * wg[4 * q4 + 1]) + (gv[2] * wg[4 * q4 + 2] + gv[3] * wg[4 * q4 + 3]); }
            bc[ii] = log_sigmoid(s) * (1.0f / 16.0f); }
#pragma unroll
        for (int ii = 1; ii < 16; ++ii) bc[ii] += bc[ii - 1];
        SEG[iq * 128 + k] = bc[15];
        __syncthreads();
        float off = 0.f, tot = 0.f;
#pragma unroll
        for (int q = 0; q < 4; ++q) { const float sv = SEG[q * 128 + k]; tot += sv; if (q < iq) off += sv; }
        unsigned kt[8];
#pragma unroll
        for (int ii = 0; ii < 16; ii += 2) {
            float qa[2], ka[2];
#pragma unroll
            for (int e = 0; e < 2; ++e) { const int i = iq * 16 + ii + e; const float bb = bc[ii + e] + off;
                const float qv = bf2f(*(const LAS unsigned short*)(RQ + i * 256 + k * 2)), kv = bf2f(*(const LAS unsigned short*)(RK + i * 256 + k * 2));
                qa[e] = qv * __expf(bb); ka[e] = kv * __expf(-bb);
                *(LAS unsigned short*)(QI + i * 256 + pos * 2) = (unsigned short)f2bf(qa[e]);
                *(LAS unsigned short*)(KI + i * 256 + pos * 2) = (unsigned short)f2bf(ka[e]); }
            kt[ii >> 1] = pk2(ka[0], ka[1]); }
        { GAS v4u* dst = (GAS v4u*)((bf16*)(F.ws + WS_KT) + (size_t)cid * 8192 + k * 64 + iq * 16);
          dst[0] = (v4u){kt[0], kt[1], kt[2], kt[3]}; dst[1] = (v4u){kt[4], kt[5], kt[6], kt[7]}; }
        if (iq == 0) ((float*)(F.ws + WS_DEXP))[(size_t)cid * 128 + k] = __expf(tot);
        { const int nn = tid & 255, jh = tid >> 8; unsigned w[16];
#pragma unroll
          for (int jj = 0; jj < 32; jj += 2) { const unsigned lo = *(const LAS unsigned short*)(RV + (32 * jh + jj) * 512 + nn * 2), hi2 = *(const LAS unsigned short*)(RV + (32 * jh + jj + 1) * 512 + nn * 2); w[jj >> 1] = lo | (hi2 << 16); }
          GAS v4u* dst = (GAS v4u*)((bf16*)(F.ws + WS_VT) + (size_t)cid * 16384 + nn * 64 + 32 * jh);
#pragma unroll
          for (int q = 0; q < 4; ++q) dst[q] = (v4u){w[4 * q], w[4 * q + 1], w[4 * q + 2], w[4 * q + 3]}; }
        __syncthreads();
        if (wave < 4) { const int ib = (wave == 1 || wave == 2) ? 1 : 0, jb = (wave >= 2) ? 1 : 0, r32 = lane & 31, hi = lane >> 5;
            f32x16 acc = (f32x16){};
            if (wave != 3) {
#pragma unroll
                for (int kk = 0; kk < 8; ++kk) { const bf16x8 af = *(const LAS bf16x8*)(KI + (32 * jb + r32) * 256 + (16 * kk + 8 * hi) * 2);
                    const bf16x8 bfr = *(const LAS bf16x8*)(QI + (32 * ib + r32) * 256 + (16 * kk + 8 * hi) * 2);
                    acc = __builtin_amdgcn_mfma_f32_32x32x16_bf16(af, bfr, acc, 0, 0, 0); } }
            const int i = 32 * ib + r32;
            bf16* at = (bf16*)(F.ws + WS_AT) + (size_t)cid * 4096 + i * 64 + 32 * jb + 4 * hi;
#pragma unroll
            for (int g = 0; g < 4; ++g) { float v[4];
#pragma unroll
                for (int e = 0; e < 4; ++e) { const int j = 32 * jb + 8 * g + 4 * hi + e; v[e] = (j <= i) ? acc[4 * g + e] : 0.f; }
                *(GAS v2u*)(at + 8 * g) = (v2u){pk2(v[0], v[1]), pk2(v[2], v[3])}; } }
        { GAS v4u* dst = (GAS v4u*)((bf16*)(F.ws + WS_QT) + (size_t)cid * 8192); const LAS v4u* src = (const LAS v4u*)QI; dst[tid] = src[tid]; dst[tid + 512] = src[tid + 512]; }
        if (h + 1 < GLA_H) P2A_STORE();
        __syncthreads();
    }
#undef P2A_LOAD
#undef P2A_STORE
}

__device__ __forceinline__ unsigned cvtpk(float lo, float hi) { typedef float f2 __attribute__((ext_vector_type(2))); typedef __bf16 b2 __attribute__((ext_vector_type(2))); f2 v = {lo, hi}; b2 r = __builtin_convertvector(v, b2); return __builtin_bit_cast(unsigned, r); }
__device__ __forceinline__ void glds16s(const void* sbase, unsigned voff, unsigned lds_dst) { unsigned keep;
    asm volatile("s_mov_b32 %0, m0\n\ts_mov_b32 m0, %3\n\ts_nop 0\n\tglobal_load_lds_dwordx4 %1, %2\n\ts_mov_b32 m0, %0" : "=&s"(keep) : "v"(voff), "s"(sbase), "s"(lds_dst) : "memory"); }
__device__ __forceinline__ void glds16s_nt(const void* sbase, unsigned voff, unsigned lds_dst) { unsigned keep;
    asm volatile("s_mov_b32 %0, m0\n\ts_mov_b32 m0, %3\n\ts_nop 0\n\tglobal_load_lds_dwordx4 %1, %2 nt\n\ts_mov_b32 m0, %0" : "=&s"(keep) : "v"(voff), "s"(sbase), "s"(lds_dst) : "memory"); }
constexpr int P2B_STAGE = 40960, P2B_BUF0 = 4096;
__device__ __forceinline__ void p2b_seq(Frame& F, int bh, int probe_skip = 0) {
    const int lane = F.lane, wave = F.wave, r32 = lane & 31, hi = lane >> 5;
    const int b = bh >> 2, h = bh & 3;
    const bf16* PQ = (const bf16*)(F.ws + WS_PQ); bf16* OG = (bf16*)(F.ws + WS_A0);
    LAS float* red = (LAS float*)F.lds;
    const unsigned lds0 = (unsigned)(uintptr_t)F.lds + P2B_BUF0;
    f32x16 S[4];
#pragma unroll
    for (int kb = 0; kb < 4; ++kb) S[kb] = (f32x16){};
    int sq[2], sk[2];
#pragma unroll
    for (int i = 0; i < 2; ++i) { const int P = wave + 8 * i;
        { const int row = 4 * P + (lane >> 4), c = (lane & 15) ^ (row & 15); sq[i] = row * 256 + c * 16; }
        { const int row = 8 * P + (lane >> 3), c = (lane & 7) ^ ((row >> 1) & 7); sk[i] = row * 128 + c * 16; } }
#define P2B_DMA(cid_, bufi_) do { const unsigned d_ = lds0 + (bufi_) * P2B_STAGE; \
        const char* q_ = (const char*)(F.ws + WS_QT) + (size_t)(cid_) * 16384; const char* k_ = (const char*)(F.ws + WS_KT) + (size_t)(cid_) * 16384; const char* a_ = (const char*)(F.ws + WS_AT) + (size_t)(cid_) * 8192; \
        glds16s(q_, sq[0], (unsigned)__builtin_amdgcn_readfirstlane(d_ + wave * 1024)); glds16s(q_, sq[1], (unsigned)__builtin_amdgcn_readfirstlane(d_ + (wave + 8) * 1024)); \
        glds16s(k_, sk[0], (unsigned)__builtin_amdgcn_readfirstlane(d_ + 16384 + wave * 1024)); glds16s(k_, sk[1], (unsigned)__builtin_amdgcn_readfirstlane(d_ + 16384 + (wave + 8) * 1024)); \
        glds16s(a_, sk[0], (unsigned)__builtin_amdgcn_readfirstlane(d_ + 32768 + wave * 1024)); } while (0)
    bf16x8 vf[4];
    LAS float* dxL = (LAS float*)(F.lds + P2B_BUF0 + 2 * P2B_STAGE);
    const int tid = F.tid;
    constexpr int P2B_VTW = P2B_BUF0 + 2 * P2B_STAGE + 1024, P2B_RW = P2B_VTW + 32768;
    static_assert(P2B_RW + 32768 <= RING_BYTES, "GLA recurrence LDS map");
    const unsigned vtw0 = (unsigned)(uintptr_t)F.lds + P2B_VTW + wave * 4096, rw0 = (unsigned)(uintptr_t)F.lds + P2B_RW + wave * 4096;
    int sv[4], sr[4];
#pragma unroll
    for (int i = 0; i < 4; ++i) { { const int row = 8 * i + (lane >> 3), c = (lane & 7) ^ ((row >> 1) & 7); sv[i] = (32 * wave + row) * 128 + c * 16; }
                                  { const int row = 16 * i + (lane >> 2), c = (lane & 3) ^ ((row >> 2) & 3); sr[i] = row * 6144 + c * 16; } }
#define P2B_DMA_V(cid_) do { const char* v_ = (const char*)(F.ws + WS_VT) + (size_t)(cid_) * 32768; _Pragma("unroll") for (int i_ = 0; i_ < 4; ++i_) glds16s(v_, sv[i_], (unsigned)__builtin_amdgcn_readfirstlane(vtw0 + i_ * 1024)); } while (0)
#define P2B_DMA_R(t0_) do { const char* r_ = (const char*)(PQ + (size_t)(t0_) * 3072 + 2048 + h * 256 + 32 * wave); _Pragma("unroll") for (int i_ = 0; i_ < 4; ++i_) glds16s(r_, sr[i_], (unsigned)__builtin_amdgcn_readfirstlane(rw0 + i_ * 1024)); } while (0)
    const LAS unsigned char* vtw = F.lds + P2B_VTW + wave * 4096 + r32 * 128; const LAS unsigned char* rwl = F.lds + P2B_RW + wave * 4096;
    { const int cid = bh * 32;
      P2B_DMA(cid, 0); P2B_DMA_V(cid); P2B_DMA_R(b * SEQ);
      if (tid < 32) *(LAS f32x4*)(dxL + 4 * tid) = *(const f32x4*)((const float*)(F.ws + WS_DEXP) + (size_t)cid * 128 + 4 * tid); }
    asm volatile("s_waitcnt vmcnt(0)" ::: "memory");
    __syncthreads();
    const int kx0 = (r32 >> 1) & 7;
#pragma unroll
    for (int s = 0; s < 4; ++s) vf[s] = *(const LAS bf16x8*)(vtw + (((2 * s + hi) ^ kx0) << 4));
    const int qoff = r32 * 256, koff = 16384 + r32 * 128, aoff = 32768 + r32 * 128;
    const int qx = r32 & 15, kx = (r32 >> 1) & 7;
    for (int n = 0; n < GLA_NCH; ++n) {
        const int cid = bh * 32 + n, t0 = b * SEQ + n * GLA_C;
        const LAS unsigned char* buf = F.lds + P2B_BUF0 + (n & 1) * P2B_STAGE;
        const LAS float* DX = dxL + (n & 1) * 128;
        f32x4 dxn = (f32x4){0.f, 0.f, 0.f, 0.f};
        if (n + 1 < GLA_NCH) { P2B_DMA(cid + 1, (n + 1) & 1);
            if (tid < 32) dxn = *(const f32x4*)((const float*)(F.ws + WS_DEXP) + (size_t)(cid + 1) * 128 + 4 * tid); }
        if (n + 1 < GLA_NCH) P2B_DMA_V(cid + 1);
        f32x16 oT[2];
        oT[0] = (f32x16){}; oT[1] = (f32x16){};
#pragma unroll
        for (int kb = 0; kb < 4; ++kb) {
            bf16x8 qf[2][2];
#pragma unroll
            for (int s = 0; s < 2; ++s)
#pragma unroll
                for (int ib = 0; ib < 2; ++ib) qf[s][ib] = *(const LAS bf16x8*)(buf + qoff + ib * 8192 + (((4 * kb + 2 * s + hi) ^ qx) << 4));
            __builtin_amdgcn_sched_barrier(0);
#pragma unroll
            for (int s = 0; s < 2; ++s) { v4u sw; sw.x = cvtpk(S[kb][8 * s], S[kb][8 * s + 1]); sw.y = cvtpk(S[kb][8 * s + 2], S[kb][8 * s + 3]); sw.z = cvtpk(S[kb][8 * s + 4], S[kb][8 * s + 5]); sw.w = cvtpk(S[kb][8 * s + 6], S[kb][8 * s + 7]);
                const bf16x8 sf = __builtin_bit_cast(bf16x8, sw);
#pragma unroll
                for (int ib = 0; ib < 2; ++ib) oT[ib] = __builtin_amdgcn_mfma_f32_32x32x16_bf16(sf, qf[s][ib], oT[ib], 0, 0, 0); }
            __builtin_amdgcn_sched_barrier(0); }
        { bf16x8 af[2][4];
#pragma unroll
          for (int ib = 0; ib < 2; ++ib)
#pragma unroll
              for (int s = 0; s < 4; ++s) af[ib][s] = *(const LAS bf16x8*)(buf + aoff + ib * 4096 + (((2 * s + hi) ^ kx) << 4));
          __builtin_amdgcn_sched_barrier(0);
#pragma unroll
          for (int ib = 0; ib < 2; ++ib)
#pragma unroll
              for (int s = 0; s < 4; ++s) oT[ib] = __builtin_amdgcn_mfma_f32_32x32x16_bf16(vf[s], af[ib][s], oT[ib], 0, 0, 0);
          __builtin_amdgcn_sched_barrier(0); }
#pragma unroll
        for (int kh = 0; kh < 2; ++kh) { bf16x8 kf[2][4];
#pragma unroll
            for (int kb = 0; kb < 2; ++kb)
#pragma unroll
                for (int s = 0; s < 4; ++s) kf[kb][s] = *(const LAS bf16x8*)(buf + koff + (2 * kh + kb) * 4096 + (((2 * s + hi) ^ kx) << 4));
            __builtin_amdgcn_sched_barrier(0);
#pragma unroll
            for (int kb = 0; kb < 2; ++kb)
#pragma unroll
                for (int s = 0; s < 4; ++s) S[2 * kh + kb] = __builtin_amdgcn_mfma_f32_32x32x16_bf16(kf[kb][s], vf[s], S[2 * kh + kb], 0, 0, 0);
            __builtin_amdgcn_sched_barrier(0); }
#pragma unroll
        for (int kb = 0; kb < 4; ++kb)
#pragma unroll
            for (int g = 0; g < 4; ++g) { const f32x4 dv = *(const LAS f32x4*)(DX + 32 * kb + 8 * g + 4 * hi);
                S[kb][4 * g] *= dv[0]; S[kb][4 * g + 1] *= dv[1]; S[kb][4 * g + 2] *= dv[2]; S[kb][4 * g + 3] *= dv[3]; }
        LAS float* rp = red + (n & 1) * 512;
#pragma unroll
        for (int ib = 0; ib < 2; ++ib) { float ss = 0.f;
#pragma unroll
            for (int r = 0; r < 16; ++r) ss += oT[ib][r] * oT[ib][r];
            ss += __shfl_xor(ss, 32);
            if (hi == 0) rp[wave * 64 + 32 * ib + r32] = ss; }
        if (n + 1 < GLA_NCH && tid < 32) *(LAS f32x4*)(dxL + ((n + 1) & 1) * 128 + 4 * tid) = dxn;
        asm volatile("s_waitcnt vmcnt(0)" ::: "memory");
        __syncthreads();
        if (probe_skip != 1)
#pragma unroll
        for (int ib = 0; ib < 2; ++ib) { float tot = 0.f;
#pragma unroll
            for (int w = 0; w < 8; ++w) tot += rp[w * 64 + 32 * ib + r32];
            const float rstd = __builtin_amdgcn_rsqf(tot * (1.0f / 256.0f) + EPS);
            const int t = t0 + 32 * ib + r32;
            bf16* orow = OG + (size_t)t * DMODEL + h * 256 + 32 * wave + 4 * hi;
#pragma unroll
            for (int g = 0; g < 4; ++g) { const int ri = 32 * ib + r32; const v2u rwv = *(const LAS v2u*)(rwl + ri * 64 + ((g ^ ((ri >> 2) & 3)) << 4) + 8 * hi);
                *(GAS v2u*)(orow + 8 * g) = (v2u){cvtpk(oT[ib][4 * g] * rstd * bflo(rwv.x), oT[ib][4 * g + 1] * rstd * bfhi(rwv.x)), cvtpk(oT[ib][4 * g + 2] * rstd * bflo(rwv.y), oT[ib][4 * g + 3] * rstd * bfhi(rwv.y))};
                __builtin_amdgcn_sched_barrier(0); } }
        if (n + 1 < GLA_NCH) {
#pragma unroll
            for (int s = 0; s < 4; ++s) vf[s] = *(const LAS bf16x8*)(vtw + (((2 * s + hi) ^ kx0) << 4));
            asm volatile("s_waitcnt lgkmcnt(0)" ::: "memory");
            P2B_DMA_R(t0 + GLA_C); }
    }
#undef P2B_DMA_V
#undef P2B_DMA_R
#undef P2B_DMA
}
__device__ __forceinline__ unsigned mono(float f) { const unsigned u = __builtin_bit_cast(unsigned, f); return (u & 0x80000000u) ? ~u : (u | 0x80000000u); }
__device__ __forceinline__ float unmono(unsigned m) { const unsigned u = (m & 0x80000000u) ? (m ^ 0x80000000u) : ~m; return __builtin_bit_cast(float, u); }
#define KMAX(a, b) ((a) > (b) ? (a) : (b))
#define KMIN(a, b) ((a) < (b) ? (a) : (b))
#define INSERT16(L, x) do { unsigned x_ = (x); _Pragma("unroll") for (int p_ = 0; p_ < 16; ++p_) { const unsigned t_ = KMAX(L[p_], x_); x_ = KMIN(L[p_], x_); L[p_] = t_; } } while (0)
#define MERGE16(L, O) do { _Pragma("unroll") for (int p_ = 0; p_ < 16; ++p_) L[p_] = KMAX(L[p_], O[15 - p_]); \
    _Pragma("unroll") for (int st_ = 8; st_ >= 1; st_ >>= 1) { _Pragma("unroll") for (int p_ = 0; p_ < 16; ++p_) { if ((p_ & st_) == 0) { const unsigned a_ = L[p_], b_ = L[p_ + st_]; L[p_] = KMAX(a_, b_); L[p_ + st_] = KMIN(a_, b_); } } } } while (0)
#define SORT16(L) do { _Pragma("unroll") for (int k_ = 2; k_ <= 16; k_ <<= 1) { _Pragma("unroll") for (int j_ = k_ >> 1; j_ >= 1; j_ >>= 1) { _Pragma("unroll") for (int i_ = 0; i_ < 16; ++i_) { \
    if ((i_ & j_) == 0) { const unsigned a_ = L[i_], b_ = L[i_ | j_]; const bool desc_ = ((i_ & k_) == 0) || (k_ == 16); L[i_] = desc_ ? KMAX(a_, b_) : KMIN(a_, b_); L[i_ | j_] = desc_ ? KMIN(a_, b_) : KMAX(a_, b_); } } } } } while (0)
__device__ __forceinline__ void p5_wave(int lane, const LAS unsigned short* row, LAS int* idsL, LAS float* gatesL) {
    const int q = lane & 3, c = (lane >> 2) & 1, head = lane >> 3, r8 = lane & 7;
    const LAS unsigned short* mine = row + lane * 32;
    unsigned L[16], O[16];
    const int sw = (lane >> 2) & 3;
#pragma unroll
    for (int it = 0; it < 4; ++it) { const int c16 = it ^ sw; const v4u v = *(const LAS v4u*)(mine + 8 * c16);
#pragma unroll
        for (int e = 0; e < 8; ++e) { const int idx = q * 32 + c16 * 8 + e; const unsigned wv = v[e >> 1]; const float sv = (e & 1) ? bfhi(wv) : bflo(wv);
            const unsigned key = (mono(sv) & ~127u) | (unsigned)(127 - idx); if (it < 2) L[8 * it + e] = key; else O[8 * (it - 2) + e] = key; } }
    SORT16(L); SORT16(O); MERGE16(L, O);
#pragma unroll
    for (int p = 0; p < 16; ++p) O[p] = __shfl_xor(L[p], 1);
    MERGE16(L, O);
#pragma unroll
    for (int p = 0; p < 16; ++p) O[p] = __shfl_xor(L[p], 2);
    MERGE16(L, O);
#pragma unroll
    for (int p = 0; p < 16; ++p) O[p] = __shfl_xor(L[p], 4);
    unsigned A[16], B[16];
#pragma unroll
    for (int p = 0; p < 16; ++p) { A[p] = c ? O[p] : L[p]; B[p] = c ? L[p] : O[p]; }
    unsigned ka = A[0], kb8 = A[8];
#pragma unroll
    for (int p = 1; p < 8; ++p) { ka = (r8 == p) ? A[p] : ka; kb8 = (r8 == p) ? A[8 + p] : kb8; }
    const float va = unmono(ka & ~127u), va8 = unmono(kb8 & ~127u);
    const unsigned pa = ((127u - (ka & 127u)) << 7), pa8 = ((127u - (kb8 & 127u)) << 7);
    const int nvalid = 16 / (r8 + 1);
    unsigned Cn[16];
#pragma unroll
    for (int j = 0; j < 16; ++j) { const float vb = unmono(B[j] & ~127u); const unsigned pb = 127u - (B[j] & 127u);
        const unsigned key = (mono(va + vb) & ~16383u) | pa | pb; Cn[j] = (j < nvalid) ? key : 0u; }
    { const float vb0 = unmono(B[0] & ~127u); const unsigned pb0 = 127u - (B[0] & 127u); const unsigned key = (mono(va8 + vb0) & ~16383u) | pa8 | pb0; INSERT16(Cn, key); }
#pragma unroll
    for (int p = 0; p < 16; ++p) O[p] = __shfl_xor(Cn[p], 1);
    MERGE16(Cn, O);
#pragma unroll
    for (int p = 0; p < 16; ++p) O[p] = __shfl_xor(Cn[p], 2);
    MERGE16(Cn, O);
#pragma unroll
    for (int p = 0; p < 16; ++p) O[p] = __shfl_xor(Cn[p], 4);
    MERGE16(Cn, O);
    unsigned k0 = Cn[0], k1 = Cn[8];
#pragma unroll
    for (int p = 1; p < 8; ++p) { k0 = (r8 == p) ? Cn[p] : k0; k1 = (r8 == p) ? Cn[8 + p] : k1; }
    const int ia0 = (k0 >> 7) & 127, ib0 = k0 & 127, ia1 = (k1 >> 7) & 127, ib1 = k1 & 127;
    const LAS unsigned short* hrow = row + head * 256;
    const float s0 = bf2f(hrow[ia0]) + bf2f(hrow[128 + ib0]), s1 = bf2f(hrow[ia1]) + bf2f(hrow[128 + ib1]);
    float mx = fmaxf(s0, s1);
    mx = fmaxf(mx, __shfl_xor(mx, 1)); mx = fmaxf(mx, __shfl_xor(mx, 2)); mx = fmaxf(mx, __shfl_xor(mx, 4));
    const float e0 = __expf(s0 - mx), e1 = __expf(s1 - mx);
    float sm = e0 + e1;
    sm += __shfl_xor(sm, 1); sm += __shfl_xor(sm, 2); sm += __shfl_xor(sm, 4);
    const float inv = 1.0f / sm;
    const int o = head * 16 + r8;
    idsL[o] = ia0 * 128 + ib0; idsL[o + 8] = ia1 * 128 + ib1; gatesL[o] = e0 * inv; gatesL[o + 8] = e1 * inv;
}
typedef float f32x2 __attribute__((ext_vector_type(2)));
typedef int i32x8 __attribute__((ext_vector_type(8)));
#ifndef MFMA_U
#define MFMA_U 1
#endif
#define FP4_CVT(W, SEL) __builtin_amdgcn_cvt_scalef32_pk_f32_fp4((W), 1.0f, (SEL))
template <bool FINAL>
__device__ __forceinline__ void peer_gather(Frame& F, int layer, const bf16* HBin, float* Hout, bf16* HB, float* RP) {
    const int lane = F.lane, half = lane >> 5; const int gw = blockIdx.x * NWAVES + F.wave, NGW = F.G * NWAVES;
    const unsigned char* UT = F.ws + WS_TAB + (size_t)(2 * layer) * PEER_NEXP * 512; const unsigned char* VT = UT + (size_t)PEER_NEXP * 512;
    const float* USC = (const float*)(F.ws + WS_TSC) + (size_t)(2 * layer) * PEER_NEXP; const float* VSC = USC + PEER_NEXP;
    const float* gf = F.in[IN_NORM_FFN] + layer * DMODEL; const float* gfin = F.in[IN_NORM_FINAL];
    LAS unsigned short* rowL = (LAS unsigned short*)(F.lds + F.wave * 8192);
    LAS int* idsL = (LAS int*)(F.lds + 65536 + F.wave * 1024); LAS float* gatesL = (LAS float*)(F.lds + 65536 + F.wave * 1024 + 512);
    LAS float* actL = (LAS float*)(F.lds + 73728 + F.wave * 512);
    LAS unsigned char* xbL = (LAS unsigned char*)(F.lds + 143360 + F.wave * 1024);
    const bf16* SC = (const bf16*)(F.ws + WS_SC);
    LAS float* wfl = (LAS float*)(F.lds + 77824);
    if (!FINAL) { const f32x4* src = (const f32x4*)(F.ws + WS_WFLF);
#pragma unroll
        for (int i = 0; i < 8; ++i) { const int ch = F.tid + 512 * i, c = ch >> 8, jb = (ch >> 3) & 31, q = ch & 7; *(LAS f32x4*)(wfl + c * 1024 + jb * 32 + ((q ^ (jb & 7)) << 2)) = src[ch]; }
        __syncthreads(); }
    const unsigned rowA = (unsigned)(uintptr_t)F.lds + F.wave * 8192;
#define ROW_DMA(tt) do { const char* r_ = (const char*)(SC + (size_t)(tt) * 2048); _Pragma("unroll") for (int i_ = 0; i_ < 4; ++i_) glds16s(r_, (unsigned)(lane * 16 + i_ * 1024), (unsigned)__builtin_amdgcn_readfirstlane(rowA + i_ * 1024)); } while (0)
    gu32* tctr = F.ctl + 2048 + 64 * (8 * layer + ((int)blockIdx.x & 7)); const int tg = (int)blockIdx.x & 7;
    int kcur = 0;
    if (lane == 0) kcur = (int)__hip_atomic_fetch_add(tctr, 1u, __ATOMIC_RELAXED, __HIP_MEMORY_SCOPE_AGENT);
    kcur = __builtin_amdgcn_readfirstlane(kcur);
    if (kcur < T_TOK / 8) ROW_DMA(8 * kcur + tg);
    while (kcur < T_TOK / 8) {
        const int t = 8 * kcur + tg;
        int j32 = lane & 31; asm volatile("" : "+v"(j32));
        asm volatile("s_waitcnt vmcnt(0)" ::: "memory");
        const GAS v4u* hin = (const GAS v4u*)(HBin + (size_t)t * DMODEL) + 4 * j32;
        v4u hw[4];
#pragma unroll
        for (int q = 0; q < 4; ++q) hw[q] = hin[q];
        int knext = 0;
        if (lane == 0) knext = (int)__hip_atomic_fetch_add(tctr, 1u, __ATOMIC_RELAXED, __HIP_MEMORY_SCOPE_AGENT);
        p5_wave(lane, rowL, idsL, gatesL);
        asm volatile("s_waitcnt lgkmcnt(0)" ::: "memory");
        knext = __builtin_amdgcn_readfirstlane(knext);
        if (knext < T_TOK / 8) ROW_DMA(8 * knext + tg);
#if MFMA_U
        int l16 = lane & 15, lq = lane >> 4; asm volatile("" : "+v"(l16)); asm volatile("" : "+v"(lq));
        int one_e8 = 0x7f7f7f7f; asm volatile("" : "+v"(one_e8));
        v4u xb[8]; float xsc;
        { float ss = 0.f; f32x4 hv[8];
#pragma unroll
          for (int q = 0; q < 4; ++q) { const v4u w = hw[q]; hv[2 * q] = (f32x4){bflo(w.x), bfhi(w.x), bflo(w.y), bfhi(w.y)}; hv[2 * q + 1] = (f32x4){bflo(w.z), bfhi(w.z), bflo(w.w), bfhi(w.w)}; }
#pragma unroll
          for (int q = 0; q < 8; ++q) { ss += (hv[q][0] * hv[q][0] + hv[q][1] * hv[q][1]) + (hv[q][2] * hv[q][2] + hv[q][3] * hv[q][3]); }
          const float rstd = __builtin_amdgcn_rsqf(wave_sum(ss) * (0.5f / DMODEL) + EPS);
          const f32x4* g4 = (const f32x4*)gf + 8 * j32;
          float mx = 0.f;
#pragma unroll
          for (int q = 0; q < 8; ++q) { const f32x4 g = g4[q]; hv[q] = (f32x4){hv[q][0] * rstd * g[0], hv[q][1] * rstd * g[1], hv[q][2] * rstd * g[2], hv[q][3] * rstd * g[3]};
              mx = fmaxf(mx, fmaxf(fmaxf(fabsf(hv[q][0]), fabsf(hv[q][1])), fmaxf(fabsf(hv[q][2]), fabsf(hv[q][3])))); }
          mx = wave_max(mx);
          const float enc = (mx > 0.f) ? 6.0f * __builtin_amdgcn_rcpf(mx) : 1.0f; xsc = (mx > 0.f) ? mx * (1.0f / 6.0f) : 1.0f;
          unsigned xw[4];
#pragma unroll
          for (int q = 0; q < 4; ++q) { unsigned w = 0;
              w = __builtin_amdgcn_cvt_scalef32_pk_fp4_f32(w, hv[2 * q][0] * enc, hv[2 * q][1] * enc, 1.0f, 0); w = __builtin_amdgcn_cvt_scalef32_pk_fp4_f32(w, hv[2 * q][2] * enc, hv[2 * q][3] * enc, 1.0f, 1);
              w = __builtin_amdgcn_cvt_scalef32_pk_fp4_f32(w, hv[2 * q + 1][0] * enc, hv[2 * q + 1][1] * enc, 1.0f, 2); w = __builtin_amdgcn_cvt_scalef32_pk_fp4_f32(w, hv[2 * q + 1][2] * enc, hv[2 * q + 1][3] * enc, 1.0f, 3); xw[q] = w; }
          if (half == 0) *(LAS v4u*)(xbL + j32 * 16) = (v4u){xw[0], xw[1], xw[2], xw[3]};
          const LAS v4u* xbr = (const LAS v4u*)(xbL + lq * 16);
#pragma unroll
          for (int kb = 0; kb < 8; ++kb) xb[kb] = xbr[4 * kb]; }
        __builtin_amdgcn_sched_barrier(0);
#else
        typedef __bf16 bf16x2_t __attribute__((ext_vector_type(2)));
        bf16x2_t xv[16];
        { float ss = 0.f; f32x4 hv[8];
#pragma unroll
          for (int q = 0; q < 4; ++q) { const v4u w = hw[q]; hv[2 * q] = (f32x4){bflo(w.x), bfhi(w.x), bflo(w.y), bfhi(w.y)}; hv[2 * q + 1] = (f32x4){bflo(w.z), bfhi(w.z), bflo(w.w), bfhi(w.w)}; }
#pragma unroll
          for (int q = 0; q < 8; ++q) { ss += (hv[q][0] * hv[q][0] + hv[q][1] * hv[q][1]) + (hv[q][2] * hv[q][2] + hv[q][3] * hv[q][3]); }
          const float rstd = __builtin_amdgcn_rsqf(wave_sum(ss) * (0.5f / DMODEL) + EPS);
          const f32x4* g4 = (const f32x4*)gf + 8 * j32;
#pragma unroll
          for (int q = 0; q < 8; ++q) { const f32x4 g = g4[q]; xv[2 * q] = __builtin_bit_cast(bf16x2_t, cvtpk(hv[q][0] * rstd * g[0], hv[q][1] * rstd * g[1])); xv[2 * q + 1] = __builtin_bit_cast(bf16x2_t, cvtpk(hv[q][2] * rstd * g[2], hv[q][3] * rstd * g[3])); } }
#endif
        const int id0 = idsL[lane], id1 = idsL[64 + lane];
        const float gt0 = gatesL[lane], gt1 = gatesL[64 + lane];
        const float su0 = USC[id0], su1 = USC[id1], sv0 = VSC[id0], sv1 = VSC[id1];
#if MFMA_U
        for (int bt = 0; bt < 2; ++bt) {
            const float gtv = bt ? gt1 : gt0, suv = bt ? su1 : su0, svv = bt ? sv1 : sv0;
            v4u uw[4][8];
#pragma unroll
            for (int g = 0; g < 4; ++g) { const int e = idsL[64 * bt + 16 * g + l16]; const GAS v4u* rp = (const GAS v4u*)(UT + (size_t)e * 512) + lq;
#pragma unroll
                for (int kb = 0; kb < 8; ++kb) uw[g][kb] = rp[4 * kb]; }
            __builtin_amdgcn_sched_barrier(0);
            f32x4 ac[4];
#pragma unroll
            for (int g = 0; g < 4; ++g) { f32x4 a = (f32x4){0.f, 0.f, 0.f, 0.f};
#pragma unroll
                for (int kb = 0; kb < 8; ++kb) { const v4u w = uw[g][kb];
                    const v4u xk = xb[kb];
                    a = __builtin_amdgcn_mfma_scale_f32_16x16x128_f8f6f4((i32x8){(int)w.x, (int)w.y, (int)w.z, (int)w.w, 0, 0, 0, 0}, (i32x8){(int)xk.x, (int)xk.y, (int)xk.z, (int)xk.w, 0, 0, 0, 0}, a, 4, 4, 0, one_e8, 0, one_e8); }
                ac[g] = a; }
            const int gs = (lane >> 2) & 3, rr = lane & 3;
            const f32x4 sg = gs == 0 ? ac[0] : gs == 1 ? ac[1] : gs == 2 ? ac[2] : ac[3];
            const float r1 = rr == 0 ? sg[0] : rr == 1 ? sg[1] : rr == 2 ? sg[2] : sg[3];
            const int xb_ = 16 * gs + 4 * lq + rr;
            const float gte = __shfl(gtv, xb_), sue = __shfl(suv, xb_), sve = __shfl(svv, xb_);
            const float d = r1 * sue * xsc;
            const float act = 0.5f * d * (1.0f + erff(d * 0.70710678118654752f)) * gte * sve;
            actL[64 * bt + xb_] = act;
        }
#else
        for (int bt = 0; bt < 2; ++bt) {
            const int idv = bt ? id1 : id0; const float gtv = bt ? gt1 : gt0, suv = bt ? su1 : su0, svv = bt ? sv1 : sv0;
            v4u uw[32];
#pragma unroll
            for (int p = 0; p < 32; ++p) { const int ea = __builtin_amdgcn_readlane(idv, 2 * p), eb = __builtin_amdgcn_readlane(idv, 2 * p + 1); const int e = half ? eb : ea;
                uw[p] = ((const GAS v4u*)(UT + (size_t)e * 512))[j32]; }
            float pd[32];
#pragma unroll
            for (int p = 0; p < 32; ++p) { float sa = 0.f, sb = 0.f;
#pragma unroll
                for (int w = 0; w < 4; ++w) { const unsigned ww = uw[p][w];
                    sa = __builtin_amdgcn_fdot2_f32_bf16(__builtin_amdgcn_cvt_scalef32_pk_bf16_fp4(ww, 1.0f, 0), xv[4 * w], sa, false); sb = __builtin_amdgcn_fdot2_f32_bf16(__builtin_amdgcn_cvt_scalef32_pk_bf16_fp4(ww, 1.0f, 1), xv[4 * w + 1], sb, false);
                    sa = __builtin_amdgcn_fdot2_f32_bf16(__builtin_amdgcn_cvt_scalef32_pk_bf16_fp4(ww, 1.0f, 2), xv[4 * w + 2], sa, false); sb = __builtin_amdgcn_fdot2_f32_bf16(__builtin_amdgcn_cvt_scalef32_pk_bf16_fp4(ww, 1.0f, 3), xv[4 * w + 3], sb, false); }
                pd[p] = sa + sb; }
            float r16[16], r8[8], r4[4], r2[2], r1;
            { const bool up = (lane & 16) != 0;
#pragma unroll
              for (int p = 0; p < 16; ++p) { const float keep = up ? pd[p + 16] : pd[p], send = up ? pd[p] : pd[p + 16]; r16[p] = keep + __shfl_xor(send, 16); } }
            { const bool up = (lane & 8) != 0;
#pragma unroll
              for (int p = 0; p < 8; ++p) { const float keep = up ? r16[p + 8] : r16[p], send = up ? r16[p] : r16[p + 8]; r8[p] = keep + __shfl_xor(send, 8); } }
            { const bool up = (lane & 4) != 0;
#pragma unroll
              for (int p = 0; p < 4; ++p) { const float keep = up ? r8[p + 4] : r8[p], send = up ? r8[p] : r8[p + 4]; r4[p] = keep + __shfl_xor(send, 4); } }
            { const bool up = (lane & 2) != 0;
#pragma unroll
              for (int p = 0; p < 2; ++p) { const float keep = up ? r4[p + 2] : r4[p], send = up ? r4[p] : r4[p + 2]; r2[p] = keep + __shfl_xor(send, 2); } }
            { const bool up = (lane & 1) != 0; const float keep = up ? r2[1] : r2[0], send = up ? r2[0] : r2[1]; r1 = keep + __shfl_xor(send, 1); }
            const int xb = 2 * (16 * ((lane >> 4) & 1) + 8 * ((lane >> 3) & 1) + 4 * ((lane >> 2) & 1) + 2 * ((lane >> 1) & 1) + (lane & 1)) + half;
            const float gte = __shfl(gtv, xb), sue = __shfl(suv, xb), sve = __shfl(svv, xb);
            const float d = r1 * sue;
            const float act = 0.5f * d * (1.0f + erff(d * 0.70710678118654752f)) * gte * sve;
            actL[64 * bt + xb] = act;
        }
#endif
        v4u hw2[4];
#pragma unroll
        for (int q = 0; q < 4; ++q) hw2[q] = hin[q];
        f32x2 acc[16];
#pragma unroll
        for (int e = 0; e < 16; ++e) acc[e] = (f32x2){0.f, 0.f};
        for (int bt = 0; bt < 2; ++bt) {
            const int idv = bt ? id1 : id0;
            v4u vw[32];
#pragma unroll
            for (int p = 0; p < 32; ++p) { const int ea = __builtin_amdgcn_readlane(idv, 2 * p), eb = __builtin_amdgcn_readlane(idv, 2 * p + 1); const int e = half ? eb : ea;
                vw[p] = ((const GAS v4u*)(VT + (size_t)e * 512))[j32]; }
            const LAS float* ap = actL + 64 * bt + half;
#pragma unroll
            for (int p = 0; p < 32; ++p) { const float w1 = ap[2 * p]; const f32x2 w2 = (f32x2){w1, w1};
#pragma unroll
                for (int w = 0; w < 4; ++w) { const unsigned ww = vw[p][w];
                    acc[4 * w] += w2 * FP4_CVT(ww, 0); acc[4 * w + 1] += w2 * FP4_CVT(ww, 1); acc[4 * w + 2] += w2 * FP4_CVT(ww, 2); acc[4 * w + 3] += w2 * FP4_CVT(ww, 3); } }
        }
        float s2 = 0.f; f32x4 hn[8];
#pragma unroll
        for (int q = 0; q < 8; ++q) { const v4u w = hw2[q >> 1]; const f32x4 hv = (q & 1) ? (f32x4){bflo(w.z), bfhi(w.z), bflo(w.w), bfhi(w.w)} : (f32x4){bflo(w.x), bfhi(w.x), bflo(w.y), bfhi(w.y)};
            const float a0 = acc[2 * q].x + __shfl_xor(acc[2 * q].x, 32), a1 = acc[2 * q].y + __shfl_xor(acc[2 * q].y, 32), a2 = acc[2 * q + 1].x + __shfl_xor(acc[2 * q + 1].x, 32), a3 = acc[2 * q + 1].y + __shfl_xor(acc[2 * q + 1].y, 32);
            hn[q] = (f32x4){hv[0] + a0, hv[1] + a1, hv[2] + a2, hv[3] + a3};
            s2 += (hn[q][0] * hn[q][0] + hn[q][1] * hn[q][1]) + (hn[q][2] * hn[q][2] + hn[q][3] * hn[q][3]); }
        s2 = wave_sum(s2) * 0.5f;
        const float rs = __builtin_amdgcn_rsqf(s2 * (1.0f / DMODEL) + EPS);
        if (FINAL) {
            const f32x4* g4 = (const f32x4*)gfin + 8 * j32; f32x4* hrow = (f32x4*)(Hout + (size_t)t * DMODEL) + 8 * j32;
            if (half == 0) {
#pragma unroll
                for (int q = 0; q < 8; ++q) { const f32x4 g = g4[q]; hrow[q] = (f32x4){hn[q][0] * rs * g[0], hn[q][1] * rs * g[1], hn[q][2] * rs * g[2], hn[q][3] * rs * g[3]}; } }
        } else {
            if (half == 0) {
                GAS v4u* hbp = (GAS v4u*)(HB + (size_t)t * DMODEL) + 4 * j32;
#pragma unroll
                for (int q = 0; q < 4; ++q) hbp[q] = (v4u){pk2(hn[2 * q][0], hn[2 * q][1]), pk2(hn[2 * q][2], hn[2 * q][3]), pk2(hn[2 * q + 1][0], hn[2 * q + 1][1]), pk2(hn[2 * q + 1][2], hn[2 * q + 1][3])}; }
            if (lane < 16) RP[(size_t)t * 16 + lane] = (lane == 0) ? s2 : 0.f;
            float pf[16];
#pragma unroll
            for (int c = 0; c < 16; ++c) { float a = 0.f;
#pragma unroll
                for (int q = 0; q < 8; ++q) { const f32x4 wv = *(const LAS f32x4*)(wfl + c * 1024 + j32 * 32 + ((q ^ (j32 & 7)) << 2)); a += (hn[q][0] * wv[0] + hn[q][1] * wv[1]) + (hn[q][2] * wv[2] + hn[q][3] * wv[3]); }
                pf[c] = a; __builtin_amdgcn_sched_barrier(0); }
            float f8[8], f4[4], f2[2], f1;
            { const bool up = (lane & 16) != 0;
#pragma unroll
              for (int p = 0; p < 8; ++p) { const float keep = up ? pf[p + 8] : pf[p], send = up ? pf[p] : pf[p + 8]; f8[p] = keep + __shfl_xor(send, 16); } }
            { const bool up = (lane & 8) != 0;
#pragma unroll
              for (int p = 0; p < 4; ++p) { const float keep = up ? f8[p + 4] : f8[p], send = up ? f8[p] : f8[p + 4]; f4[p] = keep + __shfl_xor(send, 8); } }
            { const bool up = (lane & 4) != 0;
#pragma unroll
              for (int p = 0; p < 2; ++p) { const float keep = up ? f4[p + 2] : f4[p], send = up ? f4[p] : f4[p + 2]; f2[p] = keep + __shfl_xor(send, 4); } }
            { const bool up = (lane & 2) != 0; const float keep = up ? f2[1] : f2[0], send = up ? f2[0] : f2[1]; f1 = keep + __shfl_xor(send, 2); }
            f1 += __shfl_xor(f1, 1);
            if ((lane & 33) == 0) ((float*)(F.ws + WS_FL))[(size_t)t * 16 + 8 * ((lane >> 4) & 1) + 4 * ((lane >> 3) & 1) + 2 * ((lane >> 2) & 1) + ((lane >> 1) & 1)] = f1 * rs;
        }
        kcur = knext;
    }
}

#undef ROW_DMA
__device__ __forceinline__ void p7_forget_logits(Frame& F) {
    const int rows0 = F.vcu * 64;
    for (int r0 = rows0; r0 < T_TOK; r0 += F.G * 64) {
        const f32x4 a = skinny16((const bf16*)(F.ws + WS_HB) + (size_t)r0 * DMODEL, (const bf16*)(F.ws + WS_WFL), F.wave, F.lane, (LAS float*)F.lds);
        if (F.wave < 4) {
#pragma unroll
            for (int r = 0; r < 4; ++r) { const int row = r0 + 16 * F.wave + 4 * (F.lane >> 4) + r; const float rs = pg8::row_rstd((const float*)(F.ws + WS_RP), row);
                ((float*)(F.ws + WS_FL))[(size_t)row * 16 + (F.lane & 15)] = a[r] * rs; } }
        __syncthreads(); }
}
template <class Sched> __device__ __forceinline__ void rstd_table(Frame& F, const Sched& S, LAS float* tab, int& pm0, int& pm1) {
    pm0 = -1; pm1 = -1;
#pragma unroll
    for (int i = 0; i < 3; ++i) { pg8::Unit u; if (S.next(i, u)) { if (i == 0) pm0 = u.pm; if (i == 1) pm1 = u.pm;
        if (F.tid < 256) tab[i * 256 + F.tid] = pg8::row_rstd((const float*)(F.ws + WS_RP), u.pm * 256 + F.tid); } }
    __syncthreads();
}
__device__ __forceinline__ void p9_key_bias(Frame& F, int bh, LAS float* cbL, LAS float* scr  ) {
    const int b = bh >> 4, hd = bh & 15, tid = F.tid;
    const float* FL = (const float*)(F.ws + WS_FL) + (size_t)b * SEQ * 16 + hd; const float bf = F.in[IN_FOX_B_F][hd];
    float v[4];
#pragma unroll
    for (int e = 0; e < 4; ++e) v[e] = log_sigmoid(FL[(size_t)(4 * tid + e) * 16] + bf);
    v[1] += v[0]; v[2] += v[1]; v[3] += v[2];
    float inc = v[3];
#pragma unroll
    for (int o = 1; o < 64; o <<= 1) { const float y = __shfl_up(inc, o); if (F.lane >= o) inc += y; }
    if (F.lane == 63) scr[F.wave] = inc;
    __syncthreads();
    float woff = 0.f;
#pragma unroll
    for (int w = 0; w < 8; ++w) { const float sv = scr[w]; if (w < F.wave) woff += sv; }
    const float excl = woff + inc - v[3];
    *(LAS f32x4*)(cbL + 4 * tid) = (f32x4){-L2E * (excl + v[0]), -L2E * (excl + v[1]), -L2E * (excl + v[2]), -L2E * (excl + v[3])};
    __syncthreads();
}
__device__ __forceinline__ float u2f_(unsigned u) { return __builtin_bit_cast(float, u); }
#ifndef VCH
#define VCH 16
#endif
#ifndef REF_V
#define REF_V 0
#endif
#ifndef REF_U
#define REF_U 0
#endif
#ifndef NSLICE_LOG
#define NSLICE_LOG 2
#endif
template <bool FINAL, int STAGE>
__device__ __forceinline__ void peer_gather_sl(Frame& F, int layer, const bf16* HBin, float* Hout, bf16* HB, float* RP) {
    constexpr int NSL = 1 << NSLICE_LOG;
    const int lane = F.lane;
    const unsigned char* UT = F.ws + WS_TAB + (size_t)(2 * layer) * PEER_NEXP * 512; const unsigned char* VT = UT + (size_t)PEER_NEXP * 512;
    const float* USC = (const float*)(F.ws + WS_TSC) + (size_t)(2 * layer) * PEER_NEXP; const float* VSC = USC + PEER_NEXP;
    const float* gf = F.in[IN_NORM_FFN] + layer * DMODEL; const float* gfin = F.in[IN_NORM_FINAL];
    LAS unsigned short* rowL = (LAS unsigned short*)(F.lds + F.wave * 8192);
    LAS v2u* metaL = (LAS v2u*)(F.lds + F.wave * 8192 + 4096);
    LAS int* idsL = (LAS int*)(F.lds + 65536 + F.wave * 1024); LAS float* gatesL = (LAS float*)(F.lds + 65536 + F.wave * 1024 + 512);
    LAS unsigned char* xqL = (LAS unsigned char*)(F.lds + 73728 + F.wave * 2048);
    LAS unsigned char* accL = (LAS unsigned char*)(F.lds + 90112 + F.wave * 8192);
    const bf16* SC = (const bf16*)(F.ws + WS_SC);
    const unsigned rowA = (unsigned)(uintptr_t)F.lds + F.wave * 8192;
#define ROW_DMA(tt, ln_) do { const char* r_ = (const char*)(SC + (size_t)__builtin_amdgcn_readfirstlane(tt) * 2048); _Pragma("unroll") for (int i_ = 0; i_ < 4; ++i_) glds16s(r_, (unsigned)((ln_) * 16 + i_ * 1024), (unsigned)__builtin_amdgcn_readfirstlane(rowA + i_ * 1024)); } while (0)
    gu32* tctr = F.ctl + 2048 + 64 * ((STAGE == 1 ? 16 : 0) + 8 * layer + ((int)blockIdx.x & 7)); const int tg = (int)blockIdx.x & 7;
    v2u* const metaG = (v2u*)(F.ws + WS_IDS);
#define TOK_(kq_, i_) (2048 * tg + 4 * (kq_) + (i_))
    int kq = 0;
    if (lane == 0) kq = (int)__hip_atomic_fetch_add(tctr, 1u, __ATOMIC_RELAXED, __HIP_MEMORY_SCOPE_AGENT);
    kq = __builtin_amdgcn_readfirstlane(kq);
    if (STAGE != 1) { if (kq < T_TOK / 32) ROW_DMA(TOK_(kq, 0), lane); }
    while (kq < T_TOK / 32) {
        int kqn = 0;
        LAS unsigned* rstL = (LAS unsigned*)(F.lds + MISC_OFF + 256 + F.wave * 64);
        if (STAGE != 1) {
        { int l64 = lane; asm volatile("" : "+v"(l64));
          unsigned zz = 0u; asm volatile("" : "+v"(zz));
          v4u hw0[4], hw1[4];
#pragma unroll
          for (int i = 0; i < 4; ++i) { const GAS v4u* hin = (const GAS v4u*)(HBin + (size_t)(TOK_(kq, i)) * DMODEL) + 2 * l64; hw0[i] = hin[0]; hw1[i] = hin[1]; }
          const f32x4* g4 = (const f32x4*)gf + 4 * l64;
          f32x4 gq[4];
#pragma unroll
          for (int q = 0; q < 4; ++q) gq[q] = g4[q];
#pragma unroll
          for (int i = 0; i < 4; ++i) { float hv[16];
#pragma unroll
              for (int k = 0; k < 4; ++k) { hv[2 * k] = bflo(hw0[i][k]); hv[2 * k + 1] = bfhi(hw0[i][k]); hv[8 + 2 * k] = bflo(hw1[i][k]); hv[8 + 2 * k + 1] = bfhi(hw1[i][k]); }
              float ss = 0.f;
#pragma unroll
              for (int e = 0; e < 16; ++e) ss += hv[e] * hv[e];
              const float rstd = __builtin_amdgcn_rsqf(wave_sum(ss) * (1.0f / DMODEL) + EPS);
              float mx = 0.f;
#pragma unroll
              for (int q = 0; q < 4; ++q) {
#pragma unroll
                  for (int e = 0; e < 4; ++e) { hv[4 * q + e] = hv[4 * q + e] * rstd * gq[q][e]; mx = fmaxf(mx, fabsf(hv[4 * q + e])); } }
              mx = wave_max(mx);
              const float enc = (mx > 0.f) ? 6.0f * __builtin_amdgcn_rcpf(mx) : 1.0f; const float xsc = (mx > 0.f) ? mx * (1.0f / 6.0f) : 1.0f;
              unsigned w0 = 0, w1 = 0;
              w0 = __builtin_amdgcn_cvt_scalef32_pk_fp4_f32(w0, hv[0] * enc, hv[1] * enc, 1.0f, 0); w0 = __builtin_amdgcn_cvt_scalef32_pk_fp4_f32(w0, hv[2] * enc, hv[3] * enc, 1.0f, 1);
              w0 = __builtin_amdgcn_cvt_scalef32_pk_fp4_f32(w0, hv[4] * enc, hv[5] * enc, 1.0f, 2); w0 = __builtin_amdgcn_cvt_scalef32_pk_fp4_f32(w0, hv[6] * enc, hv[7] * enc, 1.0f, 3);
              w1 = __builtin_amdgcn_cvt_scalef32_pk_fp4_f32(w1, hv[8] * enc, hv[9] * enc, 1.0f, 0); w1 = __builtin_amdgcn_cvt_scalef32_pk_fp4_f32(w1, hv[10] * enc, hv[11] * enc, 1.0f, 1);
              w1 = __builtin_amdgcn_cvt_scalef32_pk_fp4_f32(w1, hv[12] * enc, hv[13] * enc, 1.0f, 2); w1 = __builtin_amdgcn_cvt_scalef32_pk_fp4_f32(w1, hv[14] * enc, hv[15] * enc, 1.0f, 3);
              *(LAS v2u*)(xqL + i * 512 + l64 * 8) = (v2u){w0, w1};
              if (l64 == 0) rstL[i] = __builtin_bit_cast(unsigned, xsc);
              { LAS v4u* st = (LAS v4u*)(accL + i * 2048 + l64 * 32); st[0] = (v4u){zz, zz, zz, zz}; st[1] = (v4u){zz, zz, zz, zz}; } } }
#pragma nounroll
        for (int i = 0; i < 4; ++i) {
            const int t = TOK_(kq, i);
            int ln = lane; asm volatile("" : "+v"(ln));
            asm volatile("s_waitcnt vmcnt(0)" ::: "memory");
            if (i == 3) { if (ln == 0) kqn = (int)__hip_atomic_fetch_add(tctr, 1u, __ATOMIC_RELAXED, __HIP_MEMORY_SCOPE_AGENT); }
            p5_wave(ln, rowL, idsL, gatesL);
            asm volatile("s_waitcnt lgkmcnt(0)" ::: "memory");
            if (i < 3) ROW_DMA(t + 1, ln);
            else { kqn = __builtin_amdgcn_readfirstlane(kqn); if (kqn < T_TOK / 32) ROW_DMA(TOK_(kqn, 0), ln); }
            const int id0 = idsL[ln], id1 = idsL[64 + ln];
            const float gt0 = gatesL[ln], gt1 = gatesL[64 + ln];
            const float su0 = USC[id0], su1 = USC[id1], sv0 = VSC[id0], sv1 = VSC[id1];
            { const int k0 = id0 >> (14 - NSLICE_LOG), k1 = id1 >> (14 - NSLICE_LOG);
              int pos0 = 0, pos1 = 0, base = 0; unsigned offp = 0;
#pragma unroll
              for (int s = 0; s < NSL; ++s) {
                  const unsigned long long m0 = __ballot(k0 == s), m1 = __ballot(k1 == s);
                  const int c0 = __popcll(m0), c1 = __popcll(m1);
                  const int r0 = (int)__builtin_amdgcn_mbcnt_hi((unsigned)(m0 >> 32), __builtin_amdgcn_mbcnt_lo((unsigned)m0, 0u));
                  const int r1 = (int)__builtin_amdgcn_mbcnt_hi((unsigned)(m1 >> 32), __builtin_amdgcn_mbcnt_lo((unsigned)m1, 0u));
                  if (k0 == s) pos0 = base + r0;
                  if (k1 == s) pos1 = base + c0 + r1;
                  base += c0 + c1;
                  if (s < NSL - 1) offp |= (unsigned)base << (8 * s); }
              if (ln == 0) rstL[4 + i] = offp;
              const unsigned sb0 = (__builtin_bit_cast(unsigned, su0) + 0x8000u) & 0xffff0000u, sb1 = (__builtin_bit_cast(unsigned, su1) + 0x8000u) & 0xffff0000u;
              metaL[i * 128 + pos0] = (v2u){sb0 | (unsigned)id0, __builtin_bit_cast(unsigned, gt0 * sv0)};
              metaL[i * 128 + pos1] = (v2u){sb1 | (unsigned)id1, __builtin_bit_cast(unsigned, gt1 * sv1)}; }
        }
#pragma nounroll
        for (int si = 0; si < 4 * NSL; ++si) {
            const int s = si >> 2, i = si & 3;
            int ln = lane; asm volatile("" : "+v"(ln)); const int l16 = ln & 15, lq = ln >> 4;
            int one_e8 = 0x7f7f7f7f; asm volatile("" : "+v"(one_e8));
            const unsigned o = (unsigned)__builtin_amdgcn_readfirstlane((int)rstL[4 + i]);
            const float xs = u2f_(__builtin_amdgcn_readfirstlane((int)rstL[i]));
            const int lo = s == 0 ? 0 : (int)((o >> (8 * (s - 1))) & 255u), hi = s == NSL - 1 ? 128 : (int)((o >> (8 * s)) & 255u);
            const int n = hi - lo;
            if (n <= 0) continue;
#if REF_U
            {
              const int t = TOK_(__builtin_amdgcn_readfirstlane(kq), i);
              const GAS v4u* hin = (const GAS v4u*)(HBin + (size_t)t * DMODEL) + 2 * ln;
              const v4u h0 = hin[0], h1 = hin[1]; float hv[16];
#pragma unroll
              for (int k = 0; k < 4; ++k) { hv[2 * k] = bflo(h0[k]); hv[2 * k + 1] = bfhi(h0[k]); hv[8 + 2 * k] = bflo(h1[k]); hv[8 + 2 * k + 1] = bfhi(h1[k]); }
              float ss = 0.f;
#pragma unroll
              for (int e = 0; e < 16; ++e) ss += hv[e] * hv[e];
              const float rstd = __builtin_amdgcn_rsqf(wave_sum(ss) * (1.0f / DMODEL) + EPS);
              const f32x4* g4 = (const f32x4*)gf + 4 * ln;
#pragma unroll
              for (int q = 0; q < 4; ++q) { const f32x4 g = g4[q];
#pragma unroll
                  for (int e = 0; e < 4; ++e) hv[4 * q + e] = hv[4 * q + e] * rstd * g[e]; }
              LAS v2u* mt = metaL + i * 128 + lo;
              for (int p = 0; p < n; ++p) { const v2u m = mt[p]; const unsigned e = m.x & 0xffffu;
                  const v2u uw = ((const GAS v2u*)(UT + (size_t)e * 512))[ln];
                  float ds = 0.f;
#pragma unroll
                  for (int w = 0; w < 2; ++w) { const unsigned ww = uw[w];
                      const f32x2 c0 = FP4_CVT(ww, 0), c1 = FP4_CVT(ww, 1), c2 = FP4_CVT(ww, 2), c3 = FP4_CVT(ww, 3);
                      ds += c0.x * hv[8 * w] + c0.y * hv[8 * w + 1] + c1.x * hv[8 * w + 2] + c1.y * hv[8 * w + 3] + c2.x * hv[8 * w + 4] + c2.y * hv[8 * w + 5] + c3.x * hv[8 * w + 6] + c3.y * hv[8 * w + 7]; }
                  ds = wave_sum(ds);
                  const float d = ds * u2f_(m.x & 0xffff0000u);
                  const float act = 0.5f * d * (1.0f + erff(d * 0.70710678118654752f)) * u2f_(m.y);
                  if (ln == 0) ((LAS unsigned*)(mt + p))[1] = __builtin_bit_cast(unsigned, act); } }
            (void)xs; (void)l16; (void)lq; (void)one_e8;
        }
#else
            v4u xb[8];
            { const LAS v4u* xbr = (const LAS v4u*)(xqL + i * 512) + lq;
#pragma unroll
              for (int kb = 0; kb < 8; ++kb) xb[kb] = xbr[4 * kb]; }
            LAS v2u* mt = metaL + i * 128 + lo;
            for (int g0 = 0; g0 < n; g0 += 64) {
                const int rem = n - g0;
                v4u uw[4][8];
#pragma unroll
                for (int g = 0; g < 4; ++g) if (16 * g < rem) { int p = g0 + 16 * g + l16; p = p < n ? p : n - 1; const unsigned e = mt[p].x & 0xffffu; const GAS v4u* rp = (const GAS v4u*)(UT + (size_t)e * 512) + lq;
#pragma unroll
                    for (int kb = 0; kb < 8; ++kb) uw[g][kb] = rp[4 * kb]; }
                __builtin_amdgcn_sched_barrier(0);
                f32x4 ac[4];
#pragma unroll
                for (int g = 0; g < 4; ++g) { f32x4 a = (f32x4){0.f, 0.f, 0.f, 0.f};
                    if (16 * g < rem) {
                        asm volatile("s_nop 4\n\t"
                            "v_mfma_scale_f32_16x16x128_f8f6f4 %0, %1, %9, %0, %17, %17 op_sel_hi:[0,0,0] cbsz:4 blgp:4\n\t"
                            "v_mfma_scale_f32_16x16x128_f8f6f4 %0, %2, %10, %0, %17, %17 op_sel_hi:[0,0,0] cbsz:4 blgp:4\n\t"
                            "v_mfma_scale_f32_16x16x128_f8f6f4 %0, %3, %11, %0, %17, %17 op_sel_hi:[0,0,0] cbsz:4 blgp:4\n\t"
                            "v_mfma_scale_f32_16x16x128_f8f6f4 %0, %4, %12, %0, %17, %17 op_sel_hi:[0,0,0] cbsz:4 blgp:4\n\t"
                            "v_mfma_scale_f32_16x16x128_f8f6f4 %0, %5, %13, %0, %17, %17 op_sel_hi:[0,0,0] cbsz:4 blgp:4\n\t"
                            "v_mfma_scale_f32_16x16x128_f8f6f4 %0, %6, %14, %0, %17, %17 op_sel_hi:[0,0,0] cbsz:4 blgp:4\n\t"
                            "v_mfma_scale_f32_16x16x128_f8f6f4 %0, %7, %15, %0, %17, %17 op_sel_hi:[0,0,0] cbsz:4 blgp:4\n\t"
                            "v_mfma_scale_f32_16x16x128_f8f6f4 %0, %8, %16, %0, %17, %17 op_sel_hi:[0,0,0] cbsz:4 blgp:4"
                            : "+v"(a)
                            : "v"(uw[g][0]), "v"(uw[g][1]), "v"(uw[g][2]), "v"(uw[g][3]), "v"(uw[g][4]), "v"(uw[g][5]), "v"(uw[g][6]), "v"(uw[g][7]),
                              "v"(xb[0]), "v"(xb[1]), "v"(xb[2]), "v"(xb[3]), "v"(xb[4]), "v"(xb[5]), "v"(xb[6]), "v"(xb[7]), "v"(one_e8)); }
                    ac[g] = a; }
                asm volatile("s_nop 15\n\ts_nop 7" : "+v"(ac[0]), "+v"(ac[1]), "+v"(ac[2]), "+v"(ac[3]));
                const int gs = (ln >> 2) & 3, rr = ln & 3;
                const f32x4 sg = gs == 0 ? ac[0] : gs == 1 ? ac[1] : gs == 2 ? ac[2] : ac[3];
                const float r1 = rr == 0 ? sg[0] : rr == 1 ? sg[1] : rr == 2 ? sg[2] : sg[3];
                const int pp = g0 + 16 * gs + 4 * lq + rr; const bool ok = pp < n; const int pc = ok ? pp : n - 1;
                const v2u m = mt[pc];
                const float d = r1 * u2f_(m.x & 0xffff0000u) * xs;
                const float act = 0.5f * d * (1.0f + erff(d * 0.70710678118654752f)) * u2f_(m.y);
                if (ok) ((LAS unsigned*)(mt + pc))[1] = __builtin_bit_cast(unsigned, act);
            }
        }
#endif
        }
        if (STAGE == 0) {
            int ln = lane; asm volatile("" : "+v"(ln));
            const int kqs = __builtin_amdgcn_readfirstlane(kq);
#pragma unroll
            for (int i = 0; i < 4; ++i) { const int t = TOK_(kqs, i); ((GAS v4u*)(metaG + (size_t)t * 128))[ln] = ((const LAS v4u*)(metaL + i * 128))[ln]; }
        }
        if (STAGE == 1) {
            int ln = lane; asm volatile("" : "+v"(ln));
            unsigned zz = 0u; asm volatile("" : "+v"(zz));
            if (ln == 0) kqn = (int)__hip_atomic_fetch_add(tctr, 1u, __ATOMIC_RELAXED, __HIP_MEMORY_SCOPE_AGENT);
            const int kqs = __builtin_amdgcn_readfirstlane(kq);
            v4u mb[4];
#pragma unroll
            for (int i = 0; i < 4; ++i) { const int t = TOK_(kqs, i); mb[i] = ((const GAS v4u*)(metaG + (size_t)t * 128))[ln]; }
#pragma unroll
            for (int i = 0; i < 4; ++i) { ((LAS v4u*)(metaL + i * 128))[ln] = mb[i]; LAS v4u* st = (LAS v4u*)(accL + i * 2048 + ln * 32); st[0] = (v4u){zz, zz, zz, zz}; st[1] = (v4u){zz, zz, zz, zz}; }
        }
        if (STAGE != 0) {
#pragma nounroll
        for (int si = 0; si < 4 * NSL; ++si) {
            const int s = si >> 2, i = si & 3;
            int l64 = lane; asm volatile("" : "+v"(l64));
            const unsigned o = (unsigned)__builtin_amdgcn_readfirstlane((int)rstL[4 + i]);
            const int lo = s == 0 ? 0 : (int)((o >> (8 * (s - 1))) & 255u), hi = s == NSL - 1 ? 128 : (int)((o >> (8 * s)) & 255u);
            const int n = hi - lo;
            if (n <= 0) continue;
            const LAS v2u* mt = metaL + i * 128 + lo;
            f32x2 acc[8];
#pragma unroll
            for (int e = 0; e < 8; ++e) acc[e] = (f32x2){0.f, 0.f};
#if REF_V
            for (int p = 0; p < n; ++p) { const v2u m = mt[p]; const unsigned e = m.x & 0xffffu; float w1 = u2f_(m.y); asm volatile("" : "+v"(w1)); const f32x2 w2 = (f32x2){w1, w1};
                const v2u vr = ((const GAS v2u*)(VT + (size_t)e * 512))[l64];
#pragma unroll
                for (int w = 0; w < 2; ++w) { const unsigned ww = vr[w];
                    acc[4 * w] += w2 * FP4_CVT(ww, 0); acc[4 * w + 1] += w2 * FP4_CVT(ww, 1); acc[4 * w + 2] += w2 * FP4_CVT(ww, 2); acc[4 * w + 3] += w2 * FP4_CVT(ww, 3); } }
#else
            for (int c0 = 0; c0 < n; c0 += VCH) {
                const int rem = n - c0;
                int pm = c0 + (l64 & (VCH - 1)); const bool okm = pm < n; pm = okm ? pm : n - 1; const v2u m = mt[pm];
                const int idv = (int)(m.x & 0xffffu); const int avb = okm ? (int)m.y : 0;
                v2u vw[VCH];
#pragma unroll
                for (int r = 0; r < VCH; ++r) if (r < rem) { const int e = __builtin_amdgcn_readlane(idv, r); vw[r] = ((const GAS v2u*)(VT + (size_t)e * 512))[l64]; }
#pragma unroll
                for (int r = 0; r < VCH; ++r) if (r < rem) { const float w1 = u2f_(__builtin_amdgcn_readlane(avb, r)); const f32x2 w2 = (f32x2){w1, w1};
#pragma unroll
                    for (int w = 0; w < 2; ++w) { const unsigned ww = vw[r][w];
                        acc[4 * w] += w2 * FP4_CVT(ww, 0); acc[4 * w + 1] += w2 * FP4_CVT(ww, 1); acc[4 * w + 2] += w2 * FP4_CVT(ww, 2); acc[4 * w + 3] += w2 * FP4_CVT(ww, 3); } }
            }
#endif
            LAS v4u* st = (LAS v4u*)(accL + i * 2048 + l64 * 32);
            const v4u s0 = st[0], s1 = st[1];
            st[0] = (v4u){cvtpk(bflo(s0.x) + acc[0].x, bfhi(s0.x) + acc[0].y), cvtpk(bflo(s0.y) + acc[1].x, bfhi(s0.y) + acc[1].y), cvtpk(bflo(s0.z) + acc[2].x, bfhi(s0.z) + acc[2].y), cvtpk(bflo(s0.w) + acc[3].x, bfhi(s0.w) + acc[3].y)};
            st[1] = (v4u){cvtpk(bflo(s1.x) + acc[4].x, bfhi(s1.x) + acc[4].y), cvtpk(bflo(s1.y) + acc[5].x, bfhi(s1.y) + acc[5].y), cvtpk(bflo(s1.z) + acc[6].x, bfhi(s1.z) + acc[6].y), cvtpk(bflo(s1.w) + acc[7].x, bfhi(s1.w) + acc[7].y)};
        }
        int kqe = __builtin_amdgcn_readfirstlane(kq); asm volatile("" : "+s"(kqe));
#pragma nounroll
        for (int i = 0; i < 4; ++i) {
            const int t = TOK_(kqe, i);
            int l64 = lane; asm volatile("" : "+v"(l64));
            const GAS v4u* hin = (const GAS v4u*)(HBin + (size_t)t * DMODEL) + 2 * l64;
            const v4u h0 = hin[0], h1 = hin[1];
            const LAS v4u* st = (const LAS v4u*)(accL + i * 2048 + l64 * 32);
            const v4u a0 = st[0], a1 = st[1];
            float hn[16]; float s2 = 0.f;
#pragma unroll
            for (int k = 0; k < 4; ++k) { hn[2 * k] = bflo(h0[k]) + bflo(a0[k]); hn[2 * k + 1] = bfhi(h0[k]) + bfhi(a0[k]); hn[8 + 2 * k] = bflo(h1[k]) + bflo(a1[k]); hn[8 + 2 * k + 1] = bfhi(h1[k]) + bfhi(a1[k]); }
#pragma unroll
            for (int e = 0; e < 16; ++e) s2 += hn[e] * hn[e];
            s2 = wave_sum(s2);
            if (FINAL) {
                const float rs = __builtin_amdgcn_rsqf(s2 * (1.0f / DMODEL) + EPS);
                const f32x4* g4 = (const f32x4*)gfin + 4 * l64; f32x4* hrow = (f32x4*)(Hout + (size_t)t * DMODEL) + 4 * l64;
#pragma unroll
                for (int q = 0; q < 4; ++q) { const f32x4 g = g4[q]; hrow[q] = (f32x4){hn[4 * q] * rs * g[0], hn[4 * q + 1] * rs * g[1], hn[4 * q + 2] * rs * g[2], hn[4 * q + 3] * rs * g[3]}; }
            } else {
                GAS v4u* hbp = (GAS v4u*)(HB + (size_t)t * DMODEL) + 2 * l64;
                hbp[0] = (v4u){cvtpk(hn[0], hn[1]), cvtpk(hn[2], hn[3]), cvtpk(hn[4], hn[5]), cvtpk(hn[6], hn[7])};
                hbp[1] = (v4u){cvtpk(hn[8], hn[9]), cvtpk(hn[10], hn[11]), cvtpk(hn[12], hn[13]), cvtpk(hn[14], hn[15])};
                if (l64 < 16) RP[(size_t)t * 16 + l64] = (l64 == 0) ? s2 : 0.f;
            }
        }
        }
        kq = __builtin_amdgcn_readfirstlane(kqn);
    }
}
#undef ROW_DMA
#undef TOK_
#ifndef TWO_STAGE
#define TWO_STAGE 1
#endif
constexpr int N_PHASES = 14;
#ifndef ATTN_THRL
#define ATTN_THRL 8
#endif
#ifndef PROBE_OTHERS
#define PROBE_OTHERS 1
#endif
#ifndef GROUP_BAR
#define GROUP_BAR 1
#endif
#ifndef MK_PER_PHASE
#define MK_PER_PHASE 0
#endif
struct Args { const float* in[18]; float* out; unsigned char* ws; int ph_lo, ph_hi, dry, li; };
__global__ void __launch_bounds__(NWAVES * 64, 2) yoco_fwd(Args args) {
    extern __shared__ __attribute__((aligned(16))) unsigned char lds[];
    Frame F;
    F.lds = (LAS unsigned char*)lds;
    F.MISC = (volatile LAS unsigned*)(F.lds + MISC_OFF);
    F.tid = threadIdx.x; F.lane = F.tid & 63; F.wave = __builtin_amdgcn_readfirstlane(F.tid >> 6);
    F.G = gridDim.x; { const int bx = blockIdx.x; F.vcu = (F.G % 8 == 0) ? (bx % 8) * (F.G / 8) + bx / 8 : bx; }
    F.ws = args.ws; F.ctl = (gu32*)(args.ws + WS_CTL); F.out = args.out;
#pragma unroll
    for (int i = 0; i < 18; ++i) F.in[i] = args.in[i];
    for (int u = F.tid; u < (LDS_BYTES - LDSCTL_OFF) / 4; u += NWAVES * 64) ((LAS unsigned*)(F.lds + LDSCTL_OFF))[u] = 0u;
    __syncthreads();
    XcdBarrier bar; bar.bar = (unsigned*)(F.ctl + CW_BAR) + args.li * XCD_BAR_WORDS; bar.x = 0; bar.st = nullptr;
    if (!MK_PER_PHASE) bar = xcd_barrier_post((unsigned*)(F.ctl + CW_BAR) + args.li * XCD_BAR_WORDS, F.MISC + 8);
    XcdBarrier gbar; gbar.bar = (unsigned*)(F.ctl + CW_GBAR) + ((int)blockIdx.x & 7) * 4096; gbar.x = 0; gbar.st = nullptr;
    if (!MK_PER_PHASE && GROUP_BAR) gbar = xcd_barrier_post((unsigned*)(F.ctl + CW_GBAR) + ((int)blockIdx.x & 7) * 4096, F.MISC + 10);
    const int lo = args.ph_lo, hi = args.ph_hi;
#define REID() do { int t_ = threadIdx.x; asm volatile("" : "+v"(t_)); F.tid = t_; F.lane = t_ & 63; F.wave = __builtin_amdgcn_readfirstlane(t_ >> 6); } while (0)
#ifndef PHASE_OFF
#define PHASE_OFF 0
#endif
#define IN(k) (lo <= (k) && (k) < hi && !((PHASE_OFF >> (k)) & 1))
#define SEAM(k) do { if (IN(k) && IN((k) + 1)) xcd_barrier(bar); } while (0)
#define SEAM2(k, k2) do { if (IN(k) && IN(k2)) xcd_barrier(bar); } while (0)
#define GSEAM(k) do { if (IN(k) && IN((k) + 1)) { if (GROUP_BAR && !MK_PER_PHASE) grp_barrier(gbar, gridDim.x / 8); else xcd_barrier(bar); } } while (0)
#define GSEAM2(k, k2) do { if (IN(k) && IN(k2)) { if (GROUP_BAR && !MK_PER_PHASE) grp_barrier(gbar, gridDim.x / 8); else xcd_barrier(bar); } } while (0)
#ifndef REPEAT_MASK
#define REPEAT_MASK 0
#endif
#define REP(k) ((REPEAT_MASK >> (k)) & 1)
#ifdef REP_WITH_BARRIER
#define REPBAR() xcd_barrier(bar)
#else
#define REPBAR() do {} while (0)
#endif
    float* const DUMF = (float*)(F.ws + WS_END); bf16* const DUMB = (bf16*)(F.ws + WS_END + 64 * MiB); float* const DUMR = (float*)(F.ws + WS_END + 96 * MiB);
    bf16* const A0 = (bf16*)(F.ws + WS_A0); bf16* const HB = (bf16*)(F.ws + WS_HB); bf16* const PQ = (bf16*)(F.ws + WS_PQ);
    float* const RP = (float*)(F.ws + WS_RP); float* const SC = (float*)(F.ws + WS_SC);

#ifndef NPASS
#define NPASS 1
#endif
    if (IN(0)) { REID(); if (REP(0)) { p0_prologue(F);  } p0_prologue(F); } SEAM(0);
    if (IN(1)) { REID(); if (REP(1)) { pg8::Gemm g{A0, (const bf16*)(F.ws + WS_WIN), T_TOK, 3072, DMODEL}; pg8::StaticOrder S; S.init(T_TOK, 3072, F.G, (int)blockIdx.x);
        pg8::EpiBf16RS E{PQ, 3072, 0, 0, 1.f, nullptr, -1, -1, F.in[IN_GLA_NORM_O], 2048};
        pg8::gemm_phase<pg8::EpiBf16RS, pg8::StaticOrder, true, true>(F.lds, g, S, E);  } if (REP(1)) REPBAR(); pg8::Gemm g{A0, (const bf16*)(F.ws + WS_WIN), T_TOK, 3072, DMODEL}; pg8::StaticOrder S; S.init(T_TOK, 3072, F.G, (int)blockIdx.x);
        pg8::EpiBf16RS E{PQ, 3072, 0, 0, 1.f, nullptr, -1, -1, F.in[IN_GLA_NORM_O], 2048};
        pg8::gemm_phase<pg8::EpiBf16RS, pg8::StaticOrder, true, true>(F.lds, g, S, E); } SEAM(1);
    if (IN(2)) { REID(); if (REP(2)) { for (int c = blockIdx.x; c < NB * GLA_NCH; c += F.G) p2a_item(F, c >> 5, c & 31);  } for (int c = blockIdx.x; c < NB * GLA_NCH; c += F.G) p2a_item(F, c >> 5, c & 31); } SEAM(2);
    if (IN(3)) { REID(); if (REP(3)) { if ((int)blockIdx.x < NB * GLA_H) p2b_seq(F, blockIdx.x, args.dry); else { late_weights(F, NB * GLA_H, F.G - NB * GLA_H); peer_tables_convert(F, NB * GLA_H * NWAVES, (F.G - NB * GLA_H) * NWAVES); }  } if ((int)blockIdx.x < NB * GLA_H) p2b_seq(F, blockIdx.x, args.dry); else { for (int rep_ = 0; rep_ < PROBE_OTHERS; ++rep_) { late_weights(F, NB * GLA_H, F.G - NB * GLA_H); peer_tables_convert(F, NB * GLA_H * NWAVES, (F.G - NB * GLA_H) * NWAVES); __syncthreads(); } } } SEAM(3);
    if (IN(4)) { REID(); if (REP(4)) { pg8::Gemm g{A0, (const bf16*)(F.ws + WS_WGO), T_TOK, DMODEL, DMODEL}; pg8::StaticOrder S; S.init(T_TOK, DMODEL, F.G, (int)blockIdx.x);
        pg8::EpiResid<false> E{F.in[IN_X], HB, RP, DMODEL};
        pg8::gemm_phase<pg8::EpiResid<false>, pg8::StaticOrder, false, true>(F.lds, g, S, E);  } pg8::Gemm g{A0, (const bf16*)(F.ws + WS_WGO), T_TOK, DMODEL, DMODEL}; pg8::StaticOrder S; S.init(T_TOK, DMODEL, F.G, (int)blockIdx.x);
        pg8::EpiResid<false> E{F.in[IN_X], HB, RP, DMODEL};
        pg8::gemm_phase<pg8::EpiResid<false>, pg8::StaticOrder, false, true>(F.lds, g, S, E); } GSEAM(4);
    if (IN(5)) { REID(); if (REP(5)) { pg8::Gemm g{HB, (const bf16*)(F.ws + WS_WEFF), T_TOK, 2048, DMODEL}; pg8::StaticOrder S; S.init(T_TOK, 2048, F.G, (int)blockIdx.x);
        int pm0, pm1; rstd_table(F, S, (LAS float*)(F.lds + 131072), pm0, pm1); pg8::EpiBf16RS E{(bf16*)SC, 2048, 0, 0, 1.f, (const LAS float*)(F.lds + 131072), pm0, pm1, nullptr, 0};
        pg8::gemm_phase<pg8::EpiBf16RS, pg8::StaticOrder, true, true>(F.lds, g, S, E);  } pg8::Gemm g{HB, (const bf16*)(F.ws + WS_WEFF), T_TOK, 2048, DMODEL}; pg8::StaticOrder S; S.init(T_TOK, 2048, F.G, (int)blockIdx.x);
        int pm0, pm1; rstd_table(F, S, (LAS float*)(F.lds + 131072), pm0, pm1); pg8::EpiBf16RS E{(bf16*)SC, 2048, 0, 0, 1.f, (const LAS float*)(F.lds + 131072), pm0, pm1, nullptr, 0};
        pg8::gemm_phase<pg8::EpiBf16RS, pg8::StaticOrder, true, true>(F.lds, g, S, E); } GSEAM2(5, 7);
    if (IN(7)) { REID(); if (TWO_STAGE) { peer_gather_sl<false, 0>(F, 0, HB, nullptr, HB, RP); xcd_barrier(bar); REID(); peer_gather_sl<false, 1>(F, 0, HB, nullptr, HB, RP); } else peer_gather_sl<false, 2>(F, 0, HB, nullptr, HB, RP); } GSEAM(7);
    if (IN(8)) { REID(); if (REP(8)) {
        pg8::Gemm g{HB, (const bf16*)(F.ws + WS_WQKV), T_TOK, 3072, DMODEL}; pg8::StaticOrder S; S.init(T_TOK, 3072, F.G, (int)blockIdx.x);
        int pm0, pm1; rstd_table(F, S, (LAS float*)(F.lds + 131072), pm0, pm1); pg8::EpiBf16RS E{PQ, DMODEL, DMODEL, (size_t)T_TOK * DMODEL, attn_body::C2, (const LAS float*)(F.lds + 131072), pm0, pm1, nullptr, 0};
        pg8::gemm_phase<pg8::EpiBf16RS, pg8::StaticOrder, true, true>(F.lds, g, S, E);  } if (REP(8)) REPBAR();
        p7_forget_logits(F);
        pg8::Gemm g{HB, (const bf16*)(F.ws + WS_WQKV), T_TOK, 3072, DMODEL}; pg8::StaticOrder S; S.init(T_TOK, 3072, F.G, (int)blockIdx.x);
        int pm0, pm1; rstd_table(F, S, (LAS float*)(F.lds + 131072), pm0, pm1); pg8::EpiBf16RS E{PQ, DMODEL, DMODEL, (size_t)T_TOK * DMODEL, attn_body::C2, (const LAS float*)(F.lds + 131072), pm0, pm1, nullptr, 0};
        pg8::gemm_phase<pg8::EpiBf16RS, pg8::StaticOrder, true, true>(F.lds, g, S, E); } GSEAM(8);
    if (IN(9)) { REID(); for (int rep = REP(9) ? 0 : 1; rep < 2; ++rep) {
        p9_key_bias(F, F.vcu >> 1, (LAS float*)(F.lds + attn_body::LDS_CB), (LAS float*)(F.lds + attn_body::LDS_TOTAL));
        const attn_body::AttnTensors AT{(const attn_body::bf16*)PQ, (const attn_body::bf16*)(PQ + (size_t)T_TOK * DMODEL), (const attn_body::bf16*)(PQ + 2 * (size_t)T_TOK * DMODEL), (attn_body::bf16*)((rep == 0 || args.dry) ? DUMB : PQ)};
        const attn_body::StaticOrder S((int)F.G, (int)blockIdx.x);
        attn_body::attn_phase<attn_body::StaticOrder, ATTN_THRL>((char*)lds, AT, S); } } GSEAM(9);
    if (IN(10)) { REID(); if (REP(10)) { pg8::Gemm g{PQ, (const bf16*)(F.ws + WS_WFO), T_TOK, DMODEL, DMODEL}; pg8::StaticOrder S; S.init(T_TOK, DMODEL, F.G, (int)blockIdx.x);
        pg8::EpiResid<false> E{DUMF, DUMB, DUMR, DMODEL};
        pg8::gemm_phase<pg8::EpiResid<false>, pg8::StaticOrder, false, true>(F.lds, g, S, E);  } pg8::Gemm g{PQ, (const bf16*)(F.ws + WS_WFO), T_TOK, DMODEL, DMODEL}; pg8::StaticOrder S; S.init(T_TOK, DMODEL, F.G, (int)blockIdx.x);
        pg8::EpiResid<true> E{nullptr, HB, RP, DMODEL};
        pg8::gemm_phase<pg8::EpiResid<true>, pg8::StaticOrder, false, true>(F.lds, g, S, E); } GSEAM(10);
    if (IN(11)) { REID(); if (REP(11)) { pg8::Gemm g{HB, (const bf16*)(F.ws + WS_WEFF) + (size_t)2048 * DMODEL, T_TOK, 2048, DMODEL}; pg8::StaticOrder S; S.init(T_TOK, 2048, F.G, (int)blockIdx.x);
        int pm0, pm1; rstd_table(F, S, (LAS float*)(F.lds + 131072), pm0, pm1); pg8::EpiBf16RS E{(bf16*)SC, 2048, 0, 0, 1.f, (const LAS float*)(F.lds + 131072), pm0, pm1, nullptr, 0};
        pg8::gemm_phase<pg8::EpiBf16RS, pg8::StaticOrder, true, true>(F.lds, g, S, E);  } pg8::Gemm g{HB, (const bf16*)(F.ws + WS_WEFF) + (size_t)2048 * DMODEL, T_TOK, 2048, DMODEL}; pg8::StaticOrder S; S.init(T_TOK, 2048, F.G, (int)blockIdx.x);
        int pm0, pm1; rstd_table(F, S, (LAS float*)(F.lds + 131072), pm0, pm1); pg8::EpiBf16RS E{(bf16*)SC, 2048, 0, 0, 1.f, (const LAS float*)(F.lds + 131072), pm0, pm1, nullptr, 0};
        pg8::gemm_phase<pg8::EpiBf16RS, pg8::StaticOrder, true, true>(F.lds, g, S, E); } GSEAM2(11, 13);
    if (IN(13)) { REID(); if (TWO_STAGE) { peer_gather_sl<true, 0>(F, 1, HB, F.out, nullptr, nullptr); xcd_barrier(bar); REID(); peer_gather_sl<true, 1>(F, 1, HB, F.out, nullptr, nullptr); } else peer_gather_sl<true, 2>(F, 1, HB, F.out, nullptr, nullptr); }
#undef IN
#undef SEAM
}

extern "C" void kernel_launch(void* const* d_in, const int* in_sizes, int n_in, void* d_out, int out_size, void* d_ws, size_t ws_size, hipStream_t stream) {
    static int grid = 0;
    if (grid == 0) {
        if (n_in != 18 || in_sizes[0] != T_TOK * DMODEL || out_size != T_TOK * DMODEL || ws_size < WS_END + ((REPEAT_MASK || MK_PER_PHASE) ? 97 * MiB : 0)) { fprintf(stderr, "kernel_launch: unexpected shapes (n_in %d, in0 %d, out %d, ws %zu); nothing launched\n", n_in, n_in > 0 ? in_sizes[0] : -1, out_size, ws_size); grid = -1; return; }
        int dev = 0, cus = 0;
        if (hipGetDevice(&dev) != hipSuccess || hipDeviceGetAttribute(&cus, hipDeviceAttributeMultiprocessorCount, dev) != hipSuccess) { grid = -1; return; }
        if (hipFuncSetAttribute((const void*)yoco_fwd, hipFuncAttributeMaxDynamicSharedMemorySize, LDS_BYTES) != hipSuccess) { fprintf(stderr, "kernel_launch: hipFuncSetAttribute failed\n"); grid = -1; return; }
        (void)hipGetLastError();
        grid = cus;
        if (grid != 256) { fprintf(stderr, "kernel_launch: built for a 256-CU device, found %d; nothing launched\n", cus); grid = -1; return; }
    }
    if (grid < 0) return;
    if (hipMemsetAsync((char*)d_ws + WS_CTL, 0, CTL_ZERO_BYTES, stream) != hipSuccess) return;
    Args a{};
    for (int i = 0; i < 18; ++i) a.in[i] = (const float*)d_in[i];
    a.out = (float*)d_out; a.ws = (unsigned char*)d_ws;
#if MK_PER_PHASE
    for (int p = 0; p < N_PHASES; ++p) { a.ph_lo = p; a.ph_hi = p + 1;
#ifdef DUP_PHASE
        if (p == DUP_PHASE) hipLaunchKernelGGL(yoco_fwd, dim3(grid), dim3(NWAVES * 64), LDS_BYTES, stream, a);
#endif
#ifdef DRY_PHASE
        if (p == DRY_PHASE) { a.dry = 1; hipLaunchKernelGGL(yoco_fwd, dim3(grid), dim3(NWAVES * 64), LDS_BYTES, stream, a); a.dry = 0; }
#endif
        hipLaunchKernelGGL(yoco_fwd, dim3(grid), dim3(NWAVES * 64), LDS_BYTES, stream, a); }
#else
    a.ph_lo = 0; a.ph_hi = N_PHASES;
    for (int li = 0; li < NPASS; ++li) { a.li = li; hipLaunchKernelGGL(yoco_fwd, dim3(grid), dim3(NWAVES * 64), LDS_BYTES, stream, a); }
#endif
}
```

```cpp
#define NSLICE_LOG 0
#define TWO_STAGE 0
#include <hip/hip_runtime.h>
#include <cstdio>
#include <cstdint>
namespace pg8 {
#define PG8_LAS __attribute__((address_space(3)))
typedef unsigned short bf16_t;
typedef short bf16x8 __attribute__((ext_vector_type(8)));
typedef float f32x4 __attribute__((ext_vector_type(4)));
typedef unsigned u32x4 __attribute__((ext_vector_type(4)));
constexpr int BM = 256, BK = 64, HALF = 128, HTB = HALF * BK * 2  , STAGE_BYTES = 8 * HTB, NXCD = 8, WGM = 8;

__host__ __device__ __forceinline__ int lds_byte(int r, int c) { const int st = (r >> 4) * 2 + (c >> 5), rr = r & 15, cc = c & 31, ob = rr * 64 + cc * 2; return st * 1024 + (ob ^ (((ob >> 9) & 1) << 5)); }
__host__ __device__ __forceinline__ void stage_rc(int b, int& R, int& C) { const int st = b / 1024, sb = b % 1024, swz = sb ^ (((sb >> 9) & 1) << 5); R = (st >> 1) * 16 + swz / 64; C = (st & 1) * 32 + (swz % 64) / 2; }
__host__ __device__ __forceinline__ int perm32(int rho) { const int n = rho >> 4, i = rho & 15; return 8 * (i >> 2) + 4 * n + (i & 3); }

struct Unit { int pm, pn; };
struct Gemm { const bf16_t* A; const bf16_t* Bt; int M, N, K; };

struct StaticOrder {
    int nM, nN, nwg, G, c;
    __host__ __device__ void init(int M, int N, int G_, int c_) { nM = M / BM; nN = N / BM; nwg = nM * nN; G = G_; c = c_; }
    __host__ __device__ bool next(int i, Unit& u) const {
        const long L = (long)i * G + c; if (L >= nwg) return false;
        int wgid = (int)L; { const int q = nwg / NXCD, r = nwg % NXCD, xcd = wgid % NXCD, off = wgid / NXCD; wgid = (xcd < r ? xcd * (q + 1) : r * (q + 1) + (xcd - r) * q) + off; }
        const int nig = WGM * nN, gid = wgid / nig, fm = gid * WGM, gsz = (nM - fm) < WGM ? (nM - fm) : WGM;
        u.pm = fm + ((wgid % nig) % gsz); u.pn = (wgid % nig) / gsz; return true;
    }
    __device__ __forceinline__ void a_ready(const Unit&) const {}
    __device__ __forceinline__ void done(const Unit&) const {}
};

__device__ __forceinline__ unsigned cvt_pk_bf16(float lo, float hi) { unsigned r; asm volatile("v_cvt_pk_bf16_f32 %0, %1, %2" : "=v"(r) : "v"(lo), "v"(hi)); return r; }
typedef unsigned u32x2 __attribute__((ext_vector_type(2)));
constexpr float RMS_EPS = 1e-6f;
__device__ __forceinline__ float row_rstd(const float* rowpart, int row) {
    const f32x4* p = (const f32x4*)(rowpart + (size_t)row * 16);
    const f32x4 a = p[0], b = p[1], c = p[2], d = p[3];
    const float s = (((a[0] + a[1]) + (a[2] + a[3])) + ((b[0] + b[1]) + (b[2] + b[3]))) + (((c[0] + c[1]) + (c[2] + c[3])) + ((d[0] + d[1]) + (d[2] + d[3])));
    return 1.0f / sqrtf(s * (1.0f / 1024.0f) + RMS_EPS);
}
struct EpiBf16RS {
    static constexpr bool PERM = true, AFTER_DRAIN = false;
    bf16_t* O; int ldc; int split_cols; size_t split_stride; float scale0; const PG8_LAS float* rs_tab; int pm0, pm1;
    const float* gate_w; int gate_col0;
    __device__ __forceinline__ void operator()(const f32x4 (&acc)[2][2][4][2], const Unit& u, int wr, int wc, int fr, int fq) const {
        const int row0 = u.pm * BM + wr * 64 + fr; int colt = u.pn * BM; bf16_t* base = O;
        float sc = 1.f; if (split_cols) { const int t = colt / split_cols; base += (size_t)t * split_stride; colt -= t * split_cols; if (t == 0) sc = scale0; }
        const int col0 = colt + wc * 32 + 8 * fq;
#pragma unroll
        for (int ai = 0; ai < 2; ++ai)
#pragma unroll
            for (int m = 0; m < 4; ++m) { const int row = row0 + ai * HALF + m * 16; const float rs = rs_tab ? sc * rs_tab[((u.pm == pm0) ? 0 : (u.pm == pm1) ? 256 : 512) + (row & 255)] : sc;
                bf16_t* rowp = base + (size_t)row * ldc + col0;
#pragma unroll
                for (int bj = 0; bj < 2; ++bj) { f32x4 v0 = acc[ai][bj][m][0] * rs, v1 = acc[ai][bj][m][1] * rs;
                    if (gate_w && colt >= gate_col0) { const f32x4 g0 = *(const f32x4*)(gate_w + col0 - gate_col0 + bj * HALF), g1 = *(const f32x4*)(gate_w + col0 - gate_col0 + bj * HALF + 4);
#pragma unroll
                        for (int e_ = 0; e_ < 4; ++e_) { v0[e_] = v0[e_] * __builtin_amdgcn_rcpf(1.0f + __expf(-v0[e_])) * g0[e_]; v1[e_] = v1[e_] * __builtin_amdgcn_rcpf(1.0f + __expf(-v1[e_])) * g1[e_]; } }
                    u32x4 w; w.x = cvt_pk_bf16(v0[0], v0[1]); w.y = cvt_pk_bf16(v0[2], v0[3]); w.z = cvt_pk_bf16(v1[0], v1[1]); w.w = cvt_pk_bf16(v1[2], v1[3]);
                    *(u32x4*)(rowp + bj * HALF) = w; } }
    }
};
struct EpiF32RS {
    static constexpr bool PERM = false, AFTER_DRAIN = false;
    float* C; int ldc; const PG8_LAS float* rs_tab; int pm0, pm1;
    __device__ __forceinline__ void operator()(const f32x4 (&acc)[2][2][4][2], const Unit& u, int wr, int wc, int fr, int fq) const {
        const int row0 = u.pm * BM + wr * 64 + fr, col0 = u.pn * BM + wc * 32 + 4 * fq;
#pragma unroll
        for (int ai = 0; ai < 2; ++ai)
#pragma unroll
            for (int m = 0; m < 4; ++m) { const int row = row0 + ai * HALF + m * 16; const float rs = rs_tab[((u.pm == pm0) ? 0 : (u.pm == pm1) ? 256 : 512) + (row & 255)];
                float* rowp = C + (size_t)row * ldc + col0;
#pragma unroll
                for (int bj = 0; bj < 2; ++bj)
#pragma unroll
                    for (int n = 0; n < 2; ++n) *(f32x4*)(rowp + bj * HALF + n * 16) = acc[ai][bj][m][n] * rs; }
    }
};
template <bool BASE_BF16> struct EpiResid {
    static constexpr bool PERM = false, AFTER_DRAIN = false;
    const float* base; bf16_t* hb; float* rowpart; int ldc;
    __device__ __forceinline__ void operator()(const f32x4 (&acc)[2][2][4][2], const Unit& u, int wr, int wc, int fr, int fq) const {
        const int row0 = u.pm * BM + wr * 64 + fr, col0 = u.pn * BM + wc * 32 + 4 * fq;
#pragma unroll
        for (int ai = 0; ai < 2; ++ai) {
            f32x4 bv[4][2][2];
#pragma unroll
            for (int m = 0; m < 4; ++m) { const size_t off = (size_t)(row0 + ai * HALF + m * 16) * ldc + col0;
#pragma unroll
                for (int bj = 0; bj < 2; ++bj)
#pragma unroll
                    for (int n = 0; n < 2; ++n) {
                        if (BASE_BF16) { const u32x2 bw = *(const u32x2*)(hb + off + bj * HALF + n * 16); bv[m][bj][n] = (f32x4){__builtin_bit_cast(float, bw.x << 16), __builtin_bit_cast(float, bw.x & 0xffff0000u), __builtin_bit_cast(float, bw.y << 16), __builtin_bit_cast(float, bw.y & 0xffff0000u)}; }
                        else bv[m][bj][n] = *(const f32x4*)(base + off + bj * HALF + n * 16); } }
            asm volatile("" ::: "memory");
#pragma unroll
            for (int m = 0; m < 4; ++m) { const int row = row0 + ai * HALF + m * 16; const size_t off = (size_t)row * ldc + col0; float ss = 0.f;
#pragma unroll
                for (int bj = 0; bj < 2; ++bj)
#pragma unroll
                    for (int n = 0; n < 2; ++n) { const f32x4 v = bv[m][bj][n] + acc[ai][bj][m][n];
                        ss += (v[0] * v[0] + v[1] * v[1]) + (v[2] * v[2] + v[3] * v[3]);
                        u32x2 w; w.x = cvt_pk_bf16(v[0], v[1]); w.y = cvt_pk_bf16(v[2], v[3]); *(u32x2*)(hb + off + bj * HALF + n * 16) = w; }
                ss += __shfl_xor(ss, 16); ss += __shfl_xor(ss, 32);
                if (fq == 0) rowpart[(size_t)row * 16 + u.pn * 4 + wc] = ss; } }
    }
};

template <class Epi, class Sched, bool ALIGN_EPI = false, bool SP2 = false>
__device__ __forceinline__ void gemm_phase(PG8_LAS unsigned char* lds, const Gemm g, const Sched& S, const Epi& E) {
    const int tid = threadIdx.x, wid = __builtin_amdgcn_readfirstlane(tid >> 6), lane = tid & 63, wr = wid >> 2, wc = wid & 3, fr = lane & 15, fq = lane >> 4;
    const int K = g.K, nt = K / BK;
    unsigned voffA[2], voffB[2];
#pragma unroll
    for (int i = 0; i < 2; ++i) { int R, C; stage_rc(tid * 16 + i * 8192, R, C); const int Rb = Epi::PERM ? ((R & ~31) + perm32(R & 31)) : R;
        voffA[i] = (unsigned)(R * K + C) * 2u; voffB[i] = (unsigned)(Rb * K + C) * 2u; }
    const size_t kstep = (size_t)(BK * 2);
    const size_t hstep = (size_t)HALF * K * 2;
    const size_t tstep = 2 * hstep;
    const unsigned ldsw = (unsigned)wid * 1024u;
    const int aoff = lds_byte(wr * 64 + fr, fq * 8), boff = lds_byte(wc * 32 + fr, fq * 8);
#define PG8_SA(b, h) (((b) * 2 + (h)) * HTB)
#define PG8_SB(b, h) ((4 + (b) * 2 + (h)) * HTB)
#define PG8_STAGE(bufoff, gbase, voff) do { _Pragma("unroll") for (int _i = 0; _i < 2; ++_i) \
        __builtin_amdgcn_global_load_lds((const unsigned*)((const char*)(gbase) + (voff)[_i]), (PG8_LAS unsigned*)(lds + (bufoff) + ldsw + _i * 8192), 16, 0, 0); } while (0)
#define PG8_LDA(dst, b, h) do { _Pragma("unroll") for (int m = 0; m < 4; ++m) _Pragma("unroll") for (int k = 0; k < 2; ++k) dst[m][k] = *(const PG8_LAS bf16x8*)(lds + PG8_SA(b, h) + aoff + m * 2048 + k * 1024); } while (0)
#define PG8_LDB(dst, b, h) do { _Pragma("unroll") for (int n = 0; n < 2; ++n) _Pragma("unroll") for (int k = 0; k < 2; ++k) dst[n][k] = *(const PG8_LAS bf16x8*)(lds + PG8_SB(b, h) + boff + n * 2048 + k * 1024); } while (0)
#define PG8_MMA(ai, bj, At, Bt) do { __builtin_amdgcn_s_setprio(1); _Pragma("unroll") for (int m = 0; m < 4; ++m) _Pragma("unroll") for (int n = 0; n < 2; ++n) _Pragma("unroll") for (int k = 0; k < 2; ++k) \
        acc[ai][bj][m][n] = __builtin_amdgcn_mfma_f32_16x16x32_bf16(Bt[n][k], At[m][k], acc[ai][bj][m][n], 0, 0, 0); __builtin_amdgcn_s_setprio(0); } while (0)
#define PG8_WAIT_V(n) asm volatile("s_waitcnt vmcnt(" #n ")" ::: "memory")
#define PG8_WAIT_L(n) asm volatile("s_waitcnt lgkmcnt(" #n ")" ::: "memory")
#define PG8_BAR __builtin_amdgcn_s_barrier()
#define PG8_SCHED __builtin_amdgcn_sched_barrier(0)
    Unit cur, nxt; int ui = 0;
    if (!S.next(0, cur)) return;
    f32x4 acc[2][2][4][2];
#pragma unroll
    for (int a = 0; a < 2; ++a)
#pragma unroll
        for (int b = 0; b < 2; ++b)
#pragma unroll
            for (int m = 0; m < 4; ++m)
#pragma unroll
                for (int n = 0; n < 2; ++n) acc[a][b][m][n] = (f32x4){0.f, 0.f, 0.f, 0.f};
    bf16x8 At[4][2], B0[2][2], B1[2][2];
    const char* cA = (const char*)g.A + (size_t)cur.pm * tstep; const char* cB = (const char*)g.Bt + (size_t)cur.pn * tstep;
    S.a_ready(cur);
    if constexpr (SP2) {
        PG8_STAGE(PG8_SB(0, 0), cB, voffB); PG8_STAGE(PG8_SB(0, 1), cB + hstep, voffB); PG8_STAGE(PG8_SA(0, 0), cA, voffA); PG8_STAGE(PG8_SA(0, 1), cA + hstep, voffA);
        if (wr == 1) PG8_BAR;
        PG8_WAIT_V(2); PG8_BAR;
        PG8_STAGE(PG8_SB(1, 0), cB + kstep, voffB); PG8_STAGE(PG8_SA(1, 0), cA + kstep, voffA); PG8_STAGE(PG8_SB(1, 1), cB + hstep + kstep, voffB);
        PG8_WAIT_V(6); PG8_BAR;
    } else {
        PG8_STAGE(PG8_SB(0, 0), cB, voffB); PG8_STAGE(PG8_SA(0, 0), cA, voffA); PG8_STAGE(PG8_SB(0, 1), cB + hstep, voffB); PG8_STAGE(PG8_SA(0, 1), cA + hstep, voffA);
        if (wr == 1) PG8_BAR;
        PG8_WAIT_V(4); PG8_BAR;
        PG8_STAGE(PG8_SB(1, 0), cB + kstep, voffB); PG8_STAGE(PG8_SA(1, 0), cA + kstep, voffA); PG8_STAGE(PG8_SB(1, 1), cB + hstep + kstep, voffB);
        PG8_WAIT_V(6); PG8_BAR;
    }
    for (;;) {
        const bool has_next = S.next(ui + 1, nxt);
        const char* nA = has_next ? (const char*)g.A + (size_t)nxt.pm * tstep : cA; const char* nB = has_next ? (const char*)g.Bt + (size_t)nxt.pn * tstep : cB;
        for (int t = 0; t < nt; t += 2) {
            const bool last = (t == nt - 2);
            const char* a1 = cA + (size_t)(t + 1) * kstep;
            const char* a2 = last ? nA : cA + (size_t)(t + 2) * kstep; const char* b2 = last ? nB : cB + (size_t)(t + 2) * kstep;
            const char* a3 = a2 + kstep; const char* b3 = b2 + kstep;
            if (last && has_next) S.a_ready(nxt);
            if constexpr (SP2) {
            PG8_LDB(B0, 0, 0); PG8_LDB(B1, 0, 1); PG8_SCHED; PG8_LDA(At, 0, 0); PG8_STAGE(PG8_SA(1, 1), a1 + hstep, voffA);
            PG8_WAIT_V(8); PG8_WAIT_L(0); PG8_BAR; PG8_MMA(0, 0, At, B0); PG8_MMA(0, 1, At, B1); PG8_BAR; PG8_SCHED;
            PG8_LDA(At, 0, 1); PG8_STAGE(PG8_SB(0, 0), b2, voffB); PG8_STAGE(PG8_SB(0, 1), b2 + hstep, voffB); PG8_STAGE(PG8_SA(0, 0), a2, voffA);
            PG8_WAIT_V(8); PG8_WAIT_L(0); PG8_BAR; PG8_MMA(1, 0, At, B0); PG8_MMA(1, 1, At, B1); PG8_BAR; PG8_SCHED;
            PG8_LDB(B0, 1, 0); PG8_LDB(B1, 1, 1); PG8_SCHED; PG8_LDA(At, 1, 0); PG8_STAGE(PG8_SA(0, 1), a2 + hstep, voffA);
            PG8_WAIT_V(8); PG8_WAIT_L(0); PG8_BAR; PG8_MMA(0, 0, At, B0); PG8_MMA(0, 1, At, B1); PG8_BAR; PG8_SCHED;
            PG8_LDA(At, 1, 1); PG8_STAGE(PG8_SB(1, 0), b3, voffB); PG8_STAGE(PG8_SB(1, 1), b3 + hstep, voffB); PG8_STAGE(PG8_SA(1, 0), a3, voffA);
            PG8_WAIT_V(8); PG8_WAIT_L(0); PG8_BAR; PG8_MMA(1, 0, At, B0); PG8_MMA(1, 1, At, B1); PG8_BAR; PG8_SCHED;
            } else {
            PG8_LDB(B0, 0, 0); PG8_SCHED; PG8_LDA(At, 0, 0); PG8_STAGE(PG8_SA(1, 1), a1 + hstep, voffA);
            PG8_WAIT_L(8); PG8_BAR; PG8_WAIT_L(0); PG8_MMA(0, 0, At, B0); PG8_BAR; PG8_SCHED;
            PG8_LDB(B1, 0, 1); PG8_STAGE(PG8_SB(0, 0), b2, voffB);
            PG8_BAR; PG8_WAIT_L(0); PG8_MMA(0, 1, At, B1); PG8_BAR;
            PG8_LDA(At, 0, 1); PG8_STAGE(PG8_SA(0, 0), a2, voffA);
            PG8_BAR; PG8_WAIT_L(0); PG8_MMA(1, 0, At, B0); PG8_BAR; PG8_SCHED;
            PG8_STAGE(PG8_SB(0, 1), b2 + hstep, voffB);
            PG8_WAIT_V(6); PG8_BAR; PG8_MMA(1, 1, At, B1); PG8_BAR;
            PG8_LDB(B0, 1, 0); PG8_SCHED; PG8_LDA(At, 1, 0); PG8_STAGE(PG8_SA(0, 1), a2 + hstep, voffA);
            PG8_WAIT_L(8); PG8_BAR; PG8_WAIT_L(0); PG8_MMA(0, 0, At, B0); PG8_BAR; PG8_SCHED;
            PG8_LDB(B1, 1, 1); PG8_STAGE(PG8_SB(1, 0), b3, voffB);
            PG8_BAR; PG8_WAIT_L(0); PG8_MMA(0, 1, At, B1); PG8_BAR;
            PG8_LDA(At, 1, 1); PG8_STAGE(PG8_SA(1, 0), a3, voffA);
            PG8_BAR; PG8_WAIT_L(0); PG8_MMA(1, 0, At, B0); PG8_BAR; PG8_SCHED;
            PG8_STAGE(PG8_SB(1, 1), b3 + hstep, voffB);
            PG8_WAIT_V(6); PG8_BAR; PG8_MMA(1, 1, At, B1); PG8_BAR;
            }
        }
        if constexpr (ALIGN_EPI) { if (wr == 0) PG8_BAR; }
        if constexpr (!Epi::AFTER_DRAIN) { E(acc, cur, wr, wc, fr, fq); S.done(cur); }
        if (!has_next) break;
#pragma unroll
        for (int a = 0; a < 2; ++a)
#pragma unroll
            for (int b = 0; b < 2; ++b)
#pragma unroll
                for (int m = 0; m < 4; ++m)
#pragma unroll
                    for (int n = 0; n < 2; ++n) acc[a][b][m][n] = (f32x4){0.f, 0.f, 0.f, 0.f};
        cur = nxt; cA = nA; cB = nB; ++ui;
        if constexpr (ALIGN_EPI) { if (wr == 1) PG8_BAR; }
    }
    PG8_WAIT_V(0);
    if constexpr (!ALIGN_EPI) { if (wr == 0) PG8_BAR; }
    PG8_BAR;
    if constexpr (Epi::AFTER_DRAIN) { E.fused(acc, cur, wr, wc, fr, fq, lds, wid, lane); S.done(cur); }
#undef PG8_SA
#undef PG8_SB
#undef PG8_STAGE
#undef PG8_LDA
#undef PG8_LDB
#undef PG8_MMA
#undef PG8_WAIT_V
#undef PG8_WAIT_L
#undef PG8_BAR
#undef PG8_SCHED
}
}
#include <hip/hip_bf16.h>
#include <cmath>
namespace attn_body {
using bf16=__hip_bfloat16;
using bf16x8=__attribute__((ext_vector_type(8)))short;
using s16x4=__attribute__((ext_vector_type(4)))short;
using f32x16=__attribute__((ext_vector_type(16)))float;
using u32x4=__attribute__((ext_vector_type(4)))unsigned;
constexpr int BATCH=8,NHEAD=16,SEQ=2048,D=64,DM=NHEAD*D;
constexpr int NW=8,QBLK=32,QB=QBLK*NW,KVBLK=64,NQB=SEQ/QB;
constexpr int ATTN_PITCH=DM, ATTN_UNIT_ROWS=QB;
__device__ __forceinline__ int crow(int r,int hi){return (r&3)+8*(r>>2)+4*hi;}
#define SBAR() __builtin_amdgcn_sched_barrier(0)
__device__ __forceinline__ void cmask(f32x16&p0,f32x16&p1,int jb,int qrel,int hi){
  const float NEG=-INFINITY; int kb=64*jb+4*hi;
  #pragma unroll
  for(int r=0;r<16;++r){int kv=kb+(r&3)+8*(r>>2); if(kv>qrel)p0[r]=NEG; if(kv+32>qrel)p1[r]=NEG;}
}

constexpr int NSLOT=3, SLOTB=8192;
constexpr int LDS_K=0, LDS_V=NSLOT*SLOTB, LDS_WS=2*NSLOT*SLOTB, LDS_OST=LDS_WS+NW*64*4, LDS_BYTES=LDS_OST+NW*4096, LDS_CB=LDS_BYTES, LDS_TOTAL=LDS_CB+SEQ*4;
constexpr float C2=0.125f*1.4426950408889634f;
__device__ __forceinline__ void glds16(const void*gsrc,unsigned lds_dst){unsigned keep;
  asm volatile("s_mov_b32 %0, m0\n\ts_mov_b32 m0, %2\n\ts_nop 0\n\tglobal_load_lds_dwordx4 %1, off\n\ts_mov_b32 m0, %0":"=&s"(keep):"v"(gsrc),"s"(lds_dst):"memory");}
__device__ __forceinline__ float max3f(float a,float b,float c){float r;asm("v_max3_f32 %0, %1, %2, %3":"=v"(r):"v"(a),"v"(b),"v"(c));return r;}
__device__ __forceinline__ float max2f(float a,float b){float r;asm("v_max_f32_e32 %0, %1, %2":"=v"(r):"v"(a),"v"(b));return r;}
__device__ __forceinline__ float fadd_s(float a,float b){float r;asm("v_add_f32_e32 %0, %1, %2":"=v"(r):"v"(a),"v"(b));return r;}
__device__ __forceinline__ float fsub_s(float a,float b){float r;asm("v_sub_f32_e32 %0, %1, %2":"=v"(r):"v"(a),"v"(b));return r;}
typedef float f32x2_t __attribute__((ext_vector_type(2))); typedef __bf16 bf16x2_t __attribute__((ext_vector_type(2)));
__device__ __forceinline__ unsigned cvtpk_s(float lo,float hi){f32x2_t v={lo,hi};bf16x2_t b=__builtin_convertvector(v,bf16x2_t);return __builtin_bit_cast(unsigned,b);}
#define WAIT_BAR(N) asm volatile("s_waitcnt vmcnt(" #N ") lgkmcnt(0)\n\ts_barrier":::"memory")

__device__ __forceinline__ void qkt(f32x16&p0,f32x16&p1,const char*Kslot,const bf16x8*qr,const f32x16&negm,int r32,int hi){
  const char*kb=Kslot+hi*1024+r32*16;
  #pragma unroll
  for(int d0=0;d0<4;++d0){
    const bf16x8 b0=*reinterpret_cast<const bf16x8*>(kb+d0*2048);
    const bf16x8 b1=*reinterpret_cast<const bf16x8*>(kb+d0*2048+512);
    if(d0==0){p0=__builtin_amdgcn_mfma_f32_32x32x16_bf16(b0,qr[0],negm,0,0,0);p1=__builtin_amdgcn_mfma_f32_32x32x16_bf16(b1,qr[0],negm,0,0,0);}
    else{p0=__builtin_amdgcn_mfma_f32_32x32x16_bf16(b0,qr[d0],p0,0,0,0);p1=__builtin_amdgcn_mfma_f32_32x32x16_bf16(b1,qr[d0],p1,0,0,0);}}
}
typedef __attribute__((address_space(3))) const char* lds_cptr;
typedef short v4i16_t __attribute__((ext_vector_type(4)));
__device__ __forceinline__ void kload8(bf16x8*kf,lds_cptr kp){
  kf[0]=*(const __attribute__((address_space(3))) bf16x8*)(kp);      kf[1]=*(const __attribute__((address_space(3))) bf16x8*)(kp+512);
  kf[2]=*(const __attribute__((address_space(3))) bf16x8*)(kp+2048); kf[3]=*(const __attribute__((address_space(3))) bf16x8*)(kp+2560);
  kf[4]=*(const __attribute__((address_space(3))) bf16x8*)(kp+4096); kf[5]=*(const __attribute__((address_space(3))) bf16x8*)(kp+4608);
  kf[6]=*(const __attribute__((address_space(3))) bf16x8*)(kp+6144); kf[7]=*(const __attribute__((address_space(3))) bf16x8*)(kp+6656);
}
__device__ __forceinline__ void kload2(bf16x8*kf,lds_cptr kp,int j){ kf[2*j]=*(const __attribute__((address_space(3))) bf16x8*)(kp+j*2048); kf[2*j+1]=*(const __attribute__((address_space(3))) bf16x8*)(kp+j*2048+512); }
__device__ __forceinline__ s16x4 vtr(lds_cptr p){ return __builtin_bit_cast(s16x4,__builtin_amdgcn_ds_read_tr16_b64_v4i16((__attribute__((address_space(3))) v4i16_t*)p)); }
__device__ __forceinline__ float rowmax(const f32x16&p0,const f32x16&p1){
  float a=max3f(p0[0],p0[1],p1[0]),b=max3f(p0[2],p0[3],p1[1]);a=max3f(a,p1[2],p1[3]);
  #pragma unroll
  for(int r=4;r<16;r+=4){a=max3f(a,p0[r],p0[r+1]);b=max3f(b,p0[r+2],p0[r+3]);a=max3f(a,p1[r],p1[r+1]);b=max3f(b,p1[r+2],p1[r+3]);}
  const float m=max2f(a,b);
  auto rr=__builtin_amdgcn_permlane32_swap(__float_as_uint(m),__float_as_uint(m),false,false);
  return max2f(__uint_as_float(rr[0]),__uint_as_float(rr[1]));
}
__device__ __forceinline__ void pv(f32x16*o,int vb,bf16x8 pa0,bf16x8 pa1,bf16x8 pa2,bf16x8 pa3){
  #pragma unroll
  for(int d0=0;d0<2;++d0){s16x4 lo[4],hi[4];
    #pragma unroll
    for(int ks=0;ks<4;++ks){
      asm volatile("ds_read_b64_tr_b16 %0,%1 offset:%c2":"=&v"(lo[ks]):"v"(vb),"i"(d0*4096+ks*1024):"memory");
      asm volatile("ds_read_b64_tr_b16 %0,%1 offset:%c2":"=&v"(hi[ks]):"v"(vb),"i"(d0*4096+ks*1024+512):"memory");}
    asm volatile("s_waitcnt lgkmcnt(0)":::"memory");SBAR();
    #define PK(k) (bf16x8){lo[k][0],lo[k][1],lo[k][2],lo[k][3],hi[k][0],hi[k][1],hi[k][2],hi[k][3]}
    o[d0]=__builtin_amdgcn_mfma_f32_32x32x16_bf16(pa0,PK(0),o[d0],0,0,0);
    o[d0]=__builtin_amdgcn_mfma_f32_32x32x16_bf16(pa1,PK(1),o[d0],0,0,0);
    o[d0]=__builtin_amdgcn_mfma_f32_32x32x16_bf16(pa2,PK(2),o[d0],0,0,0);
    o[d0]=__builtin_amdgcn_mfma_f32_32x32x16_bf16(pa3,PK(3),o[d0],0,0,0);
    #undef PK
  }
}

#ifndef ATTN_STORE16
#define ATTN_STORE16(p,v) (*(u32x4*)(p)=(v))
#endif
typedef float f32x4v __attribute__((ext_vector_type(4)));
template<int THRL> __device__ __forceinline__ void attn_unit(int b,int h,int qb,const bf16*Q,const bf16*__restrict__ K,const bf16*__restrict__ V,bf16*O,char*shm){
  const int tid=threadIdx.x,lane=tid&63,r32=lane&31,hi=lane>>5; const int wid=__builtin_amdgcn_readfirstlane(tid>>6);
  const long rowbase=(long)b*SEQ; const int q0=qb*QB;
  const bf16*Qw=Q+(rowbase+q0+wid*QBLK)*DM+h*D;
  const bf16*Kh=K+rowbase*DM+h*D,*Vh=V+rowbase*DM+h*D;
  const unsigned lds0=(unsigned)(uintptr_t)shm;
  float*wsf=(float*)(shm+LDS_WS)+wid*64;
  const bf16*ksrc=Kh+(long)lane*DM+wid*8;
  const bf16*vsrc=Vh+(long)(16*(wid&3)+(lane>>2))*DM+(wid>>2)*32+(lane&3)*8;
  const unsigned kdst=lds0+LDS_K+wid*1024, vdst=lds0+LDS_V+wid*1024;
  #define DMA_K(t,slot) glds16(ksrc+(long)(t)*KVBLK*DM,(unsigned)__builtin_amdgcn_readfirstlane(kdst+(slot)))
  #define DMA_V(t,slot) glds16(vsrc+(long)(t)*KVBLK*DM,(unsigned)__builtin_amdgcn_readfirstlane(vdst+(slot)))
  const int vb0=(int)(lds0+LDS_V)+((lane>>4)&1)*32+(lane&3)*8+(4*hi+((lane&15)>>2))*64;
  const char*Kbase=shm+LDS_K; bf16x8 kf[8];
  const lds_cptr shm3=(lds_cptr)shm; const lds_cptr kp0=shm3+LDS_K+hi*1024+r32*16; const lds_cptr vp0=shm3+LDS_V+((lane>>4)&1)*32+(lane&3)*8+(4*hi+((lane&15)>>2))*64;
  const int NT=(q0+QB)/KVBLK;
  DMA_K(0,0);DMA_V(0,0);DMA_K(1,SLOTB);
  bf16x8 qr[4];
  #pragma unroll
  for(int d0=0;d0<4;++d0)qr[d0]=*reinterpret_cast<const bf16x8*>(&Qw[(long)r32*DM+d0*16+hi*8]);
  float mhat=0.f,l_reg=0.f;f32x16 o[2];o[0]=f32x16{};o[1]=f32x16{};float z0_=0.f;asm volatile("":"+v"(z0_));f32x16 negm;_Pragma("unroll") for(int r=0;r<16;++r)negm[r]=z0_;asm volatile("":"+v"(negm));
  const int qrel=wid*QBLK+r32;
  #define CMASK(P0,P1,t) do{int jb_=(t)-(NT-4); if(jb_>=0)cmask(P0,P1,jb_,qrel,hi);}while(0)
  #define BIAS(P0,P1,t) do{ const __attribute__((address_space(3))) f32x4v* cbt_=(const __attribute__((address_space(3))) f32x4v*)(shm3+LDS_CB+(64*(t)+4*hi)*4); \
    _Pragma("unroll") for(int g_=0;g_<4;++g_){ const f32x4v b0_=cbt_[2*g_], b1_=cbt_[8+2*g_]; \
      P0[4*g_]+=b0_[0];P0[4*g_+1]+=b0_[1];P0[4*g_+2]+=b0_[2];P0[4*g_+3]+=b0_[3]; P1[4*g_]+=b1_[0];P1[4*g_+1]+=b1_[1];P1[4*g_+2]+=b1_[2];P1[4*g_+3]+=b1_[3]; } }while(0)
  bool resc=false;
  #define START(P0,P1) do{ const float rm=rowmax(P0,P1); resc=false; \
    { const float dl=rm; mhat=fadd_s(mhat,dl); \
      _Pragma("unroll") for(int r=0;r<16;++r){P0[r]=fsub_s(P0[r],dl);P1[r]=fsub_s(P1[r],dl);} \
      _Pragma("unroll") for(int r=0;r<16;++r)negm[r]=-mhat; asm volatile("":"+v"(negm)); } \
    _Pragma("unroll") for(int r=0;r<16;++r)P0[r]=__builtin_amdgcn_exp2f(P0[r]); }while(0)
  #define RESC() do{ if(resc){ asm volatile("s_waitcnt lgkmcnt(0)":::"memory"); \
      _Pragma("unroll") for(int d_=0;d_<2;++d_) _Pragma("unroll") for(int r=0;r<16;++r)o[d_][r]*=wsf[crow(r,hi)]; } }while(0)
  f32x16 pA0,pA1,pB0,pB1;
  int sl_prev=0,sl_cur=0,sl_next=SLOTB;
  #define ROT() do{sl_prev=sl_cur;sl_cur=sl_next;sl_next=(sl_next==(NSLOT-1)*SLOTB)?0:sl_next+SLOTB;}while(0)
  DMA_K(2,2*SLOTB);
  WAIT_BAR(3);
  qkt(pA0,pA1,Kbase,qr,negm,r32,hi);asm volatile("s_nop 15\n\ts_nop 7":"+v"(pA0),"+v"(pA1));BIAS(pA0,pA1,0);CMASK(pA0,pA1,0);
  START(pA0,pA1);
  _Pragma("unroll") for(int r=0;r<16;++r)pA1[r]=__builtin_amdgcn_exp2f(pA1[r]);
  WAIT_BAR(0);
  DMA_K(3,0);DMA_V(1,SLOTB);
  ROT();
  kload8(kf,kp0+sl_cur);
  WAIT_BAR(2);
  s16x4 vlo[8],vhi[8]; u32x4 pw0,pw1,pw2,pw3;
  #define PKW(P,B) cvtpk_s(P[B],P[B+1])
  #define PAF(k) __builtin_bit_cast(bf16x8,pw##k)
  #define VFR(i) (bf16x8){vlo[i][0],vlo[i][1],vlo[i][2],vlo[i][3],vhi[i][0],vhi[i][1],vhi[i][2],vhi[i][3]}
  #define PIN(x) asm volatile("":"+v"(x))
  #define MX3(a,b,c) __builtin_fmaxf(__builtin_fmaxf((a),(b)),(c))
  #define GAPA(MF,A0,A1,A2,A3,W0,W1,PW) do{ MF; sacc+=A0; sacc+=A1; sacc+=A2; sacc+=A3; PIN(sacc); W0; W1; PIN(PW); SBAR(); }while(0)
  #define EX(v) __builtin_amdgcn_exp2f(v)
  #define GAPB(MF,X,B) do{ MF; X[B]=EX(X[B]); X[B+1]=EX(X[B+1]); X[B+2]=EX(X[B+2]); X[B+3]=EX(X[B+3]); PIN(X); SBAR(); }while(0)
  #define VRD(i) do{ vlo[i]=vtr(vp_+(((i)>>2)*4096+((i)&3)*1024)); vhi[i]=vtr(vp_+(((i)>>2)*4096+((i)&3)*1024+512)); }while(0)
  #define KRD(G,j) do{ if(G){ kload2(kf,kp0+sl_next,j); SBAR(); } }while(0)
  #define STEP(C0,C1,P0,P1,t,GK,GV,GL) do{ SBAR(); \
    const lds_cptr vp_=vp0+sl_prev; \
    VRD(0); SBAR(); float sacc=(P0[0]+P0[1]); \
    GAPA(C0=__builtin_amdgcn_mfma_f32_32x32x16_bf16(kf[0],qr[0],negm,0,0,0), P0[2],P0[3],P0[4],P0[5],     pw0[0]=PKW(P0,0), pw0[1]=PKW(P0,2), pw0); \
    VRD(4); SBAR(); GAPA(C1=__builtin_amdgcn_mfma_f32_32x32x16_bf16(kf[1],qr[0],negm,0,0,0), P0[6],P0[7],P0[8],P0[9],     pw0[2]=PKW(P0,4), pw0[3]=PKW(P0,6), pw0); \
    VRD(1); SBAR(); GAPA(C0=__builtin_amdgcn_mfma_f32_32x32x16_bf16(kf[2],qr[1],C0,0,0,0),   P0[10],P0[11],P0[12],P0[13], pw1[0]=PKW(P0,8), pw1[1]=PKW(P0,10), pw1); \
    VRD(5); SBAR(); GAPA(C1=__builtin_amdgcn_mfma_f32_32x32x16_bf16(kf[3],qr[1],C1,0,0,0),   P0[14],P0[15],P1[0],P1[1],   pw1[2]=PKW(P0,12),pw1[3]=PKW(P0,14), pw1); \
    VRD(2); SBAR(); GAPA(C0=__builtin_amdgcn_mfma_f32_32x32x16_bf16(kf[4],qr[2],C0,0,0,0),   P1[2],P1[3],P1[4],P1[5],     pw2[0]=PKW(P1,0), pw2[1]=PKW(P1,2), pw2); \
    VRD(6); SBAR(); GAPA(C1=__builtin_amdgcn_mfma_f32_32x32x16_bf16(kf[5],qr[2],C1,0,0,0),   P1[6],P1[7],P1[8],P1[9],     pw2[2]=PKW(P1,4), pw2[3]=PKW(P1,6), pw2); \
    VRD(3); SBAR(); GAPA(C0=__builtin_amdgcn_mfma_f32_32x32x16_bf16(kf[6],qr[3],C0,0,0,0),   P1[10],P1[11],P1[12],P1[13], pw3[0]=PKW(P1,8), pw3[1]=PKW(P1,10), pw3); \
    VRD(7); SBAR(); GAPA(C1=__builtin_amdgcn_mfma_f32_32x32x16_bf16(kf[7],qr[3],C1,0,0,0),   P1[14],P1[15],0.f,0.f,       pw3[2]=PKW(P1,12),pw3[3]=PKW(P1,14), pw3); \
    l_reg+=sacc; \
    if(GK){DMA_K((t)+3,sl_cur);} if(GV){DMA_V((t)+1,sl_next);} \
    { const __attribute__((address_space(3))) f32x4v* cbt_=(const __attribute__((address_space(3))) f32x4v*)(shm3+LDS_CB+(64*(t)+4*hi)*4); \
      _Pragma("unroll") for(int g_=0;g_<4;++g_){ const f32x4v b0_=cbt_[2*g_]; C0[4*g_]+=b0_[0];C0[4*g_+1]+=b0_[1];C0[4*g_+2]+=b0_[2];C0[4*g_+3]+=b0_[3]; SBAR(); \
        const f32x4v b1_=cbt_[8+2*g_]; C1[4*g_]+=b1_[0];C1[4*g_+1]+=b1_[1];C1[4*g_+2]+=b1_[2];C1[4*g_+3]+=b1_[3]; SBAR(); } } \
    CMASK(C0,C1,t); \
    { float a=MX3(C0[0],C0[1],C1[0]),b=MX3(C0[2],C0[3],C1[1]); a=MX3(a,C1[2],C1[3]); \
      _Pragma("unroll") for(int r=4;r<16;r+=4){a=MX3(a,C0[r],C0[r+1]);b=MX3(b,C0[r+2],C0[r+3]);a=MX3(a,C1[r],C1[r+1]);b=MX3(b,C1[r+2],C1[r+3]);} \
      float rm=__builtin_fmaxf(a,b); { auto rr=__builtin_amdgcn_permlane32_swap(__float_as_uint(rm),__float_as_uint(rm),false,false); rm=__builtin_fmaxf(__uint_as_float(rr[0]),__uint_as_float(rr[1])); } \
      resc=false; \
      if(__builtin_expect(__any(rm>(float)THRL),0)){ const float dl=__builtin_fmaxf(rm,0.f); mhat+=dl; \
        _Pragma("unroll") for(int r=0;r<16;++r){C0[r]-=dl;C1[r]-=dl;} \
        _Pragma("unroll") for(int r=0;r<16;++r)negm[r]=-mhat; asm volatile("":"+v"(negm)); \
        const float f=__builtin_amdgcn_exp2f(-dl); l_reg*=f; if(hi==0)wsf[r32]=f; resc=true; } } \
    SBAR(); \
    GAPB(o[0]=__builtin_amdgcn_mfma_f32_32x32x16_bf16(PAF(0),VFR(0),o[0],0,0,0), C0,0); \
    GAPB(o[1]=__builtin_amdgcn_mfma_f32_32x32x16_bf16(PAF(0),VFR(4),o[1],0,0,0), C0,4); \
    KRD(GL,0); GAPB(o[0]=__builtin_amdgcn_mfma_f32_32x32x16_bf16(PAF(1),VFR(1),o[0],0,0,0), C0,8); \
    KRD(GL,1); GAPB(o[1]=__builtin_amdgcn_mfma_f32_32x32x16_bf16(PAF(1),VFR(5),o[1],0,0,0), C0,12); \
    KRD(GL,2); GAPB(o[0]=__builtin_amdgcn_mfma_f32_32x32x16_bf16(PAF(2),VFR(2),o[0],0,0,0), C1,0); \
    KRD(GL,3); GAPB(o[1]=__builtin_amdgcn_mfma_f32_32x32x16_bf16(PAF(2),VFR(6),o[1],0,0,0), C1,4); \
    GAPB(o[0]=__builtin_amdgcn_mfma_f32_32x32x16_bf16(PAF(3),VFR(3),o[0],0,0,0), C1,8); \
    GAPB(o[1]=__builtin_amdgcn_mfma_f32_32x32x16_bf16(PAF(3),VFR(7),o[1],0,0,0), C1,12); \
    }while(0)
  int t=1;
  #undef CMASK
  #define CMASK(P0,P1,t) do{}while(0)
  for(;t+5<NT;t+=2){
    STEP(pB0,pB1,pA0,pA1,t,true,true,true);     WAIT_BAR(2); RESC(); ROT();
    STEP(pA0,pA1,pB0,pB1,t+1,true,true,true);   WAIT_BAR(2); RESC(); ROT();
  }
  #undef CMASK
  #define CMASK(P0,P1,t) do{int jb_=(t)-(NT-4); if(jb_>=0)cmask(P0,P1,jb_,qrel,hi);}while(0)
  #define ENDW(tt) do{ if((tt)+3<NT){WAIT_BAR(2);} else if((tt)+2<NT){WAIT_BAR(1);} else {WAIT_BAR(0);} }while(0)
  for(;t+1<NT;t+=2){
    STEP(pB0,pB1,pA0,pA1,t,(t+3<NT),(t+1<NT),(t+1<NT));       ENDW(t);   RESC(); ROT();
    STEP(pA0,pA1,pB0,pB1,t+1,(t+4<NT),(t+2<NT),(t+2<NT));     ENDW(t+1); RESC(); ROT();
  }
  STEP(pB0,pB1,pA0,pA1,NT-1,false,false,false); RESC();
  { float sacc=pB0[0]+pB0[1]; _Pragma("unroll") for(int r=2;r<16;++r)sacc+=pB0[r]; _Pragma("unroll") for(int r=0;r<16;++r)sacc+=pB1[r]; l_reg+=sacc;
    pw0=(u32x4){PKW(pB0,0),PKW(pB0,2),PKW(pB0,4),PKW(pB0,6)};pw1=(u32x4){PKW(pB0,8),PKW(pB0,10),PKW(pB0,12),PKW(pB0,14)};pw2=(u32x4){PKW(pB1,0),PKW(pB1,2),PKW(pB1,4),PKW(pB1,6)};pw3=(u32x4){PKW(pB1,8),PKW(pB1,10),PKW(pB1,12),PKW(pB1,14)};
    SBAR(); pv(o,vb0+sl_cur,PAF(0),PAF(1),PAF(2),PAF(3)); }
  #undef PKW
  #undef PAF
  #undef VFR
  #undef PIN
  #undef MX3
  #undef GAPA
  #undef GAPB
  #undef EX
  #undef VRD
  #undef KRD
  #undef STEP
  #undef ENDW
  {auto rr=__builtin_amdgcn_permlane32_swap(__float_as_uint(l_reg),__float_as_uint(l_reg),false,false);l_reg=__uint_as_float(rr[0])+__uint_as_float(rr[1]);}
  if(hi==0)wsf[32+r32]=l_reg;asm volatile("s_waitcnt lgkmcnt(0)":::"memory");
  float rli[16];
  #pragma unroll
  for(int r=0;r<16;++r)rli[r]=__builtin_amdgcn_rcpf(wsf[32+crow(r,hi)]);
  bf16*Ow=O+(rowbase+q0+wid*QBLK)*DM+h*D;
  { bf16*stg=(bf16*)(shm+LDS_OST)+wid*2048;
    #pragma unroll
    for(int r=0;r<16;++r){const int orow=crow(r,hi);
      #pragma unroll
      for(int d0=0;d0<2;++d0)stg[orow*64+d0*32+r32]=__float2bfloat16(o[d0][r]*rli[r]);}
    asm volatile("s_waitcnt lgkmcnt(0)":::"memory");
    #pragma unroll
    for(int i=0;i<4;++i){const int row=i*8+(lane>>3),ch=lane&7; const u32x4 v=*(const u32x4*)(stg+row*64+ch*8); ATTN_STORE16(Ow+(long)row*DM+ch*8,v);} }
  asm volatile("s_waitcnt lgkmcnt(0)\n\ts_barrier":::"memory");
  #undef DMA_K
  #undef DMA_V
  #undef BIAS
  #undef CMASK
  #undef START
  #undef RESC
  #undef ROT
}
constexpr int ATTN_LDS_BYTES=LDS_TOTAL;
struct AttnTensors { const bf16* Q; const bf16* K; const bf16* V; bf16* O; };
struct AttnUnit { int bh; int qb; };
struct StaticOrder {
  int vcu;
  __device__ __forceinline__ explicit StaticOrder(int grid,int block):vcu((block%8)*(grid/8)+block/8){}
  __device__ __forceinline__ bool next(int i,AttnUnit&u)const{ if(i>=4)return false; const int s=2*(vcu&1)+(i>>1); u.bh=vcu>>1; u.qb=(i&1)?7-s:s; return true; }
  __device__ __forceinline__ void a_ready(const AttnUnit&)const{}
  __device__ __forceinline__ void done(const AttnUnit&)const{}
};
template<class Sched,int THRL=8> __device__ __forceinline__ void attn_phase(char*lds,const AttnTensors&T,const Sched&S){
  AttnUnit u;
  for(int i=0;S.next(i,u);++i){ S.a_ready(u); attn_unit<THRL>(u.bh/NHEAD,u.bh%NHEAD,u.qb,T.Q,T.K,T.V,T.O,lds); S.done(u); }
}
#undef SBAR
#undef WAIT_BAR
}
#define GAS __attribute__((address_space(1)))
#define LAS __attribute__((address_space(3)))
typedef unsigned short bf16;
typedef unsigned v4u __attribute__((ext_vector_type(4)));
typedef float f32x4 __attribute__((ext_vector_type(4)));
typedef short bf16x8 __attribute__((ext_vector_type(8)));
typedef GAS unsigned gu32;
typedef GAS unsigned long long gu64;
#define RLX_AGENT __ATOMIC_RELAXED, __HIP_MEMORY_SCOPE_AGENT
#define LDS_WAIT() asm volatile("s_waitcnt lgkmcnt(0)" ::: "memory")
#define VM_WAIT() asm volatile("s_waitcnt vmcnt(0)" ::: "memory")
__device__ __forceinline__ unsigned long long rt() { return __builtin_amdgcn_s_memrealtime(); }
__device__ __forceinline__ unsigned f2bf(float f) { unsigned u = __builtin_bit_cast(unsigned, f); return (u + 0x7fffu + ((u >> 16) & 1u)) >> 16; }
__device__ __forceinline__ unsigned pk2(float lo, float hi) { return f2bf(lo) | (f2bf(hi) << 16); }

#define XB_TMO      128
#define XB_XCNT(j)  (256  + 64 * (j))
#define XB_XSUB(j)  (1280 + 64 * (j))
#define XB_XGEN(j)  (2304 + 64 * (j))
#define XB_TOP      3328
#define XB_TOPGEN   3392
#define XCD_BAR_WORDS 3456
#define XB_SPIN_CAP (1u << 18)

__device__ __forceinline__ unsigned xb_ld(unsigned* p)              { return __hip_atomic_load(p, __ATOMIC_RELAXED, __HIP_MEMORY_SCOPE_AGENT); }
__device__ __forceinline__ unsigned xb_add(unsigned* p, unsigned v) { return __hip_atomic_fetch_add(p, v, __ATOMIC_RELAXED, __HIP_MEMORY_SCOPE_AGENT); }
__device__ __forceinline__ unsigned xb_xcc_id() { return (unsigned)__builtin_amdgcn_s_getreg((3 << 11) | 20) & 0xFu; }
#define XB_SPIN(cond, bar) do { unsigned _sp = 0; while (cond) { __builtin_amdgcn_s_sleep(1); \
    if ((++_sp & 255u) == 0u) { if (xb_ld(&(bar)[XB_TMO])) break; if (_sp > XB_SPIN_CAP) { atomicAdd(&(bar)[XB_TMO], 1u); break; } } } } while (0)

struct XcdBarrier {
    unsigned* bar; unsigned x;
    volatile LAS unsigned* st;
};

__device__ __forceinline__ XcdBarrier xcd_barrier_post(unsigned* bar, volatile LAS unsigned* st) {
    XcdBarrier b; b.bar = bar; b.x = xb_xcc_id(); b.st = st;
    if (threadIdx.x == 0) (void)xb_add(&bar[XB_XCNT(b.x)], 1u);
    return b;
}
__device__ __forceinline__ void xcd_barrier_complete(unsigned* bar, unsigned x, unsigned& nloc, unsigned& nx) {
    const unsigned G = gridDim.x * gridDim.y * gridDim.z;
    unsigned sum, cnt, mine, sp = 0u;
    for (;;) {
        sum = 0u; cnt = 0u; mine = 0u;
#pragma unroll
        for (unsigned j = 0; j < 16; ++j) { const unsigned c = xb_ld(&bar[XB_XCNT(j)]); sum += c; cnt += (c > 0u) ? 1u : 0u; mine = (j == x) ? c : mine; }
        if (sum == G) break;
        __builtin_amdgcn_s_sleep(1);
        if ((++sp & 255u) == 0u) { if (xb_ld(&bar[XB_TMO])) break; if (sp > XB_SPIN_CAP) { atomicAdd(&bar[XB_TMO], 1u); break; } }
    }
    nloc = mine > 0u ? mine : 1u; nx = cnt > 0u ? cnt : 1u;
}

__device__ __forceinline__ void xcd_barrier(const XcdBarrier& b) {
    asm volatile("s_waitcnt vmcnt(0)" ::: "memory");
    __syncthreads();
    if (threadIdx.x == 0) {
        unsigned* bar = b.bar;
        __builtin_amdgcn_s_waitcnt(0);
        unsigned nloc = b.st[0], nx = b.st[1];
        if (nloc == 0u) { xcd_barrier_complete(bar, b.x, nloc, nx); b.st[0] = nloc; b.st[1] = nx; }
        const unsigned old = xb_add(&bar[XB_XSUB(b.x)], 1u);
        const unsigned gen = old / nloc;
        if (old + 1u == (gen + 1u) * nloc) {
            __builtin_amdgcn_fence(__ATOMIC_RELEASE, "agent");
            asm volatile("s_waitcnt vmcnt(0)" ::: "memory");
            const unsigned og = xb_add(&bar[XB_TOP], 1u);
            const unsigned tg = og / nx;
            if (og + 1u == (tg + 1u) * nx) xb_add(&bar[XB_TOPGEN], 1u);
            else XB_SPIN(xb_ld(&bar[XB_TOPGEN]) == tg, bar);
            __builtin_amdgcn_fence(__ATOMIC_ACQUIRE, "agent");
            xb_add(&bar[XB_XGEN(b.x)], 1u);
            asm volatile("s_waitcnt vmcnt(0)" ::: "memory");
        } else {
            XB_SPIN(xb_ld(&bar[XB_XGEN(b.x)]) == gen, bar);
            __builtin_amdgcn_fence(__ATOMIC_ACQUIRE, "agent");
            asm volatile("s_waitcnt vmcnt(0)" ::: "memory");
        }
    }
    __syncthreads();
}

__device__ __forceinline__ void grp_barrier_complete(unsigned* bar, unsigned x, unsigned total, unsigned& nloc, unsigned& nx) {
    unsigned sum, cnt, mine, sp = 0u;
    for (;;) {
        sum = 0u; cnt = 0u; mine = 0u;
#pragma unroll
        for (unsigned j = 0; j < 16; ++j) { const unsigned c = xb_ld(&bar[XB_XCNT(j)]); sum += c; cnt += (c > 0u) ? 1u : 0u; mine = (j == x) ? c : mine; }
        if (sum == total) break;
        __builtin_amdgcn_s_sleep(1);
        if ((++sp & 255u) == 0u) { if (xb_ld(&bar[XB_TMO])) break; if (sp > XB_SPIN_CAP) { atomicAdd(&bar[XB_TMO], 1u); break; } }
    }
    nloc = mine > 0u ? mine : 1u; nx = cnt > 0u ? cnt : 1u;
}
__device__ __forceinline__ void grp_barrier(const XcdBarrier& b, unsigned total) {
    asm volatile("s_waitcnt vmcnt(0)" ::: "memory");
    __syncthreads();
    if (threadIdx.x == 0) {
        unsigned* bar = b.bar;
        __builtin_amdgcn_s_waitcnt(0);
        unsigned nloc = b.st[0], nx = b.st[1];
        if (nloc == 0u) { grp_barrier_complete(bar, b.x, total, nloc, nx); b.st[0] = nloc; b.st[1] = nx; }
        const unsigned old = xb_add(&bar[XB_XSUB(b.x)], 1u);
        const unsigned gen = old / nloc;
        if (old + 1u == (gen + 1u) * nloc) {
            __builtin_amdgcn_fence(__ATOMIC_RELEASE, "agent");
            asm volatile("s_waitcnt vmcnt(0)" ::: "memory");
            const unsigned og = xb_add(&bar[XB_TOP], 1u);
            const unsigned tg = og / nx;
            if (og + 1u == (tg + 1u) * nx) xb_add(&bar[XB_TOPGEN], 1u);
            else XB_SPIN(xb_ld(&bar[XB_TOPGEN]) == tg, bar);
            __builtin_amdgcn_fence(__ATOMIC_ACQUIRE, "agent");
            xb_add(&bar[XB_XGEN(b.x)], 1u);
            asm volatile("s_waitcnt vmcnt(0)" ::: "memory");
        } else {
            XB_SPIN(xb_ld(&bar[XB_XGEN(b.x)]) == gen, bar);
            __builtin_amdgcn_fence(__ATOMIC_ACQUIRE, "agent");
            asm volatile("s_waitcnt vmcnt(0)" ::: "memory");
        }
    }
    __syncthreads();
}
constexpr int NWAVES = 8, NTHR = NWAVES * 64;
constexpr int T_TOK = 16384, DMODEL = 1024, NB = 8, SEQ = 2048;
constexpr int GLA_H = 4, GLA_DK = 128, GLA_DV = 256, GLA_C = 64, GLA_NCH = SEQ / GLA_C, GLA_IN = 3088;
constexpr int NCHUNK = NB * GLA_H * GLA_NCH;
constexpr int KV_TOT = 2064, FOX_H = 16;
constexpr int PEER_H = 8, PEER_K = 16, PEER_NEXP = 16384, PEER_SEL = PEER_H * PEER_K;
constexpr float EPS = 1e-6f;
constexpr float L2E = 1.4426950408889634f;

constexpr size_t MiB = 1u << 20;
constexpr size_t WS_CTL = 0, CTL_ZERO_BYTES = 256 * 1024;
constexpr size_t WS_WIN = 2 * MiB, WS_WGO = 8 * MiB, WS_WQKV = 10 * MiB, WS_WFO = 16 * MiB, WS_WEFF = 18 * MiB;
constexpr size_t WS_FL = 27 * MiB, WS_RP = 28 * MiB, WS_DEXP = 30 * MiB, WS_WGL = 30 * MiB + 512 * 1024, WS_WFL = WS_WGL + 64 * 1024, WS_WFLF = WS_WFL + 64 * 1024;
constexpr size_t WS_A0 = 32 * MiB;
constexpr size_t WS_HB = 64 * MiB;
constexpr size_t WS_PQ = 96 * MiB;
constexpr size_t WS_QT = 192 * MiB, WS_KT = 208 * MiB, WS_AT = 224 * MiB, WS_VT = 232 * MiB;
constexpr size_t WS_SC = 96 * MiB;
constexpr size_t WS_IDS = 264 * MiB, WS_GATES = 272 * MiB;
constexpr size_t WS_TAB = 280 * MiB;
constexpr size_t WS_OG = 312 * MiB;
constexpr size_t WS_TSC = 344 * MiB;
constexpr size_t WS_END = 408 * MiB;
constexpr int CW_BAR = 4096, CW_GBAR = 16384;

constexpr int RING_BYTES = 155648;
constexpr int LDSCTL_OFF = RING_BYTES, MISC_OFF = LDSCTL_OFF + 320;
constexpr int LDS_BYTES = 163840;

typedef unsigned v2u __attribute__((ext_vector_type(2)));
typedef float f32x16 __attribute__((ext_vector_type(16)));
__device__ __forceinline__ float bf2f(unsigned b) { return __builtin_bit_cast(float, b << 16); }
__device__ __forceinline__ float bflo(unsigned w) { return __builtin_bit_cast(float, w << 16); }
__device__ __forceinline__ float bfhi(unsigned w) { return __builtin_bit_cast(float, w & 0xffff0000u); }
__device__ __forceinline__ float wave_sum(float v) {
#pragma unroll
    for (int o = 1; o < 64; o <<= 1) v += __shfl_xor(v, o);
    return v;
}
__device__ __forceinline__ float wave_max(float v) {
#pragma unroll
    for (int o = 1; o < 64; o <<= 1) v = fmaxf(v, __shfl_xor(v, o));
    return v;
}
__device__ __forceinline__ float log_sigmoid(float x) { return fminf(x, 0.f) - __logf(1.0f + __expf(-fabsf(x))); }
__device__ __forceinline__ int crow16(int r, int hi) { return (r & 3) + 8 * (r >> 2) + 4 * hi; }

struct Frame {
    LAS unsigned char* lds;
    volatile LAS unsigned* MISC;
    gu32* ctl;
    int tid, lane, wave, vcu, G;
    unsigned char* ws;
    const float* in[18];
    float* out;
};
enum { IN_X = 0, IN_NORM_MIX, IN_NORM_FFN, IN_GLA_W_IN, IN_GLA_W_G2, IN_GLA_B_G, IN_GLA_NORM_O, IN_GLA_W_O, IN_KV_NORM, IN_KV_W, IN_FOX_B_F, IN_FOX_W_Q, IN_FOX_W_O,
       IN_PEER_W_Q, IN_PEER_SUB, IN_PEER_U, IN_PEER_V, IN_NORM_FINAL };

__device__ __forceinline__ void p0_transpose_item(const float* W, int K, int ldw, int c0, int N, bf16* WT, int row_off, const float* gk, int ns, float cs, LAS float* scr, int item, int lane) {
    const int nblk = N / 32, kb = item / nblk, nb = item % nblk, k0 = 64 * kb, n0 = 32 * nb;
#pragma unroll 8
    for (int i = 0; i < 32; ++i) { const int kk = 2 * i + (lane >> 5); const float g = gk ? gk[k0 + kk] : 1.f; scr[kk * 33 + (lane & 31)] = __builtin_nontemporal_load(W + (size_t)(k0 + kk) * ldw + c0 + n0 + (lane & 31)) * g; }
    LDS_WAIT(); asm volatile("" ::: "memory");
    const int c = lane & 7;
#pragma unroll
    for (int j = 0; j < 4; ++j) { const int n = (lane >> 3) + 8 * j; const LAS float* s = scr + (8 * c) * 33 + n; const float sc = (n0 + n < ns) ? cs : 1.f;
        v4u o; o.x = pk2(s[0 * 33] * sc, s[1 * 33] * sc); o.y = pk2(s[2 * 33] * sc, s[3 * 33] * sc); o.z = pk2(s[4 * 33] * sc, s[5 * 33] * sc); o.w = pk2(s[6 * 33] * sc, s[7 * 33] * sc);
        *(GAS v4u*)(WT + (size_t)(row_off + n0 + n) * K + k0 + 8 * c) = o; }
    LDS_WAIT(); asm volatile("" ::: "memory");
}
__device__ __forceinline__ void p0_weff_item(Frame& F, int item) {
    const int l = item >> 8, gi = (item >> 4) & 15, kb = item & 15, k0 = kb * 64, tid = F.tid, lane = F.lane, wave = F.wave;
    const float* wpq = F.in[IN_PEER_W_Q] + (size_t)l * DMODEL * 2048; const float* sub = F.in[IN_PEER_SUB] + ((size_t)l * 16 + gi) * 128 * 128; const float* gf = F.in[IN_NORM_FFN] + l * DMODEL;
    bf16* WT = (bf16*)(F.ws + WS_WEFF) + (size_t)l * 2048 * DMODEL;
    LAS float* At = (LAS float*)F.lds;
    LAS float* Bt = (LAS float*)(F.lds + 33792);
    { const int kk = tid >> 3, d0 = (tid & 7) * 16; const float g = gf[k0 + kk]; const f32x4* src = (const f32x4*)(wpq + (size_t)(k0 + kk) * 2048 + gi * 128 + d0);
#pragma unroll
      for (int i = 0; i < 4; ++i) { const f32x4 v = __builtin_nontemporal_load(src + i) * g; LAS float* d = At + kk * 129 + d0 + 4 * i; d[0] = v[0]; d[1] = v[1]; d[2] = v[2]; d[3] = v[3]; } }
    { const int n = tid >> 2, d0 = (tid & 3) * 32; const f32x4* src = (const f32x4*)(sub + (size_t)n * 128 + d0);
#pragma unroll
      for (int i = 0; i < 8; ++i) { const f32x4 v = src[i]; LAS float* d = Bt + n * 129 + d0 + 4 * i; d[0] = v[0]; d[1] = v[1]; d[2] = v[2]; d[3] = v[3]; } }
    __syncthreads();
    const int ti = wave >> 2, tj = wave & 3, r32 = lane & 31, hi = lane >> 5;
    const LAS float* ap = At + (32 * ti + r32) * 129 + hi; const LAS float* bp = Bt + (32 * tj + r32) * 129 + hi;
    f32x16 acc = (f32x16){};
#pragma unroll 16
    for (int s = 0; s < 64; ++s) acc = __builtin_amdgcn_mfma_f32_32x32x2f32(ap[2 * s], bp[2 * s], acc, 0, 0, 0);
    bf16* dst = WT + (size_t)(gi * 128 + 32 * tj + r32) * DMODEL + k0 + 32 * ti + 4 * hi;
#pragma unroll
    for (int g = 0; g < 4; ++g) *(GAS v2u*)(dst + 8 * g) = (v2u){pk2(acc[4 * g], acc[4 * g + 1]), pk2(acc[4 * g + 2], acc[4 * g + 3])};
    __syncthreads();
}
template <int NR> __device__ __forceinline__ void rms_rows_to_bf16(int lane, const float* const (&xrow)[NR], const float* g, bf16* const (&orow)[NR]) {
    f32x4 v[NR][4];
#pragma unroll
    for (int r = 0; r < NR; ++r) { const GAS f32x4* xr = (const GAS f32x4*)xrow[r] + lane;
#pragma unroll
        for (int j = 0; j < 4; ++j) v[r][j] = __builtin_nontemporal_load(xr + 64 * j); }
    const GAS f32x4* gr = (const GAS f32x4*)g + lane;
    f32x4 gg[4];
#pragma unroll
    for (int j = 0; j < 4; ++j) gg[j] = gr[64 * j];
#pragma unroll
    for (int r = 0; r < NR; ++r) { float s = 0.f;
#pragma unroll
        for (int j = 0; j < 4; ++j) s += (v[r][j].x * v[r][j].x + v[r][j].y * v[r][j].y) + (v[r][j].z * v[r][j].z + v[r][j].w * v[r][j].w);
        const float rstd = 1.f / sqrtf(wave_sum(s) * (1.f / DMODEL) + EPS);
        GAS unsigned long long* o8 = (GAS unsigned long long*)orow[r] + lane;
#pragma unroll
        for (int j = 0; j < 4; ++j) o8[64 * j] = (unsigned long long)pk2(v[r][j].x * rstd * gg[j].x, v[r][j].y * rstd * gg[j].y) | ((unsigned long long)pk2(v[r][j].z * rstd * gg[j].z, v[r][j].w * rstd * gg[j].w) << 32); }
}
__device__ __forceinline__ unsigned fp4_code(float y) {
    const float a = fabsf(y);
    const unsigned mag = (unsigned)(a >= 0.25f) + (unsigned)(a >= 0.75f) + (unsigned)(a >= 1.25f) + (unsigned)(a >= 1.75f) + (unsigned)(a >= 2.5f) + (unsigned)(a >= 3.5f) + (unsigned)(a >= 5.0f);
    return mag | ((__builtin_bit_cast(unsigned, y) >> 28) & 8u);
}
template <int NR> __device__ __forceinline__ void tab_rows_to_fp4(int lane, const float* const (&src)[NR], unsigned char* const (&dst)[NR], float* const (&sc_out)[NR]) {
    f32x4 a[NR], b[NR], c[NR], d[NR];
#pragma unroll
    for (int r = 0; r < NR; ++r) { const GAS f32x4* s = (const GAS f32x4*)src[r] + 4 * lane;
        a[r] = __builtin_nontemporal_load(s); b[r] = __builtin_nontemporal_load(s + 1); c[r] = __builtin_nontemporal_load(s + 2); d[r] = __builtin_nontemporal_load(s + 3); }
#pragma unroll
    for (int r = 0; r < NR; ++r) {
        float m = fmaxf(fmaxf(fmaxf(fabsf(a[r].x), fabsf(a[r].y)), fmaxf(fabsf(a[r].z), fabsf(a[r].w))), fmaxf(fmaxf(fabsf(b[r].x), fabsf(b[r].y)), fmaxf(fabsf(b[r].z), fabsf(b[r].w))));
        m = fmaxf(m, fmaxf(fmaxf(fmaxf(fabsf(c[r].x), fabsf(c[r].y)), fmaxf(fabsf(c[r].z), fabsf(c[r].w))), fmaxf(fmaxf(fabsf(d[r].x), fabsf(d[r].y)), fmaxf(fabsf(d[r].z), fabsf(d[r].w)))));
        m = wave_max(m);
        const float enc = (m > 0.f) ? 6.0f / m : 1.0f;
        unsigned w0 = 0, w1 = 0;
        w0 = __builtin_amdgcn_cvt_scalef32_pk_fp4_f32(w0, a[r].x * enc, a[r].y * enc, 1.0f, 0); w0 = __builtin_amdgcn_cvt_scalef32_pk_fp4_f32(w0, a[r].z * enc, a[r].w * enc, 1.0f, 1);
        w0 = __builtin_amdgcn_cvt_scalef32_pk_fp4_f32(w0, b[r].x * enc, b[r].y * enc, 1.0f, 2); w0 = __builtin_amdgcn_cvt_scalef32_pk_fp4_f32(w0, b[r].z * enc, b[r].w * enc, 1.0f, 3);
        w1 = __builtin_amdgcn_cvt_scalef32_pk_fp4_f32(w1, c[r].x * enc, c[r].y * enc, 1.0f, 0); w1 = __builtin_amdgcn_cvt_scalef32_pk_fp4_f32(w1, c[r].z * enc, c[r].w * enc, 1.0f, 1);
        w1 = __builtin_amdgcn_cvt_scalef32_pk_fp4_f32(w1, d[r].x * enc, d[r].y * enc, 1.0f, 2); w1 = __builtin_amdgcn_cvt_scalef32_pk_fp4_f32(w1, d[r].z * enc, d[r].w * enc, 1.0f, 3);
        ((GAS v2u*)dst[r])[lane] = (v2u){w0, w1};
        if (lane == 0) *sc_out[r] = (m > 0.f) ? m * (1.0f / 6.0f) : 1.0f; }
}
__device__ __forceinline__ void p0_prologue(Frame& F) {
    LAS float* scr = (LAS float*)(F.lds + F.wave * 16384);
    const int gw = blockIdx.x * NWAVES + F.wave, NGW = F.G * NWAVES;
    constexpr int I_IN = 16 * 96, I_SQ = 16 * 32;
    for (int it = gw; it < I_IN + I_SQ; it += NGW) {
        if (it < I_IN) p0_transpose_item(F.in[IN_GLA_W_IN], DMODEL, GLA_IN, 0, 3072, (bf16*)(F.ws + WS_WIN), 0, nullptr, 512, 0.08838834764831845f, scr, it, F.lane);
        else p0_transpose_item(F.in[IN_GLA_W_O], DMODEL, DMODEL, 0, 1024, (bf16*)(F.ws + WS_WGO), 0, nullptr, 0, 1.f, scr, it - I_IN, F.lane); }
    { const int gt = blockIdx.x * NTHR + F.tid, NT = F.G * NTHR;
      for (int idx = gt; idx < 16 * DMODEL; idx += NT) { const int j = idx >> 10, k = idx & 1023; ((bf16*)(F.ws + WS_WGL))[j * DMODEL + k] = (bf16)f2bf(F.in[IN_GLA_W_IN][(size_t)k * GLA_IN + 3072 + j]); } }
    for (int m = gw; m < T_TOK; m += 4 * NGW) {
        const float* xr[4]; bf16* orow[4];
#pragma unroll
        for (int i = 0; i < 4; ++i) { int mm = m + i * NGW; mm = mm < T_TOK ? mm : T_TOK - 1; xr[i] = F.in[IN_X] + (size_t)mm * DMODEL; orow[i] = (bf16*)(F.ws + WS_A0) + (size_t)mm * DMODEL; }
        rms_rows_to_bf16<4>(F.lane, xr, F.in[IN_NORM_MIX], orow); }
}
__device__ __forceinline__ void late_weights(Frame& F, int wg0, int nwg) {
    const int p = (int)blockIdx.x - wg0;
    for (int it = p; it < 512; it += nwg) p0_weff_item(F, it);
    LAS float* scr = (LAS float*)(F.lds + F.wave * 16384);
    const int gw = p * NWAVES + F.wave, NGW = nwg * NWAVES;
    constexpr int I_SQ = 16 * 32, I_KV = 16 * 64;
    for (int it = gw; it < 2 * I_SQ + I_KV; it += NGW) {
        int r = it;
        if (r < I_SQ) { p0_transpose_item(F.in[IN_FOX_W_Q], DMODEL, DMODEL, 0, 1024, (bf16*)(F.ws + WS_WQKV), 0, F.in[IN_NORM_MIX] + DMODEL, 0, 1.f, scr, r, F.lane); continue; } r -= I_SQ;
        if (r < I_KV) { p0_transpose_item(F.in[IN_KV_W], DMODEL, KV_TOT, 0, 2048, (bf16*)(F.ws + WS_WQKV), 1024, F.in[IN_KV_NORM], 0, 1.f, scr, r, F.lane); continue; } r -= I_KV;
        p0_transpose_item(F.in[IN_FOX_W_O], DMODEL, DMODEL, 0, 1024, (bf16*)(F.ws + WS_WFO), 0, nullptr, 0, 1.f, scr, r, F.lane); }
    { const int gt = p * NTHR + F.tid, NT = nwg * NTHR;
      for (int idx = gt; idx < 16 * DMODEL; idx += NT) { const int j = idx >> 10, k = idx & 1023;
          const float wv = F.in[IN_KV_W][(size_t)k * KV_TOT + 2048 + j] * F.in[IN_KV_NORM][k]; ((bf16*)(F.ws + WS_WFL))[j * DMODEL + k] = (bf16)f2bf(wv); ((float*)(F.ws + WS_WFLF))[j * DMODEL + k] = wv; } }
}

#ifndef TAB_ROWS_PER_ITER
#define TAB_ROWS_PER_ITER 1
#endif
__device__ __forceinline__ void peer_tables_convert(Frame& F, int w0, int nw) {
    const int gw = blockIdx.x * NWAVES + F.wave - w0;
    if (gw < 0 || gw >= nw) return;
    constexpr int NR = TAB_ROWS_PER_ITER;
    for (int r0 = gw; r0 < 4 * PEER_NEXP; r0 += NR * nw) {
        const float* src[NR]; unsigned char* dst[NR]; float* sc[NR];
#pragma unroll
        for (int i = 0; i < NR; ++i) { int r = r0 + i * nw; r = r < 4 * PEER_NEXP ? r : 4 * PEER_NEXP - 1; const int tb = r >> 14, e = r & (PEER_NEXP - 1), l = tb >> 1;
            src[i] = ((tb & 1) ? F.in[IN_PEER_V] : F.in[IN_PEER_U]) + ((size_t)l * PEER_NEXP + e) * DMODEL;
            dst[i] = F.ws + WS_TAB + ((size_t)tb * PEER_NEXP + e) * (DMODEL / 2); sc[i] = (float*)(F.ws + WS_TSC) + (size_t)tb * PEER_NEXP + e; }
        tab_rows_to_fp4<NR>(F.lane, src, dst, sc); }
}

__device__ __forceinline__ f32x4 skinny16(const bf16* A  , const bf16* Wt, int wave, int lane, LAS float* scr) {
    f32x4 acc = (f32x4){0.f, 0.f, 0.f, 0.f};
    const bf16x8* ap = (const bf16x8*)(A + (size_t)(16 * (wave & 3) + (lane & 15)) * DMODEL + 512 * (wave >> 2) + 8 * (lane >> 4));
    const bf16x8* bp = (const bf16x8*)(Wt + (size_t)(lane & 15) * DMODEL + 512 * (wave >> 2) + 8 * (lane >> 4));
    bf16x8 af[16], bfr[16];
#pragma unroll
    for (int kk = 0; kk < 16; ++kk) { af[kk] = ap[4 * kk]; bfr[kk] = bp[4 * kk]; }
#pragma unroll
    for (int kk = 0; kk < 16; ++kk) acc = __builtin_amdgcn_mfma_f32_16x16x32_bf16(af[kk], bfr[kk], acc, 0, 0, 0);
    if (wave >= 4) *(LAS f32x4*)(scr + (wave - 4) * 256 + 4 * lane) = acc;
    __syncthreads();
    if (wave < 4) acc += *(const LAS f32x4*)(scr + wave * 256 + 4 * lane);
    return acc;
}
__device__ __forceinline__ int perm16(int k16) { return 8 * ((k16 >> 2) & 1) + 4 * (k16 >> 3) + (k16 & 3); }
__device__ __forceinline__ void p2a_item(Frame& F, int b, int n) {
    const int tid = F.tid, lane = F.lane, wave = F.wave;
    const int t0 = b * SEQ + n * GLA_C;
    const bf16* PQ = (const bf16*)(F.ws + WS_PQ);
    LAS float* glrL = (LAS float*)F.lds;
    LAS float* SEG = (LAS float*)(F.lds + 4096);
    LAS unsigned char* QI = F.lds + 8192;
    LAS unsigned char* KI = F.lds + 24576;
    LAS unsigned char* RQ = F.lds + 40960;
    LAS unsigned char* RK = F.lds + 57344;
    LAS unsigned char* RV = F.lds + 73728;
    v4u rq[2], rk[2], rv[4];
#define P2A_LOAD(hh) do { _Pragma("unroll") for (int i_ = 0; i_ < 2; ++i_) { const int p_ = tid + 512 * i_; const bf16* src_ = PQ + (size_t)(t0 + (p_ >> 4)) * 3072 + (hh) * 128 + (p_ & 15) * 8; \
        rq[i_] = *(const GAS v4u*)src_; rk[i_] = *(const GAS v4u*)(src_ + 512); } \
      _Pragma("unroll") for (int i_ = 0; i_ < 4; ++i_) { const int p_ = tid + 512 * i_; rv[i_] = *(const GAS v4u*)(PQ + (size_t)(t0 + (p_ >> 5)) * 3072 + 1024 + (hh) * 256 + (p_ & 31) * 8); } } while (0)
#define P2A_STORE() do { _Pragma("unroll") for (int i_ = 0; i_ < 2; ++i_) { const int p_ = tid + 512 * i_; *(LAS v4u*)(RQ + p_ * 16) = rq[i_]; *(LAS v4u*)(RK + p_ * 16) = rk[i_]; } \
      _Pragma("unroll") for (int i_ = 0; i_ < 4; ++i_) { const int p_ = tid + 512 * i_; *(LAS v4u*)(RV + p_ * 16) = rv[i_]; } } while (0)
    P2A_LOAD(0);
    { const f32x4 a = skinny16((const bf16*)(F.ws + WS_A0) + (size_t)t0 * DMODEL, (const bf16*)(F.ws + WS_WGL), wave, lane, (LAS float*)(F.lds + 106496));
      if (wave < 4) {
#pragma unroll
        for (int r = 0; r < 4; ++r) glrL[(16 * wave + 4 * (lane >> 4) + r) * 16 + (lane & 15)] = a[r]; } }
    P2A_STORE();
    __syncthreads();
    const int k = tid & 127, iq = tid >> 7;
    const int pos = (k & ~15) | perm16(k & 15);
    for (int h = 0; h < GLA_H; ++h) {
        const int cid = (b * 4 + h) * 32 + n;
        if (h + 1 < GLA_H) P2A_LOAD(h + 1);
        float wg[16];
#pragma unroll
        for (int j = 0; j < 16; ++j) wg[j] = F.in[IN_GLA_W_G2][j * 512 + h * 128 + k];
        const float bg = F.in[IN_GLA_B_G][h * 128 + k];
        float bc[16];
#pragma unroll
        for (int ii = 0; ii < 16; ++ii) { const LAS f32x4* gp = (const LAS f32x4*)(glrL + (iq * 16 + ii) * 16); float s = bg;
#pragma unroll
            for (int q4 = 0; q4 < 4; ++q4) { const f32x4 gv = gp[q4]; s += (gv[0] * wg[4 * q4] + gv[1] * wg[4 * q4 + 1]) + (gv[2] * wg[4 * q4 + 2] + gv[3] * wg[4 * q4 + 3]); }
            bc[ii] = log_sigmoid(s) * (1.0f / 16.0f); }
#pragma unroll
        for (int ii = 1; ii < 16; ++ii) bc[ii] += bc[ii - 1];
        SEG[iq * 128 + k] = bc[15];
        __syncthreads();
        float off = 0.f, tot = 0.f;
#pragma unroll
        for (int q = 0; q < 4; ++q) { const float sv = SEG[q * 128 + k]; tot += sv; if (q < iq) off += sv; }
        unsigned kt[8];
#pragma unroll
        for (int ii = 0; ii < 16; ii += 2) {
            float qa[2], ka[2];
#pragma unroll
            for (int e = 0; e < 2; ++e) { const int i = iq * 16 + ii + e; const float bb = bc[ii + e] + off;
                const float qv = bf2f(*(const LAS unsigned short*)(RQ + i * 256 + k * 2)), kv = bf2f(*(const LAS unsigned short*)(RK + i * 256 + k * 2));
                qa[e] = qv * __expf(bb); ka[e] = kv * __expf(-bb);
                *(LAS unsigned short*)(QI + i * 256 + pos * 2) = (unsigned short)f2bf(qa[e]);
                *(LAS unsigned short*)(KI + i * 256 + pos * 2) = (unsigned short)f2bf(ka[e]); }
            kt[ii >> 1] = pk2(ka[0], ka[1]); }
        { GAS v4u* dst = (GAS v4u*)((bf16*)(F.ws + WS_KT) + (size_t)cid * 8192 + k * 64 + iq * 16);
          dst[0] = (v4u){kt[0], kt[1], kt[2], kt[3]}; dst[1] = (v4u){kt[4], kt[5], kt[6], kt[7]}; }
        if (iq == 0) ((float*)(F.ws + WS_DEXP))[(size_t)cid * 128 + k] = __expf(tot);
        { const int nn = tid & 255, jh = tid >> 8; unsigned w[16];
#pragma unroll
          for (int jj = 0; jj < 32; jj += 2) { const unsigned lo = *(const LAS unsigned short*)(RV + (32 * jh + jj) * 512 + nn * 2), hi2 = *(const LAS unsigned short*)(RV + (32 * jh + jj + 1) * 512 + nn * 2); w[jj >> 1] = lo | (hi2 << 16); }
          GAS v4u* dst = (GAS v4u*)((bf16*)(F.ws + WS_VT) + (size_t)cid * 16384 + nn * 64 + 32 * jh);
#pragma unroll
          for (int q = 0; q < 4; ++q) dst[q] = (v4u){w[4 * q], w[4 * q + 1], w[4 * q + 2], w[4 * q + 3]}; }
        __syncthreads();
        if (wave < 4) { const int ib = (wave == 1 || wave == 2) ? 1 : 0, jb = (wave >= 2) ? 1 : 0, r32 = lane & 31, hi = lane >> 5;
            f32x16 acc = (f32x16){};
            if (wave != 3) {
#pragma unroll
                for (int kk = 0; kk < 8; ++kk) { const bf16x8 af = *(const LAS bf16x8*)(KI + (32 * jb + r32) * 256 + (16 * kk + 8 * hi) * 2);
                    const bf16x8 bfr = *(const LAS bf16x8*)(QI + (32 * ib + r32) * 256 + (16 * kk + 8 * hi) * 2);
                    acc = __builtin_amdgcn_mfma_f32_32x32x16_bf16(af, bfr, acc, 0, 0, 0); } }
            const int i = 32 * ib + r32;
            bf16* at = (bf16*)(F.ws + WS_AT) + (size_t)cid * 4096 + i * 64 + 32 * jb + 4 * hi;
#pragma unroll
            for (int g = 0; g < 4; ++g) { float v[4];
#pragma unroll
                for (int e = 0; e < 4; ++e) { const int j = 32 * jb + 8 * g + 4 * hi + e; v[e] = (j <= i) ? acc[4 * g + e] : 0.f; }
                *(GAS v2u*)(at + 8 * g) = (v2u){pk2(v[0], v[1]), pk2(v[2], v[3])}; } }
        { GAS v4u* dst = (GAS v4u*)((bf16*)(F.ws + WS_QT) + (size_t)cid * 8192); const LAS v4u* src = (const LAS v4u*)QI; dst[tid] = src[tid]; dst[tid + 512] = src[tid + 512]; }
        if (h + 1 < GLA_H) P2A_STORE();
        __syncthreads();
    }
#undef P2A_LOAD
#undef P2A_STORE
}

__device__ __forceinline__ unsigned cvtpk(float lo, float hi) { typedef float f2 __attribute__((ext_vector_type(2))); typedef __bf16 b2 __attribute__((ext_vector_type(2))); f2 v = {lo, hi}; b2 r = __builtin_convertvector(v, b2); return __builtin_bit_cast(unsigned, r); }
__device__ __forceinline__ void glds16s(const void* sbase, unsigned voff, unsigned lds_dst) { unsigned keep;
    asm volatile("s_mov_b32 %0, m0\n\ts_mov_b32 m0, %3\n\ts_nop 0\n\tglobal_load_lds_dwordx4 %1, %2\n\ts_mov_b32 m0, %0" : "=&s"(keep) : "v"(voff), "s"(sbase), "s"(lds_dst) : "memory"); }
__device__ __forceinline__ void glds16s_nt(const void* sbase, unsigned voff, unsigned lds_dst) { unsigned keep;
    asm volatile("s_mov_b32 %0, m0\n\ts_mov_b32 m0, %3\n\ts_nop 0\n\tglobal_load_lds_dwordx4 %1, %2 nt\n\ts_mov_b32 m0, %0" : "=&s"(keep) : "v"(voff), "s"(sbase), "s"(lds_dst) : "memory"); }
constexpr int P2B_STAGE = 40960, P2B_BUF0 = 4096;
__device__ __forceinline__ void p2b_seq(Frame& F, int bh, int probe_skip = 0) {
    const int lane = F.lane, wave = F.wave, r32 = lane & 31, hi = lane >> 5;
    const int b = bh >> 2, h = bh & 3;
    const bf16* PQ = (const bf16*)(F.ws + WS_PQ); bf16* OG = (bf16*)(F.ws + WS_A0);
    LAS float* red = (LAS float*)F.lds;
    const unsigned lds0 = (unsigned)(uintptr_t)F.lds + P2B_BUF0;
    f32x16 S[4];
#pragma unroll
    for (int kb = 0; kb < 4; ++kb) S[kb] = (f32x16){};
    int sq[2], sk[2];
#pragma unroll
    for (int i = 0; i < 2; ++i) { const int P = wave + 8 * i;
        { const int row = 4 * P + (lane >> 4), c = (lane & 15) ^ (row & 15); sq[i] = row * 256 + c * 16; }
        { const int row = 8 * P + (lane >> 3), c = (lane & 7) ^ ((row >> 1) & 7); sk[i] = row * 128 + c * 16; } }
#define P2B_DMA(cid_, bufi_) do { const unsigned d_ = lds0 + (bufi_) * P2B_STAGE; \
        const char* q_ = (const char*)(F.ws + WS_QT) + (size_t)(cid_) * 16384; const char* k_ = (const char*)(F.ws + WS_KT) + (size_t)(cid_) * 16384; const char* a_ = (const char*)(F.ws + WS_AT) + (size_t)(cid_) * 8192; \
        glds16s(q_, sq[0], (unsigned)__builtin_amdgcn_readfirstlane(d_ + wave * 1024)); glds16s(q_, sq[1], (unsigned)__builtin_amdgcn_readfirstlane(d_ + (wave + 8) * 1024)); \
        glds16s(k_, sk[0], (unsigned)__builtin_amdgcn_readfirstlane(d_ + 16384 + wave * 1024)); glds16s(k_, sk[1], (unsigned)__builtin_amdgcn_readfirstlane(d_ + 16384 + (wave + 8) * 1024)); \
        glds16s(a_, sk[0], (unsigned)__builtin_amdgcn_readfirstlane(d_ + 32768 + wave * 1024)); } while (0)
    bf16x8 vf[4];
    LAS float* dxL = (LAS float*)(F.lds + P2B_BUF0 + 2 * P2B_STAGE);
    const int tid = F.tid;
    constexpr int P2B_VTW = P2B_BUF0 + 2 * P2B_STAGE + 1024, P2B_RW = P2B_VTW + 32768;
    static_assert(P2B_RW + 32768 <= RING_BYTES, "GLA recurrence LDS map");
    const unsigned vtw0 = (unsigned)(uintptr_t)F.lds + P2B_VTW + wave * 4096, rw0 = (unsigned)(uintptr_t)F.lds + P2B_RW + wave * 4096;
    int sv[4], sr[4];
#pragma unroll
    for (int i = 0; i < 4; ++i) { { const int row = 8 * i + (lane >> 3), c = (lane & 7) ^ ((row >> 1) & 7); sv[i] = (32 * wave + row) * 128 + c * 16; }
                                  { const int row = 16 * i + (lane >> 2), c = (lane & 3) ^ ((row >> 2) & 3); sr[i] = row * 6144 + c * 16; } }
#define P2B_DMA_V(cid_) do { const char* v_ = (const char*)(F.ws + WS_VT) + (size_t)(cid_) * 32768; _Pragma("unroll") for (int i_ = 0; i_ < 4; ++i_) glds16s(v_, sv[i_], (unsigned)__builtin_amdgcn_readfirstlane(vtw0 + i_ * 1024)); } while (0)
#define P2B_DMA_R(t0_) do { const char* r_ = (const char*)(PQ + (size_t)(t0_) * 3072 + 2048 + h * 256 + 32 * wave); _Pragma("unroll") for (int i_ = 0; i_ < 4; ++i_) glds16s(r_, sr[i_], (unsigned)__builtin_amdgcn_readfirstlane(rw0 + i_ * 1024)); } while (0)
    const LAS unsigned char* vtw = F.lds + P2B_VTW + wave * 4096 + r32 * 128; const LAS unsigned char* rwl = F.lds + P2B_RW + wave * 4096;
    { const int cid = bh * 32;
      P2B_DMA(cid, 0); P2B_DMA_V(cid); P2B_DMA_R(b * SEQ);
      if (tid < 32) *(LAS f32x4*)(dxL + 4 * tid) = *(const f32x4*)((const float*)(F.ws + WS_DEXP) + (size_t)cid * 128 + 4 * tid); }
    asm volatile("s_waitcnt vmcnt(0)" ::: "memory");
    __syncthreads();
    const int kx0 = (r32 >> 1) & 7;
#pragma unroll
    for (int s = 0; s < 4; ++s) vf[s] = *(const LAS bf16x8*)(vtw + (((2 * s + hi) ^ kx0) << 4));
    const int qoff = r32 * 256, koff = 16384 + r32 * 128, aoff = 32768 + r32 * 128;
    const int qx = r32 & 15, kx = (r32 >> 1) & 7;
    for (int n = 0; n < GLA_NCH; ++n) {
        const int cid = bh * 32 + n, t0 = b * SEQ + n * GLA_C;
        const LAS unsigned char* buf = F.lds + P2B_BUF0 + (n & 1) * P2B_STAGE;
        const LAS float* DX = dxL + (n & 1) * 128;
        f32x4 dxn = (f32x4){0.f, 0.f, 0.f, 0.f};
        if (n + 1 < GLA_NCH) { P2B_DMA(cid + 1, (n + 1) & 1);
            if (tid < 32) dxn = *(const f32x4*)((const float*)(F.ws + WS_DEXP) + (size_t)(cid + 1) * 128 + 4 * tid); }
        if (n + 1 < GLA_NCH) P2B_DMA_V(cid + 1);
        f32x16 oT[2];
        oT[0] = (f32x16){}; oT[1] = (f32x16){};
#pragma unroll
        for (int kb = 0; kb < 4; ++kb) {
            bf16x8 qf[2][2];
#pragma unroll
            for (int s = 0; s < 2; ++s)
#pragma unroll
                for (int ib = 0; ib < 2; ++ib) qf[s][ib] = *(const LAS bf16x8*)(buf + qoff + ib * 8192 + (((4 * kb + 2 * s + hi) ^ qx) << 4));
            __builtin_amdgcn_sched_barrier(0);
#pragma unroll
            for (int s = 0; s < 2; ++s) { v4u sw; sw.x = cvtpk(S[kb][8 * s], S[kb][8 * s + 1]); sw.y = cvtpk(S[kb][8 * s + 2], S[kb][8 * s + 3]); sw.z = cvtpk(S[kb][8 * s + 4], S[kb][8 * s + 5]); sw.w = cvtpk(S[kb][8 * s + 6], S[kb][8 * s + 7]);
                const bf16x8 sf = __builtin_bit_cast(bf16x8, sw);
#pragma unroll
                for (int ib = 0; ib < 2; ++ib) oT[ib] = __builtin_amdgcn_mfma_f32_32x32x16_bf16(sf, qf[s][ib], oT[ib], 0, 0, 0); }
            __builtin_amdgcn_sched_barrier(0); }
        { bf16x8 af[2][4];
#pragma unroll
          for (int ib = 0; ib < 2; ++ib)
#pragma unroll
              for (int s = 0; s < 4; ++s) af[ib][s] = *(const LAS bf16x8*)(buf + aoff + ib * 4096 + (((2 * s + hi) ^ kx) << 4));
          __builtin_amdgcn_sched_barrier(0);
#pragma unroll
          for (int ib = 0; ib < 2; ++ib)
#pragma unroll
              for (int s = 0; s < 4; ++s) oT[ib] = __builtin_amdgcn_mfma_f32_32x32x16_bf16(vf[s], af[ib][s], oT[ib], 0, 0, 0);
          __builtin_amdgcn_sched_barrier(0); }
#pragma unroll
        for (int kh = 0; kh < 2; ++kh) { bf16x8 kf[2][4];
#pragma unroll
            for (int kb = 0; kb < 2; ++kb)
#pragma unroll
                for (int s = 0; s < 4; ++s) kf[kb][s] = *(const LAS bf16x8*)(buf + koff + (2 * kh + kb) * 4096 + (((2 * s + hi) ^ kx) << 4));
            __builtin_amdgcn_sched_barrier(0);
#pragma unroll
            for (int kb = 0; kb < 2; ++kb)
#pragma unroll
                for (int s = 0; s < 4; ++s) S[2 * kh + kb] = __builtin_amdgcn_mfma_f32_32x32x16_bf16(kf[kb][s], vf[s], S[2 * kh + kb], 0, 0, 0);
            __builtin_amdgcn_sched_barrier(0); }
#pragma unroll
        for (int kb = 0; kb < 4; ++kb)
#pragma unroll
            for (int g = 0; g < 4; ++g) { const f32x4 dv = *(const LAS f32x4*)(DX + 32 * kb + 8 * g + 4 * hi);
                S[kb][4 * g] *= dv[0]; S[kb][4 * g + 1] *= dv[1]; S[kb][4 * g + 2] *= dv[2]; S[kb][4 * g + 3] *= dv[3]; }
        LAS float* rp = red + (n & 1) * 512;
#pragma unroll
        for (int ib = 0; ib < 2; ++ib) { float ss = 0.f;
#pragma unroll
            for (int r = 0; r < 16; ++r) ss += oT[ib][r] * oT[ib][r];
            ss += __shfl_xor(ss, 32);
            if (hi == 0) rp[wave * 64 + 32 * ib + r32] = ss; }
        if (n + 1 < GLA_NCH && tid < 32) *(LAS f32x4*)(dxL + ((n + 1) & 1) * 128 + 4 * tid) = dxn;
        asm volatile("s_waitcnt vmcnt(0)" ::: "memory");
        __syncthreads();
        if (probe_skip != 1)
#pragma unroll
        for (int ib = 0; ib < 2; ++ib) { float tot = 0.f;
#pragma unroll
            for (int w = 0; w < 8; ++w) tot += rp[w * 64 + 32 * ib + r32];
            const float rstd = __builtin_amdgcn_rsqf(tot * (1.0f / 256.0f) + EPS);
            const int t = t0 + 32 * ib + r32;
            bf16* orow = OG + (size_t)t * DMODEL + h * 256 + 32 * wave + 4 * hi;
#pragma unroll
            for (int g = 0; g < 4; ++g) { const int ri = 32 * ib + r32; const v2u rwv = *(const LAS v2u*)(rwl + ri * 64 + ((g ^ ((ri >> 2) & 3)) << 4) + 8 * hi);
                *(GAS v2u*)(orow + 8 * g) = (v2u){cvtpk(oT[ib][4 * g] * rstd * bflo(rwv.x), oT[ib][4 * g + 1] * rstd * bfhi(rwv.x)), cvtpk(oT[ib][4 * g + 2] * rstd * bflo(rwv.y), oT[ib][4 * g + 3] * rstd * bfhi(rwv.y))};
                __builtin_amdgcn_sched_barrier(0); } }
        if (n + 1 < GLA_NCH) {
#pragma unroll
            for (int s = 0; s < 4; ++s) vf[s] = *(const LAS bf16x8*)(vtw + (((2 * s + hi) ^ kx0) << 4));
            asm volatile("s_waitcnt lgkmcnt(0)" ::: "memory");
            P2B_DMA_R(t0 + GLA_C); }
    }
#undef P2B_DMA_V
#undef P2B_DMA_R
#undef P2B_DMA
}
__device__ __forceinline__ unsigned mono(float f) { const unsigned u = __builtin_bit_cast(unsigned, f); return (u & 0x80000000u) ? ~u : (u | 0x80000000u); }
__device__ __forceinline__ float unmono(unsigned m) { const unsigned u = (m & 0x80000000u) ? (m ^ 0x80000000u) : ~m; return __builtin_bit_cast(float, u); }
#define KMAX(a, b) ((a) > (b) ? (a) : (b))
#define KMIN(a, b) ((a) < (b) ? (a) : (b))
#define INSERT16(L, x) do { unsigned x_ = (x); _Pragma("unroll") for (int p_ = 0; p_ < 16; ++p_) { const unsigned t_ = KMAX(L[p_], x_); x_ = KMIN(L[p_], x_); L[p_] = t_; } } while (0)
#define MERGE16(L, O) do { _Pragma("unroll") for (int p_ = 0; p_ < 16; ++p_) L[p_] = KMAX(L[p_], O[15 - p_]); \
    _Pragma("unroll") for (int st_ = 8; st_ >= 1; st_ >>= 1) { _Pragma("unroll") for (int p_ = 0; p_ < 16; ++p_) { if ((p_ & st_) == 0) { const unsigned a_ = L[p_], b_ = L[p_ + st_]; L[p_] = KMAX(a_, b_); L[p_ + st_] = KMIN(a_, b_); } } } } while (0)
#define SORT16(L) do { _Pragma("unroll") for (int k_ = 2; k_ <= 16; k_ <<= 1) { _Pragma("unroll") for (int j_ = k_ >> 1; j_ >= 1; j_ >>= 1) { _Pragma("unroll") for (int i_ = 0; i_ < 16; ++i_) { \
    if ((i_ & j_) == 0) { const unsigned a_ = L[i_], b_ = L[i_ | j_]; const bool desc_ = ((i_ & k_) == 0) || (k_ == 16); L[i_] = desc_ ? KMAX(a_, b_) : KMIN(a_, b_); L[i_ | j_] = desc_ ? KMIN(a_, b_) : KMAX(a_, b_); } } } } } while (0)
__device__ __forceinline__ void p5_wave(int lane, const LAS unsigned short* row, LAS int* idsL, LAS float* gatesL) {
    const int q = lane & 3, c = (lane >> 2) & 1, head = lane >> 3, r8 = lane & 7;
    const LAS unsigned short* mine = row + lane * 32;
    unsigned L[16], O[16];
    const int sw = (lane >> 2) & 3;
#pragma unroll
    for (int it = 0; it < 4; ++it) { const int c16 = it ^ sw; const v4u v = *(const LAS v4u*)(mine + 8 * c16);
#pragma unroll
        for (int e = 0; e < 8; ++e) { const int idx = q * 32 + c16 * 8 + e; const unsigned wv = v[e >> 1]; const float sv = (e & 1) ? bfhi(wv) : bflo(wv);
            const unsigned key = (mono(sv) & ~127u) | (unsigned)(127 - idx); if (it < 2) L[8 * it + e] = key; else O[8 * (it - 2) + e] = key; } }
    SORT16(L); SORT16(O); MERGE16(L, O);
#pragma unroll
    for (int p = 0; p < 16; ++p) O[p] = __shfl_xor(L[p], 1);
    MERGE16(L, O);
#pragma unroll
    for (int p = 0; p < 16; ++p) O[p] = __shfl_xor(L[p], 2);
    MERGE16(L, O);
#pragma unroll
    for (int p = 0; p < 16; ++p) O[p] = __shfl_xor(L[p], 4);
    unsigned A[16], B[16];
#pragma unroll
    for (int p = 0; p < 16; ++p) { A[p] = c ? O[p] : L[p]; B[p] = c ? L[p] : O[p]; }
    unsigned ka = A[0], kb8 = A[8];
#pragma unroll
    for (int p = 1; p < 8; ++p) { ka = (r8 == p) ? A[p] : ka; kb8 = (r8 == p) ? A[8 + p] : kb8; }
    const float va = unmono(ka & ~127u), va8 = unmono(kb8 & ~127u);
    const unsigned pa = ((127u - (ka & 127u)) << 7), pa8 = ((127u - (kb8 & 127u)) << 7);
    const int nvalid = 16 / (r8 + 1);
    unsigned Cn[16];
#pragma unroll
    for (int j = 0; j < 16; ++j) { const float vb = unmono(B[j] & ~127u); const unsigned pb = 127u - (B[j] & 127u);
        const unsigned key = (mono(va + vb) & ~16383u) | pa | pb; Cn[j] = (j < nvalid) ? key : 0u; }
    { const float vb0 = unmono(B[0] & ~127u); const unsigned pb0 = 127u - (B[0] & 127u); const unsigned key = (mono(va8 + vb0) & ~16383u) | pa8 | pb0; INSERT16(Cn, key); }
#pragma unroll
    for (int p = 0; p < 16; ++p) O[p] = __shfl_xor(Cn[p], 1);
    MERGE16(Cn, O);
#pragma unroll
    for (int p = 0; p < 16; ++p) O[p] = __shfl_xor(Cn[p], 2);
    MERGE16(Cn, O);
#pragma unroll
    for (int p = 0; p < 16; ++p) O[p] = __shfl_xor(Cn[p], 4);
    MERGE16(Cn, O);
    unsigned k0 = Cn[0], k1 = Cn[8];
#pragma unroll
    for (int p = 1; p < 8; ++p) { k0 = (r8 == p) ? Cn[p] : k0; k1 = (r8 == p) ? Cn[8 + p] : k1; }
    const int ia0 = (k0 >> 7) & 127, ib0 = k0 & 127, ia1 = (k1 >> 7) & 127, ib1 = k1 & 127;
    const LAS unsigned short* hrow = row + head * 256;
    const float s0 = bf2f(hrow[ia0]) + bf2f(hrow[128 + ib0]), s1 = bf2f(hrow[ia1]) + bf2f(hrow[128 + ib1]);
    float mx = fmaxf(s0, s1);
    mx = fmaxf(mx, __shfl_xor(mx, 1)); mx = fmaxf(mx, __shfl_xor(mx, 2)); mx = fmaxf(mx, __shfl_xor(mx, 4));
    const float e0 = __expf(s0 - mx), e1 = __expf(s1 - mx);
    float sm = e0 + e1;
    sm += __shfl_xor(sm, 1); sm += __shfl_xor(sm, 2); sm += __shfl_xor(sm, 4);
    const float inv = 1.0f / sm;
    const int o = head * 16 + r8;
    idsL[o] = ia0 * 128 + ib0; idsL[o + 8] = ia1 * 128 + ib1; gatesL[o] = e0 * inv; gatesL[o + 8] = e1 * inv;
}
typedef float f32x2 __attribute__((ext_vector_type(2)));
typedef int i32x8 __attribute__((ext_vector_type(8)));
#ifndef MFMA_U
#define MFMA_U 1
#endif
#define FP4_CVT(W, SEL) __builtin_amdgcn_cvt_scalef32_pk_f32_fp4((W), 1.0f, (SEL))
template <bool FINAL>
__device__ __forceinline__ void peer_gather(Frame& F, int layer, const bf16* HBin, float* Hout, bf16* HB, float* RP) {
    const int lane = F.lane, half = lane >> 5; const int gw = blockIdx.x * NWAVES + F.wave, NGW = F.G * NWAVES;
    const unsigned char* UT = F.ws + WS_TAB + (size_t)(2 * layer) * PEER_NEXP * 512; const unsigned char* VT = UT + (size_t)PEER_NEXP * 512;
    const float* USC = (const float*)(F.ws + WS_TSC) + (size_t)(2 * layer) * PEER_NEXP; const float* VSC = USC + PEER_NEXP;
    const float* gf = F.in[IN_NORM_FFN] + layer * DMODEL; const float* gfin = F.in[IN_NORM_FINAL];
    LAS unsigned short* rowL = (LAS unsigned short*)(F.lds + F.wave * 8192);
    LAS int* idsL = (LAS int*)(F.lds + 65536 + F.wave * 1024); LAS float* gatesL = (LAS float*)(F.lds + 65536 + F.wave * 1024 + 512);
    LAS float* actL = (LAS float*)(F.lds + 73728 + F.wave * 512);
    LAS unsigned char* xbL = (LAS unsigned char*)(F.lds + 143360 + F.wave * 1024);
    const bf16* SC = (const bf16*)(F.ws + WS_SC);
    LAS float* wfl = (LAS float*)(F.lds + 77824);
    if (!FINAL) { const f32x4* src = (const f32x4*)(F.ws + WS_WFLF);
#pragma unroll
        for (int i = 0; i < 8; ++i) { const int ch = F.tid + 512 * i, c = ch >> 8, jb = (ch >> 3) & 31, q = ch & 7; *(LAS f32x4*)(wfl + c * 1024 + jb * 32 + ((q ^ (jb & 7)) << 2)) = src[ch]; }
        __syncthreads(); }
    const unsigned rowA = (unsigned)(uintptr_t)F.lds + F.wave * 8192;
#define ROW_DMA(tt) do { const char* r_ = (const char*)(SC + (size_t)(tt) * 2048); _Pragma("unroll") for (int i_ = 0; i_ < 4; ++i_) glds16s(r_, (unsigned)(lane * 16 + i_ * 1024), (unsigned)__builtin_amdgcn_readfirstlane(rowA + i_ * 1024)); } while (0)
    gu32* tctr = F.ctl + 2048 + 64 * (8 * layer + ((int)blockIdx.x & 7)); const int tg = (int)blockIdx.x & 7;
    int kcur = 0;
    if (lane == 0) kcur = (int)__hip_atomic_fetch_add(tctr, 1u, __ATOMIC_RELAXED, __HIP_MEMORY_SCOPE_AGENT);
    kcur = __builtin_amdgcn_readfirstlane(kcur);
    if (kcur < T_TOK / 8) ROW_DMA(8 * kcur + tg);
    while (kcur < T_TOK / 8) {
        const int t = 8 * kcur + tg;
        int j32 = lane & 31; asm volatile("" : "+v"(j32));
        asm volatile("s_waitcnt vmcnt(0)" ::: "memory");
        const GAS v4u* hin = (const GAS v4u*)(HBin + (size_t)t * DMODEL) + 4 * j32;
        v4u hw[4];
#pragma unroll
        for (int q = 0; q < 4; ++q) hw[q] = hin[q];
        int knext = 0;
        if (lane == 0) knext = (int)__hip_atomic_fetch_add(tctr, 1u, __ATOMIC_RELAXED, __HIP_MEMORY_SCOPE_AGENT);
        p5_wave(lane, rowL, idsL, gatesL);
        asm volatile("s_waitcnt lgkmcnt(0)" ::: "memory");
        knext = __builtin_amdgcn_readfirstlane(knext);
        if (knext < T_TOK / 8) ROW_DMA(8 * knext + tg);
#if MFMA_U
        int l16 = lane & 15, lq = lane >> 4; asm volatile("" : "+v"(l16)); asm volatile("" : "+v"(lq));
        int one_e8 = 0x7f7f7f7f; asm volatile("" : "+v"(one_e8));
        v4u xb[8]; float xsc;
        { float ss = 0.f; f32x4 hv[8];
#pragma unroll
          for (int q = 0; q < 4; ++q) { const v4u w = hw[q]; hv[2 * q] = (f32x4){bflo(w.x), bfhi(w.x), bflo(w.y), bfhi(w.y)}; hv[2 * q + 1] = (f32x4){bflo(w.z), bfhi(w.z), bflo(w.w), bfhi(w.w)}; }
#pragma unroll
          for (int q = 0; q < 8; ++q) { ss += (hv[q][0] * hv[q][0] + hv[q][1] * hv[q][1]) + (hv[q][2] * hv[q][2] + hv[q][3] * hv[q][3]); }
          const float rstd = __builtin_amdgcn_rsqf(wave_sum(ss) * (0.5f / DMODEL) + EPS);
          const f32x4* g4 = (const f32x4*)gf + 8 * j32;
          float mx = 0.f;
#pragma unroll
          for (int q = 0; q < 8; ++q) { const f32x4 g = g4[q]; hv[q] = (f32x4){hv[q][0] * rstd * g[0], hv[q][1] * rstd * g[1], hv[q][2] * rstd * g[2], hv[q][3] * rstd * g[3]};
              mx = fmaxf(mx, fmaxf(fmaxf(fabsf(hv[q][0]), fabsf(hv[q][1])), fmaxf(fabsf(hv[q][2]), fabsf(hv[q][3])))); }
          mx = wave_max(mx);
          const float enc = (mx > 0.f) ? 6.0f * __builtin_amdgcn_rcpf(mx) : 1.0f; xsc = (mx > 0.f) ? mx * (1.0f / 6.0f) : 1.0f;
          unsigned xw[4];
#pragma unroll
          for (int q = 0; q < 4; ++q) { unsigned w = 0;
              w = __builtin_amdgcn_cvt_scalef32_pk_fp4_f32(w, hv[2 * q][0] * enc, hv[2 * q][1] * enc, 1.0f, 0); w = __builtin_amdgcn_cvt_scalef32_pk_fp4_f32(w, hv[2 * q][2] * enc, hv[2 * q][3] * enc, 1.0f, 1);
              w = __builtin_amdgcn_cvt_scalef32_pk_fp4_f32(w, hv[2 * q + 1][0] * enc, hv[2 * q + 1][1] * enc, 1.0f, 2); w = __builtin_amdgcn_cvt_scalef32_pk_fp4_f32(w, hv[2 * q + 1][2] * enc, hv[2 * q + 1][3] * enc, 1.0f, 3); xw[q] = w; }
          if (half == 0) *(LAS v4u*)(xbL + j32 * 16) = (v4u){xw[0], xw[1], xw[2], xw[3]};
          const LAS v4u* xbr = (const LAS v4u*)(xbL + lq * 16);
#pragma unroll
          for (int kb = 0; kb < 8; ++kb) xb[kb] = xbr[4 * kb]; }
        __builtin_amdgcn_sched_barrier(0);
#else
        typedef __bf16 bf16x2_t __attribute__((ext_vector_type(2)));
        bf16x2_t xv[16];
        { float ss = 0.f; f32x4 hv[8];
#pragma unroll
          for (int q = 0; q < 4; ++q) { const v4u w = hw[q]; hv[2 * q] = (f32x4){bflo(w.x), bfhi(w.x), bflo(w.y), bfhi(w.y)}; hv[2 * q + 1] = (f32x4){bflo(w.z), bfhi(w.z), bflo(w.w), bfhi(w.w)}; }
#pragma unroll
          for (int q = 0; q < 8; ++q) { ss += (hv[q][0] * hv[q][0] + hv[q][1] * hv[q][1]) + (hv[q][2] * hv[q][2] + hv[q][3] * hv[q][3]); }
          const float rstd = __builtin_amdgcn_rsqf(wave_sum(ss) * (0.5f / DMODEL) + EPS);
          const f32x4* g4 = (const f32x4*)gf + 8 * j32;
#pragma unroll
          for (int q = 0; q < 8; ++q) { const f32x4 g = g4[q]; xv[2 * q] = __builtin_bit_cast(bf16x2_t, cvtpk(hv[q][0] * rstd * g[0], hv[q][1] * rstd * g[1])); xv[2 * q + 1] = __builtin_bit_cast(bf16x2_t, cvtpk(hv[q][2] * rstd * g[2], hv[q][3] * rstd * g[3])); } }
#endif
        const int id0 = idsL[lane], id1 = idsL[64 + lane];
        const float gt0 = gatesL[lane], gt1 = gatesL[64 + lane];
        const float su0 = USC[id0], su1 = USC[id1], sv0 = VSC[id0], sv1 = VSC[id1];
#if MFMA_U
        for (int bt = 0; bt < 2; ++bt) {
            const float gtv = bt ? gt1 : gt0, suv = bt ? su1 : su0, svv = bt ? sv1 : sv0;
            v4u uw[4][8];
#pragma unroll
            for (int g = 0; g < 4; ++g) { const int e = idsL[64 * bt + 16 * g + l16]; const GAS v4u* rp = (const GAS v4u*)(UT + (size_t)e * 512) + lq;
#pragma unroll
                for (int kb = 0; kb < 8; ++kb) uw[g][kb] = rp[4 * kb]; }
            __builtin_amdgcn_sched_barrier(0);
            f32x4 ac[4];
#pragma unroll
            for (int g = 0; g < 4; ++g) { f32x4 a = (f32x4){0.f, 0.f, 0.f, 0.f};
#pragma unroll
                for (int kb = 0; kb < 8; ++kb) { const v4u w = uw[g][kb];
                    const v4u xk = xb[kb];
                    a = __builtin_amdgcn_mfma_scale_f32_16x16x128_f8f6f4((i32x8){(int)w.x, (int)w.y, (int)w.z, (int)w.w, 0, 0, 0, 0}, (i32x8){(int)xk.x, (int)xk.y, (int)xk.z, (int)xk.w, 0, 0, 0, 0}, a, 4, 4, 0, one_e8, 0, one_e8); }
                ac[g] = a; }
            const int gs = (lane >> 2) & 3, rr = lane & 3;
            const f32x4 sg = gs == 0 ? ac[0] : gs == 1 ? ac[1] : gs == 2 ? ac[2] : ac[3];
            const float r1 = rr == 0 ? sg[0] : rr == 1 ? sg[1] : rr == 2 ? sg[2] : sg[3];
            const int xb_ = 16 * gs + 4 * lq + rr;
            const float gte = __shfl(gtv, xb_), sue = __shfl(suv, xb_), sve = __shfl(svv, xb_);
            const float d = r1 * sue * xsc;
            const float act = 0.5f * d * (1.0f + erff(d * 0.70710678118654752f)) * gte * sve;
            actL[64 * bt + xb_] = act;
        }
#else
        for (int bt = 0; bt < 2; ++bt) {
            const int idv = bt ? id1 : id0; const float gtv = bt ? gt1 : gt0, suv = bt ? su1 : su0, svv = bt ? sv1 : sv0;
            v4u uw[32];
#pragma unroll
            for (int p = 0; p < 32; ++p) { const int ea = __builtin_amdgcn_readlane(idv, 2 * p), eb = __builtin_amdgcn_readlane(idv, 2 * p + 1); const int e = half ? eb : ea;
                uw[p] = ((const GAS v4u*)(UT + (size_t)e * 512))[j32]; }
            float pd[32];
#pragma unroll
            for (int p = 0; p < 32; ++p) { float sa = 0.f, sb = 0.f;
#pragma unroll
                for (int w = 0; w < 4; ++w) { const unsigned ww = uw[p][w];
                    sa = __builtin_amdgcn_fdot2_f32_bf16(__builtin_amdgcn_cvt_scalef32_pk_bf16_fp4(ww, 1.0f, 0), xv[4 * w], sa, false); sb = __builtin_amdgcn_fdot2_f32_bf16(__builtin_amdgcn_cvt_scalef32_pk_bf16_fp4(ww, 1.0f, 1), xv[4 * w + 1], sb, false);
                    sa = __builtin_amdgcn_fdot2_f32_bf16(__builtin_amdgcn_cvt_scalef32_pk_bf16_fp4(ww, 1.0f, 2), xv[4 * w + 2], sa, false); sb = __builtin_amdgcn_fdot2_f32_bf16(__builtin_amdgcn_cvt_scalef32_pk_bf16_fp4(ww, 1.0f, 3), xv[4 * w + 3], sb, false); }
                pd[p] = sa + sb; }
            float r16[16], r8[8], r4[4], r2[2], r1;
            { const bool up = (lane & 16) != 0;
#pragma unroll
              for (int p = 0; p < 16; ++p) { const float keep = up ? pd[p + 16] : pd[p], send = up ? pd[p] : pd[p + 16]; r16[p] = keep + __shfl_xor(send, 16); } }
            { const bool up = (lane & 8) != 0;
#pragma unroll
              for (int p = 0; p < 8; ++p) { const float keep = up ? r16[p + 8] : r16[p], send = up ? r16[p] : r16[p + 8]; r8[p] = keep + __shfl_xor(send, 8); } }
            { const bool up = (lane & 4) != 0;
#pragma unroll
              for (int p = 0; p < 4; ++p) { const float keep = up ? r8[p + 4] : r8[p], send = up ? r8[p] : r8[p + 4]; r4[p] = keep + __shfl_xor(send, 4); } }
            { const bool up = (lane & 2) != 0;
#pragma unroll
              for (int p = 0; p < 2; ++p) { const float keep = up ? r4[p + 2] : r4[p], send = up ? r4[p] : r4[p + 2]; r2[p] = keep + __shfl_xor(send, 2); } }
            { const bool up = (lane & 1) != 0; const float keep = up ? r2[1] : r2[0], send = up ? r2[0] : r2[1]; r1 = keep + __shfl_xor(send, 1); }
            const int xb = 2 * (16 * ((lane >> 4) & 1) + 8 * ((lane >> 3) & 1) + 4 * ((lane >> 2) & 1) + 2 * ((lane >> 1) & 1) + (lane & 1)) + half;
            const float gte = __shfl(gtv, xb), sue = __shfl(suv, xb), sve = __shfl(svv, xb);
            const float d = r1 * sue;
            const float act = 0.5f * d * (1.0f + erff(d * 0.70710678118654752f)) * gte * sve;
            actL[64 * bt + xb] = act;
        }
#endif
        v4u hw2[4];
#pragma unroll
        for (int q = 0; q < 4; ++q) hw2[q] = hin[q];
        f32x2 acc[16];
#pragma unroll
        for (int e = 0; e < 16; ++e) acc[e] = (f32x2){0.f, 0.f};
        for (int bt = 0; bt < 2; ++bt) {
            const int idv = bt ? id1 : id0;
            v4u vw[32];
#pragma unroll
            for (int p = 0; p < 32; ++p) { const int ea = __builtin_amdgcn_readlane(idv, 2 * p), eb = __builtin_amdgcn_readlane(idv, 2 * p + 1); const int e = half ? eb : ea;
                vw[p] = ((const GAS v4u*)(VT + (size_t)e * 512))[j32]; }
            const LAS float* ap = actL + 64 * bt + half;
#pragma unroll
            for (int p = 0; p < 32; ++p) { const float w1 = ap[2 * p]; const f32x2 w2 = (f32x2){w1, w1};
#pragma unroll
                for (int w = 0; w < 4; ++w) { const unsigned ww = vw[p][w];
                    acc[4 * w] += w2 * FP4_CVT(ww, 0); acc[4 * w + 1] += w2 * FP4_CVT(ww, 1); acc[4 * w + 2] += w2 * FP4_CVT(ww, 2); acc[4 * w + 3] += w2 * FP4_CVT(ww, 3); } }
        }
        float s2 = 0.f; f32x4 hn[8];
#pragma unroll
        for (int q = 0; q < 8; ++q) { const v4u w = hw2[q >> 1]; const f32x4 hv = (q & 1) ? (f32x4){bflo(w.z), bfhi(w.z), bflo(w.w), bfhi(w.w)} : (f32x4){bflo(w.x), bfhi(w.x), bflo(w.y), bfhi(w.y)};
            const float a0 = acc[2 * q].x + __shfl_xor(acc[2 * q].x, 32), a1 = acc[2 * q].y + __shfl_xor(acc[2 * q].y, 32), a2 = acc[2 * q + 1].x + __shfl_xor(acc[2 * q + 1].x, 32), a3 = acc[2 * q + 1].y + __shfl_xor(acc[2 * q + 1].y, 32);
            hn[q] = (f32x4){hv[0] + a0, hv[1] + a1, hv[2] + a2, hv[3] + a3};
            s2 += (hn[q][0] * hn[q][0] + hn[q][1] * hn[q][1]) + (hn[q][2] * hn[q][2] + hn[q][3] * hn[q][3]); }
        s2 = wave_sum(s2) * 0.5f;
        const float rs = __builtin_amdgcn_rsqf(s2 * (1.0f / DMODEL) + EPS);
        if (FINAL) {
            const f32x4* g4 = (const f32x4*)gfin + 8 * j32; f32x4* hrow = (f32x4*)(Hout + (size_t)t * DMODEL) + 8 * j32;
            if (half == 0) {
#pragma unroll
                for (int q = 0; q < 8; ++q) { const f32x4 g = g4[q]; hrow[q] = (f32x4){hn[q][0] * rs * g[0], hn[q][1] * rs * g[1], hn[q][2] * rs * g[2], hn[q][3] * rs * g[3]}; } }
        } else {
            if (half == 0) {
                GAS v4u* hbp = (GAS v4u*)(HB + (size_t)t * DMODEL) + 4 * j32;
#pragma unroll
                for (int q = 0; q < 4; ++q) hbp[q] = (v4u){pk2(hn[2 * q][0], hn[2 * q][1]), pk2(hn[2 * q][2], hn[2 * q][3]), pk2(hn[2 * q + 1][0], hn[2 * q + 1][1]), pk2(hn[2 * q + 1][2], hn[2 * q + 1][3])}; }
            if (lane < 16) RP[(size_t)t * 16 + lane] = (lane == 0) ? s2 : 0.f;
            float pf[16];
#pragma unroll
            for (int c = 0; c < 16; ++c) { float a = 0.f;
#pragma unroll
                for (int q = 0; q < 8; ++q) { const f32x4 wv = *(const LAS f32x4*)(wfl + c * 1024 + j32 * 32 + ((q ^ (j32 & 7)) << 2)); a += (hn[q][0] * wv[0] + hn[q][1] * wv[1]) + (hn[q][2] * wv[2] + hn[q][3] * wv[3]); }
                pf[c] = a; __builtin_amdgcn_sched_barrier(0); }
            float f8[8], f4[4], f2[2], f1;
            { const bool up = (lane & 16) != 0;
#pragma unroll
              for (int p = 0; p < 8; ++p) { const float keep = up ? pf[p + 8] : pf[p], send = up ? pf[p] : pf[p + 8]; f8[p] = keep + __shfl_xor(send, 16); } }
            { const bool up = (lane & 8) != 0;
#pragma unroll
              for (int p = 0; p < 4; ++p) { const float keep = up ? f8[p + 4] : f8[p], send = up ? f8[p] : f8[p + 4]; f4[p] = keep + __shfl_xor(send, 8); } }
            { const bool up = (lane & 4) != 0;
#pragma unroll
              for (int p = 0; p < 2; ++p) { const float keep = up ? f4[p + 2] : f4[p], send = up ? f4[p] : f4[p + 2]; f2[p] = keep + __shfl_xor(send, 4); } }
            { const bool up = (lane & 2) != 0; const float keep = up ? f2[1] : f2[0], send = up ? f2[0] : f2[1]; f1 = keep + __shfl_xor(send, 2); }
            f1 += __shfl_xor(f1, 1);
            if ((lane & 33) == 0) ((float*)(F.ws + WS_FL))[(size_t)t * 16 + 8 * ((lane >> 4) & 1) + 4 * ((lane >> 3) & 1) + 2 * ((lane >> 2) & 1) + ((lane >> 1) & 1)] = f1 * rs;
        }
        kcur = knext;
    }
}

#undef ROW_DMA
__device__ __forceinline__ void p7_forget_logits(Frame& F) {
    const int rows0 = F.vcu * 64;
    for (int r0 = rows0; r0 < T_TOK; r0 += F.G * 64) {
        const f32x4 a = skinny16((const bf16*)(F.ws + WS_HB) + (size_t)r0 * DMODEL, (const bf16*)(F.ws + WS_WFL), F.wave, F.lane, (LAS float*)F.lds);
        if (F.wave < 4) {
#pragma unroll
            for (int r = 0; r < 4; ++r) { const int row = r0 + 16 * F.wave + 4 * (F.lane >> 4) + r; const float rs = pg8::row_rstd((const float*)(F.ws + WS_RP), row);
                ((float*)(F.ws + WS_FL))[(size_t)row * 16 + (F.lane & 15)] = a[r] * rs; } }
        __syncthreads(); }
}
template <class Sched> __device__ __forceinline__ void rstd_table(Frame& F, const Sched& S, LAS float* tab, int& pm0, int& pm1) {
    pm0 = -1; pm1 = -1;
#pragma unroll
    for (int i = 0; i < 3; ++i) { pg8::Unit u; if (S.next(i, u)) { if (i == 0) pm0 = u.pm; if (i == 1) pm1 = u.pm;
        if (F.tid < 256) tab[i * 256 + F.tid] = pg8::row_rstd((const float*)(F.ws + WS_RP), u.pm * 256 + F.tid); } }
    __syncthreads();
}
__device__ __forceinline__ void p9_key_bias(Frame& F, int bh, LAS float* cbL, LAS float* scr  ) {
    const int b = bh >> 4, hd = bh & 15, tid = F.tid;
    const float* FL = (const float*)(F.ws + WS_FL) + (size_t)b * SEQ * 16 + hd; const float bf = F.in[IN_FOX_B_F][hd];
    float v[4];
#pragma unroll
    for (int e = 0; e < 4; ++e) v[e] = log_sigmoid(FL[(size_t)(4 * tid + e) * 16] + bf);
    v[1] += v[0]; v[2] += v[1]; v[3] += v[2];
    float inc = v[3];
#pragma unroll
    for (int o = 1; o < 64; o <<= 1) { const float y = __shfl_up(inc, o); if (F.lane >= o) inc += y; }
    if (F.lane == 63) scr[F.wave] = inc;
    __syncthreads();
    float woff = 0.f;
#pragma unroll
    for (int w = 0; w < 8; ++w) { const float sv = scr[w]; if (w < F.wave) woff += sv; }
    const float excl = woff + inc - v[3];
    *(LAS f32x4*)(cbL + 4 * tid) = (f32x4){-L2E * (excl + v[0]), -L2E * (excl + v[1]), -L2E * (excl + v[2]), -L2E * (excl + v[3])};
    __syncthreads();
}
__device__ __forceinline__ float u2f_(unsigned u) { return __builtin_bit_cast(float, u); }
#ifndef VCH
#define VCH 16
#endif
#ifndef REF_V
#define REF_V 0
#endif
#ifndef REF_U
#define REF_U 0
#endif
#ifndef NSLICE_LOG
#define NSLICE_LOG 2
#endif
template <bool FINAL, int STAGE>
__device__ __forceinline__ void peer_gather_sl(Frame& F, int layer, const bf16* HBin, float* Hout, bf16* HB, float* RP) {
    constexpr int NSL = 1 << NSLICE_LOG;
    const int lane = F.lane;
    const unsigned char* UT = F.ws + WS_TAB + (size_t)(2 * layer) * PEER_NEXP * 512; const unsigned char* VT = UT + (size_t)PEER_NEXP * 512;
    const float* USC = (const float*)(F.ws + WS_TSC) + (size_t)(2 * layer) * PEER_NEXP; const float* VSC = USC + PEER_NEXP;
    const float* gf = F.in[IN_NORM_FFN] + layer * DMODEL; const float* gfin = F.in[IN_NORM_FINAL];
    LAS unsigned short* rowL = (LAS unsigned short*)(F.lds + F.wave * 8192);
    LAS v2u* metaL = (LAS v2u*)(F.lds + F.wave * 8192 + 4096);
    LAS int* idsL = (LAS int*)(F.lds + 65536 + F.wave * 1024); LAS float* gatesL = (LAS float*)(F.lds + 65536 + F.wave * 1024 + 512);
    LAS unsigned char* xqL = (LAS unsigned char*)(F.lds + 73728 + F.wave * 2048);
    LAS unsigned char* accL = (LAS unsigned char*)(F.lds + 90112 + F.wave * 8192);
    const bf16* SC = (const bf16*)(F.ws + WS_SC);
    const unsigned rowA = (unsigned)(uintptr_t)F.lds + F.wave * 8192;
#define ROW_DMA(tt, ln_) do { const char* r_ = (const char*)(SC + (size_t)__builtin_amdgcn_readfirstlane(tt) * 2048); _Pragma("unroll") for (int i_ = 0; i_ < 4; ++i_) glds16s(r_, (unsigned)((ln_) * 16 + i_ * 1024), (unsigned)__builtin_amdgcn_readfirstlane(rowA + i_ * 1024)); } while (0)
    gu32* tctr = F.ctl + 2048 + 64 * ((STAGE == 1 ? 16 : 0) + 8 * layer + ((int)blockIdx.x & 7)); const int tg = (int)blockIdx.x & 7;
    v2u* const metaG = (v2u*)(F.ws + WS_IDS);
#define TOK_(kq_, i_) (2048 * tg + 4 * (kq_) + (i_))
    int kq = 0;
    if (lane == 0) kq = (int)__hip_atomic_fetch_add(tctr, 1u, __ATOMIC_RELAXED, __HIP_MEMORY_SCOPE_AGENT);
    kq = __builtin_amdgcn_readfirstlane(kq);
    if (STAGE != 1) { if (kq < T_TOK / 32) ROW_DMA(TOK_(kq, 0), lane); }
    while (kq < T_TOK / 32) {
        int kqn = 0;
        LAS unsigned* rstL = (LAS unsigned*)(F.lds + MISC_OFF + 256 + F.wave * 64);
        if (STAGE != 1) {
        { int l64 = lane; asm volatile("" : "+v"(l64));
          unsigned zz = 0u; asm volatile("" : "+v"(zz));
          v4u hw0[4], hw1[4];
#pragma unroll
          for (int i = 0; i < 4; ++i) { const GAS v4u* hin = (const GAS v4u*)(HBin + (size_t)(TOK_(kq, i)) * DMODEL) + 2 * l64; hw0[i] = hin[0]; hw1[i] = hin[1]; }
          const f32x4* g4 = (const f32x4*)gf + 4 * l64;
          f32x4 gq[4];
#pragma unroll
          for (int q = 0; q < 4; ++q) gq[q] = g4[q];
#pragma unroll
          for (int i = 0; i < 4; ++i) { float hv[16];
#pragma unroll
              for (int k = 0; k < 4; ++k) { hv[2 * k] = bflo(hw0[i][k]); hv[2 * k + 1] = bfhi(hw0[i][k]); hv[8 + 2 * k] = bflo(hw1[i][k]); hv[8 + 2 * k + 1] = bfhi(hw1[i][k]); }
              float ss = 0.f;
#pragma unroll
              for (int e = 0; e < 16; ++e) ss += hv[e] * hv[e];
              const float rstd = __builtin_amdgcn_rsqf(wave_sum(ss) * (1.0f / DMODEL) + EPS);
              float mx = 0.f;
#pragma unroll
              for (int q = 0; q < 4; ++q) {
#pragma unroll
                  for (int e = 0; e < 4; ++e) { hv[4 * q + e] = hv[4 * q + e] * rstd * gq[q][e]; mx = fmaxf(mx, fabsf(hv[4 * q + e])); } }
              mx = wave_max(mx);
              const float enc = (mx > 0.f) ? 6.0f * __builtin_amdgcn_rcpf(mx) : 1.0f; const float xsc = (mx > 0.f) ? mx * (1.0f / 6.0f) : 1.0f;
              unsigned w0 = 0, w1 = 0;
              w0 = __builtin_amdgcn_cvt_scalef32_pk_fp4_f32(w0, hv[0] * enc, hv[1] * enc, 1.0f, 0); w0 = __builtin_amdgcn_cvt_scalef32_pk_fp4_f32(w0, hv[2] * enc, hv[3] * enc, 1.0f, 1);
              w0 = __builtin_amdgcn_cvt_scalef32_pk_fp4_f32(w0, hv[4] * enc, hv[5] * enc, 1.0f, 2); w0 = __builtin_amdgcn_cvt_scalef32_pk_fp4_f32(w0, hv[6] * enc, hv[7] * enc, 1.0f, 3);
              w1 = __builtin_amdgcn_cvt_scalef32_pk_fp4_f32(w1, hv[8] * enc, hv[9] * enc, 1.0f, 0); w1 = __builtin_amdgcn_cvt_scalef32_pk_fp4_f32(w1, hv[10] * enc, hv[11] * enc, 1.0f, 1);
              w1 = __builtin_amdgcn_cvt_scalef32_pk_fp4_f32(w1, hv[12] * enc, hv[13] * enc, 1.0f, 2); w1 = __builtin_amdgcn_cvt_scalef32_pk_fp4_f32(w1, hv[14] * enc, hv[15] * enc, 1.0f, 3);
              *(LAS v2u*)(xqL + i * 512 + l64 * 8) = (v2u){w0, w1};
              if (l64 == 0) rstL[i] = __builtin_bit_cast(unsigned, xsc);
              { LAS v4u* st = (LAS v4u*)(accL + i * 2048 + l64 * 32); st[0] = (v4u){zz, zz, zz, zz}; st[1] = (v4u){zz, zz, zz, zz}; } } }
#pragma nounroll
        for (int i = 0; i < 4; ++i) {
            const int t = TOK_(kq, i);
            int ln = lane; asm volatile("" : "+v"(ln));
            asm volatile("s_waitcnt vmcnt(0)" ::: "memory");
            if (i == 3) { if (ln == 0) kqn = (int)__hip_atomic_fetch_add(tctr, 1u, __ATOMIC_RELAXED, __HIP_MEMORY_SCOPE_AGENT); }
            p5_wave(ln, rowL, idsL, gatesL);
            asm volatile("s_waitcnt lgkmcnt(0)" ::: "memory");
            if (i < 3) ROW_DMA(t + 1, ln);
            else { kqn = __builtin_amdgcn_readfirstlane(kqn); if (kqn < T_TOK / 32) ROW_DMA(TOK_(kqn, 0), ln); }
            const int id0 = idsL[ln], id1 = idsL[64 + ln];
            const float gt0 = gatesL[ln], gt1 = gatesL[64 + ln];
            const float su0 = USC[id0], su1 = USC[id1], sv0 = VSC[id0], sv1 = VSC[id1];
            { const int k0 = id0 >> (14 - NSLICE_LOG), k1 = id1 >> (14 - NSLICE_LOG);
              int pos0 = 0, pos1 = 0, base = 0; unsigned offp = 0;
#pragma unroll
              for (int s = 0; s < NSL; ++s) {
                  const unsigned long long m0 = __ballot(k0 == s), m1 = __ballot(k1 == s);
                  const int c0 = __popcll(m0), c1 = __popcll(m1);
                  const int r0 = (int)__builtin_amdgcn_mbcnt_hi((unsigned)(m0 >> 32), __builtin_amdgcn_mbcnt_lo((unsigned)m0, 0u));
                  const int r1 = (int)__builtin_amdgcn_mbcnt_hi((unsigned)(m1 >> 32), __builtin_amdgcn_mbcnt_lo((unsigned)m1, 0u));
                  if (k0 == s) pos0 = base + r0;
                  if (k1 == s) pos1 = base + c0 + r1;
                  base += c0 + c1;
                  if (s < NSL - 1) offp |= (unsigned)base << (8 * s); }
              if (ln == 0) rstL[4 + i] = offp;
              const unsigned sb0 = (__builtin_bit_cast(unsigned, su0) + 0x8000u) & 0xffff0000u, sb1 = (__builtin_bit_cast(unsigned, su1) + 0x8000u) & 0xffff0000u;
              metaL[i * 128 + pos0] = (v2u){sb0 | (unsigned)id0, __builtin_bit_cast(unsigned, gt0 * sv0)};
              metaL[i * 128 + pos1] = (v2u){sb1 | (unsigned)id1, __builtin_bit_cast(unsigned, gt1 * sv1)}; }
        }
#pragma nounroll
        for (int si = 0; si < 4 * NSL; ++si) {
            const int s = si >> 2, i = si & 3;
            int ln = lane; asm volatile("" : "+v"(ln)); const int l16 = ln & 15, lq = ln >> 4;
            int one_e8 = 0x7f7f7f7f; asm volatile("" : "+v"(one_e8));
            const unsigned o = (unsigned)__builtin_amdgcn_readfirstlane((int)rstL[4 + i]);
            const float xs = u2f_(__builtin_amdgcn_readfirstlane((int)rstL[i]));
            const int lo = s == 0 ? 0 : (int)((o >> (8 * (s - 1))) & 255u), hi = s == NSL - 1 ? 128 : (int)((o >> (8 * s)) & 255u);
            const int n = hi - lo;
            if (n <= 0) continue;
#if REF_U
            {
              const int t = TOK_(__builtin_amdgcn_readfirstlane(kq), i);
              const GAS v4u* hin = (const GAS v4u*)(HBin + (size_t)t * DMODEL) + 2 * ln;
              const v4u h0 = hin[0], h1 = hin[1]; float hv[16];
#pragma unroll
              for (int k = 0; k < 4; ++k) { hv[2 * k] = bflo(h0[k]); hv[2 * k + 1] = bfhi(h0[k]); hv[8 + 2 * k] = bflo(h1[k]); hv[8 + 2 * k + 1] = bfhi(h1[k]); }
              float ss = 0.f;
#pragma unroll
              for (int e = 0; e < 16; ++e) ss += hv[e] * hv[e];
              const float rstd = __builtin_amdgcn_rsqf(wave_sum(ss) * (1.0f / DMODEL) + EPS);
              const f32x4* g4 = (const f32x4*)gf + 4 * ln;
#pragma unroll
              for (int q = 0; q < 4; ++q) { const f32x4 g = g4[q];
#pragma unroll
                  for (int e = 0; e < 4; ++e) hv[4 * q + e] = hv[4 * q + e] * rstd * g[e]; }
              LAS v2u* mt = metaL + i * 128 + lo;
              for (int p = 0; p < n; ++p) { const v2u m = mt[p]; const unsigned e = m.x & 0xffffu;
                  const v2u uw = ((const GAS v2u*)(UT + (size_t)e * 512))[ln];
                  float ds = 0.f;
#pragma unroll
                  for (int w = 0; w < 2; ++w) { const unsigned ww = uw[w];
                      const f32x2 c0 = FP4_CVT(ww, 0), c1 = FP4_CVT(ww, 1), c2 = FP4_CVT(ww, 2), c3 = FP4_CVT(ww, 3);
                      ds += c0.x * hv[8 * w] + c0.y * hv[8 * w + 1] + c1.x * hv[8 * w + 2] + c1.y * hv[8 * w + 3] + c2.x * hv[8 * w + 4] + c2.y * hv[8 * w + 5] + c3.x * hv[8 * w + 6] + c3.y * hv[8 * w + 7]; }
                  ds = wave_sum(ds);
                  const float d = ds * u2f_(m.x & 0xffff0000u);
                  const float act = 0.5f * d * (1.0f + erff(d * 0.70710678118654752f)) * u2f_(m.y);
                  if (ln == 0) ((LAS unsigned*)(mt + p))[1] = __builtin_bit_cast(unsigned, act); } }
            (void)xs; (void)l16; (void)lq; (void)one_e8;
        }
#else
            v4u xb[8];
            { const LAS v4u* xbr = (const LAS v4u*)(xqL + i * 512) + lq;
#pragma unroll
              for (int kb = 0; kb < 8; ++kb) xb[kb] = xbr[4 * kb]; }
            LAS v2u* mt = metaL + i * 128 + lo;
            for (int g0 = 0; g0 < n; g0 += 64) {
                const int rem = n - g0;
                v4u uw[4][8];
#pragma unroll
                for (int g = 0; g < 4; ++g) if (16 * g < rem) { int p = g0 + 16 * g + l16; p = p < n ? p : n - 1; const unsigned e = mt[p].x & 0xffffu; const GAS v4u* rp = (const GAS v4u*)(UT + (size_t)e * 512) + lq;
#pragma unroll
                    for (int kb = 0; kb < 8; ++kb) uw[g][kb] = rp[4 * kb]; }
                __builtin_amdgcn_sched_barrier(0);
                f32x4 ac[4];
#pragma unroll
                for (int g = 0; g < 4; ++g) { f32x4 a = (f32x4){0.f, 0.f, 0.f, 0.f};
                    if (16 * g < rem) {
                        asm volatile("s_nop 4\n\t"
                            "v_mfma_scale_f32_16x16x128_f8f6f4 %0, %1, %9, %0, %17, %17 op_sel_hi:[0,0,0] cbsz:4 blgp:4\n\t"
                            "v_mfma_scale_f32_16x16x128_f8f6f4 %0, %2, %10, %0, %17, %17 op_sel_hi:[0,0,0] cbsz:4 blgp:4\n\t"
                            "v_mfma_scale_f32_16x16x128_f8f6f4 %0, %3, %11, %0, %17, %17 op_sel_hi:[0,0,0] cbsz:4 blgp:4\n\t"
                            "v_mfma_scale_f32_16x16x128_f8f6f4 %0, %4, %12, %0, %17, %17 op_sel_hi:[0,0,0] cbsz:4 blgp:4\n\t"
                            "v_mfma_scale_f32_16x16x128_f8f6f4 %0, %5, %13, %0, %17, %17 op_sel_hi:[0,0,0] cbsz:4 blgp:4\n\t"
                            "v_mfma_scale_f32_16x16x128_f8f6f4 %0, %6, %14, %0, %17, %17 op_sel_hi:[0,0,0] cbsz:4 blgp:4\n\t"
                            "v_mfma_scale_f32_16x16x128_f8f6f4 %0, %7, %15, %0, %17, %17 op_sel_hi:[0,0,0] cbsz:4 blgp:4\n\t"
                            "v_mfma_scale_f32_16x16x128_f8f6f4 %0, %8, %16, %0, %17, %17 op_sel_hi:[0,0,0] cbsz:4 blgp:4"
                            : "+v"(a)
                            : "v"(uw[g][0]), "v"(uw[g][1]), "v"(uw[g][2]), "v"(uw[g][3]), "v"(uw[g][4]), "v"(uw[g][5]), "v"(uw[g][6]), "v"(uw[g][7]),
                              "v"(xb[0]), "v"(xb[1]), "v"(xb[2]), "v"(xb[3]), "v"(xb[4]), "v"(xb[5]), "v"(xb[6]), "v"(xb[7]), "v"(one_e8)); }
                    ac[g] = a; }
                asm volatile("s_nop 15\n\ts_nop 7" : "+v"(ac[0]), "+v"(ac[1]), "+v"(ac[2]), "+v"(ac[3]));
                const int gs = (ln >> 2) & 3, rr = ln & 3;
                const f32x4 sg = gs == 0 ? ac[0] : gs == 1 ? ac[1] : gs == 2 ? ac[2] : ac[3];
                const float r1 = rr == 0 ? sg[0] : rr == 1 ? sg[1] : rr == 2 ? sg[2] : sg[3];
                const int pp = g0 + 16 * gs + 4 * lq + rr; const bool ok = pp < n; const int pc = ok ? pp : n - 1;
                const v2u m = mt[pc];
                const float d = r1 * u2f_(m.x & 0xffff0000u) * xs;
                const float act = 0.5f * d * (1.0f + erff(d * 0.70710678118654752f)) * u2f_(m.y);
                if (ok) ((LAS unsigned*)(mt + pc))[1] = __builtin_bit_cast(unsigned, act);
            }
        }
#endif
        }
        if (STAGE == 0) {
            int ln = lane; asm volatile("" : "+v"(ln));
            const int kqs = __builtin_amdgcn_readfirstlane(kq);
#pragma unroll
            for (int i = 0; i < 4; ++i) { const int t = TOK_(kqs, i); ((GAS v4u*)(metaG + (size_t)t * 128))[ln] = ((const LAS v4u*)(metaL + i * 128))[ln]; }
        }
        if (STAGE == 1) {
            int ln = lane; asm volatile("" : "+v"(ln));
            unsigned zz = 0u; asm volatile("" : "+v"(zz));
            if (ln == 0) kqn = (int)__hip_atomic_fetch_add(tctr, 1u, __ATOMIC_RELAXED, __HIP_MEMORY_SCOPE_AGENT);
            const int kqs = __builtin_amdgcn_readfirstlane(kq);
            v4u mb[4];
#pragma unroll
            for (int i = 0; i < 4; ++i) { const int t = TOK_(kqs, i); mb[i] = ((const GAS v4u*)(metaG + (size_t)t * 128))[ln]; }
#pragma unroll
            for (int i = 0; i < 4; ++i) { ((LAS v4u*)(metaL + i * 128))[ln] = mb[i]; LAS v4u* st = (LAS v4u*)(accL + i * 2048 + ln * 32); st[0] = (v4u){zz, zz, zz, zz}; st[1] = (v4u){zz, zz, zz, zz}; }
        }
        if (STAGE != 0) {
#pragma nounroll
        for (int si = 0; si < 4 * NSL; ++si) {
            const int s = si >> 2, i = si & 3;
            int l64 = lane; asm volatile("" : "+v"(l64));
            const unsigned o = (unsigned)__builtin_amdgcn_readfirstlane((int)rstL[4 + i]);
            const int lo = s == 0 ? 0 : (int)((o >> (8 * (s - 1))) & 255u), hi = s == NSL - 1 ? 128 : (int)((o >> (8 * s)) & 255u);
            const int n = hi - lo;
            if (n <= 0) continue;
            const LAS v2u* mt = metaL + i * 128 + lo;
            f32x2 acc[8];
#pragma unroll
            for (int e = 0; e < 8; ++e) acc[e] = (f32x2){0.f, 0.f};
#if REF_V
            for (int p = 0; p < n; ++p) { const v2u m = mt[p]; const unsigned e = m.x & 0xffffu; float w1 = u2f_(m.y); asm volatile("" : "+v"(w1)); const f32x2 w2 = (f32x2){w1, w1};
                const v2u vr = ((const GAS v2u*)(VT + (size_t)e * 512))[l64];
#pragma unroll
                for (int w = 0; w < 2; ++w) { const unsigned ww = vr[w];
                    acc[4 * w] += w2 * FP4_CVT(ww, 0); acc[4 * w + 1] += w2 * FP4_CVT(ww, 1); acc[4 * w + 2] += w2 * FP4_CVT(ww, 2); acc[4 * w + 3] += w2 * FP4_CVT(ww, 3); } }
#else
            for (int c0 = 0; c0 < n; c0 += VCH) {
                const int rem = n - c0;
                int pm = c0 + (l64 & (VCH - 1)); const bool okm = pm < n; pm = okm ? pm : n - 1; const v2u m = mt[pm];
                const int idv = (int)(m.x & 0xffffu); const int avb = okm ? (int)m.y : 0;
                v2u vw[VCH];
#pragma unroll
                for (int r = 0; r < VCH; ++r) if (r < rem) { const int e = __builtin_amdgcn_readlane(idv, r); vw[r] = ((const GAS v2u*)(VT + (size_t)e * 512))[l64]; }
#pragma unroll
                for (int r = 0; r < VCH; ++r) if (r < rem) { const float w1 = u2f_(__builtin_amdgcn_readlane(avb, r)); const f32x2 w2 = (f32x2){w1, w1};
#pragma unroll
                    for (int w = 0; w < 2; ++w) { const unsigned ww = vw[r][w];
                        acc[4 * w] += w2 * FP4_CVT(ww, 0); acc[4 * w + 1] += w2 * FP4_CVT(ww, 1); acc[4 * w + 2] += w2 * FP4_CVT(ww, 2); acc[4 * w + 3] += w2 * FP4_CVT(ww, 3); } }
            }
#endif
            LAS v4u* st = (LAS v4u*)(accL + i * 2048 + l64 * 32);
            const v4u s0 = st[0], s1 = st[1];
            st[0] = (v4u){cvtpk(bflo(s0.x) + acc[0].x, bfhi(s0.x) + acc[0].y), cvtpk(bflo(s0.y) + acc[1].x, bfhi(s0.y) + acc[1].y), cvtpk(bflo(s0.z) + acc[2].x, bfhi(s0.z) + acc[2].y), cvtpk(bflo(s0.w) + acc[3].x, bfhi(s0.w) + acc[3].y)};
            st[1] = (v4u){cvtpk(bflo(s1.x) + acc[4].x, bfhi(s1.x) + acc[4].y), cvtpk(bflo(s1.y) + acc[5].x, bfhi(s1.y) + acc[5].y), cvtpk(bflo(s1.z) + acc[6].x, bfhi(s1.z) + acc[6].y), cvtpk(bflo(s1.w) + acc[7].x, bfhi(s1.w) + acc[7].y)};
        }
        int kqe = __builtin_amdgcn_readfirstlane(kq); asm volatile("" : "+s"(kqe));
#pragma nounroll
        for (int i = 0; i < 4; ++i) {
            const int t = TOK_(kqe, i);
            int l64 = lane; asm volatile("" : "+v"(l64));
            const GAS v4u* hin = (const GAS v4u*)(HBin + (size_t)t * DMODEL) + 2 * l64;
            const v4u h0 = hin[0], h1 = hin[1];
            const LAS v4u* st = (const LAS v4u*)(accL + i * 2048 + l64 * 32);
            const v4u a0 = st[0], a1 = st[1];
            float hn[16]; float s2 = 0.f;
#pragma unroll
            for (int k = 0; k < 4; ++k) { hn[2 * k] = bflo(h0[k]) + bflo(a0[k]); hn[2 * k + 1] = bfhi(h0[k]) + bfhi(a0[k]); hn[8 + 2 * k] = bflo(h1[k]) + bflo(a1[k]); hn[8 + 2 * k + 1] = bfhi(h1[k]) + bfhi(a1[k]); }
#pragma unroll
            for (int e = 0; e < 16; ++e) s2 += hn[e] * hn[e];
            s2 = wave_sum(s2);
            if (FINAL) {
                const float rs = __builtin_amdgcn_rsqf(s2 * (1.0f / DMODEL) + EPS);
                const f32x4* g4 = (const f32x4*)gfin + 4 * l64; f32x4* hrow = (f32x4*)(Hout + (size_t)t * DMODEL) + 4 * l64;
#pragma unroll
                for (int q = 0; q < 4; ++q) { const f32x4 g = g4[q]; hrow[q] = (f32x4){hn[4 * q] * rs * g[0], hn[4 * q + 1] * rs * g[1], hn[4 * q + 2] * rs * g[2], hn[4 * q + 3] * rs * g[3]}; }
            } else {
                GAS v4u* hbp = (GAS v4u*)(HB + (size_t)t * DMODEL) + 2 * l64;
                hbp[0] = (v4u){cvtpk(hn[0], hn[1]), cvtpk(hn[2], hn[3]), cvtpk(hn[4], hn[5]), cvtpk(hn[6], hn[7])};
                hbp[1] = (v4u){cvtpk(hn[8], hn[9]), cvtpk(hn[10], hn[11]), cvtpk(hn[12], hn[13]), cvtpk(hn[14], hn[15])};
                if (l64 < 16) RP[(size_t)t * 16 + l64] = (l64 == 0) ? s2 : 0.f;
            }
        }
        }
        kq = __builtin_amdgcn_readfirstlane(kqn);
    }
}
#undef ROW_DMA
#undef TOK_
#ifndef TWO_STAGE
#define TWO_STAGE 1
#endif
constexpr int N_PHASES = 14;
#ifndef ATTN_THRL
#define ATTN_THRL 8
#endif
#ifndef PROBE_OTHERS
#define PROBE_OTHERS 1
#endif
#ifndef GROUP_BAR
#define GROUP_BAR 1
#endif
#ifndef MK_PER_PHASE
#define MK_PER_PHASE 0
#endif
struct Args { const float* in[18]; float* out; unsigned char* ws; int ph_lo, ph_hi, dry, li; };
__global__ void __launch_bounds__(NWAVES * 64, 2) yoco_fwd(Args args) {
    extern __shared__ __attribute__((aligned(16))) unsigned char lds[];
    Frame F;
    F.lds = (LAS unsigned char*)lds;
    F.MISC = (volatile LAS unsigned*)(F.lds + MISC_OFF);
    F.tid = threadIdx.x; F.lane = F.tid & 63; F.wave = __builtin_amdgcn_readfirstlane(F.tid >> 6);
    F.G = gridDim.x; { const int bx = blockIdx.x; F.vcu = (F.G % 8 == 0) ? (bx % 8) * (F.G / 8) + bx / 8 : bx; }
    F.ws = args.ws; F.ctl = (gu32*)(args.ws + WS_CTL); F.out = args.out;
#pragma unroll
    for (int i = 0; i < 18; ++i) F.in[i] = args.in[i];
    for (int u = F.tid; u < (LDS_BYTES - LDSCTL_OFF) / 4; u += NWAVES * 64) ((LAS unsigned*)(F.lds + LDSCTL_OFF))[u] = 0u;
    __syncthreads();
    XcdBarrier bar; bar.bar = (unsigned*)(F.ctl + CW_BAR) + args.li * XCD_BAR_WORDS; bar.x = 0; bar.st = nullptr;
    if (!MK_PER_PHASE) bar = xcd_barrier_post((unsigned*)(F.ctl + CW_BAR) + args.li * XCD_BAR_WORDS, F.MISC + 8);
    XcdBarrier gbar; gbar.bar = (unsigned*)(F.ctl + CW_GBAR) + ((int)blockIdx.x & 7) * 4096; gbar.x = 0; gbar.st = nullptr;
    if (!MK_PER_PHASE && GROUP_BAR) gbar = xcd_barrier_post((unsigned*)(F.ctl + CW_GBAR) + ((int)blockIdx.x & 7) * 4096, F.MISC + 10);
    const int lo = args.ph_lo, hi = args.ph_hi;
#define REID() do { int t_ = threadIdx.x; asm volatile("" : "+v"(t_)); F.tid = t_; F.lane = t_ & 63; F.wave = __builtin_amdgcn_readfirstlane(t_ >> 6); } while (0)
#ifndef PHASE_OFF
#define PHASE_OFF 0
#endif
#define IN(k) (lo <= (k) && (k) < hi && !((PHASE_OFF >> (k)) & 1))
#define SEAM(k) do { if (IN(k) && IN((k) + 1)) xcd_barrier(bar); } while (0)
#define SEAM2(k, k2) do { if (IN(k) && IN(k2)) xcd_barrier(bar); } while (0)
#define GSEAM(k) do { if (IN(k) && IN((k) + 1)) { if (GROUP_BAR && !MK_PER_PHASE) grp_barrier(gbar, gridDim.x / 8); else xcd_barrier(bar); } } while (0)
#define GSEAM2(k, k2) do { if (IN(k) && IN(k2)) { if (GROUP_BAR && !MK_PER_PHASE) grp_barrier(gbar, gridDim.x / 8); else xcd_barrier(bar); } } while (0)
#ifndef REPEAT_MASK
#define REPEAT_MASK 0
#endif
#define REP(k) ((REPEAT_MASK >> (k)) & 1)
#ifdef REP_WITH_BARRIER
#define REPBAR() xcd_barrier(bar)
#else
#define REPBAR() do {} while (0)
#endif
    float* const DUMF = (float*)(F.ws + WS_END); bf16* const DUMB = (bf16*)(F.ws + WS_END + 64 * MiB); float* const DUMR = (float*)(F.ws + WS_END + 96 * MiB);
    bf16* const A0 = (bf16*)(F.ws + WS_A0); bf16* const HB = (bf16*)(F.ws + WS_HB); bf16* const PQ = (bf16*)(F.ws + WS_PQ);
    float* const RP = (float*)(F.ws + WS_RP); float* const SC = (float*)(F.ws + WS_SC);

#ifndef NPASS
#define NPASS 1
#endif
    if (IN(0)) { REID(); if (REP(0)) { p0_prologue(F);  } p0_prologue(F); } SEAM(0);
    if (IN(1)) { REID(); if (REP(1)) { pg8::Gemm g{A0, (const bf16*)(F.ws + WS_WIN), T_TOK, 3072, DMODEL}; pg8::StaticOrder S; S.init(T_TOK, 3072, F.G, (int)blockIdx.x);
        pg8::EpiBf16RS E{PQ, 3072, 0, 0, 1.f, nullptr, -1, -1, F.in[IN_GLA_NORM_O], 2048};
        pg8::gemm_phase<pg8::EpiBf16RS, pg8::StaticOrder, true, true>(F.lds, g, S, E);  } if (REP(1)) REPBAR(); pg8::Gemm g{A0, (const bf16*)(F.ws + WS_WIN), T_TOK, 3072, DMODEL}; pg8::StaticOrder S; S.init(T_TOK, 3072, F.G, (int)blockIdx.x);
        pg8::EpiBf16RS E{PQ, 3072, 0, 0, 1.f, nullptr, -1, -1, F.in[IN_GLA_NORM_O], 2048};
        pg8::gemm_phase<pg8::EpiBf16RS, pg8::StaticOrder, true, true>(F.lds, g, S, E); } GSEAM(1);
    if (IN(2)) { REID(); if (REP(2)) { for (int c = blockIdx.x; c < NB * GLA_NCH; c += F.G) p2a_item(F, c >> 5, c & 31);  } for (int c = F.vcu; c < NB * GLA_NCH; c += F.G) p2a_item(F, c >> 5, c & 31); } GSEAM(2);
    if (IN(3)) { REID(); if (REP(3)) { if ((int)blockIdx.x < NB * GLA_H) p2b_seq(F, blockIdx.x, args.dry); else { late_weights(F, NB * GLA_H, F.G - NB * GLA_H); peer_tables_convert(F, NB * GLA_H * NWAVES, (F.G - NB * GLA_H) * NWAVES); }  } if ((int)blockIdx.x < NB * GLA_H) p2b_seq(F, ((int)blockIdx.x & 7) * 4 + ((int)blockIdx.x >> 3), args.dry); else { for (int rep_ = 0; rep_ < PROBE_OTHERS; ++rep_) { late_weights(F, NB * GLA_H, F.G - NB * GLA_H); peer_tables_convert(F, NB * GLA_H * NWAVES, (F.G - NB * GLA_H) * NWAVES); __syncthreads(); } } } SEAM(3);
    if (IN(4)) { REID(); if (REP(4)) { pg8::Gemm g{A0, (const bf16*)(F.ws + WS_WGO), T_TOK, DMODEL, DMODEL}; pg8::StaticOrder S; S.init(T_TOK, DMODEL, F.G, (int)blockIdx.x);
        pg8::EpiResid<false> E{F.in[IN_X], HB, RP, DMODEL};
        pg8::gemm_phase<pg8::EpiResid<false>, pg8::StaticOrder, false, true>(F.lds, g, S, E);  } pg8::Gemm g{A0, (const bf16*)(F.ws + WS_WGO), T_TOK, DMODEL, DMODEL}; pg8::StaticOrder S; S.init(T_TOK, DMODEL, F.G, (int)blockIdx.x);
        pg8::EpiResid<false> E{F.in[IN_X], HB, RP, DMODEL};
        pg8::gemm_phase<pg8::EpiResid<false>, pg8::StaticOrder, false, true>(F.lds, g, S, E); } GSEAM(4);
    if (IN(5)) { REID(); if (REP(5)) { pg8::Gemm g{HB, (const bf16*)(F.ws + WS_WEFF), T_TOK, 2048, DMODEL}; pg8::StaticOrder S; S.init(T_TOK, 2048, F.G, (int)blockIdx.x);
        int pm0, pm1; rstd_table(F, S, (LAS float*)(F.lds + 131072), pm0, pm1); pg8::EpiBf16RS E{(bf16*)SC, 2048, 0, 0, 1.f, (const LAS float*)(F.lds + 131072), pm0, pm1, nullptr, 0};
        pg8::gemm_phase<pg8::EpiBf16RS, pg8::StaticOrder, true, true>(F.lds, g, S, E);  } pg8::Gemm g{HB, (const bf16*)(F.ws + WS_WEFF), T_TOK, 2048, DMODEL}; pg8::StaticOrder S; S.init(T_TOK, 2048, F.G, (int)blockIdx.x);
        int pm0, pm1; rstd_table(F, S, (LAS float*)(F.lds + 131072), pm0, pm1); pg8::EpiBf16RS E{(bf16*)SC, 2048, 0, 0, 1.f, (const LAS float*)(F.lds + 131072), pm0, pm1, nullptr, 0};
        pg8::gemm_phase<pg8::EpiBf16RS, pg8::StaticOrder, true, true>(F.lds, g, S, E); } GSEAM2(5, 7);
    if (IN(7)) { REID(); if (TWO_STAGE) { peer_gather_sl<false, 0>(F, 0, HB, nullptr, HB, RP); xcd_barrier(bar); REID(); peer_gather_sl<false, 1>(F, 0, HB, nullptr, HB, RP); } else peer_gather_sl<false, 2>(F, 0, HB, nullptr, HB, RP); } GSEAM(7);
    if (IN(8)) { REID(); if (REP(8)) {
        pg8::Gemm g{HB, (const bf16*)(F.ws + WS_WQKV), T_TOK, 3072, DMODEL}; pg8::StaticOrder S; S.init(T_TOK, 3072, F.G, (int)blockIdx.x);
        int pm0, pm1; rstd_table(F, S, (LAS float*)(F.lds + 131072), pm0, pm1); pg8::EpiBf16RS E{PQ, DMODEL, DMODEL, (size_t)T_TOK * DMODEL, attn_body::C2, (const LAS float*)(F.lds + 131072), pm0, pm1, nullptr, 0};
        pg8::gemm_phase<pg8::EpiBf16RS, pg8::StaticOrder, true, true>(F.lds, g, S, E);  } if (REP(8)) REPBAR();
        p7_forget_logits(F);
        pg8::Gemm g{HB, (const bf16*)(F.ws + WS_WQKV), T_TOK, 3072, DMODEL}; pg8::StaticOrder S; S.init(T_TOK, 3072, F.G, (int)blockIdx.x);
        int pm0, pm1; rstd_table(F, S, (LAS float*)(F.lds + 131072), pm0, pm1); pg8::EpiBf16RS E{PQ, DMODEL, DMODEL, (size_t)T_TOK * DMODEL, attn_body::C2, (const LAS float*)(F.lds + 131072), pm0, pm1, nullptr, 0};
        pg8::gemm_phase<pg8::EpiBf16RS, pg8::StaticOrder, true, true>(F.lds, g, S, E); } GSEAM(8);
    if (IN(9)) { REID(); for (int rep = REP(9) ? 0 : 1; rep < 2; ++rep) {
        p9_key_bias(F, F.vcu >> 1, (LAS float*)(F.lds + attn_body::LDS_CB), (LAS float*)(F.lds + attn_body::LDS_TOTAL));
        const attn_body::AttnTensors AT{(const attn_body::bf16*)PQ, (const attn_body::bf16*)(PQ + (size_t)T_TOK * DMODEL), (const attn_body::bf16*)(PQ + 2 * (size_t)T_TOK * DMODEL), (attn_body::bf16*)((rep == 0 || args.dry) ? DUMB : PQ)};
        const attn_body::StaticOrder S((int)F.G, (int)blockIdx.x);
        attn_body::attn_phase<attn_body::StaticOrder, ATTN_THRL>((char*)lds, AT, S); } } GSEAM(9);
    if (IN(10)) { REID(); if (REP(10)) { pg8::Gemm g{PQ, (const bf16*)(F.ws + WS_WFO), T_TOK, DMODEL, DMODEL}; pg8::StaticOrder S; S.init(T_TOK, DMODEL, F.G, (int)blockIdx.x);
        pg8::EpiResid<false> E{DUMF, DUMB, DUMR, DMODEL};
        pg8::gemm_phase<pg8::EpiResid<false>, pg8::StaticOrder, false, true>(F.lds, g, S, E);  } pg8::Gemm g{PQ, (const bf16*)(F.ws + WS_WFO), T_TOK, DMODEL, DMODEL}; pg8::StaticOrder S; S.init(T_TOK, DMODEL, F.G, (int)blockIdx.x);
        pg8::EpiResid<true> E{nullptr, HB, RP, DMODEL};
        pg8::gemm_phase<pg8::EpiResid<true>, pg8::StaticOrder, false, true>(F.lds, g, S, E); } GSEAM(10);
    if (IN(11)) { REID(); if (REP(11)) { pg8::Gemm g{HB, (const bf16*)(F.ws + WS_WEFF) + (size_t)2048 * DMODEL, T_TOK, 2048, DMODEL}; pg8::StaticOrder S; S.init(T_TOK, 2048, F.G, (int)blockIdx.x);
        int pm0, pm1; rstd_table(F, S, (LAS float*)(F.lds + 131072), pm0, pm1); pg8::EpiBf16RS E{(bf16*)SC, 2048, 0, 0, 1.f, (const LAS float*)(F.lds + 131072), pm0, pm1, nullptr, 0};
        pg8::gemm_phase<pg8::EpiBf16RS, pg8::StaticOrder, true, true>(F.lds, g, S, E);  } pg8::Gemm g{HB, (const bf16*)(F.ws + WS_WEFF) + (size_t)2048 * DMODEL, T_TOK, 2048, DMODEL}; pg8::StaticOrder S; S.init(T_TOK, 2048, F.G, (int)blockIdx.x);
        int pm0, pm1; rstd_table(F, S, (LAS float*)(F.lds + 131072), pm0, pm1); pg8::EpiBf16RS E{(bf16*)SC, 2048, 0, 0, 1.f, (const LAS float*)(F.lds + 131072), pm0, pm1, nullptr, 0};
        pg8::gemm_phase<pg8::EpiBf16RS, pg8::StaticOrder, true, true>(F.lds, g, S, E); } GSEAM2(11, 13);
    if (IN(13)) { REID(); if (TWO_STAGE) { peer_gather_sl<true, 0>(F, 1, HB, F.out, nullptr, nullptr); xcd_barrier(bar); REID(); peer_gather_sl<true, 1>(F, 1, HB, F.out, nullptr, nullptr); } else peer_gather_sl<true, 2>(F, 1, HB, F.out, nullptr, nullptr); }
#undef IN
#undef SEAM
}

extern "C" void kernel_launch(void* const* d_in, const int* in_sizes, int n_in, void* d_out, int out_size, void* d_ws, size_t ws_size, hipStream_t stream) {
    static int grid = 0;
    if (grid == 0) {
        if (n_in != 18 || in_sizes[0] != T_TOK * DMODEL || out_size != T_TOK * DMODEL || ws_size < WS_END + ((REPEAT_MASK || MK_PER_PHASE) ? 97 * MiB : 0)) { fprintf(stderr, "kernel_launch: unexpected shapes (n_in %d, in0 %d, out %d, ws %zu); nothing launched\n", n_in, n_in > 0 ? in_sizes[0] : -1, out_size, ws_size); grid = -1; return; }
        int dev = 0, cus = 0;
        if (hipGetDevice(&dev) != hipSuccess || hipDeviceGetAttribute(&cus, hipDeviceAttributeMultiprocessorCount, dev) != hipSuccess) { grid = -1; return; }
        if (hipFuncSetAttribute((const void*)yoco_fwd, hipFuncAttributeMaxDynamicSharedMemorySize, LDS_BYTES) != hipSuccess) { fprintf(stderr, "kernel_launch: hipFuncSetAttribute failed\n"); grid = -1; return; }
        (void)hipGetLastError();
        grid = cus;
        if (grid != 256) { fprintf(stderr, "kernel_launch: built for a 256-CU device, found %d; nothing launched\n", cus); grid = -1; return; }
    }
    if (grid < 0) return;
    if (hipMemsetAsync((char*)d_ws + WS_CTL, 0, CTL_ZERO_BYTES, stream) != hipSuccess) return;
    Args a{};
    for (int i = 0; i < 18; ++i) a.in[i] = (const float*)d_in[i];
    a.out = (float*)d_out; a.ws = (unsigned char*)d_ws;
#if MK_PER_PHASE
    for (int p = 0; p < N_PHASES; ++p) { a.ph_lo = p; a.ph_hi = p + 1;
#ifdef DUP_PHASE
        if (p == DUP_PHASE) hipLaunchKernelGGL(yoco_fwd, dim3(grid), dim3(NWAVES * 64), LDS_BYTES, stream, a);
#endif
#ifdef DRY_PHASE
        if (p == DRY_PHASE) { a.dry = 1; hipLaunchKernelGGL(yoco_fwd, dim3(grid), dim3(NWAVES * 64), LDS_BYTES, stream, a); a.dry = 0; }
#endif
        hipLaunchKernelGGL(yoco_fwd, dim3(grid), dim3(NWAVES * 64), LDS_BYTES, stream, a); }
#else
    a.ph_lo = 0; a.ph_hi = N_PHASES;
    for (int li = 0; li < NPASS; ++li) { a.li = li; hipLaunchKernelGGL(yoco_fwd, dim3(grid), dim3(NWAVES * 64), LDS_BYTES, stream, a); }
#endif
}
```

```cpp
#define NSLICE_LOG 0
#define TWO_STAGE 0
#include <hip/hip_runtime.h>
#include <cstdio>
#include <cstdint>
namespace pg8 {
#define PG8_LAS __attribute__((address_space(3)))
typedef unsigned short bf16_t;
typedef short bf16x8 __attribute__((ext_vector_type(8)));
typedef float f32x4 __attribute__((ext_vector_type(4)));
typedef unsigned u32x4 __attribute__((ext_vector_type(4)));
constexpr int BM = 256, BK = 64, HALF = 128, HTB = HALF * BK * 2  , STAGE_BYTES = 8 * HTB, NXCD = 8, WGM = 8;

__host__ __device__ __forceinline__ int lds_byte(int r, int c) { const int st = (r >> 4) * 2 + (c >> 5), rr = r & 15, cc = c & 31, ob = rr * 64 + cc * 2; return st * 1024 + (ob ^ (((ob >> 9) & 1) << 5)); }
__host__ __device__ __forceinline__ void stage_rc(int b, int& R, int& C) { const int st = b / 1024, sb = b % 1024, swz = sb ^ (((sb >> 9) & 1) << 5); R = (st >> 1) * 16 + swz / 64; C = (st & 1) * 32 + (swz % 64) / 2; }
__host__ __device__ __forceinline__ int perm32(int rho) { const int n = rho >> 4, i = rho & 15; return 8 * (i >> 2) + 4 * n + (i & 3); }

struct Unit { int pm, pn; };
struct Gemm { const bf16_t* A; const bf16_t* Bt; int M, N, K; };

struct StaticOrder {
    int nM, nN, nwg, G, c;
    __host__ __device__ void init(int M, int N, int G_, int c_) { nM = M / BM; nN = N / BM; nwg = nM * nN; G = G_; c = c_; }
    __host__ __device__ bool next(int i, Unit& u) const {
        const long L = (long)i * G + c; if (L >= nwg) return false;
        int wgid = (int)L; { const int q = nwg / NXCD, r = nwg % NXCD, xcd = wgid % NXCD, off = wgid / NXCD; wgid = (xcd < r ? xcd * (q + 1) : r * (q + 1) + (xcd - r) * q) + off; }
        const int nig = WGM * nN, gid = wgid / nig, fm = gid * WGM, gsz = (nM - fm) < WGM ? (nM - fm) : WGM;
        u.pm = fm + ((wgid % nig) % gsz); u.pn = (wgid % nig) / gsz; return true;
    }
    __device__ __forceinline__ void a_ready(const Unit&) const {}
    __device__ __forceinline__ void done(const Unit&) const {}
};

__device__ __forceinline__ unsigned cvt_pk_bf16(float lo, float hi) { unsigned r; asm volatile("v_cvt_pk_bf16_f32 %0, %1, %2" : "=v"(r) : "v"(lo), "v"(hi)); return r; }
typedef unsigned u32x2 __attribute__((ext_vector_type(2)));
constexpr float RMS_EPS = 1e-6f;
__device__ __forceinline__ float row_rstd(const float* rowpart, int row) {
    const f32x4* p = (const f32x4*)(rowpart + (size_t)row * 16);
    const f32x4 a = p[0], b = p[1], c = p[2], d = p[3];
    const float s = (((a[0] + a[1]) + (a[2] + a[3])) + ((b[0] + b[1]) + (b[2] + b[3]))) + (((c[0] + c[1]) + (c[2] + c[3])) + ((d[0] + d[1]) + (d[2] + d[3])));
    return 1.0f / sqrtf(s * (1.0f / 1024.0f) + RMS_EPS);
}
struct EpiBf16RS {
    static constexpr bool PERM = true, AFTER_DRAIN = false;
    bf16_t* O; int ldc; int split_cols; size_t split_stride; float scale0; const PG8_LAS float* rs_tab; int pm0, pm1;
    const float* gate_w; int gate_col0;
    __device__ __forceinline__ void operator()(const f32x4 (&acc)[2][2][4][2], const Unit& u, int wr, int wc, int fr, int fq) const {
        const int row0 = u.pm * BM + wr * 64 + fr; int colt = u.pn * BM; bf16_t* base = O;
        float sc = 1.f; if (split_cols) { const int t = colt / split_cols; base += (size_t)t * split_stride; colt -= t * split_cols; if (t == 0) sc = scale0; }
        const int col0 = colt + wc * 32 + 8 * fq;
#pragma unroll
        for (int ai = 0; ai < 2; ++ai)
#pragma unroll
            for (int m = 0; m < 4; ++m) { const int row = row0 + ai * HALF + m * 16; const float rs = rs_tab ? sc * rs_tab[((u.pm == pm0) ? 0 : (u.pm == pm1) ? 256 : 512) + (row & 255)] : sc;
                bf16_t* rowp = base + (size_t)row * ldc + col0;
#pragma unroll
                for (int bj = 0; bj < 2; ++bj) { f32x4 v0 = acc[ai][bj][m][0] * rs, v1 = acc[ai][bj][m][1] * rs;
                    if (gate_w && colt >= gate_col0) { const f32x4 g0 = *(const f32x4*)(gate_w + col0 - gate_col0 + bj * HALF), g1 = *(const f32x4*)(gate_w + col0 - gate_col0 + bj * HALF + 4);
#pragma unroll
                        for (int e_ = 0; e_ < 4; ++e_) { v0[e_] = v0[e_] * __builtin_amdgcn_rcpf(1.0f + __expf(-v0[e_])) * g0[e_]; v1[e_] = v1[e_] * __builtin_amdgcn_rcpf(1.0f + __expf(-v1[e_])) * g1[e_]; } }
                    u32x4 w; w.x = cvt_pk_bf16(v0[0], v0[1]); w.y = cvt_pk_bf16(v0[2], v0[3]); w.z = cvt_pk_bf16(v1[0], v1[1]); w.w = cvt_pk_bf16(v1[2], v1[3]);
                    *(u32x4*)(rowp + bj * HALF) = w; } }
    }
};
struct EpiF32RS {
    static constexpr bool PERM = false, AFTER_DRAIN = false;
    float* C; int ldc; const PG8_LAS float* rs_tab; int pm0, pm1;
    __device__ __forceinline__ void operator()(const f32x4 (&acc)[2][2][4][2], const Unit& u, int wr, int wc, int fr, int fq) const {
        const int row0 = u.pm * BM + wr * 64 + fr, col0 = u.pn * BM + wc * 32 + 4 * fq;
#pragma unroll
        for (int ai = 0; ai < 2; ++ai)
#pragma unroll
            for (int m = 0; m < 4; ++m) { const int row = row0 + ai * HALF + m * 16; const float rs = rs_tab[((u.pm == pm0) ? 0 : (u.pm == pm1) ? 256 : 512) + (row & 255)];
                float* rowp = C + (size_t)row * ldc + col0;
#pragma unroll
                for (int bj = 0; bj < 2; ++bj)
#pragma unroll
                    for (int n = 0; n < 2; ++n) *(f32x4*)(rowp + bj * HALF + n * 16) = acc[ai][bj][m][n] * rs; }
    }
};
template <bool BASE_BF16> struct EpiResid {
    static constexpr bool PERM = false, AFTER_DRAIN = false;
    const float* base; bf16_t* hb; float* rowpart; int ldc;
    __device__ __forceinline__ void operator()(const f32x4 (&acc)[2][2][4][2], const Unit& u, int wr, int wc, int fr, int fq) const {
        const int row0 = u.pm * BM + wr * 64 + fr, col0 = u.pn * BM + wc * 32 + 4 * fq;
#pragma unroll
        for (int ai = 0; ai < 2; ++ai) {
            f32x4 bv[4][2][2];
#pragma unroll
            for (int m = 0; m < 4; ++m) { const size_t off = (size_t)(row0 + ai * HALF + m * 16) * ldc + col0;
#pragma unroll
                for (int bj = 0; bj < 2; ++bj)
#pragma unroll
                    for (int n = 0; n < 2; ++n) {
                        if (BASE_BF16) { const u32x2 bw = *(const u32x2*)(hb + off + bj * HALF + n * 16); bv[m][bj][n] = (f32x4){__builtin_bit_cast(float, bw.x << 16), __builtin_bit_cast(float, bw.x & 0xffff0000u), __builtin_bit_cast(float, bw.y << 16), __builtin_bit_cast(float, bw.y & 0xffff0000u)}; }
                        else bv[m][bj][n] = *(const f32x4*)(base + off + bj * HALF + n * 16); } }
            asm volatile("" ::: "memory");
#pragma unroll
            for (int m = 0; m < 4; ++m) { const int row = row0 + ai * HALF + m * 16; const size_t off = (size_t)row * ldc + col0; float ss = 0.f;
#pragma unroll
                for (int bj = 0; bj < 2; ++bj)
#pragma unroll
                    for (int n = 0; n < 2; ++n) { const f32x4 v = bv[m][bj][n] + acc[ai][bj][m][n];
                        ss += (v[0] * v[0] + v[1] * v[1]) + (v[2] * v[2] + v[3] * v[3]);
                        u32x2 w; w.x = cvt_pk_bf16(v[0], v[1]); w.y = cvt_pk_bf16(v[2], v[3]); *(u32x2*)(hb + off + bj * HALF + n * 16) = w; }
                ss += __shfl_xor(ss, 16); ss += __shfl_xor(ss, 32);
                if (fq == 0) rowpart[(size_t)row * 16 + u.pn * 4 + wc] = ss; } }
    }
};

template <class Epi, class Sched, bool ALIGN_EPI = false, bool SP2 = false>
__device__ __forceinline__ void gemm_phase(PG8_LAS unsigned char* lds, const Gemm g, const Sched& S, const Epi& E) {
    const int tid = threadIdx.x, wid = __builtin_amdgcn_readfirstlane(tid >> 6), lane = tid & 63, wr = wid >> 2, wc = wid & 3, fr = lane & 15, fq = lane >> 4;
    const int K = g.K, nt = K / BK;
    unsigned voffA[2], voffB[2];
#pragma unroll
    for (int i = 0; i < 2; ++i) { int R, C; stage_rc(tid * 16 + i * 8192, R, C); const int Rb = Epi::PERM ? ((R & ~31) + perm32(R & 31)) : R;
        voffA[i] = (unsigned)(R * K + C) * 2u; voffB[i] = (unsigned)(Rb * K + C) * 2u; }
    const size_t kstep = (size_t)(BK * 2);
    const size_t hstep = (size_t)HALF * K * 2;
    const size_t tstep = 2 * hstep;
    const unsigned ldsw = (unsigned)wid * 1024u;
    const int aoff = lds_byte(wr * 64 + fr, fq * 8), boff = lds_byte(wc * 32 + fr, fq * 8);
#define PG8_SA(b, h) (((b) * 2 + (h)) * HTB)
#define PG8_SB(b, h) ((4 + (b) * 2 + (h)) * HTB)
#define PG8_STAGE(bufoff, gbase, voff) do { _Pragma("unroll") for (int _i = 0; _i < 2; ++_i) \
        __builtin_amdgcn_global_load_lds((const unsigned*)((const char*)(gbase) + (voff)[_i]), (PG8_LAS unsigned*)(lds + (bufoff) + ldsw + _i * 8192), 16, 0, 0); } while (0)
#define PG8_LDA(dst, b, h) do { _Pragma("unroll") for (int m = 0; m < 4; ++m) _Pragma("unroll") for (int k = 0; k < 2; ++k) dst[m][k] = *(const PG8_LAS bf16x8*)(lds + PG8_SA(b, h) + aoff + m * 2048 + k * 1024); } while (0)
#define PG8_LDB(dst, b, h) do { _Pragma("unroll") for (int n = 0; n < 2; ++n) _Pragma("unroll") for (int k = 0; k < 2; ++k) dst[n][k] = *(const PG8_LAS bf16x8*)(lds + PG8_SB(b, h) + boff + n * 2048 + k * 1024); } while (0)
#define PG8_MMA(ai, bj, At, Bt) do { __builtin_amdgcn_s_setprio(1); _Pragma("unroll") for (int m = 0; m < 4; ++m) _Pragma("unroll") for (int n = 0; n < 2; ++n) _Pragma("unroll") for (int k = 0; k < 2; ++k) \
        acc[ai][bj][m][n] = __builtin_amdgcn_mfma_f32_16x16x32_bf16(Bt[n][k], At[m][k], acc[ai][bj][m][n], 0, 0, 0); __builtin_amdgcn_s_setprio(0); } while (0)
#define PG8_WAIT_V(n) asm volatile("s_waitcnt vmcnt(" #n ")" ::: "memory")
#define PG8_WAIT_L(n) asm volatile("s_waitcnt lgkmcnt(" #n ")" ::: "memory")
#define PG8_BAR __builtin_amdgcn_s_barrier()
#define PG8_SCHED __builtin_amdgcn_sched_barrier(0)
    Unit cur, nxt; int ui = 0;
    if (!S.next(0, cur)) return;
    f32x4 acc[2][2][4][2];
#pragma unroll
    for (int a = 0; a < 2; ++a)
#pragma unroll
        for (int b = 0; b < 2; ++b)
#pragma unroll
            for (int m = 0; m < 4; ++m)
#pragma unroll
                for (int n = 0; n < 2; ++n) acc[a][b][m][n] = (f32x4){0.f, 0.f, 0.f, 0.f};
    bf16x8 At[4][2], B0[2][2], B1[2][2];
    const char* cA = (const char*)g.A + (size_t)cur.pm * tstep; const char* cB = (const char*)g.Bt + (size_t)cur.pn * tstep;
    S.a_ready(cur);
    if constexpr (SP2) {
        PG8_STAGE(PG8_SB(0, 0), cB, voffB); PG8_STAGE(PG8_SB(0, 1), cB + hstep, voffB); PG8_STAGE(PG8_SA(0, 0), cA, voffA); PG8_STAGE(PG8_SA(0, 1), cA + hstep, voffA);
        if (wr == 1) PG8_BAR;
        PG8_WAIT_V(2); PG8_BAR;
        PG8_STAGE(PG8_SB(1, 0), cB + kstep, voffB); PG8_STAGE(PG8_SA(1, 0), cA + kstep, voffA); PG8_STAGE(PG8_SB(1, 1), cB + hstep + kstep, voffB);
        PG8_WAIT_V(6); PG8_BAR;
    } else {
        PG8_STAGE(PG8_SB(0, 0), cB, voffB); PG8_STAGE(PG8_SA(0, 0), cA, voffA); PG8_STAGE(PG8_SB(0, 1), cB + hstep, voffB); PG8_STAGE(PG8_SA(0, 1), cA + hstep, voffA);
        if (wr == 1) PG8_BAR;
        PG8_WAIT_V(4); PG8_BAR;
        PG8_STAGE(PG8_SB(1, 0), cB + kstep, voffB); PG8_STAGE(PG8_SA(1, 0), cA + kstep, voffA); PG8_STAGE(PG8_SB(1, 1), cB + hstep + kstep, voffB);
        PG8_WAIT_V(6); PG8_BAR;
    }
    for (;;) {
        const bool has_next = S.next(ui + 1, nxt);
        const char* nA = has_next ? (const char*)g.A + (size_t)nxt.pm * tstep : cA; const char* nB = has_next ? (const char*)g.Bt + (size_t)nxt.pn * tstep : cB;
        for (int t = 0; t < nt; t += 2) {
            const bool last = (t == nt - 2);
            const char* a1 = cA + (size_t)(t + 1) * kstep;
            const char* a2 = last ? nA : cA + (size_t)(t + 2) * kstep; const char* b2 = last ? nB : cB + (size_t)(t + 2) * kstep;
            const char* a3 = a2 + kstep; const char* b3 = b2 + kstep;
            if (last && has_next) S.a_ready(nxt);
            if constexpr (SP2) {
            PG8_LDB(B0, 0, 0); PG8_LDB(B1, 0, 1); PG8_SCHED; PG8_LDA(At, 0, 0); PG8_STAGE(PG8_SA(1, 1), a1 + hstep, voffA);
            PG8_WAIT_V(8); PG8_WAIT_L(0); PG8_BAR; PG8_MMA(0, 0, At, B0); PG8_MMA(0, 1, At, B1); PG8_BAR; PG8_SCHED;
            PG8_LDA(At, 0, 1); PG8_STAGE(PG8_SB(0, 0), b2, voffB); PG8_STAGE(PG8_SB(0, 1), b2 + hstep, voffB); PG8_STAGE(PG8_SA(0, 0), a2, voffA);
            PG8_WAIT_V(8); PG8_WAIT_L(0); PG8_BAR; PG8_MMA(1, 0, At, B0); PG8_MMA(1, 1, At, B1); PG8_BAR; PG8_SCHED;
            PG8_LDB(B0, 1, 0); PG8_LDB(B1, 1, 1); PG8_SCHED; PG8_LDA(At, 1, 0); PG8_STAGE(PG8_SA(0, 1), a2 + hstep, voffA);
            PG8_WAIT_V(8); PG8_WAIT_L(0); PG8_BAR; PG8_MMA(0, 0, At, B0); PG8_MMA(0, 1, At, B1); PG8_BAR; PG8_SCHED;
            PG8_LDA(At, 1, 1); PG8_STAGE(PG8_SB(1, 0), b3, voffB); PG8_STAGE(PG8_SB(1, 1), b3 + hstep, voffB); PG8_STAGE(PG8_SA(1, 0), a3, voffA);
            PG8_WAIT_V(8); PG8_WAIT_L(0); PG8_BAR; PG8_MMA(1, 0, At, B0); PG8_MMA(1, 1, At, B1); PG8_BAR; PG8_SCHED;
            } else {
            PG8_LDB(B0, 0, 0); PG8_SCHED; PG8_LDA(At, 0, 0); PG8_STAGE(PG8_SA(1, 1), a1 + hstep, voffA);
            PG8_WAIT_L(8); PG8_BAR; PG8_WAIT_L(0); PG8_MMA(0, 0, At, B0); PG8_BAR; PG8_SCHED;
            PG8_LDB(B1, 0, 1); PG8_STAGE(PG8_SB(0, 0), b2, voffB);
            PG8_BAR; PG8_WAIT_L(0); PG8_MMA(0, 1, At, B1); PG8_BAR;
            PG8_LDA(At, 0, 1); PG8_STAGE(PG8_SA(0, 0), a2, voffA);
            PG8_BAR; PG8_WAIT_L(0); PG8_MMA(1, 0, At, B0); PG8_BAR; PG8_SCHED;
            PG8_STAGE(PG8_SB(0, 1), b2 + hstep, voffB);
            PG8_WAIT_V(6); PG8_BAR; PG8_MMA(1, 1, At, B1); PG8_BAR;
            PG8_LDB(B0, 1, 0); PG8_SCHED; PG8_LDA(At, 1, 0); PG8_STAGE(PG8_SA(0, 1), a2 + hstep, voffA);
            PG8_WAIT_L(8); PG8_BAR; PG8_WAIT_L(0); PG8_MMA(0, 0, At, B0); PG8_BAR; PG8_SCHED;
            PG8_LDB(B1, 1, 1); PG8_STAGE(PG8_SB(1, 0), b3, voffB);
            PG8_BAR; PG8_WAIT_L(0); PG8_MMA(0, 1, At, B1); PG8_BAR;
            PG8_LDA(At, 1, 1); PG8_STAGE(PG8_SA(1, 0), a3, voffA);
            PG8_BAR; PG8_WAIT_L(0); PG8_MMA(1, 0, At, B0); PG8_BAR; PG8_SCHED;
            PG8_STAGE(PG8_SB(1, 1), b3 + hstep, voffB);
            PG8_WAIT_V(6); PG8_BAR; PG8_MMA(1, 1, At, B1); PG8_BAR;
            }
        }
        if constexpr (ALIGN_EPI) { if (wr == 0) PG8_BAR; }
        if constexpr (!Epi::AFTER_DRAIN) { E(acc, cur, wr, wc, fr, fq); S.done(cur); }
        if (!has_next) break;
#pragma unroll
        for (int a = 0; a < 2; ++a)
#pragma unroll
            for (int b = 0; b < 2; ++b)
#pragma unroll
                for (int m = 0; m < 4; ++m)
#pragma unroll
                    for (int n = 0; n < 2; ++n) acc[a][b][m][n] = (f32x4){0.f, 0.f, 0.f, 0.f};
        cur = nxt; cA = nA; cB = nB; ++ui;
        if constexpr (ALIGN_EPI) { if (wr == 1) PG8_BAR; }
    }
    PG8_WAIT_V(0);
    if constexpr (!ALIGN_EPI) { if (wr == 0) PG8_BAR; }
    PG8_BAR;
    if constexpr (Epi::AFTER_DRAIN) { E.fused(acc, cur, wr, wc, fr, fq, lds, wid, lane); S.done(cur); }
#undef PG8_SA
#undef PG8_SB
#undef PG8_STAGE
#undef PG8_LDA
#undef PG8_LDB
#undef PG8_MMA
#undef PG8_WAIT_V
#undef PG8_WAIT_L
#undef PG8_BAR
#undef PG8_SCHED
}
}
#include <hip/hip_bf16.h>
#include <cmath>
namespace attn_body {
using bf16=__hip_bfloat16;
using bf16x8=__attribute__((ext_vector_type(8)))short;
using s16x4=__attribute__((ext_vector_type(4)))short;
using f32x16=__attribute__((ext_vector_type(16)))float;
using u32x4=__attribute__((ext_vector_type(4)))unsigned;
constexpr int BATCH=8,NHEAD=16,SEQ=2048,D=64,DM=NHEAD*D;
constexpr int NW=8,QBLK=32,QB=QBLK*NW,KVBLK=64,NQB=SEQ/QB;
constexpr int ATTN_PITCH=DM, ATTN_UNIT_ROWS=QB;
__device__ __forceinline__ int crow(int r,int hi){return (r&3)+8*(r>>2)+4*hi;}
#define SBAR() __builtin_amdgcn_sched_barrier(0)
__device__ __forceinline__ void cmask(f32x16&p0,f32x16&p1,int jb,int qrel,int hi){
  const float NEG=-INFINITY; int kb=64*jb+4*hi;
  #pragma unroll
  for(int r=0;r<16;++r){int kv=kb+(r&3)+8*(r>>2); if(kv>qrel)p0[r]=NEG; if(kv+32>qrel)p1[r]=NEG;}
}

constexpr int NSLOT=3, SLOTB=8192;
constexpr int LDS_K=0, LDS_V=NSLOT*SLOTB, LDS_WS=2*NSLOT*SLOTB, LDS_OST=LDS_WS+NW*64*4, LDS_BYTES=LDS_OST+NW*4096, LDS_CB=LDS_BYTES, LDS_TOTAL=LDS_CB+SEQ*4;
constexpr float C2=0.125f*1.4426950408889634f;
__device__ __forceinline__ void glds16(const void*gsrc,unsigned lds_dst){unsigned keep;
  asm volatile("s_mov_b32 %0, m0\n\ts_mov_b32 m0, %2\n\ts_nop 0\n\tglobal_load_lds_dwordx4 %1, off\n\ts_mov_b32 m0, %0":"=&s"(keep):"v"(gsrc),"s"(lds_dst):"memory");}
__device__ __forceinline__ float max3f(float a,float b,float c){float r;asm("v_max3_f32 %0, %1, %2, %3":"=v"(r):"v"(a),"v"(b),"v"(c));return r;}
__device__ __forceinline__ float max2f(float a,float b){float r;asm("v_max_f32_e32 %0, %1, %2":"=v"(r):"v"(a),"v"(b));return r;}
__device__ __forceinline__ float fadd_s(float a,float b){float r;asm("v_add_f32_e32 %0, %1, %2":"=v"(r):"v"(a),"v"(b));return r;}
__device__ __forceinline__ float fsub_s(float a,float b){float r;asm("v_sub_f32_e32 %0, %1, %2":"=v"(r):"v"(a),"v"(b));return r;}
typedef float f32x2_t __attribute__((ext_vector_type(2))); typedef __bf16 bf16x2_t __attribute__((ext_vector_type(2)));
__device__ __forceinline__ unsigned cvtpk_s(float lo,float hi){f32x2_t v={lo,hi};bf16x2_t b=__builtin_convertvector(v,bf16x2_t);return __builtin_bit_cast(unsigned,b);}
#define WAIT_BAR(N) asm volatile("s_waitcnt vmcnt(" #N ") lgkmcnt(0)\n\ts_barrier":::"memory")

__device__ __forceinline__ void qkt(f32x16&p0,f32x16&p1,const char*Kslot,const bf16x8*qr,const f32x16&negm,int r32,int hi){
  const char*kb=Kslot+hi*1024+r32*16;
  #pragma unroll
  for(int d0=0;d0<4;++d0){
    const bf16x8 b0=*reinterpret_cast<const bf16x8*>(kb+d0*2048);
    const bf16x8 b1=*reinterpret_cast<const bf16x8*>(kb+d0*2048+512);
    if(d0==0){p0=__builtin_amdgcn_mfma_f32_32x32x16_bf16(b0,qr[0],negm,0,0,0);p1=__builtin_amdgcn_mfma_f32_32x32x16_bf16(b1,qr[0],negm,0,0,0);}
    else{p0=__builtin_amdgcn_mfma_f32_32x32x16_bf16(b0,qr[d0],p0,0,0,0);p1=__builtin_amdgcn_mfma_f32_32x32x16_bf16(b1,qr[d0],p1,0,0,0);}}
}
typedef __attribute__((address_space(3))) const char* lds_cptr;
typedef short v4i16_t __attribute__((ext_vector_type(4)));
__device__ __forceinline__ void kload8(bf16x8*kf,lds_cptr kp){
  kf[0]=*(const __attribute__((address_space(3))) bf16x8*)(kp);      kf[1]=*(const __attribute__((address_space(3))) bf16x8*)(kp+512);
  kf[2]=*(const __attribute__((address_space(3))) bf16x8*)(kp+2048); kf[3]=*(const __attribute__((address_space(3))) bf16x8*)(kp+2560);
  kf[4]=*(const __attribute__((address_space(3))) bf16x8*)(kp+4096); kf[5]=*(const __attribute__((address_space(3))) bf16x8*)(kp+4608);
  kf[6]=*(const __attribute__((address_space(3))) bf16x8*)(kp+6144); kf[7]=*(const __attribute__((address_space(3))) bf16x8*)(kp+6656);
}
__device__ __forceinline__ void kload2(bf16x8*kf,lds_cptr kp,int j){ kf[2*j]=*(const __attribute__((address_space(3))) bf16x8*)(kp+j*2048); kf[2*j+1]=*(const __attribute__((address_space(3))) bf16x8*)(kp+j*2048+512); }
__device__ __forceinline__ s16x4 vtr(lds_cptr p){ return __builtin_bit_cast(s16x4,__builtin_amdgcn_ds_read_tr16_b64_v4i16((__attribute__((address_space(3))) v4i16_t*)p)); }
__device__ __forceinline__ float rowmax(const f32x16&p0,const f32x16&p1){
  float a=max3f(p0[0],p0[1],p1[0]),b=max3f(p0[2],p0[3],p1[1]);a=max3f(a,p1[2],p1[3]);
  #pragma unroll
  for(int r=4;r<16;r+=4){a=max3f(a,p0[r],p0[r+1]);b=max3f(b,p0[r+2],p0[r+3]);a=max3f(a,p1[r],p1[r+1]);b=max3f(b,p1[r+2],p1[r+3]);}
  const float m=max2f(a,b);
  auto rr=__builtin_amdgcn_permlane32_swap(__float_as_uint(m),__float_as_uint(m),false,false);
  return max2f(__uint_as_float(rr[0]),__uint_as_float(rr[1]));
}
__device__ __forceinline__ void pv(f32x16*o,int vb,bf16x8 pa0,bf16x8 pa1,bf16x8 pa2,bf16x8 pa3){
  #pragma unroll
  for(int d0=0;d0<2;++d0){s16x4 lo[4],hi[4];
    #pragma unroll
    for(int ks=0;ks<4;++ks){
      asm volatile("ds_read_b64_tr_b16 %0,%1 offset:%c2":"=&v"(lo[ks]):"v"(vb),"i"(d0*4096+ks*1024):"memory");
      asm volatile("ds_read_b64_tr_b16 %0,%1 offset:%c2":"=&v"(hi[ks]):"v"(vb),"i"(d0*4096+ks*1024+512):"memory");}
    asm volatile("s_waitcnt lgkmcnt(0)":::"memory");SBAR();
    #define PK(k) (bf16x8){lo[k][0],lo[k][1],lo[k][2],lo[k][3],hi[k][0],hi[k][1],hi[k][2],hi[k][3]}
    o[d0]=__builtin_amdgcn_mfma_f32_32x32x16_bf16(pa0,PK(0),o[d0],0,0,0);
    o[d0]=__builtin_amdgcn_mfma_f32_32x32x16_bf16(pa1,PK(1),o[d0],0,0,0);
    o[d0]=__builtin_amdgcn_mfma_f32_32x32x16_bf16(pa2,PK(2),o[d0],0,0,0);
    o[d0]=__builtin_amdgcn_mfma_f32_32x32x16_bf16(pa3,PK(3),o[d0],0,0,0);
    #undef PK
  }
}

#ifndef ATTN_STORE16
#define ATTN_STORE16(p,v) (*(u32x4*)(p)=(v))
#endif
typedef float f32x4v __attribute__((ext_vector_type(4)));
template<int THRL> __device__ __forceinline__ void attn_unit(int b,int h,int qb,const bf16*Q,const bf16*__restrict__ K,const bf16*__restrict__ V,bf16*O,char*shm){
  const int tid=threadIdx.x,lane=tid&63,r32=lane&31,hi=lane>>5; const int wid=__builtin_amdgcn_readfirstlane(tid>>6);
  const long rowbase=(long)b*SEQ; const int q0=qb*QB;
  const bf16*Qw=Q+(rowbase+q0+wid*QBLK)*DM+h*D;
  const bf16*Kh=K+rowbase*DM+h*D,*Vh=V+rowbase*DM+h*D;
  const unsigned lds0=(unsigned)(uintptr_t)shm;
  float*wsf=(float*)(shm+LDS_WS)+wid*64;
  const bf16*ksrc=Kh+(long)lane*DM+wid*8;
  const bf16*vsrc=Vh+(long)(16*(wid&3)+(lane>>2))*DM+(wid>>2)*32+(lane&3)*8;
  const unsigned kdst=lds0+LDS_K+wid*1024, vdst=lds0+LDS_V+wid*1024;
  #define DMA_K(t,slot) glds16(ksrc+(long)(t)*KVBLK*DM,(unsigned)__builtin_amdgcn_readfirstlane(kdst+(slot)))
  #define DMA_V(t,slot) glds16(vsrc+(long)(t)*KVBLK*DM,(unsigned)__builtin_amdgcn_readfirstlane(vdst+(slot)))
  const int vb0=(int)(lds0+LDS_V)+((lane>>4)&1)*32+(lane&3)*8+(4*hi+((lane&15)>>2))*64;
  const char*Kbase=shm+LDS_K; bf16x8 kf[8];
  const lds_cptr shm3=(lds_cptr)shm; const lds_cptr kp0=shm3+LDS_K+hi*1024+r32*16; const lds_cptr vp0=shm3+LDS_V+((lane>>4)&1)*32+(lane&3)*8+(4*hi+((lane&15)>>2))*64;
  const int NT=(q0+QB)/KVBLK;
  DMA_K(0,0);DMA_V(0,0);DMA_K(1,SLOTB);
  bf16x8 qr[4];
  #pragma unroll
  for(int d0=0;d0<4;++d0)qr[d0]=*reinterpret_cast<const bf16x8*>(&Qw[(long)r32*DM+d0*16+hi*8]);
  float mhat=0.f,l_reg=0.f;f32x16 o[2];o[0]=f32x16{};o[1]=f32x16{};float z0_=0.f;asm volatile("":"+v"(z0_));f32x16 negm;_Pragma("unroll") for(int r=0;r<16;++r)negm[r]=z0_;asm volatile("":"+v"(negm));
  const int qrel=wid*QBLK+r32;
  #define CMASK(P0,P1,t) do{int jb_=(t)-(NT-4); if(jb_>=0)cmask(P0,P1,jb_,qrel,hi);}while(0)
  #define BIAS(P0,P1,t) do{ const __attribute__((address_space(3))) f32x4v* cbt_=(const __attribute__((address_space(3))) f32x4v*)(shm3+LDS_CB+(64*(t)+4*hi)*4); \
    _Pragma("unroll") for(int g_=0;g_<4;++g_){ const f32x4v b0_=cbt_[2*g_], b1_=cbt_[8+2*g_]; \
      P0[4*g_]+=b0_[0];P0[4*g_+1]+=b0_[1];P0[4*g_+2]+=b0_[2];P0[4*g_+3]+=b0_[3]; P1[4*g_]+=b1_[0];P1[4*g_+1]+=b1_[1];P1[4*g_+2]+=b1_[2];P1[4*g_+3]+=b1_[3]; } }while(0)
  bool resc=false;
  #define START(P0,P1) do{ const float rm=rowmax(P0,P1); resc=false; \
    { const float dl=rm; mhat=fadd_s(mhat,dl); \
      _Pragma("unroll") for(int r=0;r<16;++r){P0[r]=fsub_s(P0[r],dl);P1[r]=fsub_s(P1[r],dl);} \
      _Pragma("unroll") for(int r=0;r<16;++r)negm[r]=-mhat; asm volatile("":"+v"(negm)); } \
    _Pragma("unroll") for(int r=0;r<16;++r)P0[r]=__builtin_amdgcn_exp2f(P0[r]); }while(0)
  #define RESC() do{ if(resc){ asm volatile("s_waitcnt lgkmcnt(0)":::"memory"); \
      _Pragma("unroll") for(int d_=0;d_<2;++d_) _Pragma("unroll") for(int r=0;r<16;++r)o[d_][r]*=wsf[crow(r,hi)]; } }while(0)
  f32x16 pA0,pA1,pB0,pB1;
  int sl_prev=0,sl_cur=0,sl_next=SLOTB;
  #define ROT() do{sl_prev=sl_cur;sl_cur=sl_next;sl_next=(sl_next==(NSLOT-1)*SLOTB)?0:sl_next+SLOTB;}while(0)
  DMA_K(2,2*SLOTB);
  WAIT_BAR(3);
  qkt(pA0,pA1,Kbase,qr,negm,r32,hi);asm volatile("s_nop 15\n\ts_nop 7":"+v"(pA0),"+v"(pA1));BIAS(pA0,pA1,0);CMASK(pA0,pA1,0);
  START(pA0,pA1);
  _Pragma("unroll") for(int r=0;r<16;++r)pA1[r]=__builtin_amdgcn_exp2f(pA1[r]);
  WAIT_BAR(0);
  DMA_K(3,0);DMA_V(1,SLOTB);
  ROT();
  kload8(kf,kp0+sl_cur);
  WAIT_BAR(2);
  s16x4 vlo[8],vhi[8]; u32x4 pw0,pw1,pw2,pw3;
  #define PKW(P,B) cvtpk_s(P[B],P[B+1])
  #define PAF(k) __builtin_bit_cast(bf16x8,pw##k)
  #define VFR(i) (bf16x8){vlo[i][0],vlo[i][1],vlo[i][2],vlo[i][3],vhi[i][0],vhi[i][1],vhi[i][2],vhi[i][3]}
  #define PIN(x) asm volatile("":"+v"(x))
  #define MX3(a,b,c) __builtin_fmaxf(__builtin_fmaxf((a),(b)),(c))
  #define GAPA(MF,A0,A1,A2,A3,W0,W1,PW) do{ MF; sacc+=A0; sacc+=A1; sacc+=A2; sacc+=A3; PIN(sacc); W0; W1; PIN(PW); SBAR(); }while(0)
  #define EX(v) __builtin_amdgcn_exp2f(v)
  #define GAPB(MF,X,B) do{ MF; X[B]=EX(X[B]); X[B+1]=EX(X[B+1]); X[B+2]=EX(X[B+2]); X[B+3]=EX(X[B+3]); PIN(X); SBAR(); }while(0)
  #define VRD(i) do{ vlo[i]=vtr(vp_+(((i)>>2)*4096+((i)&3)*1024)); vhi[i]=vtr(vp_+(((i)>>2)*4096+((i)&3)*1024+512)); }while(0)
  #define KRD(G,j) do{ if(G){ kload2(kf,kp0+sl_next,j); SBAR(); } }while(0)
  #define STEP(C0,C1,P0,P1,t,GK,GV,GL) do{ SBAR(); \
    const lds_cptr vp_=vp0+sl_prev; \
    VRD(0); SBAR(); float sacc=(P0[0]+P0[1]); \
    GAPA(C0=__builtin_amdgcn_mfma_f32_32x32x16_bf16(kf[0],qr[0],negm,0,0,0), P0[2],P0[3],P0[4],P0[5],     pw0[0]=PKW(P0,0), pw0[1]=PKW(P0,2), pw0); \
    VRD(4); SBAR(); GAPA(C1=__builtin_amdgcn_mfma_f32_32x32x16_bf16(kf[1],qr[0],negm,0,0,0), P0[6],P0[7],P0[8],P0[9],     pw0[2]=PKW(P0,4), pw0[3]=PKW(P0,6), pw0); \
    VRD(1); SBAR(); GAPA(C0=__builtin_amdgcn_mfma_f32_32x32x16_bf16(kf[2],qr[1],C0,0,0,0),   P0[10],P0[11],P0[12],P0[13], pw1[0]=PKW(P0,8), pw1[1]=PKW(P0,10), pw1); \
    VRD(5); SBAR(); GAPA(C1=__builtin_amdgcn_mfma_f32_32x32x16_bf16(kf[3],qr[1],C1,0,0,0),   P0[14],P0[15],P1[0],P1[1],   pw1[2]=PKW(P0,12),pw1[3]=PKW(P0,14), pw1); \
    VRD(2); SBAR(); GAPA(C0=__builtin_amdgcn_mfma_f32_32x32x16_bf16(kf[4],qr[2],C0,0,0,0),   P1[2],P1[3],P1[4],P1[5],     pw2[0]=PKW(P1,0), pw2[1]=PKW(P1,2), pw2); \
    VRD(6); SBAR(); GAPA(C1=__builtin_amdgcn_mfma_f32_32x32x16_bf16(kf[5],qr[2],C1,0,0,0),   P1[6],P1[7],P1[8],P1[9],     pw2[2]=PKW(P1,4), pw2[3]=PKW(P1,6), pw2); \
    VRD(3); SBAR(); GAPA(C0=__builtin_amdgcn_mfma_f32_32x32x16_bf16(kf[6],qr[3],C0,0,0,0),   P1[10],P1[11],P1[12],P1[13], pw3[0]=PKW(P1,8), pw3[1]=PKW(P1,10), pw3); \
    VRD(7); SBAR(); GAPA(C1=__builtin_amdgcn_mfma_f32_32x32x16_bf16(kf[7],qr[3],C1,0,0,0),   P1[14],P1[15],0.f,0.f,       pw3[2]=PKW(P1,12),pw3[3]=PKW(P1,14), pw3); \
    l_reg+=sacc; \
    if(GK){DMA_K((t)+3,sl_cur);} if(GV){DMA_V((t)+1,sl_next);} \
    { const __attribute__((address_space(3))) f32x4v* cbt_=(const __attribute__((address_space(3))) f32x4v*)(shm3+LDS_CB+(64*(t)+4*hi)*4); \
      _Pragma("unroll") for(int g_=0;g_<4;++g_){ const f32x4v b0_=cbt_[2*g_]; C0[4*g_]+=b0_[0];C0[4*g_+1]+=b0_[1];C0[4*g_+2]+=b0_[2];C0[4*g_+3]+=b0_[3]; SBAR(); \
        const f32x4v b1_=cbt_[8+2*g_]; C1[4*g_]+=b1_[0];C1[4*g_+1]+=b1_[1];C1[4*g_+2]+=b1_[2];C1[4*g_+3]+=b1_[3]; SBAR(); } } \
    CMASK(C0,C1,t); \
    { float a=MX3(C0[0],C0[1],C1[0]),b=MX3(C0[2],C0[3],C1[1]); a=MX3(a,C1[2],C1[3]); \
      _Pragma("unroll") for(int r=4;r<16;r+=4){a=MX3(a,C0[r],C0[r+1]);b=MX3(b,C0[r+2],C0[r+3]);a=MX3(a,C1[r],C1[r+1]);b=MX3(b,C1[r+2],C1[r+3]);} \
      float rm=__builtin_fmaxf(a,b); { auto rr=__builtin_amdgcn_permlane32_swap(__float_as_uint(rm),__float_as_uint(rm),false,false); rm=__builtin_fmaxf(__uint_as_float(rr[0]),__uint_as_float(rr[1])); } \
      resc=false; \
      if(__builtin_expect(__any(rm>(float)THRL),0)){ const float dl=__builtin_fmaxf(rm,0.f); mhat+=dl; \
        _Pragma("unroll") for(int r=0;r<16;++r){C0[r]-=dl;C1[r]-=dl;} \
        _Pragma("unroll") for(int r=0;r<16;++r)negm[r]=-mhat; asm volatile("":"+v"(negm)); \
        const float f=__builtin_amdgcn_exp2f(-dl); l_reg*=f; if(hi==0)wsf[r32]=f; resc=true; } } \
    SBAR(); \
    GAPB(o[0]=__builtin_amdgcn_mfma_f32_32x32x16_bf16(PAF(0),VFR(0),o[0],0,0,0), C0,0); \
    GAPB(o[1]=__builtin_amdgcn_mfma_f32_32x32x16_bf16(PAF(0),VFR(4),o[1],0,0,0), C0,4); \
    KRD(GL,0); GAPB(o[0]=__builtin_amdgcn_mfma_f32_32x32x16_bf16(PAF(1),VFR(1),o[0],0,0,0), C0,8); \
    KRD(GL,1); GAPB(o[1]=__builtin_amdgcn_mfma_f32_32x32x16_bf16(PAF(1),VFR(5),o[1],0,0,0), C0,12); \
    KRD(GL,2); GAPB(o[0]=__builtin_amdgcn_mfma_f32_32x32x16_bf16(PAF(2),VFR(2),o[0],0,0,0), C1,0); \
    KRD(GL,3); GAPB(o[1]=__builtin_amdgcn_mfma_f32_32x32x16_bf16(PAF(2),VFR(6),o[1],0,0,0), C1,4); \
    GAPB(o[0]=__builtin_amdgcn_mfma_f32_32x32x16_bf16(PAF(3),VFR(3),o[0],0,0,0), C1,8); \
    GAPB(o[1]=__builtin_amdgcn_mfma_f32_32x32x16_bf16(PAF(3),VFR(7),o[1],0,0,0), C1,12); \
    }while(0)
  int t=1;
  #undef CMASK
  #define CMASK(P0,P1,t) do{}while(0)
  for(;t+5<NT;t+=2){
    STEP(pB0,pB1,pA0,pA1,t,true,true,true);     WAIT_BAR(2); RESC(); ROT();
    STEP(pA0,pA1,pB0,pB1,t+1,true,true,true);   WAIT_BAR(2); RESC(); ROT();
  }
  #undef CMASK
  #define CMASK(P0,P1,t) do{int jb_=(t)-(NT-4); if(jb_>=0)cmask(P0,P1,jb_,qrel,hi);}while(0)
  #define ENDW(tt) do{ if((tt)+3<NT){WAIT_BAR(2);} else if((tt)+2<NT){WAIT_BAR(1);} else {WAIT_BAR(0);} }while(0)
  for(;t+1<NT;t+=2){
    STEP(pB0,pB1,pA0,pA1,t,(t+3<NT),(t+1<NT),(t+1<NT));       ENDW(t);   RESC(); ROT();
    STEP(pA0,pA1,pB0,pB1,t+1,(t+4<NT),(t+2<NT),(t+2<NT));     ENDW(t+1); RESC(); ROT();
  }
  STEP(pB0,pB1,pA0,pA1,NT-1,false,false,false); RESC();
  { float sacc=pB0[0]+pB0[1]; _Pragma("unroll") for(int r=2;r<16;++r)sacc+=pB0[r]; _Pragma("unroll") for(int r=0;r<16;++r)sacc+=pB1[r]; l_reg+=sacc;
    pw0=(u32x4){PKW(pB0,0),PKW(pB0,2),PKW(pB0,4),PKW(pB0,6)};pw1=(u32x4){PKW(pB0,8),PKW(pB0,10),PKW(pB0,12),PKW(pB0,14)};pw2=(u32x4){PKW(pB1,0),PKW(pB1,2),PKW(pB1,4),PKW(pB1,6)};pw3=(u32x4){PKW(pB1,8),PKW(pB1,10),PKW(pB1,12),PKW(pB1,14)};
    SBAR(); pv(o,vb0+sl_cur,PAF(0),PAF(1),PAF(2),PAF(3)); }
  #undef PKW
  #undef PAF
  #undef VFR
  #undef PIN
  #undef MX3
  #undef GAPA
  #undef GAPB
  #undef EX
  #undef VRD
  #undef KRD
  #undef STEP
  #undef ENDW
  {auto rr=__builtin_amdgcn_permlane32_swap(__float_as_uint(l_reg),__float_as_uint(l_reg),false,false);l_reg=__uint_as_float(rr[0])+__uint_as_float(rr[1]);}
  if(hi==0)wsf[32+r32]=l_reg;asm volatile("s_waitcnt lgkmcnt(0)":::"memory");
  float rli[16];
  #pragma unroll
  for(int r=0;r<16;++r)rli[r]=__builtin_amdgcn_rcpf(wsf[32+crow(r,hi)]);
  bf16*Ow=O+(rowbase+q0+wid*QBLK)*DM+h*D;
  { bf16*stg=(bf16*)(shm+LDS_OST)+wid*2048;
    #pragma unroll
    for(int r=0;r<16;++r){const int orow=crow(r,hi);
      #pragma unroll
      for(int d0=0;d0<2;++d0)stg[orow*64+d0*32+r32]=__float2bfloat16(o[d0][r]*rli[r]);}
    asm volatile("s_waitcnt lgkmcnt(0)":::"memory");
    #pragma unroll
    for(int i=0;i<4;++i){const int row=i*8+(lane>>3),ch=lane&7; const u32x4 v=*(const u32x4*)(stg+row*64+ch*8); ATTN_STORE16(Ow+(long)row*DM+ch*8,v);} }
  asm volatile("s_waitcnt lgkmcnt(0)\n\ts_barrier":::"memory");
  #undef DMA_K
  #undef DMA_V
  #undef BIAS
  #undef CMASK
  #undef START
  #undef RESC
  #undef ROT
}
constexpr int ATTN_LDS_BYTES=LDS_TOTAL;
struct AttnTensors { const bf16* Q; const bf16* K; const bf16* V; bf16* O; };
struct AttnUnit { int bh; int qb; };
struct StaticOrder {
  int vcu;
  __device__ __forceinline__ explicit StaticOrder(int grid,int block):vcu((block%8)*(grid/8)+block/8){}
  __device__ __forceinline__ bool next(int i,AttnUnit&u)const{ if(i>=4)return false; const int s=2*(vcu&1)+(i>>1); u.bh=vcu>>1; u.qb=(i&1)?7-s:s; return true; }
  __device__ __forceinline__ void a_ready(const AttnUnit&)const{}
  __device__ __forceinline__ void done(const AttnUnit&)const{}
};
template<class Sched,int THRL=8> __device__ __forceinline__ void attn_phase(char*lds,const AttnTensors&T,const Sched&S){
  AttnUnit u;
  for(int i=0;S.next(i,u);++i){ S.a_ready(u); attn_unit<THRL>(u.bh/NHEAD,u.bh%NHEAD,u.qb,T.Q,T.K,T.V,T.O,lds); S.done(u); }
}
#undef SBAR
#undef WAIT_BAR
}
#define GAS __attribute__((address_space(1)))
#define LAS __attribute__((address_space(3)))
typedef unsigned short bf16;
typedef unsigned v4u __attribute__((ext_vector_type(4)));
typedef float f32x4 __attribute__((ext_vector_type(4)));
typedef short bf16x8 __attribute__((ext_vector_type(8)));
typedef GAS unsigned gu32;
typedef GAS unsigned long long gu64;
#define RLX_AGENT __ATOMIC_RELAXED, __HIP_MEMORY_SCOPE_AGENT
#define LDS_WAIT() asm volatile("s_waitcnt lgkmcnt(0)" ::: "memory")
#define VM_WAIT() asm volatile("s_waitcnt vmcnt(0)" ::: "memory")
__device__ __forceinline__ unsigned long long rt() { return __builtin_amdgcn_s_memrealtime(); }
__device__ __forceinline__ unsigned f2bf(float f) { unsigned u = __builtin_bit_cast(unsigned, f); return (u + 0x7fffu + ((u >> 16) & 1u)) >> 16; }
__device__ __forceinline__ unsigned pk2(float lo, float hi) { return f2bf(lo) | (f2bf(hi) << 16); }

#define XB_TMO      128
#define XB_XCNT(j)  (256  + 64 * (j))
#define XB_XSUB(j)  (1280 + 64 * (j))
#define XB_XGEN(j)  (2304 + 64 * (j))
#define XB_TOP      3328
#define XB_TOPGEN   3392
#define XCD_BAR_WORDS 3456
#define XB_SPIN_CAP (1u << 18)

__device__ __forceinline__ unsigned xb_ld(unsigned* p)              { return __hip_atomic_load(p, __ATOMIC_RELAXED, __HIP_MEMORY_SCOPE_AGENT); }
__device__ __forceinline__ unsigned xb_add(unsigned* p, unsigned v) { return __hip_atomic_fetch_add(p, v, __ATOMIC_RELAXED, __HIP_MEMORY_SCOPE_AGENT); }
__device__ __forceinline__ unsigned xb_xcc_id() { return (unsigned)__builtin_amdgcn_s_getreg((3 << 11) | 20) & 0xFu; }
#define XB_SPIN(cond, bar) do { unsigned _sp = 0; while (cond) { __builtin_amdgcn_s_sleep(1); \
    if ((++_sp & 255u) == 0u) { if (xb_ld(&(bar)[XB_TMO])) break; if (_sp > XB_SPIN_CAP) { atomicAdd(&(bar)[XB_TMO], 1u); break; } } } } while (0)

struct XcdBarrier {
    unsigned* bar; unsigned x;
    volatile LAS unsigned* st;
};

__device__ __forceinline__ XcdBarrier xcd_barrier_post(unsigned* bar, volatile LAS unsigned* st) {
    XcdBarrier b; b.bar = bar; b.x = xb_xcc_id(); b.st = st;
    if (threadIdx.x == 0) (void)xb_add(&bar[XB_XCNT(b.x)], 1u);
    return b;
}
__device__ __forceinline__ void xcd_barrier_complete(unsigned* bar, unsigned x, unsigned& nloc, unsigned& nx) {
    const unsigned G = gridDim.x * gridDim.y * gridDim.z;
    unsigned sum, cnt, mine, sp = 0u;
    for (;;) {
        sum = 0u; cnt = 0u; mine = 0u;
#pragma unroll
        for (unsigned j = 0; j < 16; ++j) { const unsigned c = xb_ld(&bar[XB_XCNT(j)]); sum += c; cnt += (c > 0u) ? 1u : 0u; mine = (j == x) ? c : mine; }
        if (sum == G) break;
        __builtin_amdgcn_s_sleep(1);
        if ((++sp & 255u) == 0u) { if (xb_ld(&bar[XB_TMO])) break; if (sp > XB_SPIN_CAP) { atomicAdd(&bar[XB_TMO], 1u); break; } }
    }
    nloc = mine > 0u ? mine : 1u; nx = cnt > 0u ? cnt : 1u;
}

__device__ __forceinline__ void xcd_barrier(const XcdBarrier& b) {
    asm volatile("s_waitcnt vmcnt(0)" ::: "memory");
    __syncthreads();
    if (threadIdx.x == 0) {
        unsigned* bar = b.bar;
        __builtin_amdgcn_s_waitcnt(0);
        unsigned nloc = b.st[0], nx = b.st[1];
        if (nloc == 0u) { xcd_barrier_complete(bar, b.x, nloc, nx); b.st[0] = nloc; b.st[1] = nx; }
        const unsigned old = xb_add(&bar[XB_XSUB(b.x)], 1u);
        const unsigned gen = old / nloc;
        if (old + 1u == (gen + 1u) * nloc) {
            __builtin_amdgcn_fence(__ATOMIC_RELEASE, "agent");
            asm volatile("s_waitcnt vmcnt(0)" ::: "memory");
            const unsigned og = xb_add(&bar[XB_TOP], 1u);
            const unsigned tg = og / nx;
            if (og + 1u == (tg + 1u) * nx) xb_add(&bar[XB_TOPGEN], 1u);
            else XB_SPIN(xb_ld(&bar[XB_TOPGEN]) == tg, bar);
            __builtin_amdgcn_fence(__ATOMIC_ACQUIRE, "agent");
            xb_add(&bar[XB_XGEN(b.x)], 1u);
            asm volatile("s_waitcnt vmcnt(0)" ::: "memory");
        } else {
            XB_SPIN(xb_ld(&bar[XB_XGEN(b.x)]) == gen, bar);
            __builtin_amdgcn_fence(__ATOMIC_ACQUIRE, "agent");
            asm volatile("s_waitcnt vmcnt(0)" ::: "memory");
        }
    }
    __syncthreads();
}

__device__ __forceinline__ void grp_barrier_complete(unsigned* bar, unsigned x, unsigned total, unsigned& nloc, unsigned& nx) {
    unsigned sum, cnt, mine, sp = 0u;
    for (;;) {
        sum = 0u; cnt = 0u; mine = 0u;
#pragma unroll
        for (unsigned j = 0; j < 16; ++j) { const unsigned c = xb_ld(&bar[XB_XCNT(j)]); sum += c; cnt += (c > 0u) ? 1u : 0u; mine = (j == x) ? c : mine; }
        if (sum == total) break;
        __builtin_amdgcn_s_sleep(1);
        if ((++sp & 255u) == 0u) { if (xb_ld(&bar[XB_TMO])) break; if (sp > XB_SPIN_CAP) { atomicAdd(&bar[XB_TMO], 1u); break; } }
    }
    nloc = mine > 0u ? mine : 1u; nx = cnt > 0u ? cnt : 1u;
}
__device__ __forceinline__ void grp_barrier(const XcdBarrier& b, unsigned total) {
    asm volatile("s_waitcnt vmcnt(0)" ::: "memory");
    __syncthreads();
    if (threadIdx.x == 0) {
        unsigned* bar = b.bar;
        __builtin_amdgcn_s_waitcnt(0);
        unsigned nloc = b.st[0], nx = b.st[1];
        if (nloc == 0u) { grp_barrier_complete(bar, b.x, total, nloc, nx); b.st[0] = nloc; b.st[1] = nx; }
        const unsigned old = xb_add(&bar[XB_XSUB(b.x)], 1u);
        const unsigned gen = old / nloc;
        if (old + 1u == (gen + 1u) * nloc) {
            __builtin_amdgcn_fence(__ATOMIC_RELEASE, "agent");
            asm volatile("s_waitcnt vmcnt(0)" ::: "memory");
            const unsigned og = xb_add(&bar[XB_TOP], 1u);
            const unsigned tg = og / nx;
            if (og + 1u == (tg + 1u) * nx) xb_add(&bar[XB_TOPGEN], 1u);
            else XB_SPIN(xb_ld(&bar[XB_TOPGEN]) == tg, bar);
            __builtin_amdgcn_fence(__ATOMIC_ACQUIRE, "agent");
            xb_add(&bar[XB_XGEN(b.x)], 1u);
            asm volatile("s_waitcnt vmcnt(0)" ::: "memory");
        } else {
            XB_SPIN(xb_ld(&bar[XB_XGEN(b.x)]) == gen, bar);
            __builtin_amdgcn_fence(__ATOMIC_ACQUIRE, "agent");
            asm volatile("s_waitcnt vmcnt(0)" ::: "memory");
        }
    }
    __syncthreads();
}
constexpr int NWAVES = 8, NTHR = NWAVES * 64;
constexpr int T_TOK = 16384, DMODEL = 1024, NB = 8, SEQ = 2048;
constexpr int GLA_H = 4, GLA_DK = 128, GLA_DV = 256, GLA_C = 64, GLA_NCH = SEQ / GLA_C, GLA_IN = 3088;
constexpr int NCHUNK = NB * GLA_H * GLA_NCH;
constexpr int KV_TOT = 2064, FOX_H = 16;
constexpr int PEER_H = 8, PEER_K = 16, PEER_NEXP = 16384, PEER_SEL = PEER_H * PEER_K;
constexpr float EPS = 1e-6f;
constexpr float L2E = 1.4426950408889634f;

constexpr size_t MiB = 1u << 20;
constexpr size_t WS_CTL = 0, CTL_ZERO_BYTES = 256 * 1024;
constexpr size_t WS_WIN = 2 * MiB, WS_WGO = 8 * MiB, WS_WQKV = 10 * MiB, WS_WFO = 16 * MiB, WS_WEFF = 18 * MiB;
constexpr size_t WS_FL = 27 * MiB, WS_RP = 28 * MiB, WS_DEXP = 30 * MiB, WS_WGL = 30 * MiB + 512 * 1024, WS_WFL = WS_WGL + 64 * 1024, WS_WFLF = WS_WFL + 64 * 1024;
constexpr size_t WS_A0 = 32 * MiB;
constexpr size_t WS_HB = 64 * MiB;
constexpr size_t WS_PQ = 96 * MiB;
constexpr size_t WS_QT = 192 * MiB, WS_KT = 208 * MiB, WS_AT = 224 * MiB, WS_VT = 232 * MiB;
constexpr size_t WS_SC = 96 * MiB;
constexpr size_t WS_IDS = 264 * MiB, WS_GATES = 272 * MiB;
constexpr size_t WS_TAB = 280 * MiB;
constexpr size_t WS_OG = 312 * MiB;
constexpr size_t WS_TSC = 344 * MiB;
constexpr size_t WS_END = 408 * MiB;
constexpr int CW_BAR = 4096, CW_GBAR = 16384;

constexpr int RING_BYTES = 155648;
constexpr int LDSCTL_OFF = RING_BYTES, MISC_OFF = LDSCTL_OFF + 320;
constexpr int LDS_BYTES = 163840;

typedef unsigned v2u __attribute__((ext_vector_type(2)));
typedef float f32x16 __attribute__((ext_vector_type(16)));
__device__ __forceinline__ float bf2f(unsigned b) { return __builtin_bit_cast(float, b << 16); }
__device__ __forceinline__ float bflo(unsigned w) { return __builtin_bit_cast(float, w << 16); }
__device__ __forceinline__ float bfhi(unsigned w) { return __builtin_bit_cast(float, w & 0xffff0000u); }
__device__ __forceinline__ float wave_sum(float v) {
#pragma unroll
    for (int o = 1; o < 64; o <<= 1) v += __shfl_xor(v, o);
    return v;
}
__device__ __forceinline__ float wave_max(float v) {
#pragma unroll
    for (int o = 1; o < 64; o <<= 1) v = fmaxf(v, __shfl_xor(v, o));
    return v;
}
__device__ __forceinline__ float log_sigmoid(float x) { return fminf(x, 0.f) - __logf(1.0f + __expf(-fabsf(x))); }
__device__ __forceinline__ int crow16(int r, int hi) { return (r & 3) + 8 * (r >> 2) + 4 * hi; }

struct Frame {
    LAS unsigned char* lds;
    volatile LAS unsigned* MISC;
    gu32* ctl;
    int tid, lane, wave, vcu, G;
    unsigned char* ws;
    const float* in[18];
    float* out;
};
enum { IN_X = 0, IN_NORM_MIX, IN_NORM_FFN, IN_GLA_W_IN, IN_GLA_W_G2, IN_GLA_B_G, IN_GLA_NORM_O, IN_GLA_W_O, IN_KV_NORM, IN_KV_W, IN_FOX_B_F, IN_FOX_W_Q, IN_FOX_W_O,
       IN_PEER_W_Q, IN_PEER_SUB, IN_PEER_U, IN_PEER_V, IN_NORM_FINAL };

__device__ __forceinline__ void p0_transpose_item(const float* W, int K, int ldw, int c0, int N, bf16* WT, int row_off, const float* gk, int ns, float cs, LAS float* scr, int item, int lane) {
    const int nblk = N / 32, kb = item / nblk, nb = item % nblk, k0 = 64 * kb, n0 = 32 * nb;
#pragma unroll 8
    for (int i = 0; i < 32; ++i) { const int kk = 2 * i + (lane >> 5); const float g = gk ? gk[k0 + kk] : 1.f; scr[kk * 33 + (lane & 31)] = __builtin_nontemporal_load(W + (size_t)(k0 + kk) * ldw + c0 + n0 + (lane & 31)) * g; }
    LDS_WAIT(); asm volatile("" ::: "memory");
    const int c = lane & 7;
#pragma unroll
    for (int j = 0; j < 4; ++j) { const int n = (lane >> 3) + 8 * j; const LAS float* s = scr + (8 * c) * 33 + n; const float sc = (n0 + n < ns) ? cs : 1.f;
        v4u o; o.x = pk2(s[0 * 33] * sc, s[1 * 33] * sc); o.y = pk2(s[2 * 33] * sc, s[3 * 33] * sc); o.z = pk2(s[4 * 33] * sc, s[5 * 33] * sc); o.w = pk2(s[6 * 33] * sc, s[7 * 33] * sc);
        *(GAS v4u*)(WT + (size_t)(row_off + n0 + n) * K + k0 + 8 * c) = o; }
    LDS_WAIT(); asm volatile("" ::: "memory");
}
__device__ __forceinline__ void p0_weff_item(Frame& F, int item) {
    const int l = item >> 8, gi = (item >> 4) & 15, kb = item & 15, k0 = kb * 64, tid = F.tid, lane = F.lane, wave = F.wave;
    const float* wpq = F.in[IN_PEER_W_Q] + (size_t)l * DMODEL * 2048; const float* sub = F.in[IN_PEER_SUB] + ((size_t)l * 16 + gi) * 128 * 128; const float* gf = F.in[IN_NORM_FFN] + l * DMODEL;
    bf16* WT = (bf16*)(F.ws + WS_WEFF) + (size_t)l * 2048 * DMODEL;
    LAS float* At = (LAS float*)F.lds;
    LAS float* Bt = (LAS float*)(F.lds + 33792);
    { const int kk = tid >> 3, d0 = (tid & 7) * 16; const float g = gf[k0 + kk]; const f32x4* src = (const f32x4*)(wpq + (size_t)(k0 + kk) * 2048 + gi * 128 + d0);
#pragma unroll
      for (int i = 0; i < 4; ++i) { const f32x4 v = __builtin_nontemporal_load(src + i) * g; LAS float* d = At + kk * 129 + d0 + 4 * i; d[0] = v[0]; d[1] = v[1]; d[2] = v[2]; d[3] = v[3]; } }
    { const int n = tid >> 2, d0 = (tid & 3) * 32; const f32x4* src = (const f32x4*)(sub + (size_t)n * 128 + d0);
#pragma unroll
      for (int i = 0; i < 8; ++i) { const f32x4 v = src[i]; LAS float* d = Bt + n * 129 + d0 + 4 * i; d[0] = v[0]; d[1] = v[1]; d[2] = v[2]; d[3] = v[3]; } }
    __syncthreads();
    const int ti = wave >> 2, tj = wave & 3, r32 = lane & 31, hi = lane >> 5;
    const LAS float* ap = At + (32 * ti + r32) * 129 + hi; const LAS float* bp = Bt + (32 * tj + r32) * 129 + hi;
    f32x16 acc = (f32x16){};
#pragma unroll 16
    for (int s = 0; s < 64; ++s) acc = __builtin_amdgcn_mfma_f32_32x32x2f32(ap[2 * s], bp[2 * s], acc, 0, 0, 0);
    bf16* dst = WT + (size_t)(gi * 128 + 32 * tj + r32) * DMODEL + k0 + 32 * ti + 4 * hi;
#pragma unroll
    for (int g = 0; g < 4; ++g) *(GAS v2u*)(dst + 8 * g) = (v2u){pk2(acc[4 * g], acc[4 * g + 1]), pk2(acc[4 * g + 2], acc[4 * g + 3])};
    __syncthreads();
}
template <int NR> __device__ __forceinline__ void rms_rows_to_bf16(int lane, const float* const (&xrow)[NR], const float* g, bf16* const (&orow)[NR]) {
    f32x4 v[NR][4];
#pragma unroll
    for (int r = 0; r < NR; ++r) { const GAS f32x4* xr = (const GAS f32x4*)xrow[r] + lane;
#pragma unroll
        for (int j = 0; j < 4; ++j) v[r][j] = __builtin_nontemporal_load(xr + 64 * j); }
    const GAS f32x4* gr = (const GAS f32x4*)g + lane;
    f32x4 gg[4];
#pragma unroll
    for (int j = 0; j < 4; ++j) gg[j] = gr[64 * j];
#pragma unroll
    for (int r = 0; r < NR; ++r) { float s = 0.f;
#pragma unroll
        for (int j = 0; j < 4; ++j) s += (v[r][j].x * v[r][j].x + v[r][j].y * v[r][j].y) + (v[r][j].z * v[r][j].z + v[r][j].w * v[r][j].w);
        const float rstd = 1.f / sqrtf(wave_sum(s) * (1.f / DMODEL) + EPS);
        GAS unsigned long long* o8 = (GAS unsigned long long*)orow[r] + lane;
#pragma unroll
        for (int j = 0; j < 4; ++j) o8[64 * j] = (unsigned long long)pk2(v[r][j].x * rstd * gg[j].x, v[r][j].y * rstd * gg[j].y) | ((unsigned long long)pk2(v[r][j].z * rstd * gg[j].z, v[r][j].w * rstd * gg[j].w) << 32); }
}
__device__ __forceinline__ unsigned fp4_code(float y) {
    const float a = fabsf(y);
    const unsigned mag = (unsigned)(a >= 0.25f) + (unsigned)(a >= 0.75f) + (unsigned)(a >= 1.25f) + (unsigned)(a >= 1.75f) + (unsigned)(a >= 2.5f) + (unsigned)(a >= 3.5f) + (unsigned)(a >= 5.0f);
    return mag | ((__builtin_bit_cast(unsigned, y) >> 28) & 8u);
}
template <int NR> __device__ __forceinline__ void tab_rows_to_fp4(int lane, const float* const (&src)[NR], unsigned char* const (&dst)[NR], float* const (&sc_out)[NR]) {
    f32x4 a[NR], b[NR], c[NR], d[NR];
#pragma unroll
    for (int r = 0; r < NR; ++r) { const GAS f32x4* s = (const GAS f32x4*)src[r] + 4 * lane;
        a[r] = __builtin_nontemporal_load(s); b[r] = __builtin_nontemporal_load(s + 1); c[r] = __builtin_nontemporal_load(s + 2); d[r] = __builtin_nontemporal_load(s + 3); }
#pragma unroll
    for (int r = 0; r < NR; ++r) {
        float m = fmaxf(fmaxf(fmaxf(fabsf(a[r].x), fabsf(a[r].y)), fmaxf(fabsf(a[r].z), fabsf(a[r].w))), fmaxf(fmaxf(fabsf(b[r].x), fabsf(b[r].y)), fmaxf(fabsf(b[r].z), fabsf(b[r].w))));
        m = fmaxf(m, fmaxf(fmaxf(fmaxf(fabsf(c[r].x), fabsf(c[r].y)), fmaxf(fabsf(c[r].z), fabsf(c[r].w))), fmaxf(fmaxf(fabsf(d[r].x), fabsf(d[r].y)), fmaxf(fabsf(d[r].z), fabsf(d[r].w)))));
        m = wave_max(m);
        const float enc = (m > 0.f) ? 6.0f / m : 1.0f;
        unsigned w0 = 0, w1 = 0;
        w0 = __builtin_amdgcn_cvt_scalef32_pk_fp4_f32(w0, a[r].x * enc, a[r].y * enc, 1.0f, 0); w0 = __builtin_amdgcn_cvt_scalef32_pk_fp4_f32(w0, a[r].z * enc, a[r].w * enc, 1.0f, 1);
        w0 = __builtin_amdgcn_cvt_scalef32_pk_fp4_f32(w0, b[r].x * enc, b[r].y * enc, 1.0f, 2); w0 = __builtin_amdgcn_cvt_scalef32_pk_fp4_f32(w0, b[r].z * enc, b[r].w * enc, 1.0f, 3);
        w1 = __builtin_amdgcn_cvt_scalef32_pk_fp4_f32(w1, c[r].x * enc, c[r].y * enc, 1.0f, 0); w1 = __builtin_amdgcn_cvt_scalef32_pk_fp4_f32(w1, c[r].z * enc, c[r].w * enc, 1.0f, 1);
        w1 = __builtin_amdgcn_cvt_scalef32_pk_fp4_f32(w1, d[r].x * enc, d[r].y * enc, 1.0f, 2); w1 = __builtin_amdgcn_cvt_scalef32_pk_fp4_f32(w1, d[r].z * enc, d[r].w * enc, 1.0f, 3);
        ((GAS v2u*)dst[r])[lane] = (v2u){w0, w1};
        if (lane == 0) *sc_out[r] = (m > 0.f) ? m * (1.0f / 6.0f) : 1.0f; }
}
__device__ __forceinline__ void p0_prologue(Frame& F) {
    LAS float* scr = (LAS float*)(F.lds + F.wave * 16384);
    const int gw = blockIdx.x * NWAVES + F.wave, NGW = F.G * NWAVES;
    constexpr int I_IN = 16 * 96, I_SQ = 16 * 32;
    for (int it = gw; it < I_IN + I_SQ; it += NGW) {
        if (it < I_IN) p0_transpose_item(F.in[IN_GLA_W_IN], DMODEL, GLA_IN, 0, 3072, (bf16*)(F.ws + WS_WIN), 0, nullptr, 512, 0.08838834764831845f, scr, it, F.lane);
        else p0_transpose_item(F.in[IN_GLA_W_O], DMODEL, DMODEL, 0, 1024, (bf16*)(F.ws + WS_WGO), 0, nullptr, 0, 1.f, scr, it - I_IN, F.lane); }
    { const int gt = blockIdx.x * NTHR + F.tid, NT = F.G * NTHR;
      for (int idx = gt; idx < 16 * DMODEL; idx += NT) { const int j = idx >> 10, k = idx & 1023; ((bf16*)(F.ws + WS_WGL))[j * DMODEL + k] = (bf16)f2bf(F.in[IN_GLA_W_IN][(size_t)k * GLA_IN + 3072 + j]); } }
    for (int m = gw; m < T_TOK; m += 4 * NGW) {
        const float* xr[4]; bf16* orow[4];
#pragma unroll
        for (int i = 0; i < 4; ++i) { int mm = m + i * NGW; mm = mm < T_TOK ? mm : T_TOK - 1; xr[i] = F.in[IN_X] + (size_t)mm * DMODEL; orow[i] = (bf16*)(F.ws + WS_A0) + (size_t)mm * DMODEL; }
        rms_rows_to_bf16<4>(F.lane, xr, F.in[IN_NORM_MIX], orow); }
}
__device__ __forceinline__ void late_weights(Frame& F, int wg0, int nwg) {
    const int p = (int)blockIdx.x - wg0;
    for (int it = p; it < 512; it += nwg) p0_weff_item(F, it);
    LAS float* scr = (LAS float*)(F.lds + F.wave * 16384);
    const int gw = p * NWAVES + F.wave, NGW = nwg * NWAVES;
    constexpr int I_SQ = 16 * 32, I_KV = 16 * 64;
    for (int it = gw; it < 2 * I_SQ + I_KV; it += NGW) {
        int r = it;
        if (r < I_SQ) { p0_transpose_item(F.in[IN_FOX_W_Q], DMODEL, DMODEL, 0, 1024, (bf16*)(F.ws + WS_WQKV), 0, F.in[IN_NORM_MIX] + DMODEL, 0, 1.f, scr, r, F.lane); continue; } r -= I_SQ;
        if (r < I_KV) { p0_transpose_item(F.in[IN_KV_W], DMODEL, KV_TOT, 0, 2048, (bf16*)(F.ws + WS_WQKV), 1024, F.in[IN_KV_NORM], 0, 1.f, scr, r, F.lane); continue; } r -= I_KV;
        p0_transpose_item(F.in[IN_FOX_W_O], DMODEL, DMODEL, 0, 1024, (bf16*)(F.ws + WS_WFO), 0, nullptr, 0, 1.f, scr, r, F.lane); }
    { const int gt = p * NTHR + F.tid, NT = nwg * NTHR;
      for (int idx = gt; idx < 16 * DMODEL; idx += NT) { const int j = idx >> 10, k = idx & 1023;
          const float wv = F.in[IN_KV_W][(size_t)k * KV_TOT + 2048 + j] * F.in[IN_KV_NORM][k]; ((bf16*)(F.ws + WS_WFL))[j * DMODEL + k] = (bf16)f2bf(wv); ((float*)(F.ws + WS_WFLF))[j * DMODEL + k] = wv; } }
}

#ifndef TAB_ROWS_PER_ITER
#define TAB_ROWS_PER_ITER 1
#endif
__device__ __forceinline__ void peer_tables_convert(Frame& F, int w0, int nw) {
    const int gw = blockIdx.x * NWAVES + F.wave - w0;
    if (gw < 0 || gw >= nw) return;
    constexpr int NR = TAB_ROWS_PER_ITER;
    for (int r0 = gw; r0 < 4 * PEER_NEXP; r0 += NR * nw) {
        const float* src[NR]; unsigned char* dst[NR]; float* sc[NR];
#pragma unroll
        for (int i = 0; i < NR; ++i) { int r = r0 + i * nw; r = r < 4 * PEER_NEXP ? r : 4 * PEER_NEXP - 1; const int tb = r >> 14, e = r & (PEER_NEXP - 1), l = tb >> 1;
            src[i] = ((tb & 1) ? F.in[IN_PEER_V] : F.in[IN_PEER_U]) + ((size_t)l * PEER_NEXP + e) * DMODEL;
            dst[i] = F.ws + WS_TAB + ((size_t)tb * PEER_NEXP + e) * (DMODEL / 2); sc[i] = (float*)(F.ws + WS_TSC) + (size_t)tb * PEER_NEXP + e; }
        tab_rows_to_fp4<NR>(F.lane, src, dst, sc); }
}

__device__ __forceinline__ f32x4 skinny16(const bf16* A  , const bf16* Wt, int wave, int lane, LAS float* scr) {
    f32x4 acc = (f32x4){0.f, 0.f, 0.f, 0.f};
    const bf16x8* ap = (const bf16x8*)(A + (size_t)(16 * (wave & 3) + (lane & 15)) * DMODEL + 512 * (wave >> 2) + 8 * (lane >> 4));
    const bf16x8* bp = (const bf16x8*)(Wt + (size_t)(lane & 15) * DMODEL + 512 * (wave >> 2) + 8 * (lane >> 4));
    bf16x8 af[16], bfr[16];
#pragma unroll
    for (int kk = 0; kk < 16; ++kk) { af[kk] = ap[4 * kk]; bfr[kk] = bp[4 * kk]; }
#pragma unroll
    for (int kk = 0; kk < 16; ++kk) acc = __builtin_amdgcn_mfma_f32_16x16x32_bf16(af[kk], bfr[kk], acc, 0, 0, 0);
    if (wave >= 4) *(LAS f32x4*)(scr + (wave - 4) * 256 + 4 * lane) = acc;
    __syncthreads();
    if (wave < 4) acc += *(const LAS f32x4*)(scr + wave * 256 + 4 * lane);
    return acc;
}
__device__ __forceinline__ int perm16(int k16) { return 8 * ((k16 >> 2) & 1) + 4 * (k16 >> 3) + (k16 & 3); }
__device__ __forceinline__ void p2a_item(Frame& F, int b, int n) {
    const int tid = F.tid, lane = F.lane, wave = F.wave;
    const int t0 = b * SEQ + n * GLA_C;
    const bf16* PQ = (const bf16*)(F.ws + WS_PQ);
    LAS float* glrL = (LAS float*)F.lds;
    LAS float* SEG = (LAS float*)(F.lds + 4096);
    LAS unsigned char* QI = F.lds + 8192;
    LAS unsigned char* KI = F.lds + 24576;
    LAS unsigned char* RQ = F.lds + 40960;
    LAS unsigned char* RK = F.lds + 57344;
    LAS unsigned char* RV = F.lds + 73728;
    v4u rq[2], rk[2], rv[4];
#define P2A_LOAD(hh) do { _Pragma("unroll") for (int i_ = 0; i_ < 2; ++i_) { const int p_ = tid + 512 * i_; const bf16* src_ = PQ + (size_t)(t0 + (p_ >> 4)) * 3072 + (hh) * 128 + (p_ & 15) * 8; \
        rq[i_] = *(const GAS v4u*)src_; rk[i_] = *(const GAS v4u*)(src_ + 512); } \
      _Pragma("unroll") for (int i_ = 0; i_ < 4; ++i_) { const int p_ = tid + 512 * i_; rv[i_] = *(const GAS v4u*)(PQ + (size_t)(t0 + (p_ >> 5)) * 3072 + 1024 + (hh) * 256 + (p_ & 31) * 8); } } while (0)
#define P2A_STORE() do { _Pragma("unroll") for (int i_ = 0; i_ < 2; ++i_) { const int p_ = tid + 512 * i_; *(LAS v4u*)(RQ + p_ * 16) = rq[i_]; *(LAS v4u*)(RK + p_ * 16) = rk[i_]; } \
      _Pragma("unroll") for (int i_ = 0; i_ < 4; ++i_) { const int p_ = tid + 512 * i_; *(LAS v4u*)(RV + p_ * 16) = rv[i_]; } } while (0)
    P2A_LOAD(0);
    { const f32x4 a = skinny16((const bf16*)(F.ws + WS_A0) + (size_t)t0 * DMODEL, (const bf16*)(F.ws + WS_WGL), wave, lane, (LAS float*)(F.lds + 106496));
      if (wave < 4) {
#pragma unroll
        for (int r = 0; r < 4; ++r) glrL[(16 * wave + 4 * (lane >> 4) + r) * 16 + (lane & 15)] = a[r]; } }
    P2A_STORE();
    __syncthreads();
    const int k = tid & 127, iq = tid >> 7;
    const int pos = (k & ~15) | perm16(k & 15);
    float wgn[16], bgn;
#pragma unroll
    for (int j = 0; j < 16; ++j) wgn[j] = F.in[IN_GLA_W_G2][j * 512 + k];
    bgn = F.in[IN_GLA_B_G][k];
    for (int h = 0; h < GLA_H; ++h) {
        const int cid = (b * 4 + h) * 32 + n;
        if (h + 1 < GLA_H) P2A_LOAD(h + 1);
        float wg[16];
#pragma unroll
        for (int j = 0; j < 16; ++j) wg[j] = wgn[j];
        const float bg = bgn;
        if (h + 1 < GLA_H) {
#pragma unroll
            for (int j = 0; j < 16; ++j) wgn[j] = F.in[IN_GLA_W_G2][j * 512 + (h + 1) * 128 + k];
            bgn = F.in[IN_GLA_B_G][(h + 1) * 128 + k]; }
        float bc[16];
#pragma unroll
        for (int ii = 0; ii < 16; ++ii) { const LAS f32x4* gp = (const LAS f32x4*)(glrL + (iq * 16 + ii) * 16); float s = bg;
#pragma unroll
            for (int q4 = 0; q4 < 4; ++q4) { const f32x4 gv = gp[q4]; s += (gv[0] * wg[4 * q4] + gv[1] * wg[4 * q4 + 1]) + (gv[2] * wg[4 * q4 + 2] + gv[3] * wg[4 * q4 + 3]); }
            bc[ii] = log_sigmoid(s) * (1.0f / 16.0f); }
#pragma unroll
        for (int ii = 1; ii < 16; ++ii) bc[ii] += bc[ii - 1];
        SEG[iq * 128 + k] = bc[15];
        __syncthreads();
        float off = 0.f, tot = 0.f;
#pragma unroll
        for (int q = 0; q < 4; ++q) { const float sv = SEG[q * 128 + k]; tot += sv; if (q < iq) off += sv; }
        unsigned kt[8];
#pragma unroll
        for (int ii = 0; ii < 16; ii += 2) {
            float qa[2], ka[2];
#pragma unroll
            for (int e = 0; e < 2; ++e) { const int i = iq * 16 + ii + e; const float bb = bc[ii + e] + off;
                const float qv = bf2f(*(const LAS unsigned short*)(RQ + i * 256 + k * 2)), kv = bf2f(*(const LAS unsigned short*)(RK + i * 256 + k * 2));
                qa[e] = qv * __expf(bb); ka[e] = kv * __expf(-bb);
                *(LAS unsigned short*)(QI + i * 256 + pos * 2) = (unsigned short)f2bf(qa[e]);
                *(LAS unsigned short*)(KI + i * 256 + pos * 2) = (unsigned short)f2bf(ka[e]); }
            kt[ii >> 1] = pk2(ka[0], ka[1]); }
        { GAS v4u* dst = (GAS v4u*)((bf16*)(F.ws + WS_KT) + (size_t)cid * 8192 + k * 64 + iq * 16);
          dst[0] = (v4u){kt[0], kt[1], kt[2], kt[3]}; dst[1] = (v4u){kt[4], kt[5], kt[6], kt[7]}; }
        if (iq == 0) ((float*)(F.ws + WS_DEXP))[(size_t)cid * 128 + k] = __expf(tot);
        { const int nn = tid & 255, jh = tid >> 8; unsigned w[16];
#pragma unroll
          for (int jj = 0; jj < 32; jj += 2) { const unsigned lo = *(const LAS unsigned short*)(RV + (32 * jh + jj) * 512 + nn * 2), hi2 = *(const LAS unsigned short*)(RV + (32 * jh + jj + 1) * 512 + nn * 2); w[jj >> 1] = lo | (hi2 << 16); }
          GAS v4u* dst = (GAS v4u*)((bf16*)(F.ws + WS_VT) + (size_t)cid * 16384 + nn * 64 + 32 * jh);
#pragma unroll
          for (int q = 0; q < 4; ++q) dst[q] = (v4u){w[4 * q], w[4 * q + 1], w[4 * q + 2], w[4 * q + 3]}; }
        __syncthreads();
        if (wave < 4) { const int ib = (wave == 1 || wave == 2) ? 1 : 0, jb = (wave >= 2) ? 1 : 0, r32 = lane & 31, hi = lane >> 5;
            f32x16 acc = (f32x16){};
            if (wave != 3) {
#pragma unroll
                for (int kk = 0; kk < 8; ++kk) { const bf16x8 af = *(const LAS bf16x8*)(KI + (32 * jb + r32) * 256 + (16 * kk + 8 * hi) * 2);
                    const bf16x8 bfr = *(const LAS bf16x8*)(QI + (32 * ib + r32) * 256 + (16 * kk + 8 * hi) * 2);
                    acc = __builtin_amdgcn_mfma_f32_32x32x16_bf16(af, bfr, acc, 0, 0, 0); } }
            const int i = 32 * ib + r32;
            bf16* at = (bf16*)(F.ws + WS_AT) + (size_t)cid * 4096 + i * 64 + 32 * jb + 4 * hi;
#pragma unroll
            for (int g = 0; g < 4; ++g) { float v[4];
#pragma unroll
                for (int e = 0; e < 4; ++e) { const int j = 32 * jb + 8 * g + 4 * hi + e; v[e] = (j <= i) ? acc[4 * g + e] : 0.f; }
                *(GAS v2u*)(at + 8 * g) = (v2u){pk2(v[0], v[1]), pk2(v[2], v[3])}; } }
        { GAS v4u* dst = (GAS v4u*)((bf16*)(F.ws + WS_QT) + (size_t)cid * 8192); const LAS v4u* src = (const LAS v4u*)QI; dst[tid] = src[tid]; dst[tid + 512] = src[tid + 512]; }
        if (h + 1 < GLA_H) P2A_STORE();
        __syncthreads();
    }
#undef P2A_LOAD
#undef P2A_STORE
}

__device__ __forceinline__ unsigned cvtpk(float lo, float hi) { typedef float f2 __attribute__((ext_vector_type(2))); typedef __bf16 b2 __attribute__((ext_vector_type(2))); f2 v = {lo, hi}; b2 r = __builtin_convertvector(v, b2); return __builtin_bit_cast(unsigned, r); }
__device__ __forceinline__ void glds16s(const void* sbase, unsigned voff, unsigned lds_dst) { unsigned keep;
    asm volatile("s_mov_b32 %0, m0\n\ts_mov_b32 m0, %3\n\ts_nop 0\n\tglobal_load_lds_dwordx4 %1, %2\n\ts_mov_b32 m0, %0" : "=&s"(keep) : "v"(voff), "s"(sbase), "s"(lds_dst) : "memory"); }
__device__ __forceinline__ void glds16s_nt(const void* sbase, unsigned voff, unsigned lds_dst) { unsigned keep;
    asm volatile("s_mov_b32 %0, m0\n\ts_mov_b32 m0, %3\n\ts_nop 0\n\tglobal_load_lds_dwordx4 %1, %2 nt\n\ts_mov_b32 m0, %0" : "=&s"(keep) : "v"(voff), "s"(sbase), "s"(lds_dst) : "memory"); }
constexpr int P2B_STAGE = 40960, P2B_BUF0 = 4096;
__device__ __forceinline__ void p2b_seq(Frame& F, int bh, int probe_skip = 0) {
    const int lane = F.lane, wave = F.wave, r32 = lane & 31, hi = lane >> 5;
    const int b = bh >> 2, h = bh & 3;
    const bf16* PQ = (const bf16*)(F.ws + WS_PQ); bf16* OG = (bf16*)(F.ws + WS_A0);
    LAS float* red = (LAS float*)F.lds;
    const unsigned lds0 = (unsigned)(uintptr_t)F.lds + P2B_BUF0;
    f32x16 S[4];
#pragma unroll
    for (int kb = 0; kb < 4; ++kb) S[kb] = (f32x16){};
    int sq[2], sk[2];
#pragma unroll
    for (int i = 0; i < 2; ++i) { const int P = wave + 8 * i;
        { const int row = 4 * P + (lane >> 4), c = (lane & 15) ^ (row & 15); sq[i] = row * 256 + c * 16; }
        { const int row = 8 * P + (lane >> 3), c = (lane & 7) ^ ((row >> 1) & 7); sk[i] = row * 128 + c * 16; } }
#define P2B_DMA(cid_, bufi_) do { const unsigned d_ = lds0 + (bufi_) * P2B_STAGE; \
        const char* q_ = (const char*)(F.ws + WS_QT) + (size_t)(cid_) * 16384; const char* k_ = (const char*)(F.ws + WS_KT) + (size_t)(cid_) * 16384; const char* a_ = (const char*)(F.ws + WS_AT) + (size_t)(cid_) * 8192; \
        glds16s(q_, sq[0], (unsigned)__builtin_amdgcn_readfirstlane(d_ + wave * 1024)); glds16s(q_, sq[1], (unsigned)__builtin_amdgcn_readfirstlane(d_ + (wave + 8) * 1024)); \
        glds16s(k_, sk[0], (unsigned)__builtin_amdgcn_readfirstlane(d_ + 16384 + wave * 1024)); glds16s(k_, sk[1], (unsigned)__builtin_amdgcn_readfirstlane(d_ + 16384 + (wave + 8) * 1024)); \
        glds16s(a_, sk[0], (unsigned)__builtin_amdgcn_readfirstlane(d_ + 32768 + wave * 1024)); } while (0)
    bf16x8 vf[4];
    LAS float* dxL = (LAS float*)(F.lds + P2B_BUF0 + 2 * P2B_STAGE);
    const int tid = F.tid;
    constexpr int P2B_VTW = P2B_BUF0 + 2 * P2B_STAGE + 1024, P2B_RW = P2B_VTW + 32768;
    static_assert(P2B_RW + 32768 <= RING_BYTES, "GLA recurrence LDS map");
    const unsigned vtw0 = (unsigned)(uintptr_t)F.lds + P2B_VTW + wave * 4096, rw0 = (unsigned)(uintptr_t)F.lds + P2B_RW + wave * 4096;
    int sv[4], sr[4];
#pragma unroll
    for (int i = 0; i < 4; ++i) { { const int row = 8 * i + (lane >> 3), c = (lane & 7) ^ ((row >> 1) & 7); sv[i] = (32 * wave + row) * 128 + c * 16; }
                                  { const int row = 16 * i + (lane >> 2), c = (lane & 3) ^ ((row >> 2) & 3); sr[i] = row * 6144 + c * 16; } }
#define P2B_DMA_V(cid_) do { const char* v_ = (const char*)(F.ws + WS_VT) + (size_t)(cid_) * 32768; _Pragma("unroll") for (int i_ = 0; i_ < 4; ++i_) glds16s(v_, sv[i_], (unsigned)__builtin_amdgcn_readfirstlane(vtw0 + i_ * 1024)); } while (0)
#define P2B_DMA_R(t0_) do { const char* r_ = (const char*)(PQ + (size_t)(t0_) * 3072 + 2048 + h * 256 + 32 * wave); _Pragma("unroll") for (int i_ = 0; i_ < 4; ++i_) glds16s(r_, sr[i_], (unsigned)__builtin_amdgcn_readfirstlane(rw0 + i_ * 1024)); } while (0)
    const LAS unsigned char* vtw = F.lds + P2B_VTW + wave * 4096 + r32 * 128; const LAS unsigned char* rwl = F.lds + P2B_RW + wave * 4096;
    { const int cid = bh * 32;
      P2B_DMA(cid, 0); P2B_DMA_V(cid); P2B_DMA_R(b * SEQ);
      if (tid < 32) *(LAS f32x4*)(dxL + 4 * tid) = *(const f32x4*)((const float*)(F.ws + WS_DEXP) + (size_t)cid * 128 + 4 * tid); }
    asm volatile("s_waitcnt vmcnt(0)" ::: "memory");
    __syncthreads();
    const int kx0 = (r32 >> 1) & 7;
#pragma unroll
    for (int s = 0; s < 4; ++s) vf[s] = *(const LAS bf16x8*)(vtw + (((2 * s + hi) ^ kx0) << 4));
    const int qoff = r32 * 256, koff = 16384 + r32 * 128, aoff = 32768 + r32 * 128;
    const int qx = r32 & 15, kx = (r32 >> 1) & 7;
    for (int n = 0; n < GLA_NCH; ++n) {
        const int cid = bh * 32 + n, t0 = b * SEQ + n * GLA_C;
        const LAS unsigned char* buf = F.lds + P2B_BUF0 + (n & 1) * P2B_STAGE;
        const LAS float* DX = dxL + (n & 1) * 128;
        f32x4 dxn = (f32x4){0.f, 0.f, 0.f, 0.f};
        if (n + 1 < GLA_NCH) { P2B_DMA(cid + 1, (n + 1) & 1);
            if (tid < 32) dxn = *(const f32x4*)((const float*)(F.ws + WS_DEXP) + (size_t)(cid + 1) * 128 + 4 * tid); }
        if (n + 1 < GLA_NCH) P2B_DMA_V(cid + 1);
        f32x16 oT[2];
        oT[0] = (f32x16){}; oT[1] = (f32x16){};
#pragma unroll
        for (int kb = 0; kb < 4; ++kb) {
            bf16x8 qf[2][2];
#pragma unroll
            for (int s = 0; s < 2; ++s)
#pragma unroll
                for (int ib = 0; ib < 2; ++ib) qf[s][ib] = *(const LAS bf16x8*)(buf + qoff + ib * 8192 + (((4 * kb + 2 * s + hi) ^ qx) << 4));
            __builtin_amdgcn_sched_barrier(0);
#pragma unroll
            for (int s = 0; s < 2; ++s) { v4u sw; sw.x = cvtpk(S[kb][8 * s], S[kb][8 * s + 1]); sw.y = cvtpk(S[kb][8 * s + 2], S[kb][8 * s + 3]); sw.z = cvtpk(S[kb][8 * s + 4], S[kb][8 * s + 5]); sw.w = cvtpk(S[kb][8 * s + 6], S[kb][8 * s + 7]);
                const bf16x8 sf = __builtin_bit_cast(bf16x8, sw);
#pragma unroll
                for (int ib = 0; ib < 2; ++ib) oT[ib] = __builtin_amdgcn_mfma_f32_32x32x16_bf16(sf, qf[s][ib], oT[ib], 0, 0, 0); }
            __builtin_amdgcn_sched_barrier(0); }
        { bf16x8 af[2][4];
#pragma unroll
          for (int ib = 0; ib < 2; ++ib)
#pragma unroll
              for (int s = 0; s < 4; ++s) af[ib][s] = *(const LAS bf16x8*)(buf + aoff + ib * 4096 + (((2 * s + hi) ^ kx) << 4));
          __builtin_amdgcn_sched_barrier(0);
#pragma unroll
          for (int ib = 0; ib < 2; ++ib)
#pragma unroll
              for (int s = 0; s < 4; ++s) oT[ib] = __builtin_amdgcn_mfma_f32_32x32x16_bf16(vf[s], af[ib][s], oT[ib], 0, 0, 0);
          __builtin_amdgcn_sched_barrier(0); }
#pragma unroll
        for (int kh = 0; kh < 2; ++kh) { bf16x8 kf[2][4];
#pragma unroll
            for (int kb = 0; kb < 2; ++kb)
#pragma unroll
                for (int s = 0; s < 4; ++s) kf[kb][s] = *(const LAS bf16x8*)(buf + koff + (2 * kh + kb) * 4096 + (((2 * s + hi) ^ kx) << 4));
            __builtin_amdgcn_sched_barrier(0);
#pragma unroll
            for (int kb = 0; kb < 2; ++kb)
#pragma unroll
                for (int s = 0; s < 4; ++s) S[2 * kh + kb] = __builtin_amdgcn_mfma_f32_32x32x16_bf16(kf[kb][s], vf[s], S[2 * kh + kb], 0, 0, 0);
            __builtin_amdgcn_sched_barrier(0); }
#pragma unroll
        for (int kb = 0; kb < 4; ++kb)
#pragma unroll
            for (int g = 0; g < 4; ++g) { const f32x4 dv = *(const LAS f32x4*)(DX + 32 * kb + 8 * g + 4 * hi);
                S[kb][4 * g] *= dv[0]; S[kb][4 * g + 1] *= dv[1]; S[kb][4 * g + 2] *= dv[2]; S[kb][4 * g + 3] *= dv[3]; }
        LAS float* rp = red + (n & 1) * 512;
#pragma unroll
        for (int ib = 0; ib < 2; ++ib) { float ss = 0.f;
#pragma unroll
            for (int r = 0; r < 16; ++r) ss += oT[ib][r] * oT[ib][r];
            ss += __shfl_xor(ss, 32);
            if (hi == 0) rp[wave * 64 + 32 * ib + r32] = ss; }
        if (n + 1 < GLA_NCH && tid < 32) *(LAS f32x4*)(dxL + ((n + 1) & 1) * 128 + 4 * tid) = dxn;
        asm volatile("s_waitcnt vmcnt(0)" ::: "memory");
        __syncthreads();
        if (probe_skip != 1)
#pragma unroll
        for (int ib = 0; ib < 2; ++ib) { float tot = 0.f;
#pragma unroll
            for (int w = 0; w < 8; ++w) tot += rp[w * 64 + 32 * ib + r32];
            const float rstd = __builtin_amdgcn_rsqf(tot * (1.0f / 256.0f) + EPS);
            const int t = t0 + 32 * ib + r32;
            bf16* orow = OG + (size_t)t * DMODEL + h * 256 + 32 * wave + 4 * hi;
#pragma unroll
            for (int g = 0; g < 4; ++g) { const int ri = 32 * ib + r32; const v2u rwv = *(const LAS v2u*)(rwl + ri * 64 + ((g ^ ((ri >> 2) & 3)) << 4) + 8 * hi);
                *(GAS v2u*)(orow + 8 * g) = (v2u){cvtpk(oT[ib][4 * g] * rstd * bflo(rwv.x), oT[ib][4 * g + 1] * rstd * bfhi(rwv.x)), cvtpk(oT[ib][4 * g + 2] * rstd * bflo(rwv.y), oT[ib][4 * g + 3] * rstd * bfhi(rwv.y))};
                __builtin_amdgcn_sched_barrier(0); } }
        if (n + 1 < GLA_NCH) {
#pragma unroll
            for (int s = 0; s < 4; ++s) vf[s] = *(const LAS bf16x8*)(vtw + (((2 * s + hi) ^ kx0) << 4));
            asm volatile("s_waitcnt lgkmcnt(0)" ::: "memory");
            P2B_DMA_R(t0 + GLA_C); }
    }
#undef P2B_DMA_V
#undef P2B_DMA_R
#undef P2B_DMA
}
__device__ __forceinline__ unsigned mono(float f) { const unsigned u = __builtin_bit_cast(unsigned, f); return (u & 0x80000000u) ? ~u : (u | 0x80000000u); }
__device__ __forceinline__ float unmono(unsigned m) { const unsigned u = (m & 0x80000000u) ? (m ^ 0x80000000u) : ~m; return __builtin_bit_cast(float, u); }
#define KMAX(a, b) ((a) > (b) ? (a) : (b))
#define KMIN(a, b) ((a) < (b) ? (a) : (b))
#define INSERT16(L, x) do { unsigned x_ = (x); _Pragma("unroll") for (int p_ = 0; p_ < 16; ++p_) { const unsigned t_ = KMAX(L[p_], x_); x_ = KMIN(L[p_], x_); L[p_] = t_; } } while (0)
#define MERGE16(L, O) do { _Pragma("unroll") for (int p_ = 0; p_ < 16; ++p_) L[p_] = KMAX(L[p_], O[15 - p_]); \
    _Pragma("unroll") for (int st_ = 8; st_ >= 1; st_ >>= 1) { _Pragma("unroll") for (int p_ = 0; p_ < 16; ++p_) { if ((p_ & st_) == 0) { const unsigned a_ = L[p_], b_ = L[p_ + st_]; L[p_] = KMAX(a_, b_); L[p_ + st_] = KMIN(a_, b_); } } } } while (0)
#define SORT16(L) do { _Pragma("unroll") for (int k_ = 2; k_ <= 16; k_ <<= 1) { _Pragma("unroll") for (int j_ = k_ >> 1; j_ >= 1; j_ >>= 1) { _Pragma("unroll") for (int i_ = 0; i_ < 16; ++i_) { \
    if ((i_ & j_) == 0) { const unsigned a_ = L[i_], b_ = L[i_ | j_]; const bool desc_ = ((i_ & k_) == 0) || (k_ == 16); L[i_] = desc_ ? KMAX(a_, b_) : KMIN(a_, b_); L[i_ | j_] = desc_ ? KMIN(a_, b_) : KMAX(a_, b_); } } } } } while (0)
__device__ __forceinline__ void p5_wave(int lane, const LAS unsigned short* row, LAS int* idsL, LAS float* gatesL) {
    const int q = lane & 3, c = (lane >> 2) & 1, head = lane >> 3, r8 = lane & 7;
    const LAS unsigned short* mine = row + lane * 32;
    unsigned L[16], O[16];
    const int sw = (lane >> 2) & 3;
#pragma unroll
    for (int it = 0; it < 4; ++it) { const int c16 = it ^ sw; const v4u v = *(const LAS v4u*)(mine + 8 * c16);
#pragma unroll
        for (int e = 0; e < 8; ++e) { const int idx = q * 32 + c16 * 8 + e; const unsigned wv = v[e >> 1]; const float sv = (e & 1) ? bfhi(wv) : bflo(wv);
            const unsigned key = (mono(sv) & ~127u) | (unsigned)(127 - idx); if (it < 2) L[8 * it + e] = key; else O[8 * (it - 2) + e] = key; } }
    SORT16(L); SORT16(O); MERGE16(L, O);
#pragma unroll
    for (int p = 0; p < 16; ++p) O[p] = __shfl_xor(L[p], 1);
    MERGE16(L, O);
#pragma unroll
    for (int p = 0; p < 16; ++p) O[p] = __shfl_xor(L[p], 2);
    MERGE16(L, O);
#pragma unroll
    for (int p = 0; p < 16; ++p) O[p] = __shfl_xor(L[p], 4);
    unsigned A[16], B[16];
#pragma unroll
    for (int p = 0; p < 16; ++p) { A[p] = c ? O[p] : L[p]; B[p] = c ? L[p] : O[p]; }
    unsigned ka = A[0], kb8 = A[8];
#pragma unroll
    for (int p = 1; p < 8; ++p) { ka = (r8 == p) ? A[p] : ka; kb8 = (r8 == p) ? A[8 + p] : kb8; }
    const float va = unmono(ka & ~127u), va8 = unmono(kb8 & ~127u);
    const unsigned pa = ((127u - (ka & 127u)) << 7), pa8 = ((127u - (kb8 & 127u)) << 7);
    const int nvalid = 16 / (r8 + 1);
    unsigned Cn[16];
#pragma unroll
    for (int j = 0; j < 16; ++j) { const float vb = unmono(B[j] & ~127u); const unsigned pb = 127u - (B[j] & 127u);
        const unsigned key = (mono(va + vb) & ~16383u) | pa | pb; Cn[j] = (j < nvalid) ? key : 0u; }
    { const float vb0 = unmono(B[0] & ~127u); const unsigned pb0 = 127u - (B[0] & 127u); const unsigned key = (mono(va8 + vb0) & ~16383u) | pa8 | pb0; INSERT16(Cn, key); }
#pragma unroll
    for (int p = 0; p < 16; ++p) O[p] = __shfl_xor(Cn[p], 1);
    MERGE16(Cn, O);
#pragma unroll
    for (int p = 0; p < 16; ++p) O[p] = __shfl_xor(Cn[p], 2);
    MERGE16(Cn, O);
#pragma unroll
    for (int p = 0; p < 16; ++p) O[p] = __shfl_xor(Cn[p], 4);
    MERGE16(Cn, O);
    unsigned k0 = Cn[0], k1 = Cn[8];
#pragma unroll
    for (int p = 1; p < 8; ++p) { k0 = (r8 == p) ? Cn[p] : k0; k1 = (r8 == p) ? Cn[8 + p] : k1; }
    const int ia0 = (k0 >> 7) & 127, ib0 = k0 & 127, ia1 = (k1 >> 7) & 127, ib1 = k1 & 127;
    const LAS unsigned short* hrow = row + head * 256;
    const float s0 = bf2f(hrow[ia0]) + bf2f(hrow[128 + ib0]), s1 = bf2f(hrow[ia1]) + bf2f(hrow[128 + ib1]);
    float mx = fmaxf(s0, s1);
    mx = fmaxf(mx, __shfl_xor(mx, 1)); mx = fmaxf(mx, __shfl_xor(mx, 2)); mx = fmaxf(mx, __shfl_xor(mx, 4));
    const float e0 = __expf(s0 - mx), e1 = __expf(s1 - mx);
    float sm = e0 + e1;
    sm += __shfl_xor(sm, 1); sm += __shfl_xor(sm, 2); sm += __shfl_xor(sm, 4);
    const float inv = 1.0f / sm;
    const int o = head * 16 + r8;
    idsL[o] = ia0 * 128 + ib0; idsL[o + 8] = ia1 * 128 + ib1; gatesL[o] = e0 * inv; gatesL[o + 8] = e1 * inv;
}
typedef float f32x2 __attribute__((ext_vector_type(2)));
typedef int i32x8 __attribute__((ext_vector_type(8)));
#ifndef MFMA_U
#define MFMA_U 1
#endif
#define FP4_CVT(W, SEL) __builtin_amdgcn_cvt_scalef32_pk_f32_fp4((W), 1.0f, (SEL))
template <bool FINAL>
__device__ __forceinline__ void peer_gather(Frame& F, int layer, const bf16* HBin, float* Hout, bf16* HB, float* RP) {
    const int lane = F.lane, half = lane >> 5; const int gw = blockIdx.x * NWAVES + F.wave, NGW = F.G * NWAVES;
    const unsigned char* UT = F.ws + WS_TAB + (size_t)(2 * layer) * PEER_NEXP * 512; const unsigned char* VT = UT + (size_t)PEER_NEXP * 512;
    const float* USC = (const float*)(F.ws + WS_TSC) + (size_t)(2 * layer) * PEER_NEXP; const float* VSC = USC + PEER_NEXP;
    const float* gf = F.in[IN_NORM_FFN] + layer * DMODEL; const float* gfin = F.in[IN_NORM_FINAL];
    LAS unsigned short* rowL = (LAS unsigned short*)(F.lds + F.wave * 8192);
    LAS int* idsL = (LAS int*)(F.lds + 65536 + F.wave * 1024); LAS float* gatesL = (LAS float*)(F.lds + 65536 + F.wave * 1024 + 512);
    LAS float* actL = (LAS float*)(F.lds + 73728 + F.wave * 512);
    LAS unsigned char* xbL = (LAS unsigned char*)(F.lds + 143360 + F.wave * 1024);
    const bf16* SC = (const bf16*)(F.ws + WS_SC);
    LAS float* wfl = (LAS float*)(F.lds + 77824);
    if (!FINAL) { const f32x4* src = (const f32x4*)(F.ws + WS_WFLF);
#pragma unroll
        for (int i = 0; i < 8; ++i) { const int ch = F.tid + 512 * i, c = ch >> 8, jb = (ch >> 3) & 31, q = ch & 7; *(LAS f32x4*)(wfl + c * 1024 + jb * 32 + ((q ^ (jb & 7)) << 2)) = src[ch]; }
        __syncthreads(); }
    const unsigned rowA = (unsigned)(uintptr_t)F.lds + F.wave * 8192;
#define ROW_DMA(tt) do { const char* r_ = (const char*)(SC + (size_t)(tt) * 2048); _Pragma("unroll") for (int i_ = 0; i_ < 4; ++i_) glds16s(r_, (unsigned)(lane * 16 + i_ * 1024), (unsigned)__builtin_amdgcn_readfirstlane(rowA + i_ * 1024)); } while (0)
    gu32* tctr = F.ctl + 2048 + 64 * (8 * layer + ((int)blockIdx.x & 7)); const int tg = (int)blockIdx.x & 7;
    int kcur = 0;
    if (lane == 0) kcur = (int)__hip_atomic_fetch_add(tctr, 1u, __ATOMIC_RELAXED, __HIP_MEMORY_SCOPE_AGENT);
    kcur = __builtin_amdgcn_readfirstlane(kcur);
    if (kcur < T_TOK / 8) ROW_DMA(8 * kcur + tg);
    while (kcur < T_TOK / 8) {
        const int t = 8 * kcur + tg;
        int j32 = lane & 31; asm volatile("" : "+v"(j32));
        asm volatile("s_waitcnt vmcnt(0)" ::: "memory");
        const GAS v4u* hin = (const GAS v4u*)(HBin + (size_t)t * DMODEL) + 4 * j32;
        v4u hw[4];
#pragma unroll
        for (int q = 0; q < 4; ++q) hw[q] = hin[q];
        int knext = 0;
        if (lane == 0) knext = (int)__hip_atomic_fetch_add(tctr, 1u, __ATOMIC_RELAXED, __HIP_MEMORY_SCOPE_AGENT);
        p5_wave(lane, rowL, idsL, gatesL);
        asm volatile("s_waitcnt lgkmcnt(0)" ::: "memory");
        knext = __builtin_amdgcn_readfirstlane(knext);
        if (knext < T_TOK / 8) ROW_DMA(8 * knext + tg);
#if MFMA_U
        int l16 = lane & 15, lq = lane >> 4; asm volatile("" : "+v"(l16)); asm volatile("" : "+v"(lq));
        int one_e8 = 0x7f7f7f7f; asm volatile("" : "+v"(one_e8));
        v4u xb[8]; float xsc;
        { float ss = 0.f; f32x4 hv[8];
#pragma unroll
          for (int q = 0; q < 4; ++q) { const v4u w = hw[q]; hv[2 * q] = (f32x4){bflo(w.x), bfhi(w.x), bflo(w.y), bfhi(w.y)}; hv[2 * q + 1] = (f32x4){bflo(w.z), bfhi(w.z), bflo(w.w), bfhi(w.w)}; }
#pragma unroll
          for (int q = 0; q < 8; ++q) { ss += (hv[q][0] * hv[q][0] + hv[q][1] * hv[q][1]) + (hv[q][2] * hv[q][2] + hv[q][3] * hv[q][3]); }
          const float rstd = __builtin_amdgcn_rsqf(wave_sum(ss) * (0.5f / DMODEL) + EPS);
          const f32x4* g4 = (const f32x4*)gf + 8 * j32;
          float mx = 0.f;
#pragma unroll
          for (int q = 0; q < 8; ++q) { const f32x4 g = g4[q]; hv[q] = (f32x4){hv[q][0] * rstd * g[0], hv[q][1] * rstd * g[1], hv[q][2] * rstd * g[2], hv[q][3] * rstd * g[3]};
              mx = fmaxf(mx, fmaxf(fmaxf(fabsf(hv[q][0]), fabsf(hv[q][1])), fmaxf(fabsf(hv[q][2]), fabsf(hv[q][3])))); }
          mx = wave_max(mx);
          const float enc = (mx > 0.f) ? 6.0f * __builtin_amdgcn_rcpf(mx) : 1.0f; xsc = (mx > 0.f) ? mx * (1.0f / 6.0f) : 1.0f;
          unsigned xw[4];
#pragma unroll
          for (int q = 0; q < 4; ++q) { unsigned w = 0;
              w = __builtin_amdgcn_cvt_scalef32_pk_fp4_f32(w, hv[2 * q][0] * enc, hv[2 * q][1] * enc, 1.0f, 0); w = __builtin_amdgcn_cvt_scalef32_pk_fp4_f32(w, hv[2 * q][2] * enc, hv[2 * q][3] * enc, 1.0f, 1);
              w = __builtin_amdgcn_cvt_scalef32_pk_fp4_f32(w, hv[2 * q + 1][0] * enc, hv[2 * q + 1][1] * enc, 1.0f, 2); w = __builtin_amdgcn_cvt_scalef32_pk_fp4_f32(w, hv[2 * q + 1][2] * enc, hv[2 * q + 1][3] * enc, 1.0f, 3); xw[q] = w; }
          if (half == 0) *(LAS v4u*)(xbL + j32 * 16) = (v4u){xw[0], xw[1], xw[2], xw[3]};
          const LAS v4u* xbr = (const LAS v4u*)(xbL + lq * 16);
#pragma unroll
          for (int kb = 0; kb < 8; ++kb) xb[kb] = xbr[4 * kb]; }
        __builtin_amdgcn_sched_barrier(0);
#else
        typedef __bf16 bf16x2_t __attribute__((ext_vector_type(2)));
        bf16x2_t xv[16];
        { float ss = 0.f; f32x4 hv[8];
#pragma unroll
          for (int q = 0; q < 4; ++q) { const v4u w = hw[q]; hv[2 * q] = (f32x4){bflo(w.x), bfhi(w.x), bflo(w.y), bfhi(w.y)}; hv[2 * q + 1] = (f32x4){bflo(w.z), bfhi(w.z), bflo(w.w), bfhi(w.w)}; }
#pragma unroll
          for (int q = 0; q < 8; ++q) { ss += (hv[q][0] * hv[q][0] + hv[q][1] * hv[q][1]) + (hv[q][2] * hv[q][2] + hv[q][3] * hv[q][3]); }
          const float rstd = __builtin_amdgcn_rsqf(wave_sum(ss) * (0.5f / DMODEL) + EPS);
          const f32x4* g4 = (const f32x4*)gf + 8 * j32;
#pragma unroll
          for (int q = 0; q < 8; ++q) { const f32x4 g = g4[q]; xv[2 * q] = __builtin_bit_cast(bf16x2_t, cvtpk(hv[q][0] * rstd * g[0], hv[q][1] * rstd * g[1])); xv[2 * q + 1] = __builtin_bit_cast(bf16x2_t, cvtpk(hv[q][2] * rstd * g[2], hv[q][3] * rstd * g[3])); } }
#endif
        const int id0 = idsL[lane], id1 = idsL[64 + lane];
        const float gt0 = gatesL[lane], gt1 = gatesL[64 + lane];
        const float su0 = USC[id0], su1 = USC[id1], sv0 = VSC[id0], sv1 = VSC[id1];
#if MFMA_U
        for (int bt = 0; bt < 2; ++bt) {
            const float gtv = bt ? gt1 : gt0, suv = bt ? su1 : su0, svv = bt ? sv1 : sv0;
            v4u uw[4][8];
#pragma unroll
            for (int g = 0; g < 4; ++g) { const int e = idsL[64 * bt + 16 * g + l16]; const GAS v4u* rp = (const GAS v4u*)(UT + (size_t)e * 512) + lq;
#pragma unroll
                for (int kb = 0; kb < 8; ++kb) uw[g][kb] = rp[4 * kb]; }
            __builtin_amdgcn_sched_barrier(0);
            f32x4 ac[4];
#pragma unroll
            for (int g = 0; g < 4; ++g) { f32x4 a = (f32x4){0.f, 0.f, 0.f, 0.f};
#pragma unroll
                for (int kb = 0; kb < 8; ++kb) { const v4u w = uw[g][kb];
                    const v4u xk = xb[kb];
                    a = __builtin_amdgcn_mfma_scale_f32_16x16x128_f8f6f4((i32x8){(int)w.x, (int)w.y, (int)w.z, (int)w.w, 0, 0, 0, 0}, (i32x8){(int)xk.x, (int)xk.y, (int)xk.z, (int)xk.w, 0, 0, 0, 0}, a, 4, 4, 0, one_e8, 0, one_e8); }
                ac[g] = a; }
            const int gs = (lane >> 2) & 3, rr = lane & 3;
            const f32x4 sg = gs == 0 ? ac[0] : gs == 1 ? ac[1] : gs == 2 ? ac[2] : ac[3];
            const float r1 = rr == 0 ? sg[0] : rr == 1 ? sg[1] : rr == 2 ? sg[2] : sg[3];
            const int xb_ = 16 * gs + 4 * lq + rr;
            const float gte = __shfl(gtv, xb_), sue = __shfl(suv, xb_), sve = __shfl(svv, xb_);
            const float d = r1 * sue * xsc;
            const float act = 0.5f * d * (1.0f + erff(d * 0.70710678118654752f)) * gte * sve;
            actL[64 * bt + xb_] = act;
        }
#else
        for (int bt = 0; bt < 2; ++bt) {
            const int idv = bt ? id1 : id0; const float gtv = bt ? gt1 : gt0, suv = bt ? su1 : su0, svv = bt ? sv1 : sv0;
            v4u uw[32];
#pragma unroll
            for (int p = 0; p < 32; ++p) { const int ea = __builtin_amdgcn_readlane(idv, 2 * p), eb = __builtin_amdgcn_readlane(idv, 2 * p + 1); const int e = half ? eb : ea;
                uw[p] = ((const GAS v4u*)(UT + (size_t)e * 512))[j32]; }
            float pd[32];
#pragma unroll
            for (int p = 0; p < 32; ++p) { float sa = 0.f, sb = 0.f;
#pragma unroll
                for (int w = 0; w < 4; ++w) { const unsigned ww = uw[p][w];
                    sa = __builtin_amdgcn_fdot2_f32_bf16(__builtin_amdgcn_cvt_scalef32_pk_bf16_fp4(ww, 1.0f, 0), xv[4 * w], sa, false); sb = __builtin_amdgcn_fdot2_f32_bf16(__builtin_amdgcn_cvt_scalef32_pk_bf16_fp4(ww, 1.0f, 1), xv[4 * w + 1], sb, false);
                    sa = __builtin_amdgcn_fdot2_f32_bf16(__builtin_amdgcn_cvt_scalef32_pk_bf16_fp4(ww, 1.0f, 2), xv[4 * w + 2], sa, false); sb = __builtin_amdgcn_fdot2_f32_bf16(__builtin_amdgcn_cvt_scalef32_pk_bf16_fp4(ww, 1.0f, 3), xv[4 * w + 3], sb, false); }
                pd[p] = sa + sb; }
            float r16[16], r8[8], r4[4], r2[2], r1;
            { const bool up = (lane & 16) != 0;
#pragma unroll
              for (int p = 0; p < 16; ++p) { const float keep = up ? pd[p + 16] : pd[p], send = up ? pd[p] : pd[p + 16]; r16[p] = keep + __shfl_xor(send, 16); } }
            { const bool up = (lane & 8) != 0;
#pragma unroll
              for (int p = 0; p < 8; ++p) { const float keep = up ? r16[p + 8] : r16[p], send = up ? r16[p] : r16[p + 8]; r8[p] = keep + __shfl_xor(send, 8); } }
            { const bool up = (lane & 4) != 0;
#pragma unroll
              for (int p = 0; p < 4; ++p) { const float keep = up ? r8[p + 4] : r8[p], send = up ? r8[p] : r8[p + 4]; r4[p] = keep + __shfl_xor(send, 4); } }
            { const bool up = (lane & 2) != 0;
#pragma unroll
              for (int p = 0; p < 2; ++p) { const float keep = up ? r4[p + 2] : r4[p], send = up ? r4[p] : r4[p + 2]; r2[p] = keep + __shfl_xor(send, 2); } }
            { const bool up = (lane & 1) != 0; const float keep = up ? r2[1] : r2[0], send = up ? r2[0] : r2[1]; r1 = keep + __shfl_xor(send, 1); }
            const int xb = 2 * (16 * ((lane >> 4) & 1) + 8 * ((lane >> 3) & 1) + 4 * ((lane >> 2) & 1) + 2 * ((lane >> 1) & 1) + (lane & 1)) + half;
            const float gte = __shfl(gtv, xb), sue = __shfl(suv, xb), sve = __shfl(svv, xb);
            const float d = r1 * sue;
            const float act = 0.5f * d * (1.0f + erff(d * 0.70710678118654752f)) * gte * sve;
            actL[64 * bt + xb] = act;
        }
#endif
        v4u hw2[4];
#pragma unroll
        for (int q = 0; q < 4; ++q) hw2[q] = hin[q];
        f32x2 acc[16];
#pragma unroll
        for (int e = 0; e < 16; ++e) acc[e] = (f32x2){0.f, 0.f};
        for (int bt = 0; bt < 2; ++bt) {
            const int idv = bt ? id1 : id0;
            v4u vw[32];
#pragma unroll
            for (int p = 0; p < 32; ++p) { const int ea = __builtin_amdgcn_readlane(idv, 2 * p), eb = __builtin_amdgcn_readlane(idv, 2 * p + 1); const int e = half ? eb : ea;
                vw[p] = ((const GAS v4u*)(VT + (size_t)e * 512))[j32]; }
            const LAS float* ap = actL + 64 * bt + half;
#pragma unroll
            for (int p = 0; p < 32; ++p) { const float w1 = ap[2 * p]; const f32x2 w2 = (f32x2){w1, w1};
#pragma unroll
                for (int w = 0; w < 4; ++w) { const unsigned ww = vw[p][w];
                    acc[4 * w] += w2 * FP4_CVT(ww, 0); acc[4 * w + 1] += w2 * FP4_CVT(ww, 1); acc[4 * w + 2] += w2 * FP4_CVT(ww, 2); acc[4 * w + 3] += w2 * FP4_CVT(ww, 3); } }
        }
        float s2 = 0.f; f32x4 hn[8];
#pragma unroll
        for (int q = 0; q < 8; ++q) { const v4u w = hw2[q >> 1]; const f32x4 hv = (q & 1) ? (f32x4){bflo(w.z), bfhi(w.z), bflo(w.w), bfhi(w.w)} : (f32x4){bflo(w.x), bfhi(w.x), bflo(w.y), bfhi(w.y)};
            const float a0 = acc[2 * q].x + __shfl_xor(acc[2 * q].x, 32), a1 = acc[2 * q].y + __shfl_xor(acc[2 * q].y, 32), a2 = acc[2 * q + 1].x + __shfl_xor(acc[2 * q + 1].x, 32), a3 = acc[2 * q + 1].y + __shfl_xor(acc[2 * q + 1].y, 32);
            hn[q] = (f32x4){hv[0] + a0, hv[1] + a1, hv[2] + a2, hv[3] + a3};
            s2 += (hn[q][0] * hn[q][0] + hn[q][1] * hn[q][1]) + (hn[q][2] * hn[q][2] + hn[q][3] * hn[q][3]); }
        s2 = wave_sum(s2) * 0.5f;
        const float rs = __builtin_amdgcn_rsqf(s2 * (1.0f / DMODEL) + EPS);
        if (FINAL) {
            const f32x4* g4 = (const f32x4*)gfin + 8 * j32; f32x4* hrow = (f32x4*)(Hout + (size_t)t * DMODEL) + 8 * j32;
            if (half == 0) {
#pragma unroll
                for (int q = 0; q < 8; ++q) { const f32x4 g = g4[q]; hrow[q] = (f32x4){hn[q][0] * rs * g[0], hn[q][1] * rs * g[1], hn[q][2] * rs * g[2], hn[q][3] * rs * g[3]}; } }
        } else {
            if (half == 0) {
                GAS v4u* hbp = (GAS v4u*)(HB + (size_t)t * DMODEL) + 4 * j32;
#pragma unroll
                for (int q = 0; q < 4; ++q) hbp[q] = (v4u){pk2(hn[2 * q][0], hn[2 * q][1]), pk2(hn[2 * q][2], hn[2 * q][3]), pk2(hn[2 * q + 1][0], hn[2 * q + 1][1]), pk2(hn[2 * q + 1][2], hn[2 * q + 1][3])}; }
            if (lane < 16) RP[(size_t)t * 16 + lane] = (lane == 0) ? s2 : 0.f;
            float pf[16];
#pragma unroll
            for (int c = 0; c < 16; ++c) { float a = 0.f;
#pragma unroll
                for (int q = 0; q < 8; ++q) { const f32x4 wv = *(const LAS f32x4*)(wfl + c * 1024 + j32 * 32 + ((q ^ (j32 & 7)) << 2)); a += (hn[q][0] * wv[0] + hn[q][1] * wv[1]) + (hn[q][2] * wv[2] + hn[q][3] * wv[3]); }
                pf[c] = a; __builtin_amdgcn_sched_barrier(0); }
            float f8[8], f4[4], f2[2], f1;
            { const bool up = (lane & 16) != 0;
#pragma unroll
              for (int p = 0; p < 8; ++p) { const float keep = up ? pf[p + 8] : pf[p], send = up ? pf[p] : pf[p + 8]; f8[p] = keep + __shfl_xor(send, 16); } }
            { const bool up = (lane & 8) != 0;
#pragma unroll
              for (int p = 0; p < 4; ++p) { const float keep = up ? f8[p + 4] : f8[p], send = up ? f8[p] : f8[p + 4]; f4[p] = keep + __shfl_xor(send, 8); } }
            { const bool up = (lane & 4) != 0;
#pragma unroll
              for (int p = 0; p < 2; ++p) { const float keep = up ? f4[p + 2] : f4[p], send = up ? f4[p] : f4[p + 2]; f2[p] = keep + __shfl_xor(send, 4); } }
            { const bool up = (lane & 2) != 0; const float keep = up ? f2[1] : f2[0], send = up ? f2[0] : f2[1]; f1 = keep + __shfl_xor(send, 2); }
            f1 += __shfl_xor(f1, 1);
            if ((lane & 33) == 0) ((float*)(F.ws + WS_FL))[(size_t)t * 16 + 8 * ((lane >> 4) & 1) + 4 * ((lane >> 3) & 1) + 2 * ((lane >> 2) & 1) + ((lane >> 1) & 1)] = f1 * rs;
        }
        kcur = knext;
    }
}

#undef ROW_DMA
__device__ __forceinline__ void p7_forget_logits(Frame& F) {
    const int rows0 = F.vcu * 64;
    for (int r0 = rows0; r0 < T_TOK; r0 += F.G * 64) {
        const f32x4 a = skinny16((const bf16*)(F.ws + WS_HB) + (size_t)r0 * DMODEL, (const bf16*)(F.ws + WS_WFL), F.wave, F.lane, (LAS float*)F.lds);
        if (F.wave < 4) {
            f32x4 o4;
#pragma unroll
            for (int r = 0; r < 4; ++r) { const int row = r0 + 16 * F.wave + 4 * (F.lane >> 4) + r; o4[r] = a[r] * pg8::row_rstd((const float*)(F.ws + WS_RP), row); }
            { const int row = r0 + 16 * F.wave + 4 * (F.lane >> 4); *(f32x4*)((float*)(F.ws + WS_FL) + ((size_t)((row >> 11) * 16 + (F.lane & 15)) * SEQ + (row & (SEQ - 1)))) = o4; } }
        __syncthreads(); }
}
template <class Sched> __device__ __forceinline__ void rstd_table(Frame& F, const Sched& S, LAS float* tab, int& pm0, int& pm1) {
    pm0 = -1; pm1 = -1;
#pragma unroll
    for (int i = 0; i < 3; ++i) { pg8::Unit u; if (S.next(i, u)) { if (i == 0) pm0 = u.pm; if (i == 1) pm1 = u.pm;
        if (F.tid < 256) tab[i * 256 + F.tid] = pg8::row_rstd((const float*)(F.ws + WS_RP), u.pm * 256 + F.tid); } }
    __syncthreads();
}
__device__ __forceinline__ void p9_key_bias(Frame& F, int bh, LAS float* cbL, LAS float* scr  ) {
    const int b = bh >> 4, hd = bh & 15, tid = F.tid;
    const float* FL = (const float*)(F.ws + WS_FL) + (size_t)(b * 16 + hd) * SEQ; const float bf = F.in[IN_FOX_B_F][hd];
    float v[4];
    { const f32x4 f4 = *(const f32x4*)(FL + 4 * tid);
#pragma unroll
      for (int e = 0; e < 4; ++e) v[e] = log_sigmoid(f4[e] + bf); }
    v[1] += v[0]; v[2] += v[1]; v[3] += v[2];
    float inc = v[3];
#pragma unroll
    for (int o = 1; o < 64; o <<= 1) { const float y = __shfl_up(inc, o); if (F.lane >= o) inc += y; }
    if (F.lane == 63) scr[F.wave] = inc;
    __syncthreads();
    float woff = 0.f;
#pragma unroll
    for (int w = 0; w < 8; ++w) { const float sv = scr[w]; if (w < F.wave) woff += sv; }
    const float excl = woff + inc - v[3];
    *(LAS f32x4*)(cbL + 4 * tid) = (f32x4){-L2E * (excl + v[0]), -L2E * (excl + v[1]), -L2E * (excl + v[2]), -L2E * (excl + v[3])};
    __syncthreads();
}
__device__ __forceinline__ float u2f_(unsigned u) { return __builtin_bit_cast(float, u); }
#ifndef VCH
#define VCH 16
#endif
#ifndef REF_V
#define REF_V 0
#endif
#ifndef REF_U
#define REF_U 0
#endif
#ifndef NSLICE_LOG
#define NSLICE_LOG 2
#endif
template <bool FINAL, int STAGE>
__device__ __forceinline__ void peer_gather_sl(Frame& F, int layer, const bf16* HBin, float* Hout, bf16* HB, float* RP) {
    constexpr int NSL = 1 << NSLICE_LOG;
    const int lane = F.lane;
    const unsigned char* UT = F.ws + WS_TAB + (size_t)(2 * layer) * PEER_NEXP * 512; const unsigned char* VT = UT + (size_t)PEER_NEXP * 512;
    const float* USC = (const float*)(F.ws + WS_TSC) + (size_t)(2 * layer) * PEER_NEXP; const float* VSC = USC + PEER_NEXP;
    const float* gf = F.in[IN_NORM_FFN] + layer * DMODEL; const float* gfin = F.in[IN_NORM_FINAL];
    LAS unsigned short* rowL = (LAS unsigned short*)(F.lds + F.wave * 8192);
    LAS v2u* metaL = (LAS v2u*)(F.lds + F.wave * 8192 + 4096);
    LAS int* idsL = (LAS int*)(F.lds + 65536 + F.wave * 1024); LAS float* gatesL = (LAS float*)(F.lds + 65536 + F.wave * 1024 + 512);
    LAS unsigned char* xqL = (LAS unsigned char*)(F.lds + 73728 + F.wave * 2048);
    LAS unsigned char* accL = (LAS unsigned char*)(F.lds + 90112 + F.wave * 8192);
    const bf16* SC = (const bf16*)(F.ws + WS_SC);
    const unsigned rowA = (unsigned)(uintptr_t)F.lds + F.wave * 8192;
#define ROW_DMA(tt, ln_) do { const char* r_ = (const char*)(SC + (size_t)__builtin_amdgcn_readfirstlane(tt) * 2048); _Pragma("unroll") for (int i_ = 0; i_ < 4; ++i_) glds16s(r_, (unsigned)((ln_) * 16 + i_ * 1024), (unsigned)__builtin_amdgcn_readfirstlane(rowA + i_ * 1024)); } while (0)
    gu32* tctr = F.ctl + 2048 + 64 * ((STAGE == 1 ? 16 : 0) + 8 * layer + ((int)blockIdx.x & 7)); const int tg = (int)blockIdx.x & 7;
    v2u* const metaG = (v2u*)(F.ws + WS_IDS);
#define TOK_(kq_, i_) (2048 * tg + 4 * (kq_) + (i_))
    int kq = 0;
    if (lane == 0) kq = (int)__hip_atomic_fetch_add(tctr, 1u, __ATOMIC_RELAXED, __HIP_MEMORY_SCOPE_AGENT);
    kq = __builtin_amdgcn_readfirstlane(kq);
    if (STAGE != 1) { if (kq < T_TOK / 32) ROW_DMA(TOK_(kq, 0), lane); }
    while (kq < T_TOK / 32) {
        int kqn = 0;
        LAS unsigned* rstL = (LAS unsigned*)(F.lds + MISC_OFF + 256 + F.wave * 64);
        if (STAGE != 1) {
        { int l64 = lane; asm volatile("" : "+v"(l64));
          unsigned zz = 0u; asm volatile("" : "+v"(zz));
          v4u hw0[4], hw1[4];
#pragma unroll
          for (int i = 0; i < 4; ++i) { const GAS v4u* hin = (const GAS v4u*)(HBin + (size_t)(TOK_(kq, i)) * DMODEL) + 2 * l64; hw0[i] = hin[0]; hw1[i] = hin[1]; }
          const f32x4* g4 = (const f32x4*)gf + 4 * l64;
          f32x4 gq[4];
#pragma unroll
          for (int q = 0; q < 4; ++q) gq[q] = g4[q];
#pragma unroll
          for (int i = 0; i < 4; ++i) { float hv[16];
#pragma unroll
              for (int k = 0; k < 4; ++k) { hv[2 * k] = bflo(hw0[i][k]); hv[2 * k + 1] = bfhi(hw0[i][k]); hv[8 + 2 * k] = bflo(hw1[i][k]); hv[8 + 2 * k + 1] = bfhi(hw1[i][k]); }
              float ss = 0.f;
#pragma unroll
              for (int e = 0; e < 16; ++e) ss += hv[e] * hv[e];
              const float rstd = __builtin_amdgcn_rsqf(wave_sum(ss) * (1.0f / DMODEL) + EPS);
              float mx = 0.f;
#pragma unroll
              for (int q = 0; q < 4; ++q) {
#pragma unroll
                  for (int e = 0; e < 4; ++e) { hv[4 * q + e] = hv[4 * q + e] * rstd * gq[q][e]; mx = fmaxf(mx, fabsf(hv[4 * q + e])); } }
              mx = wave_max(mx);
              const float enc = (mx > 0.f) ? 6.0f * __builtin_amdgcn_rcpf(mx) : 1.0f; const float xsc = (mx > 0.f) ? mx * (1.0f / 6.0f) : 1.0f;
              unsigned w0 = 0, w1 = 0;
              w0 = __builtin_amdgcn_cvt_scalef32_pk_fp4_f32(w0, hv[0] * enc, hv[1] * enc, 1.0f, 0); w0 = __builtin_amdgcn_cvt_scalef32_pk_fp4_f32(w0, hv[2] * enc, hv[3] * enc, 1.0f, 1);
              w0 = __builtin_amdgcn_cvt_scalef32_pk_fp4_f32(w0, hv[4] * enc, hv[5] * enc, 1.0f, 2); w0 = __builtin_amdgcn_cvt_scalef32_pk_fp4_f32(w0, hv[6] * enc, hv[7] * enc, 1.0f, 3);
              w1 = __builtin_amdgcn_cvt_scalef32_pk_fp4_f32(w1, hv[8] * enc, hv[9] * enc, 1.0f, 0); w1 = __builtin_amdgcn_cvt_scalef32_pk_fp4_f32(w1, hv[10] * enc, hv[11] * enc, 1.0f, 1);
              w1 = __builtin_amdgcn_cvt_scalef32_pk_fp4_f32(w1, hv[12] * enc, hv[13] * enc, 1.0f, 2); w1 = __builtin_amdgcn_cvt_scalef32_pk_fp4_f32(w1, hv[14] * enc, hv[15] * enc, 1.0f, 3);
              *(LAS v2u*)(xqL + i * 512 + l64 * 8) = (v2u){w0, w1};
              if (l64 == 0) rstL[i] = __builtin_bit_cast(unsigned, xsc);
              { LAS v4u* st = (LAS v4u*)(accL + i * 2048 + l64 * 32); st[0] = (v4u){zz, zz, zz, zz}; st[1] = (v4u){zz, zz, zz, zz}; } } }
#pragma nounroll
        for (int i = 0; i < 4; ++i) {
            const int t = TOK_(kq, i);
            int ln = lane; asm volatile("" : "+v"(ln));
            asm volatile("s_waitcnt vmcnt(0)" ::: "memory");
            if (i == 3) { if (ln == 0) kqn = (int)__hip_atomic_fetch_add(tctr, 1u, __ATOMIC_RELAXED, __HIP_MEMORY_SCOPE_AGENT); }
            p5_wave(ln, rowL, idsL, gatesL);
            asm volatile("s_waitcnt lgkmcnt(0)" ::: "memory");
            if (i < 3) ROW_DMA(t + 1, ln);
            else { kqn = __builtin_amdgcn_readfirstlane(kqn); if (kqn < T_TOK / 32) ROW_DMA(TOK_(kqn, 0), ln); }
            const int id0 = idsL[ln], id1 = idsL[64 + ln];
            const float gt0 = gatesL[ln], gt1 = gatesL[64 + ln];
            const float su0 = USC[id0], su1 = USC[id1], sv0 = VSC[id0], sv1 = VSC[id1];
            { const int k0 = id0 >> (14 - NSLICE_LOG), k1 = id1 >> (14 - NSLICE_LOG);
              int pos0 = 0, pos1 = 0, base = 0; unsigned offp = 0;
#pragma unroll
              for (int s = 0; s < NSL; ++s) {
                  const unsigned long long m0 = __ballot(k0 == s), m1 = __ballot(k1 == s);
                  const int c0 = __popcll(m0), c1 = __popcll(m1);
                  const int r0 = (int)__builtin_amdgcn_mbcnt_hi((unsigned)(m0 >> 32), __builtin_amdgcn_mbcnt_lo((unsigned)m0, 0u));
                  const int r1 = (int)__builtin_amdgcn_mbcnt_hi((unsigned)(m1 >> 32), __builtin_amdgcn_mbcnt_lo((unsigned)m1, 0u));
                  if (k0 == s) pos0 = base + r0;
                  if (k1 == s) pos1 = base + c0 + r1;
                  base += c0 + c1;
                  if (s < NSL - 1) offp |= (unsigned)base << (8 * s); }
              if (ln == 0) rstL[4 + i] = offp;
              const unsigned sb0 = (__builtin_bit_cast(unsigned, su0) + 0x8000u) & 0xffff0000u, sb1 = (__builtin_bit_cast(unsigned, su1) + 0x8000u) & 0xffff0000u;
              metaL[i * 128 + pos0] = (v2u){sb0 | (unsigned)id0, __builtin_bit_cast(unsigned, gt0 * sv0)};
              metaL[i * 128 + pos1] = (v2u){sb1 | (unsigned)id1, __builtin_bit_cast(unsigned, gt1 * sv1)}; }
        }
#pragma nounroll
        for (int si = 0; si < 4 * NSL; ++si) {
            const int s = si >> 2, i = si & 3;
            int ln = lane; asm volatile("" : "+v"(ln)); const int l16 = ln & 15, lq = ln >> 4;
            int one_e8 = 0x7f7f7f7f; asm volatile("" : "+v"(one_e8));
            const unsigned o = (unsigned)__builtin_amdgcn_readfirstlane((int)rstL[4 + i]);
            const float xs = u2f_(__builtin_amdgcn_readfirstlane((int)rstL[i]));
            const int lo = s == 0 ? 0 : (int)((o >> (8 * (s - 1))) & 255u), hi = s == NSL - 1 ? 128 : (int)((o >> (8 * s)) & 255u);
            const int n = hi - lo;
            if (n <= 0) continue;
#if REF_U
            {
              const int t = TOK_(__builtin_amdgcn_readfirstlane(kq), i);
              const GAS v4u* hin = (const GAS v4u*)(HBin + (size_t)t * DMODEL) + 2 * ln;
              const v4u h0 = hin[0], h1 = hin[1]; float hv[16];
#pragma unroll
              for (int k = 0; k < 4; ++k) { hv[2 * k] = bflo(h0[k]); hv[2 * k + 1] = bfhi(h0[k]); hv[8 + 2 * k] = bflo(h1[k]); hv[8 + 2 * k + 1] = bfhi(h1[k]); }
              float ss = 0.f;
#pragma unroll
              for (int e = 0; e < 16; ++e) ss += hv[e] * hv[e];
              const float rstd = __builtin_amdgcn_rsqf(wave_sum(ss) * (1.0f / DMODEL) + EPS);
              const f32x4* g4 = (const f32x4*)gf + 4 * ln;
#pragma unroll
              for (int q = 0; q < 4; ++q) { const f32x4 g = g4[q];
#pragma unroll
                  for (int e = 0; e < 4; ++e) hv[4 * q + e] = hv[4 * q + e] * rstd * g[e]; }
              LAS v2u* mt = metaL + i * 128 + lo;
              for (int p = 0; p < n; ++p) { const v2u m = mt[p]; const unsigned e = m.x & 0xffffu;
                  const v2u uw = ((const GAS v2u*)(UT + (size_t)e * 512))[ln];
                  float ds = 0.f;
#pragma unroll
                  for (int w = 0; w < 2; ++w) { const unsigned ww = uw[w];
                      const f32x2 c0 = FP4_CVT(ww, 0), c1 = FP4_CVT(ww, 1), c2 = FP4_CVT(ww, 2), c3 = FP4_CVT(ww, 3);
                      ds += c0.x * hv[8 * w] + c0.y * hv[8 * w + 1] + c1.x * hv[8 * w + 2] + c1.y * hv[8 * w + 3] + c2.x * hv[8 * w + 4] + c2.y * hv[8 * w + 5] + c3.x * hv[8 * w + 6] + c3.y * hv[8 * w + 7]; }
                  ds = wave_sum(ds);
                  const float d = ds * u2f_(m.x & 0xffff0000u);
                  const float act = 0.5f * d * (1.0f + erff(d * 0.70710678118654752f)) * u2f_(m.y);
                  if (ln == 0) ((LAS unsigned*)(mt + p))[1] = __builtin_bit_cast(unsigned, act); } }
            (void)xs; (void)l16; (void)lq; (void)one_e8;
        }
#else
            v4u xb[8];
            { const LAS v4u* xbr = (const LAS v4u*)(xqL + i * 512) + lq;
#pragma unroll
              for (int kb = 0; kb < 8; ++kb) xb[kb] = xbr[4 * kb]; }
            LAS v2u* mt = metaL + i * 128 + lo;
            for (int g0 = 0; g0 < n; g0 += 64) {
                const int rem = n - g0;
                v4u uw[4][8];
#pragma unroll
                for (int g = 0; g < 4; ++g) if (16 * g < rem) { int p = g0 + 16 * g + l16; p = p < n ? p : n - 1; const unsigned e = mt[p].x & 0xffffu; const GAS v4u* rp = (const GAS v4u*)(UT + (size_t)e * 512) + lq;
#pragma unroll
                    for (int kb = 0; kb < 8; ++kb) uw[g][kb] = rp[4 * kb]; }
                __builtin_amdgcn_sched_barrier(0);
                f32x4 ac[4];
#pragma unroll
                for (int g = 0; g < 4; ++g) { f32x4 a = (f32x4){0.f, 0.f, 0.f, 0.f};
                    if (16 * g < rem) {
                        asm volatile("s_nop 4\n\t"
                            "v_mfma_scale_f32_16x16x128_f8f6f4 %0, %1, %9, %0, %17, %17 op_sel_hi:[0,0,0] cbsz:4 blgp:4\n\t"
                            "v_mfma_scale_f32_16x16x128_f8f6f4 %0, %2, %10, %0, %17, %17 op_sel_hi:[0,0,0] cbsz:4 blgp:4\n\t"
                            "v_mfma_scale_f32_16x16x128_f8f6f4 %0, %3, %11, %0, %17, %17 op_sel_hi:[0,0,0] cbsz:4 blgp:4\n\t"
                            "v_mfma_scale_f32_16x16x128_f8f6f4 %0, %4, %12, %0, %17, %17 op_sel_hi:[0,0,0] cbsz:4 blgp:4\n\t"
                            "v_mfma_scale_f32_16x16x128_f8f6f4 %0, %5, %13, %0, %17, %17 op_sel_hi:[0,0,0] cbsz:4 blgp:4\n\t"
                            "v_mfma_scale_f32_16x16x128_f8f6f4 %0, %6, %14, %0, %17, %17 op_sel_hi:[0,0,0] cbsz:4 blgp:4\n\t"
                            "v_mfma_scale_f32_16x16x128_f8f6f4 %0, %7, %15, %0, %17, %17 op_sel_hi:[0,0,0] cbsz:4 blgp:4\n\t"
                            "v_mfma_scale_f32_16x16x128_f8f6f4 %0, %8, %16, %0, %17, %17 op_sel_hi:[0,0,0] cbsz:4 blgp:4"
                            : "+v"(a)
                            : "v"(uw[g][0]), "v"(uw[g][1]), "v"(uw[g][2]), "v"(uw[g][3]), "v"(uw[g][4]), "v"(uw[g][5]), "v"(uw[g][6]), "v"(uw[g][7]),
                              "v"(xb[0]), "v"(xb[1]), "v"(xb[2]), "v"(xb[3]), "v"(xb[4]), "v"(xb[5]), "v"(xb[6]), "v"(xb[7]), "v"(one_e8)); }
                    ac[g] = a; }
                asm volatile("s_nop 15\n\ts_nop 7" : "+v"(ac[0]), "+v"(ac[1]), "+v"(ac[2]), "+v"(ac[3]));
                const int gs = (ln >> 2) & 3, rr = ln & 3;
                const f32x4 sg = gs == 0 ? ac[0] : gs == 1 ? ac[1] : gs == 2 ? ac[2] : ac[3];
                const float r1 = rr == 0 ? sg[0] : rr == 1 ? sg[1] : rr == 2 ? sg[2] : sg[3];
                const int pp = g0 + 16 * gs + 4 * lq + rr; const bool ok = pp < n; const int pc = ok ? pp : n - 1;
                const v2u m = mt[pc];
                const float d = r1 * u2f_(m.x & 0xffff0000u) * xs;
                const float act = 0.5f * d * (1.0f + erff(d * 0.70710678118654752f)) * u2f_(m.y);
                if (ok) ((LAS unsigned*)(mt + pc))[1] = __builtin_bit_cast(unsigned, act);
            }
        }
#endif
        }
        if (STAGE == 0) {
            int ln = lane; asm volatile("" : "+v"(ln));
            const int kqs = __builtin_amdgcn_readfirstlane(kq);
#pragma unroll
            for (int i = 0; i < 4; ++i) { const int t = TOK_(kqs, i); ((GAS v4u*)(metaG + (size_t)t * 128))[ln] = ((const LAS v4u*)(metaL + i * 128))[ln]; }
        }
        if (STAGE == 1) {
            int ln = lane; asm volatile("" : "+v"(ln));
            unsigned zz = 0u; asm volatile("" : "+v"(zz));
            if (ln == 0) kqn = (int)__hip_atomic_fetch_add(tctr, 1u, __ATOMIC_RELAXED, __HIP_MEMORY_SCOPE_AGENT);
            const int kqs = __builtin_amdgcn_readfirstlane(kq);
            v4u mb[4];
#pragma unroll
            for (int i = 0; i < 4; ++i) { const int t = TOK_(kqs, i); mb[i] = ((const GAS v4u*)(metaG + (size_t)t * 128))[ln]; }
#pragma unroll
            for (int i = 0; i < 4; ++i) { ((LAS v4u*)(metaL + i * 128))[ln] = mb[i]; LAS v4u* st = (LAS v4u*)(accL + i * 2048 + ln * 32); st[0] = (v4u){zz, zz, zz, zz}; st[1] = (v4u){zz, zz, zz, zz}; }
        }
        if (STAGE != 0) {
#pragma nounroll
        for (int si = 0; si < 4 * NSL; ++si) {
            const int s = si >> 2, i = si & 3;
            int l64 = lane; asm volatile("" : "+v"(l64));
            const unsigned o = (unsigned)__builtin_amdgcn_readfirstlane((int)rstL[4 + i]);
            const int lo = s == 0 ? 0 : (int)((o >> (8 * (s - 1))) & 255u), hi = s == NSL - 1 ? 128 : (int)((o >> (8 * s)) & 255u);
            const int n = hi - lo;
            if (n <= 0) continue;
            const LAS v2u* mt = metaL + i * 128 + lo;
            f32x2 acc[8];
#pragma unroll
            for (int e = 0; e < 8; ++e) acc[e] = (f32x2){0.f, 0.f};
#if REF_V
            for (int p = 0; p < n; ++p) { const v2u m = mt[p]; const unsigned e = m.x & 0xffffu; float w1 = u2f_(m.y); asm volatile("" : "+v"(w1)); const f32x2 w2 = (f32x2){w1, w1};
                const v2u vr = ((const GAS v2u*)(VT + (size_t)e * 512))[l64];
#pragma unroll
                for (int w = 0; w < 2; ++w) { const unsigned ww = vr[w];
                    acc[4 * w] += w2 * FP4_CVT(ww, 0); acc[4 * w + 1] += w2 * FP4_CVT(ww, 1); acc[4 * w + 2] += w2 * FP4_CVT(ww, 2); acc[4 * w + 3] += w2 * FP4_CVT(ww, 3); } }
#else
            for (int c0 = 0; c0 < n; c0 += VCH) {
                const int rem = n - c0;
                int pm = c0 + (l64 & (VCH - 1)); const bool okm = pm < n; pm = okm ? pm : n - 1; const v2u m = mt[pm];
                const int idv = (int)(m.x & 0xffffu); const int avb = okm ? (int)m.y : 0;
                v2u vw[VCH];
#pragma unroll
                for (int r = 0; r < VCH; ++r) if (r < rem) { const int e = __builtin_amdgcn_readlane(idv, r); vw[r] = ((const GAS v2u*)(VT + (size_t)e * 512))[l64]; }
#pragma unroll
                for (int r = 0; r < VCH; ++r) if (r < rem) { const float w1 = u2f_(__builtin_amdgcn_readlane(avb, r)); const f32x2 w2 = (f32x2){w1, w1};
#pragma unroll
                    for (int w = 0; w < 2; ++w) { const unsigned ww = vw[r][w];
                        acc[4 * w] += w2 * FP4_CVT(ww, 0); acc[4 * w + 1] += w2 * FP4_CVT(ww, 1); acc[4 * w + 2] += w2 * FP4_CVT(ww, 2); acc[4 * w + 3] += w2 * FP4_CVT(ww, 3); } }
            }
#endif
            LAS v4u* st = (LAS v4u*)(accL + i * 2048 + l64 * 32);
            const v4u s0 = st[0], s1 = st[1];
            st[0] = (v4u){cvtpk(bflo(s0.x) + acc[0].x, bfhi(s0.x) + acc[0].y), cvtpk(bflo(s0.y) + acc[1].x, bfhi(s0.y) + acc[1].y), cvtpk(bflo(s0.z) + acc[2].x, bfhi(s0.z) + acc[2].y), cvtpk(bflo(s0.w) + acc[3].x, bfhi(s0.w) + acc[3].y)};
            st[1] = (v4u){cvtpk(bflo(s1.x) + acc[4].x, bfhi(s1.x) + acc[4].y), cvtpk(bflo(s1.y) + acc[5].x, bfhi(s1.y) + acc[5].y), cvtpk(bflo(s1.z) + acc[6].x, bfhi(s1.z) + acc[6].y), cvtpk(bflo(s1.w) + acc[7].x, bfhi(s1.w) + acc[7].y)};
        }
        int kqe = __builtin_amdgcn_readfirstlane(kq); asm volatile("" : "+s"(kqe));
#pragma nounroll
        for (int i = 0; i < 4; ++i) {
            const int t = TOK_(kqe, i);
            int l64 = lane; asm volatile("" : "+v"(l64));
            const GAS v4u* hin = (const GAS v4u*)(HBin + (size_t)t * DMODEL) + 2 * l64;
            const v4u h0 = hin[0], h1 = hin[1];
            const LAS v4u* st = (const LAS v4u*)(accL + i * 2048 + l64 * 32);
            const v4u a0 = st[0], a1 = st[1];
            float hn[16]; float s2 = 0.f;
#pragma unroll
            for (int k = 0; k < 4; ++k) { hn[2 * k] = bflo(h0[k]) + bflo(a0[k]); hn[2 * k + 1] = bfhi(h0[k]) + bfhi(a0[k]); hn[8 + 2 * k] = bflo(h1[k]) + bflo(a1[k]); hn[8 + 2 * k + 1] = bfhi(h1[k]) + bfhi(a1[k]); }
#pragma unroll
            for (int e = 0; e < 16; ++e) s2 += hn[e] * hn[e];
            s2 = wave_sum(s2);
            if (FINAL) {
                const float rs = __builtin_amdgcn_rsqf(s2 * (1.0f / DMODEL) + EPS);
                const f32x4* g4 = (const f32x4*)gfin + 4 * l64; f32x4* hrow = (f32x4*)(Hout + (size_t)t * DMODEL) + 4 * l64;
#pragma unroll
                for (int q = 0; q < 4; ++q) { const f32x4 g = g4[q]; hrow[q] = (f32x4){hn[4 * q] * rs * g[0], hn[4 * q + 1] * rs * g[1], hn[4 * q + 2] * rs * g[2], hn[4 * q + 3] * rs * g[3]}; }
            } else {
                GAS v4u* hbp = (GAS v4u*)(HB + (size_t)t * DMODEL) + 2 * l64;
                hbp[0] = (v4u){cvtpk(hn[0], hn[1]), cvtpk(hn[2], hn[3]), cvtpk(hn[4], hn[5]), cvtpk(hn[6], hn[7])};
                hbp[1] = (v4u){cvtpk(hn[8], hn[9]), cvtpk(hn[10], hn[11]), cvtpk(hn[12], hn[13]), cvtpk(hn[14], hn[15])};
                if (l64 < 16) RP[(size_t)t * 16 + l64] = (l64 == 0) ? s2 : 0.f;
            }
        }
        }
        kq = __builtin_amdgcn_readfirstlane(kqn);
    }
}
#undef ROW_DMA
#undef TOK_
#ifndef TWO_STAGE
#define TWO_STAGE 1
#endif
constexpr int N_PHASES = 14;
#ifndef ATTN_THRL
#define ATTN_THRL 8
#endif
#ifndef PROBE_OTHERS
#define PROBE_OTHERS 1
#endif
#ifndef GROUP_BAR
#define GROUP_BAR 1
#endif
#ifndef MK_PER_PHASE
#define MK_PER_PHASE 0
#endif
struct Args { const float* in[18]; float* out; unsigned char* ws; int ph_lo, ph_hi, dry, li; };
__global__ void __launch_bounds__(NWAVES * 64, 2) yoco_fwd(Args args) {
    extern __shared__ __attribute__((aligned(16))) unsigned char lds[];
    Frame F;
    F.lds = (LAS unsigned char*)lds;
    F.MISC = (volatile LAS unsigned*)(F.lds + MISC_OFF);
    F.tid = threadIdx.x; F.lane = F.tid & 63; F.wave = __builtin_amdgcn_readfirstlane(F.tid >> 6);
    F.G = gridDim.x; { const int bx = blockIdx.x; F.vcu = (F.G % 8 == 0) ? (bx % 8) * (F.G / 8) + bx / 8 : bx; }
    F.ws = args.ws; F.ctl = (gu32*)(args.ws + WS_CTL); F.out = args.out;
#pragma unroll
    for (int i = 0; i < 18; ++i) F.in[i] = args.in[i];
    for (int u = F.tid; u < (LDS_BYTES - LDSCTL_OFF) / 4; u += NWAVES * 64) ((LAS unsigned*)(F.lds + LDSCTL_OFF))[u] = 0u;
    __syncthreads();
    XcdBarrier bar; bar.bar = (unsigned*)(F.ctl + CW_BAR) + args.li * XCD_BAR_WORDS; bar.x = 0; bar.st = nullptr;
    if (!MK_PER_PHASE) bar = xcd_barrier_post((unsigned*)(F.ctl + CW_BAR) + args.li * XCD_BAR_WORDS, F.MISC + 8);
    XcdBarrier gbar; gbar.bar = (unsigned*)(F.ctl + CW_GBAR) + ((int)blockIdx.x & 7) * 4096; gbar.x = 0; gbar.st = nullptr;
    if (!MK_PER_PHASE && GROUP_BAR) gbar = xcd_barrier_post((unsigned*)(F.ctl + CW_GBAR) + ((int)blockIdx.x & 7) * 4096, F.MISC + 10);
    const int lo = args.ph_lo, hi = args.ph_hi;
#define REID() do { int t_ = threadIdx.x; asm volatile("" : "+v"(t_)); F.tid = t_; F.lane = t_ & 63; F.wave = __builtin_amdgcn_readfirstlane(t_ >> 6); } while (0)
#ifndef PHASE_OFF
#define PHASE_OFF 0
#endif
#define IN(k) (lo <= (k) && (k) < hi && !((PHASE_OFF >> (k)) & 1))
#define SEAM(k) do { if (IN(k) && IN((k) + 1)) xcd_barrier(bar); } while (0)
#define SEAM2(k, k2) do { if (IN(k) && IN(k2)) xcd_barrier(bar); } while (0)
#define GSEAM(k) do { if (IN(k) && IN((k) + 1)) { if (GROUP_BAR && !MK_PER_PHASE) grp_barrier(gbar, gridDim.x / 8); else xcd_barrier(bar); } } while (0)
#define GSEAM2(k, k2) do { if (IN(k) && IN(k2)) { if (GROUP_BAR && !MK_PER_PHASE) grp_barrier(gbar, gridDim.x / 8); else xcd_barrier(bar); } } while (0)
#ifndef REPEAT_MASK
#define REPEAT_MASK 0
#endif
#define REP(k) ((REPEAT_MASK >> (k)) & 1)
#ifdef REP_WITH_BARRIER
#define REPBAR() xcd_barrier(bar)
#else
#define REPBAR() do {} while (0)
#endif
    float* const DUMF = (float*)(F.ws + WS_END); bf16* const DUMB = (bf16*)(F.ws + WS_END + 64 * MiB); float* const DUMR = (float*)(F.ws + WS_END + 96 * MiB);
    bf16* const A0 = (bf16*)(F.ws + WS_A0); bf16* const HB = (bf16*)(F.ws + WS_HB); bf16* const PQ = (bf16*)(F.ws + WS_PQ);
    float* const RP = (float*)(F.ws + WS_RP); float* const SC = (float*)(F.ws + WS_SC);

#ifndef NPASS
#define NPASS 1
#endif
    if (IN(0)) { REID(); if (REP(0)) { p0_prologue(F);  } p0_prologue(F); } SEAM(0);
    if (IN(1)) { REID(); if (REP(1)) { pg8::Gemm g{A0, (const bf16*)(F.ws + WS_WIN), T_TOK, 3072, DMODEL}; pg8::StaticOrder S; S.init(T_TOK, 3072, F.G, (int)blockIdx.x);
        pg8::EpiBf16RS E{PQ, 3072, 0, 0, 1.f, nullptr, -1, -1, F.in[IN_GLA_NORM_O], 2048};
        pg8::gemm_phase<pg8::EpiBf16RS, pg8::StaticOrder, true, true>(F.lds, g, S, E);  } if (REP(1)) REPBAR(); pg8::Gemm g{A0, (const bf16*)(F.ws + WS_WIN), T_TOK, 3072, DMODEL}; pg8::StaticOrder S; S.init(T_TOK, 3072, F.G, (int)blockIdx.x);
        pg8::EpiBf16RS E{PQ, 3072, 0, 0, 1.f, nullptr, -1, -1, F.in[IN_GLA_NORM_O], 2048};
        pg8::gemm_phase<pg8::EpiBf16RS, pg8::StaticOrder, true, true>(F.lds, g, S, E); } GSEAM(1);
    if (IN(2)) { REID(); if (REP(2)) { for (int c = blockIdx.x; c < NB * GLA_NCH; c += F.G) p2a_item(F, c >> 5, c & 31);  } for (int c = F.vcu; c < NB * GLA_NCH; c += F.G) p2a_item(F, c >> 5, c & 31); } GSEAM(2);
    if (IN(3)) { REID(); if (REP(3)) { if ((int)blockIdx.x < NB * GLA_H) p2b_seq(F, blockIdx.x, args.dry); else { late_weights(F, NB * GLA_H, F.G - NB * GLA_H); peer_tables_convert(F, NB * GLA_H * NWAVES, (F.G - NB * GLA_H) * NWAVES); }  } if ((int)blockIdx.x < NB * GLA_H) p2b_seq(F, ((int)blockIdx.x & 7) * 4 + ((int)blockIdx.x >> 3), args.dry); else { for (int rep_ = 0; rep_ < PROBE_OTHERS; ++rep_) { late_weights(F, NB * GLA_H, F.G - NB * GLA_H); peer_tables_convert(F, NB * GLA_H * NWAVES, (F.G - NB * GLA_H) * NWAVES); __syncthreads(); } } } SEAM(3);
    if (IN(4)) { REID(); if (REP(4)) { pg8::Gemm g{A0, (const bf16*)(F.ws + WS_WGO), T_TOK, DMODEL, DMODEL}; pg8::StaticOrder S; S.init(T_TOK, DMODEL, F.G, (int)blockIdx.x);
        pg8::EpiResid<false> E{F.in[IN_X], HB, RP, DMODEL};
        pg8::gemm_phase<pg8::EpiResid<false>, pg8::StaticOrder, false, true>(F.lds, g, S, E);  } pg8::Gemm g{A0, (const bf16*)(F.ws + WS_WGO), T_TOK, DMODEL, DMODEL}; pg8::StaticOrder S; S.init(T_TOK, DMODEL, F.G, (int)blockIdx.x);
        pg8::EpiResid<false> E{F.in[IN_X], HB, RP, DMODEL};
        pg8::gemm_phase<pg8::EpiResid<false>, pg8::StaticOrder, false, true>(F.lds, g, S, E); } GSEAM(4);
    if (IN(5)) { REID(); if (REP(5)) { pg8::Gemm g{HB, (const bf16*)(F.ws + WS_WEFF), T_TOK, 2048, DMODEL}; pg8::StaticOrder S; S.init(T_TOK, 2048, F.G, (int)blockIdx.x);
        int pm0, pm1; rstd_table(F, S, (LAS float*)(F.lds + 131072), pm0, pm1); pg8::EpiBf16RS E{(bf16*)SC, 2048, 0, 0, 1.f, (const LAS float*)(F.lds + 131072), pm0, pm1, nullptr, 0};
        pg8::gemm_phase<pg8::EpiBf16RS, pg8::StaticOrder, true, true>(F.lds, g, S, E);  } pg8::Gemm g{HB, (const bf16*)(F.ws + WS_WEFF), T_TOK, 2048, DMODEL}; pg8::StaticOrder S; S.init(T_TOK, 2048, F.G, (int)blockIdx.x);
        int pm0, pm1; rstd_table(F, S, (LAS float*)(F.lds + 131072), pm0, pm1); pg8::EpiBf16RS E{(bf16*)SC, 2048, 0, 0, 1.f, (const LAS float*)(F.lds + 131072), pm0, pm1, nullptr, 0};
        pg8::gemm_phase<pg8::EpiBf16RS, pg8::StaticOrder, true, true>(F.lds, g, S, E); } GSEAM2(5, 7);
    if (IN(7)) { REID(); if (TWO_STAGE) { peer_gather_sl<false, 0>(F, 0, HB, nullptr, HB, RP); xcd_barrier(bar); REID(); peer_gather_sl<false, 1>(F, 0, HB, nullptr, HB, RP); } else peer_gather_sl<false, 2>(F, 0, HB, nullptr, HB, RP); } GSEAM(7);
    if (IN(8)) { REID(); if (REP(8)) {
        pg8::Gemm g{HB, (const bf16*)(F.ws + WS_WQKV), T_TOK, 3072, DMODEL}; pg8::StaticOrder S; S.init(T_TOK, 3072, F.G, (int)blockIdx.x);
        int pm0, pm1; rstd_table(F, S, (LAS float*)(F.lds + 131072), pm0, pm1); pg8::EpiBf16RS E{PQ, DMODEL, DMODEL, (size_t)T_TOK * DMODEL, attn_body::C2, (const LAS float*)(F.lds + 131072), pm0, pm1, nullptr, 0};
        pg8::gemm_phase<pg8::EpiBf16RS, pg8::StaticOrder, true, true>(F.lds, g, S, E);  } if (REP(8)) REPBAR();
        p7_forget_logits(F);
        pg8::Gemm g{HB, (const bf16*)(F.ws + WS_WQKV), T_TOK, 3072, DMODEL}; pg8::StaticOrder S; S.init(T_TOK, 3072, F.G, (int)blockIdx.x);
        int pm0, pm1; rstd_table(F, S, (LAS float*)(F.lds + 131072), pm0, pm1); pg8::EpiBf16RS E{PQ, DMODEL, DMODEL, (size_t)T_TOK * DMODEL, attn_body::C2, (const LAS float*)(F.lds + 131072), pm0, pm1, nullptr, 0};
        pg8::gemm_phase<pg8::EpiBf16RS, pg8::StaticOrder, true, true>(F.lds, g, S, E); } GSEAM(8);
    if (IN(9)) { REID(); for (int rep = REP(9) ? 0 : 1; rep < 2; ++rep) {
        p9_key_bias(F, F.vcu >> 1, (LAS float*)(F.lds + attn_body::LDS_CB), (LAS float*)(F.lds + attn_body::LDS_TOTAL));
        const attn_body::AttnTensors AT{(const attn_body::bf16*)PQ, (const attn_body::bf16*)(PQ + (size_t)T_TOK * DMODEL), (const attn_body::bf16*)(PQ + 2 * (size_t)T_TOK * DMODEL), (attn_body::bf16*)((rep == 0 || args.dry) ? DUMB : PQ)};
        const attn_body::StaticOrder S((int)F.G, (int)blockIdx.x);
        attn_body::attn_phase<attn_body::StaticOrder, ATTN_THRL>((char*)lds, AT, S); } } GSEAM(9);
    if (IN(10)) { REID(); if (REP(10)) { pg8::Gemm g{PQ, (const bf16*)(F.ws + WS_WFO), T_TOK, DMODEL, DMODEL}; pg8::StaticOrder S; S.init(T_TOK, DMODEL, F.G, (int)blockIdx.x);
        pg8::EpiResid<false> E{DUMF, DUMB, DUMR, DMODEL};
        pg8::gemm_phase<pg8::EpiResid<false>, pg8::StaticOrder, false, true>(F.lds, g, S, E);  } pg8::Gemm g{PQ, (const bf16*)(F.ws + WS_WFO), T_TOK, DMODEL, DMODEL}; pg8::StaticOrder S; S.init(T_TOK, DMODEL, F.G, (int)blockIdx.x);
        pg8::EpiResid<true> E{nullptr, HB, RP, DMODEL};
        pg8::gemm_phase<pg8::EpiResid<true>, pg8::StaticOrder, false, true>(F.lds, g, S, E); } GSEAM(10);
    if (IN(11)) { REID(); if (REP(11)) { pg8::Gemm g{HB, (const bf16*)(F.ws + WS_WEFF) + (size_t)2048 * DMODEL, T_TOK, 2048, DMODEL}; pg8::StaticOrder S; S.init(T_TOK, 2048, F.G, (int)blockIdx.x);
        int pm0, pm1; rstd_table(F, S, (LAS float*)(F.lds + 131072), pm0, pm1); pg8::EpiBf16RS E{(bf16*)SC, 2048, 0, 0, 1.f, (const LAS float*)(F.lds + 131072), pm0, pm1, nullptr, 0};
        pg8::gemm_phase<pg8::EpiBf16RS, pg8::StaticOrder, true, true>(F.lds, g, S, E);  } pg8::Gemm g{HB, (const bf16*)(F.ws + WS_WEFF) + (size_t)2048 * DMODEL, T_TOK, 2048, DMODEL}; pg8::StaticOrder S; S.init(T_TOK, 2048, F.G, (int)blockIdx.x);
        int pm0, pm1; rstd_table(F, S, (LAS float*)(F.lds + 131072), pm0, pm1); pg8::EpiBf16RS E{(bf16*)SC, 2048, 0, 0, 1.f, (const LAS float*)(F.lds + 131072), pm0, pm1, nullptr, 0};
        pg8::gemm_phase<pg8::EpiBf16RS, pg8::StaticOrder, true, true>(F.lds, g, S, E); } GSEAM2(11, 13);
    if (IN(13)) { REID(); if (TWO_STAGE) { peer_gather_sl<true, 0>(F, 1, HB, F.out, nullptr, nullptr); xcd_barrier(bar); REID(); peer_gather_sl<true, 1>(F, 1, HB, F.out, nullptr, nullptr); } else peer_gather_sl<true, 2>(F, 1, HB, F.out, nullptr, nullptr); }
#undef IN
#undef SEAM
}

extern "C" void kernel_launch(void* const* d_in, const int* in_sizes, int n_in, void* d_out, int out_size, void* d_ws, size_t ws_size, hipStream_t stream) {
    static int grid = 0;
    if (grid == 0) {
        if (n_in != 18 || in_sizes[0] != T_TOK * DMODEL || out_size != T_TOK * DMODEL || ws_size < WS_END + ((REPEAT_MASK || MK_PER_PHASE) ? 97 * MiB : 0)) { fprintf(stderr, "kernel_launch: unexpected shapes (n_in %d, in0 %d, out %d, ws %zu); nothing launched\n", n_in, n_in > 0 ? in_sizes[0] : -1, out_size, ws_size); grid = -1; return; }
        int dev = 0, cus = 0;
        if (hipGetDevice(&dev) != hipSuccess || hipDeviceGetAttribute(&cus, hipDeviceAttributeMultiprocessorCount, dev) != hipSuccess) { grid = -1; return; }
        if (hipFuncSetAttribute((const void*)yoco_fwd, hipFuncAttributeMaxDynamicSharedMemorySize, LDS_BYTES) != hipSuccess) { fprintf(stderr, "kernel_launch: hipFuncSetAttribute failed\n"); grid = -1; return; }
        (void)hipGetLastError();
        grid = cus;
        if (grid != 256) { fprintf(stderr, "kernel_launch: built for a 256-CU device, found %d; nothing launched\n", cus); grid = -1; return; }
    }
    if (grid < 0) return;
    if (hipMemsetAsync((char*)d_ws + WS_CTL, 0, CTL_ZERO_BYTES, stream) != hipSuccess) return;
    Args a{};
    for (int i = 0; i < 18; ++i) a.in[i] = (const float*)d_in[i];
    a.out = (float*)d_out; a.ws = (unsigned char*)d_ws;
#if MK_PER_PHASE
    for (int p = 0; p < N_PHASES; ++p) { a.ph_lo = p; a.ph_hi = p + 1;
#ifdef DUP_PHASE
        if (p == DUP_PHASE) hipLaunchKernelGGL(yoco_fwd, dim3(grid), dim3(NWAVES * 64), LDS_BYTES, stream, a);
#endif
#ifdef DRY_PHASE
        if (p == DRY_PHASE) { a.dry = 1; hipLaunchKernelGGL(yoco_fwd, dim3(grid), dim3(NWAVES * 64), LDS_BYTES, stream, a); a.dry = 0; }
#endif
        hipLaunchKernelGGL(yoco_fwd, dim3(grid), dim3(NWAVES * 64), LDS_BYTES, stream, a); }
#else
    a.ph_lo = 0; a.ph_hi = N_PHASES;
    for (int li = 0; li < NPASS; ++li) { a.li = li; hipLaunchKernelGGL(yoco_fwd, dim3(grid), dim3(NWAVES * 64), LDS_BYTES, stream, a); }
#endif
}
```
